# Optimizing an MI355X kernel written in HIP

```python
import jax, jax.numpy as jnp
from jax import lax
import numpy as np

D_MODEL = 1024
BATCH = 8
SEQ = 2048
DEPTH = 2
DEC_BATCH = 128
DEC_SEQ = 8
PAST_LEN = 16384
PAGE_SIZE = 128

N_A_LAYERS = DEPTH // 2
N_B_LAYERS = DEPTH - N_A_LAYERS
D_RNN = D_MODEL
RG_BLOCKS = 8
RG_BLOCK_W = D_RNN // RG_BLOCKS
CONV_W = 4
RG_C = 8.0
HEAD_DIM = 64
N_HEADS = D_MODEL // HEAD_DIM
N_KV_HEADS = 4
GROUP = N_HEADS // N_KV_HEADS
WINDOW = 128
ROPE_THETA = 10000.0
N_KEYS = 128
N_EXPERTS = N_KEYS * N_KEYS
PEER_HEADS = 8
PEER_TOPK = 16
D_KEY = 256
PEER_CHUNK = 128
EPS = 1e-6

kernel_name = 'yoco_rglru_swa_sink_peer_step'


def rmsnorm(x, g):
    xf = x.astype(jnp.float32)
    y = xf * lax.rsqrt(jnp.mean(xf * xf, axis=-1, keepdims=True) + EPS)
    return (y * g.astype(jnp.float32)).astype(x.dtype)


def rope(x, pos):
    half = HEAD_DIM // 2
    inv = ROPE_THETA ** (-jnp.arange(half, dtype=jnp.float32) / half)
    ang = pos.astype(jnp.float32)[:, None] * inv[None, :]
    cos = jnp.cos(ang)[:, None, :]
    sin = jnp.sin(ang)[:, None, :]
    xf = x.astype(jnp.float32)
    x1, x2 = xf[..., :half], xf[..., half:]
    return jnp.concatenate([x1 * cos - x2 * sin, x2 * cos + x1 * sin], axis=-1).astype(x.dtype)


def causal_conv(x, buf, w, b):
    xp = jnp.concatenate([buf.astype(x.dtype), x], axis=1)
    t = x.shape[1]
    y = b
    for k in range(CONV_W):
        y = y + w[k] * xp[:, k:k + t]
    return y, xp[:, -(CONV_W - 1):]


def block_diag(x, w, b):
    xb = x.reshape(x.shape[:-1] + (RG_BLOCKS, RG_BLOCK_W))
    return jnp.einsum('btnc,ncd->btnd', xb, w).reshape(x.shape) + b


def rg_lru(x, h0, wa, ba, wx, bx, lam):
    f32 = jnp.float32
    r = jax.nn.sigmoid(block_diag(x, wa, ba).astype(f32))
    i = jax.nn.sigmoid(block_diag(x, wx, bx).astype(f32))
    log_a = -RG_C * r * jax.nn.softplus(-lam.astype(f32))
    a = jnp.exp(log_a)
    mult = jnp.sqrt(-jnp.expm1(2.0 * log_a))
    bterm = mult * i * x.astype(f32)
    bterm = bterm.at[:, 0].add(a[:, 0] * h0.astype(f32))

    def comb(lhs, rhs):
        a1, b1 = lhs
        a2, b2 = rhs
        return a1 * a2, a2 * b1 + b2

    _, h = lax.associative_scan(comb, (a, bterm), axis=1)
    return h.astype(x.dtype), h[:, -1].astype(x.dtype)


def recurrent_block(xn, conv_buf, h0, w_in, conv_w, conv_b, wa, ba, wx, bx, lam, w_out):
    proj = xn @ w_in
    gate = jax.nn.gelu(proj[..., :D_RNN], approximate=True)
    xc, new_buf = causal_conv(proj[..., D_RNN:], conv_buf, conv_w, conv_b)
    h, h_last = rg_lru(xc, h0, wa, ba, wx, bx, lam)
    return (h * gate) @ w_out, new_buf, h_last


def sink_softmax(s, mask, sink):
    s = jnp.where(mask, s, -jnp.inf)
    m = jnp.maximum(jnp.max(s, axis=-1, keepdims=True), sink)
    p = jnp.exp(s - m)
    return p / (jnp.sum(p, axis=-1, keepdims=True) + jnp.exp(sink - m))


def swa_prompt(q, k, v, sinks):
    b, t = q.shape[:2]
    c = WINDOW
    nb = t // c
    scale = HEAD_DIM ** -0.5
    qb = q.reshape(b, nb, c, N_KV_HEADS, GROUP, HEAD_DIM)
    pad = jnp.zeros((b, c, N_KV_HEADS, HEAD_DIM), k.dtype)
    kblk = jnp.concatenate([pad, k], axis=1).reshape(b, nb + 1, c, N_KV_HEADS, HEAD_DIM)
    vblk = jnp.concatenate([pad, v], axis=1).reshape(b, nb + 1, c, N_KV_HEADS, HEAD_DIM)
    kb = jnp.concatenate([kblk[:, :-1], kblk[:, 1:]], axis=2)
    vb = jnp.concatenate([vblk[:, :-1], vblk[:, 1:]], axis=2)
    blk = jnp.arange(nb)[:, None, None]
    qpos = blk * c + jnp.arange(c)[None, :, None]
    kpos = (blk - 1) * c + jnp.arange(2 * c)[None, None, :]
    mask = (kpos >= 0) & (kpos <= qpos) & (qpos - kpos < WINDOW)
    s = jnp.einsum('bnqkgd,bnskd->bnkgqs', qb, kb).astype(jnp.float32) * scale
    sink = sinks.astype(jnp.float32).reshape(N_KV_HEADS, GROUP, 1, 1)
    p = sink_softmax(s, mask[None, :, None, None], sink)
    o = jnp.einsum('bnkgqs,bnskd->bnqkgd', p.astype(v.dtype), vb)
    return o.reshape(b, t, N_HEADS * HEAD_DIM)


def swa_sample(q, kall, vall, qpos, kpos, sinks):
    b, nq = q.shape[:2]
    scale = HEAD_DIM ** -0.5
    qg = q.reshape(b, nq, N_KV_HEADS, GROUP, HEAD_DIM)
    mask = (kpos[None, :] <= qpos[:, None]) & (qpos[:, None] - kpos[None, :] < WINDOW)
    s = jnp.einsum('bqkgd,bskd->bkgqs', qg, kall).astype(jnp.float32) * scale
    sink = sinks.astype(jnp.float32).reshape(N_KV_HEADS, GROUP, 1, 1)
    p = sink_softmax(s, mask, sink)
    o = jnp.einsum('bkgqs,bskd->bqkgd', p.astype(vall.dtype), vall)
    return o.reshape(b, nq, N_HEADS * HEAD_DIM)


def peer(xn, wq, subkeys, u, v):
    shp = xn.shape
    xt = xn.reshape(-1, D_MODEL)
    t = xt.shape[0]
    q = (xt @ wq).reshape(t, PEER_HEADS, 2, D_KEY // 2)
    s = jnp.einsum('thpc,pnc->thpn', q, subkeys).astype(jnp.float32)
    sv, si = lax.top_k(s, PEER_TOPK)
    cand = sv[:, :, 0, :, None] + sv[:, :, 1, None, :]
    cv, ci = lax.top_k(cand.reshape(t, PEER_HEADS, PEER_TOPK * PEER_TOPK), PEER_TOPK)
    ia = jnp.take_along_axis(si[:, :, 0], ci // PEER_TOPK, axis=-1)
    ib = jnp.take_along_axis(si[:, :, 1], ci % PEER_TOPK, axis=-1)
    eidx = ia * N_KEYS + ib
    gate = jax.nn.softmax(cv, axis=-1).astype(xt.dtype)
    npad = (-t) % PEER_CHUNK
    nc = (t + npad) // PEER_CHUNK
    xp = jnp.pad(xt, ((0, npad), (0, 0))).reshape(nc, PEER_CHUNK, D_MODEL)
    ep = jnp.pad(eidx, ((0, npad), (0, 0), (0, 0))).reshape(nc, PEER_CHUNK, PEER_HEADS, PEER_TOPK)
    gp = jnp.pad(gate, ((0, npad), (0, 0), (0, 0))).reshape(nc, PEER_CHUNK, PEER_HEADS, PEER_TOPK)

    def chunk(args):
        xc, ec, gc = args
        hc = jax.nn.gelu(jnp.einsum('chkd,cd->chk', u[ec], xc), approximate=False)
        return jnp.einsum('chk,chkd->cd', hc * gc, v[ec])

    out = lax.map(chunk, (xp, ep, gp))
    return out.reshape(-1, D_MODEL)[:t].reshape(shp)


def trunk(x, pos, is_prompt, conv_states, h_states, kbuf, vbuf, w):
    b, t = x.shape[:2]
    new_conv, new_h = [], []
    k_new = v_new = None
    kall = vall = kpos = None
    for layer in range(DEPTH):
        if layer < N_A_LAYERS:
            a = layer
            if is_prompt:
                cb = jnp.zeros((b, CONV_W - 1, D_RNN), x.dtype)
                h0 = jnp.zeros((b, D_RNN), x.dtype)
            else:
                cb = conv_states[a]
                h0 = h_states[a]
            y, cb_new, h_last = recurrent_block(
                rmsnorm(x, w['rg_norm'][a]), cb, h0, w['rg_w_in'][a], w['rg_conv_w'][a],
                w['rg_conv_b'][a], w['rg_wa'][a], w['rg_ba'][a], w['rg_wx'][a], w['rg_bx'][a],
                w['rg_lambda'][a], w['rg_w_out'][a])
            x = x + y
            new_conv.append(cb_new)
            new_h.append(h_last)
        else:
            bi = layer - N_A_LAYERS
            if bi == 0:
                kv = (rmsnorm(x, w['kv_norm']) @ w['w_kv']).reshape(b, t, 2, N_KV_HEADS, HEAD_DIM)
                k = rope(kv[:, :, 0], pos)
                v = kv[:, :, 1]
                if is_prompt:
                    k_new, v_new = k[:, -WINDOW:], v[:, -WINDOW:]
                else:
                    kall = jnp.concatenate([kbuf.astype(k.dtype), k], axis=1)
                    vall = jnp.concatenate([vbuf.astype(v.dtype), v], axis=1)
                    kpos = jnp.concatenate([PAST_LEN - WINDOW + jnp.arange(WINDOW), pos])
                    k_new, v_new = kall[:, -WINDOW:], vall[:, -WINDOW:]
            q = rope((rmsnorm(x, w['attn_norm'][bi]) @ w['w_q'][bi]).reshape(b, t, N_HEADS, HEAD_DIM), pos)
            if is_prompt:
                o = swa_prompt(q, k, v, w['sinks'][bi])
            else:
                o = swa_sample(q, kall, vall, pos, kpos, w['sinks'][bi])
            x = x + o @ w['w_o'][bi]
        x = x + peer(rmsnorm(x, w['ffn_norm'][layer]), w['peer_wq'][layer], w['peer_subkeys'][layer],
                     w['peer_u'][layer], w['peer_v'][layer])
    return rmsnorm(x, w['final_norm']), jnp.stack(new_conv), jnp.stack(new_h), k_new, v_new


def setup_inputs(seed: int = 0) -> dict:
    key = jax.random.key(seed)
    ks = jax.random.split(key, 32)
    f32 = jnp.float32

    def nrm(k, shape, scale):
        return jax.random.normal(k, shape, f32) * scale

    def gain(k, shape):
        return 1.0 + 0.02 * jax.random.normal(k, shape, f32)

    na, nb = N_A_LAYERS, N_B_LAYERS
    a0 = jax.random.uniform(ks[10], (na, D_RNN), f32, 0.9, 0.999)
    return {
        'x_prompt': nrm(ks[0], (BATCH, SEQ, D_MODEL), 1.0),
        'x_sample': nrm(ks[1], (DEC_BATCH, DEC_SEQ, D_MODEL), 1.0),
        'state_conv': nrm(ks[2], (na, DEC_BATCH, CONV_W - 1, D_RNN), 1.0),
        'state_h': nrm(ks[3], (na, DEC_BATCH, D_RNN), 0.5),
        'cache_k': nrm(ks[4], (DEC_BATCH, WINDOW, N_KV_HEADS, HEAD_DIM), 1.0),
        'cache_v': nrm(ks[5], (DEC_BATCH, WINDOW, N_KV_HEADS, HEAD_DIM), 1.0),
        'rg_norm': gain(ks[6], (na, D_MODEL)),
        'rg_w_in': nrm(ks[7], (na, D_MODEL, 2 * D_RNN), D_MODEL ** -0.5),
        'rg_conv_w': nrm(ks[8], (na, CONV_W, D_RNN), CONV_W ** -0.5),
        'rg_conv_b': nrm(ks[9], (na, D_RNN), 0.02),
        'rg_wa': nrm(ks[11], (na, RG_BLOCKS, RG_BLOCK_W, RG_BLOCK_W), RG_BLOCK_W ** -0.5),
        'rg_ba': nrm(ks[12], (na, D_RNN), 0.02),
        'rg_wx': nrm(ks[13], (na, RG_BLOCKS, RG_BLOCK_W, RG_BLOCK_W), RG_BLOCK_W ** -0.5),
        'rg_bx': nrm(ks[14], (na, D_RNN), 0.02),
        'rg_lambda': jnp.log(a0) - jnp.log1p(-a0),
        'rg_w_out': nrm(ks[15], (na, D_RNN, D_MODEL), D_RNN ** -0.5),
        'kv_norm': gain(ks[16], (D_MODEL,)),
        'w_kv': nrm(ks[17], (D_MODEL, 2 * N_KV_HEADS * HEAD_DIM), D_MODEL ** -0.5),
        'attn_norm': gain(ks[18], (nb, D_MODEL)),
        'w_q': nrm(ks[19], (nb, D_MODEL, N_HEADS * HEAD_DIM), D_MODEL ** -0.5),
        'sinks': nrm(ks[20], (nb, N_HEADS), 1.0),
        'w_o': nrm(ks[21], (nb, N_HEADS * HEAD_DIM, D_MODEL), (N_HEADS * HEAD_DIM) ** -0.5),
        'ffn_norm': gain(ks[22], (DEPTH, D_MODEL)),
        'peer_wq': nrm(ks[23], (DEPTH, D_MODEL, PEER_HEADS * D_KEY), D_MODEL ** -0.5),
        'peer_subkeys': nrm(ks[24], (DEPTH, 2, N_KEYS, D_KEY // 2), (D_KEY // 2) ** -0.5),
        'peer_u': nrm(ks[25], (DEPTH, N_EXPERTS, D_MODEL), D_MODEL ** -0.5),
        'peer_v': nrm(ks[26], (DEPTH, N_EXPERTS, D_MODEL), 0.1),
        'final_norm': gain(ks[27], (D_MODEL,)),
    }


def reference(x_prompt, x_sample, state_conv, state_h, cache_k, cache_v,
              rg_norm, rg_w_in, rg_conv_w, rg_conv_b, rg_wa, rg_ba, rg_wx, rg_bx, rg_lambda, rg_w_out,
              kv_norm, w_kv, attn_norm, w_q, sinks, w_o,
              ffn_norm, peer_wq, peer_subkeys, peer_u, peer_v, final_norm):
    w = dict(rg_norm=rg_norm, rg_w_in=rg_w_in, rg_conv_w=rg_conv_w, rg_conv_b=rg_conv_b,
             rg_wa=rg_wa, rg_ba=rg_ba, rg_wx=rg_wx, rg_bx=rg_bx, rg_lambda=rg_lambda,
             rg_w_out=rg_w_out, kv_norm=kv_norm, w_kv=w_kv, attn_norm=attn_norm, w_q=w_q,
             sinks=sinks, w_o=w_o, ffn_norm=ffn_norm, peer_wq=peer_wq,
             peer_subkeys=peer_subkeys, peer_u=peer_u, peer_v=peer_v, final_norm=final_norm)
    pos_p = jnp.arange(x_prompt.shape[1])
    y_prompt, conv_p, h_p, k_p, v_p = trunk(x_prompt, pos_p, True, None, None, None, None, w)
    pos_s = PAST_LEN + jnp.arange(x_sample.shape[1])
    y_sample, conv_s, h_s, k_s, v_s = trunk(x_sample, pos_s, False, state_conv, state_h,
                                            cache_k, cache_v, w)
    return (y_prompt, y_sample, conv_p, h_p, k_p, v_p, conv_s, h_s, k_s, v_s)
```

```cpp
#include <hip/hip_runtime.h>
#include <hip/hip_cooperative_groups.h>
#include <cstdio>
#include <cstdint>
namespace cg = cooperative_groups;

typedef unsigned short u16;
typedef __attribute__((ext_vector_type(8))) short bf16x8;
typedef __attribute__((ext_vector_type(4))) float f32x4;

#define NTOK 17408
#define NTP 16384
#define MIB 1048576ull
#define NPHASE 20
#ifndef MULTI_LAUNCH
#define MULTI_LAUNCH 0
#endif

#define OFF_WT_IN   (0 * MIB)
#define OFF_WT_OUT  (4 * MIB)
#define OFF_WT_BD   (6 * MIB)
#define OFF_WT_PQ0  (7 * MIB)
#define OFF_WT_PQ1  (11 * MIB)
#define OFF_WT_KVQ  (15 * MIB)
#define OFF_WT_O    (18 * MIB)
#define OFF_WT_SK0  (20 * MIB)
#define OFF_WT_SK1  (20 * MIB + 524288ull)
#define OFF_ROPE    (21 * MIB)
#define OFF_U16     (22 * MIB)
#define OFF_V16     (54 * MIB)
#define OFF_XN      (86 * MIB)
#define OFF_X       (120 * MIB)
#define OFF_GATE16  (188 * MIB)
#define OFF_REC32   (222 * MIB)
#define OFF_XC32    (290 * MIB)
#define OFF_XC16    (358 * MIB)
#define OFF_LOGA    (222 * MIB)
#define OFF_IG16    (22 * MIB)
#define OFF_AGGA    (56 * MIB)
#define OFF_AGGB    (57 * MIB)
#define OFF_HG16    (358 * MIB)
#define OFF_QP16    (188 * MIB)
#define OFF_S32     (256 * MIB)
#define OFF_IDX     (188 * MIB)
#define OFF_PGATE   (197 * MIB)
#define OFF_K16     (188 * MIB)
#define OFF_V16A    (197 * MIB)
#define OFF_Q16     (206 * MIB)
#define OFF_O16     (240 * MIB)
#define WS_NEEDED   (392 * MIB)

#define OUT_Y      0
#define OUT_CONVP  17825792
#define OUT_HP     17850368
#define OUT_KP     17858560
#define OUT_VP     18120704
#define OUT_CONVS  18382848
#define OUT_HS     18776064
#define OUT_KS     18907136
#define OUT_VS     23101440

struct Params {
  const float *x_prompt, *x_sample, *state_conv, *state_h, *cache_k, *cache_v;
  const float *rg_norm, *rg_w_in, *rg_conv_w, *rg_conv_b, *rg_wa, *rg_ba, *rg_wx, *rg_bx, *rg_lambda, *rg_w_out;
  const float *kv_norm, *w_kv, *attn_norm, *w_q, *sinks, *w_o, *ffn_norm, *peer_wq, *peer_subkeys, *peer_u, *peer_v, *final_norm;
  float* out;
  char* ws;
  int ph_begin, ph_end;
};

__device__ __forceinline__ u16 f2bf(float f) {
  unsigned u = __float_as_uint(f);
  u += 0x7fffu + ((u >> 16) & 1u);
  return (u16)(u >> 16);
}
__device__ __forceinline__ float bf2f(u16 h) { return __uint_as_float(((unsigned)h) << 16); }
__device__ __forceinline__ unsigned pack2(float a, float b) { return (unsigned)f2bf(a) | ((unsigned)f2bf(b) << 16); }
__device__ __forceinline__ float bflo(unsigned u) { return __uint_as_float(u << 16); }
__device__ __forceinline__ float bfhi(unsigned u) { return __uint_as_float(u & 0xffff0000u); }
__device__ __forceinline__ float wave_sum(float v) {
#pragma unroll
  for (int o = 32; o > 0; o >>= 1) v += __shfl_xor(v, o);
  return v;
}
__device__ __forceinline__ const float* xin_row(const Params& p, int token) {
  return token < NTP ? p.x_prompt + (size_t)token * 1024 : p.x_sample + (size_t)(token - NTP) * 1024;
}
__device__ __forceinline__ float gelu_tanh(float x) {
  float u = 0.7978845608028654f * (x + 0.044715f * x * x * x);
  float e = __expf(2.f * u);
  float th = 1.f - 2.f / (e + 1.f);
  return 0.5f * x * (1.f + th);
}
__device__ __forceinline__ float sigmoidf_(float x) { return 1.f / (1.f + __expf(-x)); }

template <int CTRL>
__device__ __forceinline__ int dpp_i(int v) { return __builtin_amdgcn_update_dpp(v, v, CTRL, 0xf, 0xf, false); }
__device__ __forceinline__ int grp_max_i(int v) {
  v = max(v, dpp_i<0xB1>(v));
  v = max(v, dpp_i<0x4E>(v));
  v = max(v, dpp_i<0x141>(v));
  v = max(v, dpp_i<0x140>(v));
  return v;
}
__device__ __forceinline__ float grp_max_f(float v) {
  v = fmaxf(v, __int_as_float(dpp_i<0xB1>(__float_as_int(v))));
  v = fmaxf(v, __int_as_float(dpp_i<0x4E>(__float_as_int(v))));
  v = fmaxf(v, __int_as_float(dpp_i<0x141>(__float_as_int(v))));
  v = fmaxf(v, __int_as_float(dpp_i<0x140>(__float_as_int(v))));
  return v;
}
__device__ __forceinline__ float grp_sum_f(float v) {
  v += __int_as_float(dpp_i<0xB1>(__float_as_int(v)));
  v += __int_as_float(dpp_i<0x4E>(__float_as_int(v)));
  v += __int_as_float(dpp_i<0x141>(__float_as_int(v)));
  v += __int_as_float(dpp_i<0x140>(__float_as_int(v)));
  return v;
}

__device__ void transpose_unit(const float* __restrict__ src, int ld_src, u16* __restrict__ dst, int ld_dst,
                               int kt, int nt, const float* __restrict__ gain, float* lds) {
  const int tid = threadIdx.x;
#pragma unroll
  for (int j = 0; j < 4; ++j) {
    int idx = tid + j * 256;
    int k = idx >> 4, c4 = idx & 15;
    float4 v = *(const float4*)(src + (size_t)(kt * 64 + k) * ld_src + nt * 64 + c4 * 4);
    float g = gain ? gain[kt * 64 + k] : 1.f;
    float* d = lds + k * 65 + c4 * 4;
    d[0] = v.x * g; d[1] = v.y * g; d[2] = v.z * g; d[3] = v.w * g;
  }
  __syncthreads();
#pragma unroll
  for (int j = 0; j < 2; ++j) {
    int c = tid + j * 256;
    int n = c >> 3, kc = c & 7;
    uint4 o;
    o.x = pack2(lds[(kc * 8 + 0) * 65 + n], lds[(kc * 8 + 1) * 65 + n]);
    o.y = pack2(lds[(kc * 8 + 2) * 65 + n], lds[(kc * 8 + 3) * 65 + n]);
    o.z = pack2(lds[(kc * 8 + 4) * 65 + n], lds[(kc * 8 + 5) * 65 + n]);
    o.w = pack2(lds[(kc * 8 + 6) * 65 + n], lds[(kc * 8 + 7) * 65 + n]);
    *(uint4*)(dst + (size_t)(nt * 64 + n) * ld_dst + kt * 64 + kc * 8) = o;
  }
  __syncthreads();
}

__device__ void transpose_job(const Params& p, int u, float* lds) {
  char* ws = p.ws;
  if (u < 512) { transpose_unit(p.rg_w_in, 2048, (u16*)(ws + OFF_WT_IN), 1024, u >> 5, u & 31, nullptr, lds); return; }
  u -= 512;
  if (u < 256) { transpose_unit(p.rg_w_out, 1024, (u16*)(ws + OFF_WT_OUT), 1024, u >> 4, u & 15, nullptr, lds); return; }
  u -= 256;
  if (u < 64) {
    int which = u >> 5; int r = u & 31; int bi = r >> 2; int t = r & 3;
    const float* src = (which ? p.rg_wx : p.rg_wa) + (size_t)bi * 16384;
    u16* dst = (u16*)(ws + OFF_WT_BD) + (size_t)(which * 1024 + bi * 128) * 128;
    transpose_unit(src, 128, dst, 128, t >> 1, t & 1, nullptr, lds); return;
  }
  u -= 64;
  if (u < 1024) {
    int l = u >> 9; int r = u & 511;
    transpose_unit(p.peer_wq + (size_t)l * 2097152, 2048, (u16*)(ws + (l ? OFF_WT_PQ1 : OFF_WT_PQ0)), 1024, r >> 5, r & 31, nullptr, lds); return;
  }
  u -= 1024;
  if (u < 128) { transpose_unit(p.w_kv, 512, (u16*)(ws + OFF_WT_KVQ), 1024, u >> 3, u & 7, p.kv_norm, lds); return; }
  u -= 128;
  if (u < 256) { transpose_unit(p.w_q, 1024, (u16*)(ws + OFF_WT_KVQ) + (size_t)512 * 1024, 1024, u >> 4, u & 15, p.attn_norm, lds); return; }
  u -= 256;
  transpose_unit(p.w_o, 1024, (u16*)(ws + OFF_WT_O), 1024, u >> 4, u & 15, nullptr, lds);
}

__device__ __forceinline__ void cvt_unit(const float* __restrict__ src, u16* __restrict__ dst, size_t base) {
  const int tid = threadIdx.x;
#pragma unroll
  for (int j = 0; j < 2; ++j) {
    size_t o = base + j * 1024 + tid * 4;
    float4 v = *(const float4*)(src + o);
    uint2 w; w.x = pack2(v.x, v.y); w.y = pack2(v.z, v.w);
    *(uint2*)(dst + o) = w;
  }
}

__device__ __forceinline__ void rmsnorm_row(const float* __restrict__ x, const float* __restrict__ g, u16* __restrict__ o, int lane) {
  float4 v[4];
  float ss = 0.f;
#pragma unroll
  for (int i = 0; i < 4; ++i) {
    v[i] = *(const float4*)(x + i * 256 + lane * 4);
    ss += v[i].x * v[i].x + v[i].y * v[i].y + v[i].z * v[i].z + v[i].w * v[i].w;
  }
  ss = wave_sum(ss);
  float r = rsqrtf(ss * (1.f / 1024.f) + 1e-6f);
#pragma unroll
  for (int i = 0; i < 4; ++i) {
    float4 gg = *(const float4*)(g + i * 256 + lane * 4);
    uint2 w; w.x = pack2(v[i].x * r * gg.x, v[i].y * r * gg.y); w.y = pack2(v[i].z * r * gg.z, v[i].w * r * gg.w);
    *(uint2*)(o + i * 256 + lane * 4) = w;
  }
}

__device__ void ph_convert0(const Params& p, char* smem) {
  const int tid = threadIdx.x, lane = tid & 63, wid = tid >> 6;
  const int NT = 2496, NSK = 256, NROPE = 257, NRMS = 4352, NCACHE = 3840;
  const int total = NT + NSK + NROPE + NRMS + NCACHE;
  for (int u0 = blockIdx.x; u0 < total; u0 += gridDim.x) {
    int u = u0;
    if (u < NT) { transpose_job(p, u, (float*)smem); continue; }
    u -= NT;
    if (u < NSK) {
      int l = u >> 7; int r = u & 127;
      const float* src = p.peer_subkeys + (size_t)l * 32768;
      u16* dst = (u16*)(p.ws + (l ? OFF_WT_SK1 : OFF_WT_SK0));
#pragma unroll
      for (int j = 0; j < 2; ++j) {
        int i = r * 2048 + j * 1024 + tid * 4;
        int s = ((i >> 14) & 1) * 16384 + (i & 16383);
        float4 v = *(const float4*)(src + s);
        uint2 w; w.x = pack2(v.x, v.y); w.y = pack2(v.z, v.w);
        *(uint2*)(dst + i) = w;
      }
      continue;
    }
    u -= NSK;
    if (u < NROPE) {
      int i = u * 256 + tid;
      if (i < 2056 * 32) {
        int pi = i >> 5, d = i & 31;
        int pos = pi < 2048 ? pi : (16384 + pi - 2048);
        float inv = (float)pow(10000.0, -(double)d / 32.0);
        float ang = (float)pos * inv;
        double sn, cs;
        sincos((double)ang, &sn, &cs);
        float2* rt = (float2*)(p.ws + OFF_ROPE);
        rt[i] = make_float2((float)cs, (float)sn);
      }
      continue;
    }
    u -= NROPE;
    if (u < NRMS) {
      int t = u * 4 + wid;
      rmsnorm_row(xin_row(p, t), p.rg_norm, (u16*)(p.ws + OFF_XN) + (size_t)t * 1024, lane);
      continue;
    }
    u -= NRMS;
    {
      int which = u / 1920; int r = u - which * 1920;
      int b = r / 15, c = r - b * 15;
      const float* src = (which ? p.cache_v : p.cache_k) + (size_t)b * 32768 + 2048 + c * 2048;
      float* dst = p.out + (which ? OUT_VS : OUT_KS) + (size_t)b * 32768 + c * 2048;
#pragma unroll
      for (int j = 0; j < 2; ++j) {
        int o = j * 1024 + tid * 4;
        *(float4*)(dst + o) = *(const float4*)(src + o);
      }
    }
  }
}

__device__ void ph_cvt_tables(const Params& p, int layer) {
  for (int u = blockIdx.x; u < 16384; u += gridDim.x) {
    int which = u >> 13; int r = u & 8191;
    const float* src = (which ? p.peer_v : p.peer_u) + (size_t)layer * 16777216;
    u16* dst = (u16*)(p.ws + (which ? OFF_V16 : OFF_U16));
    cvt_unit(src, dst, (size_t)r * 2048);
  }
}

__device__ void ph_rmsnorm(const Params& p, const float* g) {
  const int lane = threadIdx.x & 63, wid = threadIdx.x >> 6;
  const float* x = (const float*)(p.ws + OFF_X);
  u16* xn = (u16*)(p.ws + OFF_XN);
  for (int u = blockIdx.x; u < 4352; u += gridDim.x) {
    int t = u * 4 + wid;
    rmsnorm_row(x + (size_t)t * 1024, g, xn + (size_t)t * 1024, lane);
  }
}

template <class Epi>
__device__ __forceinline__ void gemm_tiles(const u16* __restrict__ A, int lda, const u16* __restrict__ W, int ldw,
                                           int K, int kmod, int ntn, const Epi& epi, char* smem) {
  const int tid = threadIdx.x, lane = tid & 63, wid = tid >> 6;
  const int wr = wid >> 1, wc = wid & 1, fr = lane & 15, fq = lane >> 4;
  const int ld_row = tid >> 3, ld_ch = tid & 7;
  const int total = 136 * ntn;
  const int nk = K >> 6;
  for (int tile = blockIdx.x; tile < total; tile += gridDim.x) {
    const int tm = tile / ntn, tn = tile - tm * ntn;
    const u16* Ag = A + (size_t)(tm * 128 + ld_row) * lda + (kmod ? (tn % kmod) * 128 : 0) + ld_ch * 8;
    const u16* Wg = W + (size_t)(tn * 128 + ld_row) * ldw + ld_ch * 8;
    f32x4 acc[4][4];
#pragma unroll
    for (int m = 0; m < 4; ++m)
#pragma unroll
      for (int n = 0; n < 4; ++n) acc[m][n] = f32x4{0.f, 0.f, 0.f, 0.f};
    uint4 ra[4], rw[4];
#pragma unroll
    for (int i = 0; i < 4; ++i) {
      ra[i] = *(const uint4*)(Ag + (size_t)(i * 32) * lda);
      rw[i] = *(const uint4*)(Wg + (size_t)(i * 32) * ldw);
    }
    {
      char* sW = smem; char* sA = smem + 18432;
#pragma unroll
      for (int i = 0; i < 4; ++i) {
        *(uint4*)(sW + (ld_row + i * 32) * 144 + ld_ch * 16) = rw[i];
        *(uint4*)(sA + (ld_row + i * 32) * 144 + ld_ch * 16) = ra[i];
      }
    }
    __syncthreads();
    for (int kt = 0; kt < nk; ++kt) {
      const int cur = kt & 1;
      const bool more = (kt + 1 < nk);
      if (more) {
        const int k0 = (kt + 1) * 64;
#pragma unroll
        for (int i = 0; i < 4; ++i) {
          ra[i] = *(const uint4*)(Ag + (size_t)(i * 32) * lda + k0);
          rw[i] = *(const uint4*)(Wg + (size_t)(i * 32) * ldw + k0);
        }
      }
      const char* sW = smem + cur * 36864;
      const char* sA = sW + 18432;
#pragma unroll
      for (int ks = 0; ks < 2; ++ks) {
        bf16x8 a[4], b[4];
#pragma unroll
        for (int m = 0; m < 4; ++m) a[m] = *(const bf16x8*)(sW + (wr * 64 + m * 16 + fr) * 144 + ks * 64 + fq * 16);
#pragma unroll
        for (int n = 0; n < 4; ++n) b[n] = *(const bf16x8*)(sA + (wc * 64 + n * 16 + fr) * 144 + ks * 64 + fq * 16);
#pragma unroll
        for (int m = 0; m < 4; ++m)
#pragma unroll
          for (int n = 0; n < 4; ++n) acc[m][n] = __builtin_amdgcn_mfma_f32_16x16x32_bf16(a[m], b[n], acc[m][n], 0, 0, 0);
      }
      if (more) {
        char* dW = smem + (cur ^ 1) * 36864; char* dA = dW + 18432;
#pragma unroll
        for (int i = 0; i < 4; ++i) {
          *(uint4*)(dW + (ld_row + i * 32) * 144 + ld_ch * 16) = rw[i];
          *(uint4*)(dA + (ld_row + i * 32) * 144 + ld_ch * 16) = ra[i];
        }
      }
      __syncthreads();
    }
    epi(acc, tm * 128 + wc * 64, tn * 128 + wr * 64, fr, fq);
  }
}

struct EpiWin {
  u16* gate16; float* rec32;
  __device__ __forceinline__ void operator()(const f32x4 (&acc)[4][4], int tok0, int feat0, int fr, int fq) const {
#pragma unroll
    for (int n = 0; n < 4; ++n) {
      const int tok = tok0 + n * 16 + fr;
#pragma unroll
      for (int m = 0; m < 4; ++m) {
        const int f = feat0 + m * 16 + fq * 4;
        f32x4 v = acc[m][n];
        if (feat0 < 1024) {
          uint2 w; w.x = pack2(gelu_tanh(v[0]), gelu_tanh(v[1])); w.y = pack2(gelu_tanh(v[2]), gelu_tanh(v[3]));
          *(uint2*)(gate16 + (size_t)tok * 1024 + f) = w;
        } else {
          *(float4*)(rec32 + (size_t)tok * 1024 + (f - 1024)) = make_float4(v[0], v[1], v[2], v[3]);
        }
      }
    }
  }
};
struct EpiBd {
  float* loga; u16* ig16; const float *ba, *bx, *lam;
  __device__ __forceinline__ void operator()(const f32x4 (&acc)[4][4], int tok0, int feat0, int fr, int fq) const {
#pragma unroll
    for (int m = 0; m < 4; ++m) {
      const int f = feat0 + m * 16 + fq * 4;
      if (feat0 < 1024) {
        float4 b4 = *(const float4*)(ba + f);
        float4 l4 = *(const float4*)(lam + f);
        float sp0 = log1pf(__expf(-l4.x)), sp1 = log1pf(__expf(-l4.y)), sp2 = log1pf(__expf(-l4.z)), sp3 = log1pf(__expf(-l4.w));
#pragma unroll
        for (int n = 0; n < 4; ++n) {
          const int tok = tok0 + n * 16 + fr;
          f32x4 v = acc[m][n];
          float4 o;
          o.x = -8.f * sigmoidf_(v[0] + b4.x) * sp0;
          o.y = -8.f * sigmoidf_(v[1] + b4.y) * sp1;
          o.z = -8.f * sigmoidf_(v[2] + b4.z) * sp2;
          o.w = -8.f * sigmoidf_(v[3] + b4.w) * sp3;
          *(float4*)(loga + (size_t)tok * 1024 + f) = o;
        }
      } else {
        float4 b4 = *(const float4*)(bx + (f - 1024));
#pragma unroll
        for (int n = 0; n < 4; ++n) {
          const int tok = tok0 + n * 16 + fr;
          f32x4 v = acc[m][n];
          uint2 w;
          w.x = pack2(sigmoidf_(v[0] + b4.x), sigmoidf_(v[1] + b4.y));
          w.y = pack2(sigmoidf_(v[2] + b4.z), sigmoidf_(v[3] + b4.w));
          *(uint2*)(ig16 + (size_t)tok * 1024 + (f - 1024)) = w;
        }
      }
    }
  }
};
struct EpiResid {
  const Params* p; float* xres; int first;
  __device__ __forceinline__ void operator()(const f32x4 (&acc)[4][4], int tok0, int feat0, int fr, int fq) const {
#pragma unroll
    for (int n = 0; n < 4; ++n) {
      const int tok = tok0 + n * 16 + fr;
      const float* base = first ? xin_row(*p, tok) : (xres + (size_t)tok * 1024);
#pragma unroll
      for (int m = 0; m < 4; ++m) {
        const int f = feat0 + m * 16 + fq * 4;
        float4 b = *(const float4*)(base + f);
        f32x4 v = acc[m][n];
        *(float4*)(xres + (size_t)tok * 1024 + f) = make_float4(b.x + v[0], b.y + v[1], b.z + v[2], b.w + v[3]);
      }
    }
  }
};
struct EpiBf16 {
  u16* o; int ld;
  __device__ __forceinline__ void operator()(const f32x4 (&acc)[4][4], int tok0, int feat0, int fr, int fq) const {
#pragma unroll
    for (int n = 0; n < 4; ++n) {
      const int tok = tok0 + n * 16 + fr;
#pragma unroll
      for (int m = 0; m < 4; ++m) {
        const int f = feat0 + m * 16 + fq * 4;
        f32x4 v = acc[m][n];
        uint2 w; w.x = pack2(v[0], v[1]); w.y = pack2(v[2], v[3]);
        *(uint2*)(o + (size_t)tok * ld + f) = w;
      }
    }
  }
};
struct EpiF32 {
  float* o; int ld;
  __device__ __forceinline__ void operator()(const f32x4 (&acc)[4][4], int tok0, int feat0, int fr, int fq) const {
#pragma unroll
    for (int n = 0; n < 4; ++n) {
      const int tok = tok0 + n * 16 + fr;
#pragma unroll
      for (int m = 0; m < 4; ++m) {
        const int f = feat0 + m * 16 + fq * 4;
        f32x4 v = acc[m][n];
        *(float4*)(o + (size_t)tok * ld + f) = make_float4(v[0], v[1], v[2], v[3]);
      }
    }
  }
};
struct EpiKvq {
  u16 *k16, *v16, *q16; const float2* rope; float* out;
  __device__ __forceinline__ void operator()(const f32x4 (&acc)[4][4], int tok0, int feat0, int fr, int fq) const {
#pragma unroll
    for (int n = 0; n < 4; ++n) {
      const int tok = tok0 + n * 16 + fr;
      int b, t, pi, orow; bool is_p = tok < NTP;
      if (is_p) { b = tok >> 11; t = tok & 2047; pi = t; orow = t - 1920; }
      else { int ts = tok - NTP; b = ts >> 3; t = ts & 7; pi = 2048 + t; orow = 120 + t; }
      if (feat0 >= 256 && feat0 < 512) {
        const int kvh = (feat0 - 256) >> 6;
#pragma unroll
        for (int m = 0; m < 4; ++m) {
          const int d = m * 16 + fq * 4;
          f32x4 v = acc[m][n];
          uint2 w; w.x = pack2(v[0], v[1]); w.y = pack2(v[2], v[3]);
          *(uint2*)(v16 + (size_t)tok * 256 + kvh * 64 + d) = w;
          if (orow >= 0) {
            float* dst = out + (is_p ? OUT_VP : OUT_VS) + ((size_t)(b * 128 + orow) * 4 + kvh) * 64 + d;
            *(float4*)dst = make_float4(v[0], v[1], v[2], v[3]);
          }
        }
      } else {
        const bool isk = feat0 < 256;
        const float sc = isk ? 1.f : 0.125f;
#pragma unroll
        for (int m = 0; m < 2; ++m) {
          const int d = m * 16 + fq * 4;
          f32x4 x1 = acc[m][n], x2 = acc[m + 2][n];
          const float2* rp = rope + pi * 32 + d;
          float o1[4], o2[4];
#pragma unroll
          for (int j = 0; j < 4; ++j) {
            float2 csn = rp[j];
            o1[j] = (x1[j] * csn.x - x2[j] * csn.y) * sc;
            o2[j] = (x2[j] * csn.x + x1[j] * csn.y) * sc;
          }
          uint2 w1, w2;
          w1.x = pack2(o1[0], o1[1]); w1.y = pack2(o1[2], o1[3]);
          w2.x = pack2(o2[0], o2[1]); w2.y = pack2(o2[2], o2[3]);
          if (isk) {
            const int kvh = feat0 >> 6;
            *(uint2*)(k16 + (size_t)tok * 256 + kvh * 64 + d) = w1;
            *(uint2*)(k16 + (size_t)tok * 256 + kvh * 64 + d + 32) = w2;
            if (orow >= 0) {
              float* dst = out + (is_p ? OUT_KP : OUT_KS) + ((size_t)(b * 128 + orow) * 4 + kvh) * 64 + d;
              *(float4*)dst = make_float4(o1[0], o1[1], o1[2], o1[3]);
              *(float4*)(dst + 32) = make_float4(o2[0], o2[1], o2[2], o2[3]);
            }
          } else {
            const int f = feat0 - 512;
            *(uint2*)(q16 + (size_t)tok * 1024 + f + d) = w1;
            *(uint2*)(q16 + (size_t)tok * 1024 + f + d + 32) = w2;
          }
        }
      }
    }
  }
};

__device__ void ph_conv(const Params& p) {
  const float* rec = (const float*)(p.ws + OFF_REC32);
  float* xc32 = (float*)(p.ws + OFF_XC32);
  u16* xc16 = (u16*)(p.ws + OFF_XC16);
  const int nunits = NTOK * 256;
  for (int idx = blockIdx.x * 256 + threadIdx.x; idx < nunits; idx += gridDim.x * 256) {
    const int tok = idx >> 8, c = (idx & 255) * 4;
    int b, t; const float* buf = nullptr;
    if (tok < NTP) { b = tok >> 11; t = tok & 2047; }
    else { int ts = tok - NTP; b = ts >> 3; t = ts & 7; buf = p.state_conv + (size_t)b * 3072; }
    float4 r[4];
    r[0] = *(const float4*)(rec + (size_t)tok * 1024 + c);
#pragma unroll
    for (int L = 1; L <= 3; ++L) {
      if (t - L >= 0) r[L] = *(const float4*)(rec + (size_t)(tok - L) * 1024 + c);
      else if (buf) r[L] = *(const float4*)(buf + (size_t)(3 + t - L) * 1024 + c);
      else r[L] = make_float4(0.f, 0.f, 0.f, 0.f);
    }
    float4 w0 = *(const float4*)(p.rg_conv_w + c), w1 = *(const float4*)(p.rg_conv_w + 1024 + c);
    float4 w2 = *(const float4*)(p.rg_conv_w + 2048 + c), w3 = *(const float4*)(p.rg_conv_w + 3072 + c);
    float4 cb = *(const float4*)(p.rg_conv_b + c);
    float4 o;
    o.x = cb.x + w3.x * r[0].x + w2.x * r[1].x + w1.x * r[2].x + w0.x * r[3].x;
    o.y = cb.y + w3.y * r[0].y + w2.y * r[1].y + w1.y * r[2].y + w0.y * r[3].y;
    o.z = cb.z + w3.z * r[0].z + w2.z * r[1].z + w1.z * r[2].z + w0.z * r[3].z;
    o.w = cb.w + w3.w * r[0].w + w2.w * r[1].w + w1.w * r[2].w + w0.w * r[3].w;
    *(float4*)(xc32 + (size_t)tok * 1024 + c) = o;
    uint2 w; w.x = pack2(o.x, o.y); w.y = pack2(o.z, o.w);
    *(uint2*)(xc16 + (size_t)tok * 1024 + c) = w;
    if (tok < NTP) {
      if (t >= 2045) *(float4*)(p.out + OUT_CONVP + ((size_t)b * 3 + (t - 2045)) * 1024 + c) = r[0];
    } else {
      if (t >= 5) *(float4*)(p.out + OUT_CONVS + ((size_t)b * 3 + (t - 5)) * 1024 + c) = r[0];
    }
  }
}

__device__ __forceinline__ void scan_step(const float* loga, const u16* ig16, const float* xc32, size_t off, float4& a, float4& bt) {
  float4 la = *(const float4*)(loga + off);
  uint2 gi = *(const uint2*)(ig16 + off);
  float4 xc = *(const float4*)(xc32 + off);
  a.x = __expf(la.x); a.y = __expf(la.y); a.z = __expf(la.z); a.w = __expf(la.w);
  bt.x = sqrtf(-expm1f(2.f * la.x)) * bflo(gi.x) * xc.x;
  bt.y = sqrtf(-expm1f(2.f * la.y)) * bfhi(gi.x) * xc.y;
  bt.z = sqrtf(-expm1f(2.f * la.z)) * bflo(gi.y) * xc.z;
  bt.w = sqrtf(-expm1f(2.f * la.w)) * bfhi(gi.y) * xc.w;
}
__device__ void ph_scanA(const Params& p) {
  const float* loga = (const float*)(p.ws + OFF_LOGA);
  const u16* ig16 = (const u16*)(p.ws + OFF_IG16);
  const float* xc32 = (const float*)(p.ws + OFF_XC32);
  float* aggA = (float*)(p.ws + OFF_AGGA);
  float* aggB = (float*)(p.ws + OFF_AGGB);
  const int c = threadIdx.x * 4;
  for (int item = blockIdx.x; item < 256; item += gridDim.x) {
    const int b = item >> 5, ch = item & 31;
    float4 A = make_float4(1.f, 1.f, 1.f, 1.f), B = make_float4(0.f, 0.f, 0.f, 0.f);
    const size_t tok0 = (size_t)b * 2048 + ch * 64;
#pragma unroll 4
    for (int s = 0; s < 64; ++s) {
      float4 a, bt;
      scan_step(loga, ig16, xc32, (tok0 + s) * 1024 + c, a, bt);
      A.x *= a.x; A.y *= a.y; A.z *= a.z; A.w *= a.w;
      B.x = a.x * B.x + bt.x; B.y = a.y * B.y + bt.y; B.z = a.z * B.z + bt.z; B.w = a.w * B.w + bt.w;
    }
    *(float4*)(aggA + (size_t)item * 1024 + c) = A;
    *(float4*)(aggB + (size_t)item * 1024 + c) = B;
  }
}
__device__ void ph_scanB(const Params& p) {
  const float* loga = (const float*)(p.ws + OFF_LOGA);
  const u16* ig16 = (const u16*)(p.ws + OFF_IG16);
  const float* xc32 = (const float*)(p.ws + OFF_XC32);
  const u16* gate16 = (const u16*)(p.ws + OFF_GATE16);
  u16* hg16 = (u16*)(p.ws + OFF_HG16);
  const float* aggA = (const float*)(p.ws + OFF_AGGA);
  const float* aggB = (const float*)(p.ws + OFF_AGGB);
  const int c = threadIdx.x * 4;
  for (int item = blockIdx.x; item < 384; item += gridDim.x) {
    float4 h = make_float4(0.f, 0.f, 0.f, 0.f);
    size_t tok0; int nsteps; float* hout = nullptr;
    if (item < 256) {
      const int b = item >> 5, ch = item & 31;
      for (int j = 0; j < ch; ++j) {
        float4 A = *(const float4*)(aggA + (size_t)(b * 32 + j) * 1024 + c);
        float4 B = *(const float4*)(aggB + (size_t)(b * 32 + j) * 1024 + c);
        h.x = A.x * h.x + B.x; h.y = A.y * h.y + B.y; h.z = A.z * h.z + B.z; h.w = A.w * h.w + B.w;
      }
      tok0 = (size_t)b * 2048 + ch * 64; nsteps = 64;
      if (ch == 31) hout = p.out + OUT_HP + (size_t)b * 1024 + c;
    } else {
      const int b = item - 256;
      h = *(const float4*)(p.state_h + (size_t)b * 1024 + c);
      tok0 = (size_t)NTP + b * 8; nsteps = 8;
      hout = p.out + OUT_HS + (size_t)b * 1024 + c;
    }
#pragma unroll 4
    for (int s = 0; s < nsteps; ++s) {
      float4 a, bt;
      const size_t off = (tok0 + s) * 1024 + c;
      scan_step(loga, ig16, xc32, off, a, bt);
      h.x = a.x * h.x + bt.x; h.y = a.y * h.y + bt.y; h.z = a.z * h.z + bt.z; h.w = a.w * h.w + bt.w;
      uint2 g = *(const uint2*)(gate16 + off);
      uint2 w; w.x = pack2(h.x * bflo(g.x), h.y * bfhi(g.x)); w.y = pack2(h.z * bflo(g.y), h.w * bfhi(g.y));
      *(uint2*)(hg16 + off) = w;
    }
    if (hout) *(float4*)hout = h;
  }
}

__device__ __forceinline__ int mkkey(float v, int n) {
  int i = __float_as_int(v);
  i ^= (i >> 31) & 0x7fffffff;
  return (i & ~127) | (127 - n);
}
__device__ __forceinline__ float keyval(int k) {
  int i = (k & ~127) | 64;
  i ^= (i >> 31) & 0x7fffffff;
  return __int_as_float(i);
}
__device__ __forceinline__ int keyidx(int k) { return 127 - (k & 127); }
#define CE(i, j) { int hi_ = max(k[i], k[j]); int lo_ = min(k[i], k[j]); k[i] = hi_; k[j] = lo_; }

__device__ void ph_topk(const Params& p, char* smem) {
  const int tid = threadIdx.x, lane = tid & 63, wid = tid >> 6, g = lane >> 4, li = lane & 15;
  const float* s32 = (const float*)(p.ws + OFF_S32);
  int* idx_out = (int*)(p.ws + OFF_IDX);
  float* gate_out = (float*)(p.ws + OFF_PGATE);
  int* tkey = (int*)smem + wid * 256;
  for (int tb = blockIdx.x; tb < 4352; tb += gridDim.x) {
    const int t = tb * 4 + wid;
    const float* srow = s32 + (size_t)t * 2048;
#pragma unroll 1
    for (int ps = 0; ps < 4; ++ps) {
      const int R = ps * 4 + g;
      const float* r = srow + R * 128;
      float4 v0 = *(const float4*)(r + li * 4), v1 = *(const float4*)(r + 64 + li * 4);
      int k[8];
      k[0] = mkkey(v0.x, li * 4 + 0); k[1] = mkkey(v0.y, li * 4 + 1); k[2] = mkkey(v0.z, li * 4 + 2); k[3] = mkkey(v0.w, li * 4 + 3);
      k[4] = mkkey(v1.x, 64 + li * 4 + 0); k[5] = mkkey(v1.y, 64 + li * 4 + 1); k[6] = mkkey(v1.z, 64 + li * 4 + 2); k[7] = mkkey(v1.w, 64 + li * 4 + 3);
      CE(0, 1) CE(2, 3) CE(4, 5) CE(6, 7)
      CE(0, 2) CE(1, 3) CE(4, 6) CE(5, 7)
      CE(1, 2) CE(5, 6)
      CE(0, 4) CE(1, 5) CE(2, 6) CE(3, 7)
      CE(2, 4) CE(3, 5)
      CE(1, 2) CE(3, 4) CE(5, 6)
      int res = (int)0x80000000;
#pragma unroll
      for (int it = 0; it < 16; ++it) {
        const int M = grp_max_i(k[0]);
        const bool win = (k[0] == M);
        if (li == it) res = M;
#pragma unroll
        for (int i = 0; i < 7; ++i) k[i] = win ? k[i + 1] : k[i];
        k[7] = win ? (int)0x80000000 : k[7];
      }
      tkey[R * 16 + li] = res;
    }
    __syncthreads();
#pragma unroll 1
    for (int ps2 = 0; ps2 < 2; ++ps2) {
      const int h = ps2 * 4 + g;
      const int* t0 = tkey + (h * 2) * 16;
      const int* t1 = t0 + 16;
      const float sv0 = keyval(t0[li]);
      int ptr = 0;
      float head = sv0 + keyval(t1[0]);
      float rv = 0.f; int rc = 0;
#pragma unroll 1
      for (int it = 0; it < 16; ++it) {
        const float M = grp_max_f(head);
        const unsigned long long bm = __ballot(head == M);
        const unsigned gm = (unsigned)(bm >> (g * 16)) & 0xffffu;
        const int wl = __ffs(gm) - 1;
        const bool win = (li == wl);
        const int C = grp_max_i(win ? (li * 16 + ptr) : -1);
        if (li == it) { rv = M; rc = C; }
        if (win) {
          ++ptr;
          head = (ptr < 16) ? sv0 + keyval(t1[ptr & 15]) : -3.0e38f;
        }
      }
      const int ia = keyidx(t0[rc >> 4]);
      const int ib = keyidx(t1[rc & 15]);
      const float mx = grp_max_f(rv);
      const float ex = __expf(rv - mx);
      const float sm = grp_sum_f(ex);
      idx_out[(size_t)t * 128 + h * 16 + li] = ia * 128 + ib;
      gate_out[(size_t)t * 128 + h * 16 + li] = ex / sm;
    }
    __syncthreads();
  }
}

__device__ __forceinline__ float dot8(uint4 u, const float* x) {
  float d = bflo(u.x) * x[0];
  d = fmaf(bfhi(u.x), x[1], d);
  d = fmaf(bflo(u.y), x[2], d);
  d = fmaf(bfhi(u.y), x[3], d);
  d = fmaf(bflo(u.z), x[4], d);
  d = fmaf(bfhi(u.z), x[5], d);
  d = fmaf(bflo(u.w), x[6], d);
  d = fmaf(bfhi(u.w), x[7], d);
  return d;
}
__device__ __forceinline__ void axpy8(float w, uint4 u, float* o) {
  o[0] = fmaf(w, bflo(u.x), o[0]); o[1] = fmaf(w, bfhi(u.x), o[1]);
  o[2] = fmaf(w, bflo(u.y), o[2]); o[3] = fmaf(w, bfhi(u.y), o[3]);
  o[4] = fmaf(w, bflo(u.z), o[4]); o[5] = fmaf(w, bfhi(u.z), o[5]);
  o[6] = fmaf(w, bflo(u.w), o[6]); o[7] = fmaf(w, bfhi(u.w), o[7]);
}
__device__ void ph_expert(const Params& p, int layer) {
  const int lane = threadIdx.x & 63, wid = threadIdx.x >> 6;
  u16* xn16 = (u16*)(p.ws + OFF_XN);
  float* xres = (float*)(p.ws + OFF_X);
  const int* idxs = (const int*)(p.ws + OFF_IDX);
  const float* gates = (const float*)(p.ws + OFF_PGATE);
  const u16* U = (const u16*)(p.ws + OFF_U16);
  const u16* V = (const u16*)(p.ws + OFF_V16);
  for (int tb = blockIdx.x; tb < 4352; tb += gridDim.x) {
    const int t = tb * 4 + wid;
    float x[16];
    {
      const uint4* xr = (const uint4*)(xn16 + (size_t)t * 1024);
      uint4 xa = xr[lane], xb = xr[64 + lane];
      x[0] = bflo(xa.x); x[1] = bfhi(xa.x); x[2] = bflo(xa.y); x[3] = bfhi(xa.y);
      x[4] = bflo(xa.z); x[5] = bfhi(xa.z); x[6] = bflo(xa.w); x[7] = bfhi(xa.w);
      x[8] = bflo(xb.x); x[9] = bfhi(xb.x); x[10] = bflo(xb.y); x[11] = bfhi(xb.y);
      x[12] = bflo(xb.z); x[13] = bfhi(xb.z); x[14] = bflo(xb.w); x[15] = bfhi(xb.w);
    }
    const int e_lo = idxs[(size_t)t * 128 + lane], e_hi = idxs[(size_t)t * 128 + 64 + lane];
    const float g_lo = gates[(size_t)t * 128 + lane], g_hi = gates[(size_t)t * 128 + 64 + lane];
    float h_lo = 0.f, h_hi = 0.f;
#pragma unroll 1
    for (int k4 = 0; k4 < 128; k4 += 4) {
      uint4 ua[4], ub[4];
#pragma unroll
      for (int j = 0; j < 4; ++j) {
        const int k = k4 + j;
        const int e = __builtin_amdgcn_readlane(k4 < 64 ? e_lo : e_hi, k & 63);
        const uint4* ur = (const uint4*)(U + (size_t)e * 1024);
        ua[j] = ur[lane]; ub[j] = ur[64 + lane];
      }
#pragma unroll
      for (int j = 0; j < 4; ++j) {
        const int k = k4 + j;
        float d = dot8(ua[j], x) + dot8(ub[j], x + 8);
        d = wave_sum(d);
        if (lane == (k & 63)) { if (k4 < 64) h_lo = d; else h_hi = d; }
      }
    }
    const float w_lo = 0.5f * h_lo * (1.f + erff(h_lo * 0.70710678118654752f)) * g_lo;
    const float w_hi = 0.5f * h_hi * (1.f + erff(h_hi * 0.70710678118654752f)) * g_hi;
    float o[16];
#pragma unroll
    for (int i = 0; i < 16; ++i) o[i] = 0.f;
#pragma unroll 1
    for (int k4 = 0; k4 < 128; k4 += 4) {
      uint4 va[4], vb[4]; float w[4];
#pragma unroll
      for (int j = 0; j < 4; ++j) {
        const int k = k4 + j;
        const int e = __builtin_amdgcn_readlane(k4 < 64 ? e_lo : e_hi, k & 63);
        w[j] = __int_as_float(__builtin_amdgcn_readlane(__float_as_int(k4 < 64 ? w_lo : w_hi), k & 63));
        const uint4* vr = (const uint4*)(V + (size_t)e * 1024);
        va[j] = vr[lane]; vb[j] = vr[64 + lane];
      }
#pragma unroll
      for (int j = 0; j < 4; ++j) { axpy8(w[j], va[j], o); axpy8(w[j], vb[j], o + 8); }
    }
    float* xr = xres + (size_t)t * 1024;
    float4 r0 = *(const float4*)(xr + lane * 8), r1 = *(const float4*)(xr + lane * 8 + 4);
    float4 r2 = *(const float4*)(xr + 512 + lane * 8), r3 = *(const float4*)(xr + 512 + lane * 8 + 4);
    o[0] += r0.x; o[1] += r0.y; o[2] += r0.z; o[3] += r0.w; o[4] += r1.x; o[5] += r1.y; o[6] += r1.z; o[7] += r1.w;
    o[8] += r2.x; o[9] += r2.y; o[10] += r2.z; o[11] += r2.w; o[12] += r3.x; o[13] += r3.y; o[14] += r3.z; o[15] += r3.w;
    float ss = 0.f;
#pragma unroll
    for (int i = 0; i < 16; ++i) ss += o[i] * o[i];
    ss = wave_sum(ss);
    const float rs = rsqrtf(ss * (1.f / 1024.f) + 1e-6f);
    if (layer == 0) {
      *(float4*)(xr + lane * 8) = make_float4(o[0], o[1], o[2], o[3]);
      *(float4*)(xr + lane * 8 + 4) = make_float4(o[4], o[5], o[6], o[7]);
      *(float4*)(xr + 512 + lane * 8) = make_float4(o[8], o[9], o[10], o[11]);
      *(float4*)(xr + 512 + lane * 8 + 4) = make_float4(o[12], o[13], o[14], o[15]);
      uint4 wa, wb;
      wa.x = pack2(o[0] * rs, o[1] * rs); wa.y = pack2(o[2] * rs, o[3] * rs); wa.z = pack2(o[4] * rs, o[5] * rs); wa.w = pack2(o[6] * rs, o[7] * rs);
      wb.x = pack2(o[8] * rs, o[9] * rs); wb.y = pack2(o[10] * rs, o[11] * rs); wb.z = pack2(o[12] * rs, o[13] * rs); wb.w = pack2(o[14] * rs, o[15] * rs);
      uint4* xw = (uint4*)(xn16 + (size_t)t * 1024);
      xw[lane] = wa; xw[64 + lane] = wb;
    } else {
      const float* fg = p.final_norm;
      float4 g0 = *(const float4*)(fg + lane * 8), g1 = *(const float4*)(fg + lane * 8 + 4);
      float4 g2 = *(const float4*)(fg + 512 + lane * 8), g3 = *(const float4*)(fg + 512 + lane * 8 + 4);
      float* y = p.out + OUT_Y + (size_t)t * 1024;
      *(float4*)(y + lane * 8) = make_float4(o[0] * rs * g0.x, o[1] * rs * g0.y, o[2] * rs * g0.z, o[3] * rs * g0.w);
      *(float4*)(y + lane * 8 + 4) = make_float4(o[4] * rs * g1.x, o[5] * rs * g1.y, o[6] * rs * g1.z, o[7] * rs * g1.w);
      *(float4*)(y + 512 + lane * 8) = make_float4(o[8] * rs * g2.x, o[9] * rs * g2.y, o[10] * rs * g2.z, o[11] * rs * g2.w);
      *(float4*)(y + 512 + lane * 8 + 4) = make_float4(o[12] * rs * g3.x, o[13] * rs * g3.y, o[14] * rs * g3.z, o[15] * rs * g3.w);
    }
  }
}

__device__ void ph_attn(const Params& p, char* smem) {
  const int tid = threadIdx.x, lane = tid & 63, wid = tid >> 6, fr = lane & 15, fq = lane >> 4;
  const u16* k16 = (const u16*)(p.ws + OFF_K16);
  const u16* v16 = (const u16*)(p.ws + OFF_V16A);
  const u16* q16 = (const u16*)(p.ws + OFF_Q16);
  u16* o16 = (u16*)(p.ws + OFF_O16);
  u16* Ks = (u16*)smem;
  u16* Vt = (u16*)(smem + 27648);
  for (int item = blockIdx.x; item < 1536; item += gridDim.x) {
    const bool is_p = item < 1024;
    int b, kvh, q0 = 0, nsub, nvalid, kpos0, minpos, tokbase;
    if (is_p) { b = item >> 7; kvh = (item >> 5) & 3; q0 = (item & 31) * 64; nsub = 4; nvalid = 192; kpos0 = q0 - 128; minpos = 0; tokbase = b * 2048; }
    else { int it2 = item - 1024; b = it2 >> 2; kvh = it2 & 3; nsub = 1; nvalid = 136; kpos0 = -128; minpos = -100000; tokbase = NTP + b * 8; }
    __syncthreads();
    for (int c = tid; c < 1536; c += 256) {
      const int j = c >> 3, ch = c & 7;
      uint4 kk = make_uint4(0, 0, 0, 0), vv = make_uint4(0, 0, 0, 0);
      if (is_p) {
        const int kp = kpos0 + j;
        if (kp >= 0) {
          const size_t off = (size_t)(tokbase + kp) * 256 + kvh * 64 + ch * 8;
          kk = *(const uint4*)(k16 + off); vv = *(const uint4*)(v16 + off);
        }
      } else {
        if (j < 128) {
          const size_t off = ((size_t)(b * 128 + j) * 4 + kvh) * 64 + ch * 8;
          float4 a0 = *(const float4*)(p.cache_k + off), a1 = *(const float4*)(p.cache_k + off + 4);
          float4 c0 = *(const float4*)(p.cache_v + off), c1 = *(const float4*)(p.cache_v + off + 4);
          kk.x = pack2(a0.x, a0.y); kk.y = pack2(a0.z, a0.w); kk.z = pack2(a1.x, a1.y); kk.w = pack2(a1.z, a1.w);
          vv.x = pack2(c0.x, c0.y); vv.y = pack2(c0.z, c0.w); vv.z = pack2(c1.x, c1.y); vv.w = pack2(c1.z, c1.w);
        } else if (j < 136) {
          const size_t off = (size_t)(tokbase + j - 128) * 256 + kvh * 64 + ch * 8;
          kk = *(const uint4*)(k16 + off); vv = *(const uint4*)(v16 + off);
        }
      }
      *(uint4*)(Ks + j * 72 + ch * 8) = kk;
      u16* vd = Vt + (ch * 8) * 200 + j;
      vd[0] = (u16)(vv.x & 0xffff); vd[200] = (u16)(vv.x >> 16);
      vd[400] = (u16)(vv.y & 0xffff); vd[600] = (u16)(vv.y >> 16);
      vd[800] = (u16)(vv.z & 0xffff); vd[1000] = (u16)(vv.z >> 16);
      vd[1200] = (u16)(vv.w & 0xffff); vd[1400] = (u16)(vv.w >> 16);
    }
    __syncthreads();
    const int head = kvh * 4 + wid;
    const float sink = p.sinks[head];
#pragma unroll 1
    for (int sub = 0; sub < nsub; ++sub) {
      int qtok, qp;
      if (is_p) { qp = q0 + sub * 16 + fr; qtok = tokbase + qp; }
      else { qp = fr & 7; qtok = tokbase + (fr & 7); }
      const u16* qrow = q16 + (size_t)qtok * 1024 + head * 64;
      const bf16x8 qf0 = *(const bf16x8*)(qrow + fq * 8);
      const bf16x8 qf1 = *(const bf16x8*)(qrow + 32 + fq * 8);
      f32x4 s[12];
#pragma unroll
      for (int ks = 0; ks < 12; ++ks) {
        const bf16x8 kf0 = *(const bf16x8*)(Ks + (ks * 16 + fr) * 72 + fq * 8);
        const bf16x8 kf1 = *(const bf16x8*)(Ks + (ks * 16 + fr) * 72 + 32 + fq * 8);
        f32x4 z = {0.f, 0.f, 0.f, 0.f};
        z = __builtin_amdgcn_mfma_f32_16x16x32_bf16(kf0, qf0, z, 0, 0, 0);
        s[ks] = __builtin_amdgcn_mfma_f32_16x16x32_bf16(kf1, qf1, z, 0, 0, 0);
        if ((ks & 3) == 3) __builtin_amdgcn_sched_barrier(0);
      }
      float mx = sink;
#pragma unroll
      for (int ks = 0; ks < 12; ++ks)
#pragma unroll
        for (int j = 0; j < 4; ++j) {
          const int jj = ks * 16 + fq * 4 + j;
          const int kp = kpos0 + jj;
          const bool valid = (jj < nvalid) && (kp >= minpos) && (kp <= qp) && (qp - kp < 128);
          const float v = valid ? s[ks][j] : -1.0e30f;
          s[ks][j] = v;
          mx = fmaxf(mx, v);
        }
      mx = fmaxf(mx, __shfl_xor(mx, 16));
      mx = fmaxf(mx, __shfl_xor(mx, 32));
      float sum = 0.f;
#pragma unroll
      for (int ks = 0; ks < 12; ++ks)
#pragma unroll
        for (int j = 0; j < 4; ++j) {
          const float pv = (s[ks][j] > -1.0e29f) ? __expf(s[ks][j] - mx) : 0.f;
          s[ks][j] = pv;
          sum += pv;
        }
      sum += __shfl_xor(sum, 16);
      sum += __shfl_xor(sum, 32);
      sum += __expf(sink - mx);
      const float inv = 1.f / sum;
      f32x4 o[4];
#pragma unroll
      for (int d = 0; d < 4; ++d) o[d] = f32x4{0.f, 0.f, 0.f, 0.f};
#pragma unroll
      for (int kk = 0; kk < 6; ++kk) {
        union { bf16x8 v; unsigned u[4]; } pb;
        pb.u[0] = pack2(s[2 * kk][0], s[2 * kk][1]); pb.u[1] = pack2(s[2 * kk][2], s[2 * kk][3]);
        pb.u[2] = pack2(s[2 * kk + 1][0], s[2 * kk + 1][1]); pb.u[3] = pack2(s[2 * kk + 1][2], s[2 * kk + 1][3]);
#pragma unroll
        for (int d = 0; d < 4; ++d) {
          union { bf16x8 v; uint2 h[2]; } vf;
          const u16* vr = Vt + (d * 16 + fr) * 200 + fq * 4;
          vf.h[0] = *(const uint2*)(vr + (2 * kk) * 16);
          vf.h[1] = *(const uint2*)(vr + (2 * kk + 1) * 16);
          o[d] = __builtin_amdgcn_mfma_f32_16x16x32_bf16(vf.v, pb.v, o[d], 0, 0, 0);
        }
        __builtin_amdgcn_sched_barrier(0);
      }
      if (is_p || fr < 8) {
#pragma unroll
        for (int d = 0; d < 4; ++d) {
          uint2 w; w.x = pack2(o[d][0] * inv, o[d][1] * inv); w.y = pack2(o[d][2] * inv, o[d][3] * inv);
          *(uint2*)(o16 + (size_t)qtok * 1024 + head * 64 + d * 16 + fq * 4) = w;
        }
      }
    }
  }
}

template <int ph>
__device__ __forceinline__ void run_phase(const Params& p, char* smem) {
  char* ws = p.ws;
  switch (ph) {
    case 0: ph_convert0(p, smem); break;
    case 1: {
      EpiWin e{(u16*)(ws + OFF_GATE16), (float*)(ws + OFF_REC32)};
      gemm_tiles((const u16*)(ws + OFF_XN), 1024, (const u16*)(ws + OFF_WT_IN), 1024, 1024, 0, 16, e, smem);
    } break;
    case 2: ph_conv(p); break;
    case 3: {
      EpiBd e{(float*)(ws + OFF_LOGA), (u16*)(ws + OFF_IG16), p.rg_ba, p.rg_bx, p.rg_lambda};
      gemm_tiles((const u16*)(ws + OFF_XC16), 1024, (const u16*)(ws + OFF_WT_BD), 128, 128, 8, 16, e, smem);
    } break;
    case 4: ph_scanA(p); break;
    case 5: ph_scanB(p); break;
    case 6: {
      EpiResid e{&p, (float*)(ws + OFF_X), 1};
      gemm_tiles((const u16*)(ws + OFF_HG16), 1024, (const u16*)(ws + OFF_WT_OUT), 1024, 1024, 0, 8, e, smem);
      ph_cvt_tables(p, 0);
    } break;
    case 7: ph_rmsnorm(p, p.ffn_norm); break;
    case 8: case 16: {
      EpiBf16 e{(u16*)(ws + OFF_QP16), 2048};
      gemm_tiles((const u16*)(ws + OFF_XN), 1024, (const u16*)(ws + (ph == 8 ? OFF_WT_PQ0 : OFF_WT_PQ1)), 1024, 1024, 0, 16, e, smem);
    } break;
    case 9: case 17: {
      EpiF32 e{(float*)(ws + OFF_S32), 2048};
      gemm_tiles((const u16*)(ws + OFF_QP16), 2048, (const u16*)(ws + (ph == 9 ? OFF_WT_SK0 : OFF_WT_SK1)), 128, 128, 16, 16, e, smem);
    } break;
    case 10: case 18: ph_topk(p, smem); break;
    case 11: ph_expert(p, 0); break;
    case 12: {
      EpiKvq e{(u16*)(ws + OFF_K16), (u16*)(ws + OFF_V16A), (u16*)(ws + OFF_Q16), (const float2*)(ws + OFF_ROPE), p.out};
      gemm_tiles((const u16*)(ws + OFF_XN), 1024, (const u16*)(ws + OFF_WT_KVQ), 1024, 1024, 0, 12, e, smem);
      ph_cvt_tables(p, 1);
    } break;
    case 13: ph_attn(p, smem); break;
    case 14: {
      EpiResid e{&p, (float*)(ws + OFF_X), 0};
      gemm_tiles((const u16*)(ws + OFF_O16), 1024, (const u16*)(ws + OFF_WT_O), 1024, 1024, 0, 8, e, smem);
    } break;
    case 15: ph_rmsnorm(p, p.ffn_norm + 1024); break;
    case 19: ph_expert(p, 1); break;
    default: break;
  }
}

__global__ void __launch_bounds__(256, 2) yoco_megakernel(Params p) {
  __shared__ __attribute__((aligned(16))) char smem[73728];
  cg::grid_group grid = cg::this_grid();
#define PH(k) if (p.ph_begin <= k && k < p.ph_end) { run_phase<k>(p, smem); if (k + 1 < p.ph_end) grid.sync(); }
  PH(0) PH(1) PH(2) PH(3) PH(4) PH(5) PH(6) PH(7) PH(8) PH(9)
  PH(10) PH(11) PH(12) PH(13) PH(14) PH(15) PH(16) PH(17) PH(18) PH(19)
}

extern "C" void kernel_launch(void* const* d_in, const int* in_sizes, int n_in, void* d_out, int out_size,
                              void* d_ws, size_t ws_size, hipStream_t stream) {
  static int grid_blocks = 0;
  if (!grid_blocks) {
    int dev = 0, cus = 0, per_cu = 0;
    hipGetDevice(&dev);
    hipDeviceGetAttribute(&cus, hipDeviceAttributeMultiprocessorCount, dev);
    hipOccupancyMaxActiveBlocksPerMultiprocessor(&per_cu, yoco_megakernel, 256, 0);
    if (per_cu > 2) per_cu = 2;
    if (per_cu < 1) per_cu = 1;
    grid_blocks = cus * per_cu;
    if (ws_size < WS_NEEDED) fprintf(stderr, "workspace too small: %zu < %llu\n", ws_size, (unsigned long long)WS_NEEDED);
  }
  Params p{};
  const float** f = (const float**)&p;
  for (int i = 0; i < 28; ++i) f[i] = (const float*)d_in[i];
  p.out = (float*)d_out;
  p.ws = (char*)d_ws;
#if MULTI_LAUNCH
  for (int ph = 0; ph < NPHASE; ++ph) {
    p.ph_begin = ph; p.ph_end = ph + 1;
    hipLaunchKernelGGL(yoco_megakernel, dim3(grid_blocks), dim3(256), 0, stream, p);
  }
#else
  p.ph_begin = 0; p.ph_end = NPHASE;
  void* args[] = {&p};
  hipError_t e = hipLaunchCooperativeKernel((void*)yoco_megakernel, dim3(grid_blocks), dim3(256), args, 0, stream);
  if (e != hipSuccess) fprintf(stderr, "cooperative launch failed: %s (grid %d)\n", hipGetErrorString(e), grid_blocks);
#endif
}
```

```cpp
#include <hip/hip_runtime.h>
#include <hip/hip_cooperative_groups.h>
#include <cstdio>
#include <cstdint>
namespace cg = cooperative_groups;

typedef unsigned short u16;
typedef __attribute__((ext_vector_type(8))) short bf16x8;
typedef __attribute__((ext_vector_type(4))) float f32x4;

#define NTOK 17408
#define NTP 16384
#define MIB 1048576ull
#define NPHASE 20
#ifndef MULTI_LAUNCH
#define MULTI_LAUNCH 0
#endif

#define OFF_WT_IN   (0 * MIB)
#define OFF_WT_OUT  (4 * MIB)
#define OFF_WT_BD   (6 * MIB)
#define OFF_WT_PQ0  (7 * MIB)
#define OFF_WT_PQ1  (11 * MIB)
#define OFF_WT_KVQ  (15 * MIB)
#define OFF_WT_O    (18 * MIB)
#define OFF_WT_SK0  (20 * MIB)
#define OFF_WT_SK1  (20 * MIB + 524288ull)
#define OFF_ROPE    (21 * MIB)
#define OFF_USC     (21 * MIB + 655360ull)
#define OFF_VSC     (21 * MIB + 655360ull + 65536ull)
#define OFF_U8      (22 * MIB)
#define OFF_V8      (38 * MIB)
#define OFF_XN      (86 * MIB)
#define OFF_X       (120 * MIB)
#define OFF_GATE16  (188 * MIB)
#define OFF_REC32   (222 * MIB)
#define OFF_XC32    (290 * MIB)
#define OFF_XC16    (358 * MIB)
#define OFF_LOGA    (222 * MIB)
#define OFF_IG16    (22 * MIB)
#define OFF_AGGA    (56 * MIB)
#define OFF_AGGB    (57 * MIB)
#define OFF_HG16    (358 * MIB)
#define OFF_QP16    (188 * MIB)
#define OFF_S32     (256 * MIB)
#define OFF_IDX     (188 * MIB)
#define OFF_PGATE   (197 * MIB)
#define OFF_K16     (188 * MIB)
#define OFF_V16A    (197 * MIB)
#define OFF_Q16     (206 * MIB)
#define OFF_O16     (240 * MIB)
#define WS_NEEDED   (392 * MIB)

#define OUT_Y      0
#define OUT_CONVP  17825792
#define OUT_HP     17850368
#define OUT_KP     17858560
#define OUT_VP     18120704
#define OUT_CONVS  18382848
#define OUT_HS     18776064
#define OUT_KS     18907136
#define OUT_VS     23101440

struct Params {
  const float *x_prompt, *x_sample, *state_conv, *state_h, *cache_k, *cache_v;
  const float *rg_norm, *rg_w_in, *rg_conv_w, *rg_conv_b, *rg_wa, *rg_ba, *rg_wx, *rg_bx, *rg_lambda, *rg_w_out;
  const float *kv_norm, *w_kv, *attn_norm, *w_q, *sinks, *w_o, *ffn_norm, *peer_wq, *peer_subkeys, *peer_u, *peer_v, *final_norm;
  float* out;
  char* ws;
  int ph_begin, ph_end;
};

__device__ __forceinline__ u16 f2bf(float f) {
  unsigned u = __float_as_uint(f);
  u += 0x7fffu + ((u >> 16) & 1u);
  return (u16)(u >> 16);
}
__device__ __forceinline__ float bf2f(u16 h) { return __uint_as_float(((unsigned)h) << 16); }
__device__ __forceinline__ unsigned pack2(float a, float b) { return (unsigned)f2bf(a) | ((unsigned)f2bf(b) << 16); }
__device__ __forceinline__ float bflo(unsigned u) { return __uint_as_float(u << 16); }
__device__ __forceinline__ float bfhi(unsigned u) { return __uint_as_float(u & 0xffff0000u); }
__device__ __forceinline__ float wave_sum(float v) {
#pragma unroll
  for (int o = 32; o > 0; o >>= 1) v += __shfl_xor(v, o);
  return v;
}
__device__ __forceinline__ const float* xin_row(const Params& p, int token) {
  return token < NTP ? p.x_prompt + (size_t)token * 1024 : p.x_sample + (size_t)(token - NTP) * 1024;
}
__device__ __forceinline__ float gelu_tanh(float x) {
  float u = 0.7978845608028654f * (x + 0.044715f * x * x * x);
  float e = __expf(2.f * u);
  float th = 1.f - 2.f / (e + 1.f);
  return 0.5f * x * (1.f + th);
}
__device__ __forceinline__ float sigmoidf_(float x) { return 1.f / (1.f + __expf(-x)); }

template <int CTRL>
__device__ __forceinline__ int dpp_i(int v) { return __builtin_amdgcn_update_dpp(v, v, CTRL, 0xf, 0xf, false); }
__device__ __forceinline__ int grp_max_i(int v) {
  v = max(v, dpp_i<0xB1>(v));
  v = max(v, dpp_i<0x4E>(v));
  v = max(v, dpp_i<0x141>(v));
  v = max(v, dpp_i<0x140>(v));
  return v;
}
__device__ __forceinline__ float grp_max_f(float v) {
  v = fmaxf(v, __int_as_float(dpp_i<0xB1>(__float_as_int(v))));
  v = fmaxf(v, __int_as_float(dpp_i<0x4E>(__float_as_int(v))));
  v = fmaxf(v, __int_as_float(dpp_i<0x141>(__float_as_int(v))));
  v = fmaxf(v, __int_as_float(dpp_i<0x140>(__float_as_int(v))));
  return v;
}
__device__ __forceinline__ float grp_sum_f(float v) {
  v += __int_as_float(dpp_i<0xB1>(__float_as_int(v)));
  v += __int_as_float(dpp_i<0x4E>(__float_as_int(v)));
  v += __int_as_float(dpp_i<0x141>(__float_as_int(v)));
  v += __int_as_float(dpp_i<0x140>(__float_as_int(v)));
  return v;
}

__device__ void transpose_unit(const float* __restrict__ src, int ld_src, u16* __restrict__ dst, int ld_dst,
                               int kt, int nt, const float* __restrict__ gain, float* lds) {
  const int tid = threadIdx.x;
#pragma unroll
  for (int j = 0; j < 4; ++j) {
    int idx = tid + j * 256;
    int k = idx >> 4, c4 = idx & 15;
    float4 v = *(const float4*)(src + (size_t)(kt * 64 + k) * ld_src + nt * 64 + c4 * 4);
    float g = gain ? gain[kt * 64 + k] : 1.f;
    float* d = lds + k * 65 + c4 * 4;
    d[0] = v.x * g; d[1] = v.y * g; d[2] = v.z * g; d[3] = v.w * g;
  }
  __syncthreads();
#pragma unroll
  for (int j = 0; j < 2; ++j) {
    int c = tid + j * 256;
    int n = c >> 3, kc = c & 7;
    uint4 o;
    o.x = pack2(lds[(kc * 8 + 0) * 65 + n], lds[(kc * 8 + 1) * 65 + n]);
    o.y = pack2(lds[(kc * 8 + 2) * 65 + n], lds[(kc * 8 + 3) * 65 + n]);
    o.z = pack2(lds[(kc * 8 + 4) * 65 + n], lds[(kc * 8 + 5) * 65 + n]);
    o.w = pack2(lds[(kc * 8 + 6) * 65 + n], lds[(kc * 8 + 7) * 65 + n]);
    *(uint4*)(dst + (size_t)(nt * 64 + n) * ld_dst + kt * 64 + kc * 8) = o;
  }
  __syncthreads();
}

__device__ void transpose_job(const Params& p, int u, float* lds) {
  char* ws = p.ws;
  if (u < 512) { transpose_unit(p.rg_w_in, 2048, (u16*)(ws + OFF_WT_IN), 1024, u >> 5, u & 31, nullptr, lds); return; }
  u -= 512;
  if (u < 256) { transpose_unit(p.rg_w_out, 1024, (u16*)(ws + OFF_WT_OUT), 1024, u >> 4, u & 15, nullptr, lds); return; }
  u -= 256;
  if (u < 64) {
    int which = u >> 5; int r = u & 31; int bi = r >> 2; int t = r & 3;
    const float* src = (which ? p.rg_wx : p.rg_wa) + (size_t)bi * 16384;
    u16* dst = (u16*)(ws + OFF_WT_BD) + (size_t)(which * 1024 + bi * 128) * 128;
    transpose_unit(src, 128, dst, 128, t >> 1, t & 1, nullptr, lds); return;
  }
  u -= 64;
  if (u < 1024) {
    int l = u >> 9; int r = u & 511;
    transpose_unit(p.peer_wq + (size_t)l * 2097152, 2048, (u16*)(ws + (l ? OFF_WT_PQ1 : OFF_WT_PQ0)), 1024, r >> 5, r & 31, nullptr, lds); return;
  }
  u -= 1024;
  if (u < 128) { transpose_unit(p.w_kv, 512, (u16*)(ws + OFF_WT_KVQ), 1024, u >> 3, u & 7, p.kv_norm, lds); return; }
  u -= 128;
  if (u < 256) { transpose_unit(p.w_q, 1024, (u16*)(ws + OFF_WT_KVQ) + (size_t)512 * 1024, 1024, u >> 4, u & 15, p.attn_norm, lds); return; }
  u -= 256;
  transpose_unit(p.w_o, 1024, (u16*)(ws + OFF_WT_O), 1024, u >> 4, u & 15, nullptr, lds);
}

__device__ __forceinline__ void cvt_unit(const float* __restrict__ src, u16* __restrict__ dst, size_t base) {
  const int tid = threadIdx.x;
#pragma unroll
  for (int j = 0; j < 2; ++j) {
    size_t o = base + j * 1024 + tid * 4;
    float4 v = *(const float4*)(src + o);
    uint2 w; w.x = pack2(v.x, v.y); w.y = pack2(v.z, v.w);
    *(uint2*)(dst + o) = w;
  }
}

__device__ __forceinline__ void rmsnorm_row(const float* __restrict__ x, const float* __restrict__ g, u16* __restrict__ o, int lane) {
  float4 v[4];
  float ss = 0.f;
#pragma unroll
  for (int i = 0; i < 4; ++i) {
    v[i] = *(const float4*)(x + i * 256 + lane * 4);
    ss += v[i].x * v[i].x + v[i].y * v[i].y + v[i].z * v[i].z + v[i].w * v[i].w;
  }
  ss = wave_sum(ss);
  float r = rsqrtf(ss * (1.f / 1024.f) + 1e-6f);
#pragma unroll
  for (int i = 0; i < 4; ++i) {
    float4 gg = *(const float4*)(g + i * 256 + lane * 4);
    uint2 w; w.x = pack2(v[i].x * r * gg.x, v[i].y * r * gg.y); w.y = pack2(v[i].z * r * gg.z, v[i].w * r * gg.w);
    *(uint2*)(o + i * 256 + lane * 4) = w;
  }
}

__device__ void ph_convert0(const Params& p, char* smem) {
  const int tid = threadIdx.x, lane = tid & 63, wid = tid >> 6;
  const int NT = 2496, NSK = 256, NROPE = 257, NRMS = 4352, NCACHE = 3840;
  const int total = NT + NSK + NROPE + NRMS + NCACHE;
  for (int u0 = blockIdx.x; u0 < total; u0 += gridDim.x) {
    int u = u0;
    if (u < NT) { transpose_job(p, u, (float*)smem); continue; }
    u -= NT;
    if (u < NSK) {
      int l = u >> 7; int r = u & 127;
      const float* src = p.peer_subkeys + (size_t)l * 32768;
      u16* dst = (u16*)(p.ws + (l ? OFF_WT_SK1 : OFF_WT_SK0));
#pragma unroll
      for (int j = 0; j < 2; ++j) {
        int i = r * 2048 + j * 1024 + tid * 4;
        int s = ((i >> 14) & 1) * 16384 + (i & 16383);
        float4 v = *(const float4*)(src + s);
        uint2 w; w.x = pack2(v.x, v.y); w.y = pack2(v.z, v.w);
        *(uint2*)(dst + i) = w;
      }
      continue;
    }
    u -= NSK;
    if (u < NROPE) {
      int i = u * 256 + tid;
      if (i < 2056 * 32) {
        int pi = i >> 5, d = i & 31;
        int pos = pi < 2048 ? pi : (16384 + pi - 2048);
        float inv = (float)pow(10000.0, -(double)d / 32.0);
        float ang = (float)pos * inv;
        double sn, cs;
        sincos((double)ang, &sn, &cs);
        float2* rt = (float2*)(p.ws + OFF_ROPE);
        rt[i] = make_float2((float)cs, (float)sn);
      }
      continue;
    }
    u -= NROPE;
    if (u < NRMS) {
      int t = u * 4 + wid;
      rmsnorm_row(xin_row(p, t), p.rg_norm, (u16*)(p.ws + OFF_XN) + (size_t)t * 1024, lane);
      continue;
    }
    u -= NRMS;
    {
      int which = u / 1920; int r = u - which * 1920;
      int b = r / 15, c = r - b * 15;
      const float* src = (which ? p.cache_v : p.cache_k) + (size_t)b * 32768 + 2048 + c * 2048;
      float* dst = p.out + (which ? OUT_VS : OUT_KS) + (size_t)b * 32768 + c * 2048;
#pragma unroll
      for (int j = 0; j < 2; ++j) {
        int o = j * 1024 + tid * 4;
        *(float4*)(dst + o) = *(const float4*)(src + o);
      }
    }
  }
}

__device__ void ph_cvt_tables(const Params& p, int layer) {
  const int lane = threadIdx.x & 63, wid = threadIdx.x >> 6;
  for (int u = blockIdx.x; u < 8192; u += gridDim.x) {
    const int which = u >> 12; const int row = (u & 4095) * 4 + wid;
    const float* src = (which ? p.peer_v : p.peer_u) + (size_t)layer * 16777216 + (size_t)row * 1024 + lane * 16;
    unsigned char* dst = (unsigned char*)(p.ws + (which ? OFF_V8 : OFF_U8)) + (size_t)row * 1024 + lane * 16;
    float* sc = (float*)(p.ws + (which ? OFF_VSC : OFF_USC));
    float4 a = *(const float4*)(src), b = *(const float4*)(src + 4), c = *(const float4*)(src + 8), d = *(const float4*)(src + 12);
    float m = fmaxf(fmaxf(fmaxf(fabsf(a.x), fabsf(a.y)), fmaxf(fabsf(a.z), fabsf(a.w))), fmaxf(fmaxf(fabsf(b.x), fabsf(b.y)), fmaxf(fabsf(b.z), fabsf(b.w))));
    m = fmaxf(m, fmaxf(fmaxf(fmaxf(fabsf(c.x), fabsf(c.y)), fmaxf(fabsf(c.z), fabsf(c.w))), fmaxf(fmaxf(fabsf(d.x), fabsf(d.y)), fmaxf(fabsf(d.z), fabsf(d.w)))));
#pragma unroll
    for (int o = 32; o > 0; o >>= 1) m = fmaxf(m, __shfl_xor(m, o));
    const float scl = m > 0.f ? 440.f / m : 1.f;
    uint4 w; int t;
    t = 0; t = __builtin_amdgcn_cvt_pk_fp8_f32(a.x * scl, a.y * scl, t, false); t = __builtin_amdgcn_cvt_pk_fp8_f32(a.z * scl, a.w * scl, t, true); w.x = (unsigned)t;
    t = 0; t = __builtin_amdgcn_cvt_pk_fp8_f32(b.x * scl, b.y * scl, t, false); t = __builtin_amdgcn_cvt_pk_fp8_f32(b.z * scl, b.w * scl, t, true); w.y = (unsigned)t;
    t = 0; t = __builtin_amdgcn_cvt_pk_fp8_f32(c.x * scl, c.y * scl, t, false); t = __builtin_amdgcn_cvt_pk_fp8_f32(c.z * scl, c.w * scl, t, true); w.z = (unsigned)t;
    t = 0; t = __builtin_amdgcn_cvt_pk_fp8_f32(d.x * scl, d.y * scl, t, false); t = __builtin_amdgcn_cvt_pk_fp8_f32(d.z * scl, d.w * scl, t, true); w.w = (unsigned)t;
    *(uint4*)dst = w;
    if (lane == 0) sc[row] = m > 0.f ? m / 440.f : 1.f;
  }
}

__device__ void ph_rmsnorm(const Params& p, const float* g) {
  const int lane = threadIdx.x & 63, wid = threadIdx.x >> 6;
  const float* x = (const float*)(p.ws + OFF_X);
  u16* xn = (u16*)(p.ws + OFF_XN);
  for (int u = blockIdx.x; u < 4352; u += gridDim.x) {
    int t = u * 4 + wid;
    rmsnorm_row(x + (size_t)t * 1024, g, xn + (size_t)t * 1024, lane);
  }
}

template <class Epi>
__device__ __forceinline__ void gemm_tiles(const u16* __restrict__ A, int lda, const u16* __restrict__ W, int ldw,
                                           int K, int kmod, int ntn, const Epi& epi, char* smem) {
  const int tid = threadIdx.x, lane = tid & 63, wid = tid >> 6;
  const int wr = wid >> 1, wc = wid & 1, fr = lane & 15, fq = lane >> 4;
  const int ld_row = tid >> 3, ld_ch = tid & 7;
  const int total = 136 * ntn;
  const int nk = K >> 6;
  for (int tile = blockIdx.x; tile < total; tile += gridDim.x) {
    const int tm = tile / ntn, tn = tile - tm * ntn;
    const u16* Ag = A + (size_t)(tm * 128 + ld_row) * lda + (kmod ? (tn % kmod) * 128 : 0) + ld_ch * 8;
    const u16* Wg = W + (size_t)(tn * 128 + ld_row) * ldw + ld_ch * 8;
    f32x4 acc[4][4];
#pragma unroll
    for (int m = 0; m < 4; ++m)
#pragma unroll
      for (int n = 0; n < 4; ++n) acc[m][n] = f32x4{0.f, 0.f, 0.f, 0.f};
    uint4 ra[4], rw[4];
#pragma unroll
    for (int i = 0; i < 4; ++i) {
      ra[i] = *(const uint4*)(Ag + (size_t)(i * 32) * lda);
      rw[i] = *(const uint4*)(Wg + (size_t)(i * 32) * ldw);
    }
    {
      char* sW = smem; char* sA = smem + 18432;
#pragma unroll
      for (int i = 0; i < 4; ++i) {
        *(uint4*)(sW + (ld_row + i * 32) * 144 + ld_ch * 16) = rw[i];
        *(uint4*)(sA + (ld_row + i * 32) * 144 + ld_ch * 16) = ra[i];
      }
    }
    __syncthreads();
    for (int kt = 0; kt < nk; ++kt) {
      const int cur = kt & 1;
      const bool more = (kt + 1 < nk);
      if (more) {
        const int k0 = (kt + 1) * 64;
#pragma unroll
        for (int i = 0; i < 4; ++i) {
          ra[i] = *(const uint4*)(Ag + (size_t)(i * 32) * lda + k0);
          rw[i] = *(const uint4*)(Wg + (size_t)(i * 32) * ldw + k0);
        }
      }
      const char* sW = smem + cur * 36864;
      const char* sA = sW + 18432;
#pragma unroll
      for (int ks = 0; ks < 2; ++ks) {
        bf16x8 a[4], b[4];
#pragma unroll
        for (int m = 0; m < 4; ++m) a[m] = *(const bf16x8*)(sW + (wr * 64 + m * 16 + fr) * 144 + ks * 64 + fq * 16);
#pragma unroll
        for (int n = 0; n < 4; ++n) b[n] = *(const bf16x8*)(sA + (wc * 64 + n * 16 + fr) * 144 + ks * 64 + fq * 16);
#pragma unroll
        for (int m = 0; m < 4; ++m)
#pragma unroll
          for (int n = 0; n < 4; ++n) acc[m][n] = __builtin_amdgcn_mfma_f32_16x16x32_bf16(a[m], b[n], acc[m][n], 0, 0, 0);
      }
      if (more) {
        char* dW = smem + (cur ^ 1) * 36864; char* dA = dW + 18432;
#pragma unroll
        for (int i = 0; i < 4; ++i) {
          *(uint4*)(dW + (ld_row + i * 32) * 144 + ld_ch * 16) = rw[i];
          *(uint4*)(dA + (ld_row + i * 32) * 144 + ld_ch * 16) = ra[i];
        }
      }
      __syncthreads();
    }
    epi(acc, tm * 128 + wc * 64, tn * 128 + wr * 64, fr, fq);
  }
}

struct EpiWin {
  u16* gate16; float* rec32;
  __device__ __forceinline__ void operator()(const f32x4 (&acc)[4][4], int tok0, int feat0, int fr, int fq) const {
#pragma unroll
    for (int n = 0; n < 4; ++n) {
      const int tok = tok0 + n * 16 + fr;
#pragma unroll
      for (int m = 0; m < 4; ++m) {
        const int f = feat0 + m * 16 + fq * 4;
        f32x4 v = acc[m][n];
        if (feat0 < 1024) {
          uint2 w; w.x = pack2(gelu_tanh(v[0]), gelu_tanh(v[1])); w.y = pack2(gelu_tanh(v[2]), gelu_tanh(v[3]));
          *(uint2*)(gate16 + (size_t)tok * 1024 + f) = w;
        } else {
          *(float4*)(rec32 + (size_t)tok * 1024 + (f - 1024)) = make_float4(v[0], v[1], v[2], v[3]);
        }
      }
    }
  }
};
struct EpiBd {
  float* loga; u16* ig16; const float *ba, *bx, *lam;
  __device__ __forceinline__ void operator()(const f32x4 (&acc)[4][4], int tok0, int feat0, int fr, int fq) const {
#pragma unroll
    for (int m = 0; m < 4; ++m) {
      const int f = feat0 + m * 16 + fq * 4;
      if (feat0 < 1024) {
        float4 b4 = *(const float4*)(ba + f);
        float4 l4 = *(const float4*)(lam + f);
        float sp0 = log1pf(__expf(-l4.x)), sp1 = log1pf(__expf(-l4.y)), sp2 = log1pf(__expf(-l4.z)), sp3 = log1pf(__expf(-l4.w));
#pragma unroll
        for (int n = 0; n < 4; ++n) {
          const int tok = tok0 + n * 16 + fr;
          f32x4 v = acc[m][n];
          float4 o;
          o.x = -8.f * sigmoidf_(v[0] + b4.x) * sp0;
          o.y = -8.f * sigmoidf_(v[1] + b4.y) * sp1;
          o.z = -8.f * sigmoidf_(v[2] + b4.z) * sp2;
          o.w = -8.f * sigmoidf_(v[3] + b4.w) * sp3;
          *(float4*)(loga + (size_t)tok * 1024 + f) = o;
        }
      } else {
        float4 b4 = *(const float4*)(bx + (f - 1024));
#pragma unroll
        for (int n = 0; n < 4; ++n) {
          const int tok = tok0 + n * 16 + fr;
          f32x4 v = acc[m][n];
          uint2 w;
          w.x = pack2(sigmoidf_(v[0] + b4.x), sigmoidf_(v[1] + b4.y));
          w.y = pack2(sigmoidf_(v[2] + b4.z), sigmoidf_(v[3] + b4.w));
          *(uint2*)(ig16 + (size_t)tok * 1024 + (f - 1024)) = w;
        }
      }
    }
  }
};
struct EpiResid {
  const Params* p; float* xres; int first;
  __device__ __forceinline__ void operator()(const f32x4 (&acc)[4][4], int tok0, int feat0, int fr, int fq) const {
#pragma unroll
    for (int n = 0; n < 4; ++n) {
      const int tok = tok0 + n * 16 + fr;
      const float* base = first ? xin_row(*p, tok) : (xres + (size_t)tok * 1024);
#pragma unroll
      for (int m = 0; m < 4; ++m) {
        const int f = feat0 + m * 16 + fq * 4;
        float4 b = *(const float4*)(base + f);
        f32x4 v = acc[m][n];
        *(float4*)(xres + (size_t)tok * 1024 + f) = make_float4(b.x + v[0], b.y + v[1], b.z + v[2], b.w + v[3]);
      }
    }
  }
};
struct EpiBf16 {
  u16* o; int ld;
  __device__ __forceinline__ void operator()(const f32x4 (&acc)[4][4], int tok0, int feat0, int fr, int fq) const {
#pragma unroll
    for (int n = 0; n < 4; ++n) {
      const int tok = tok0 + n * 16 + fr;
#pragma unroll
      for (int m = 0; m < 4; ++m) {
        const int f = feat0 + m * 16 + fq * 4;
        f32x4 v = acc[m][n];
        uint2 w; w.x = pack2(v[0], v[1]); w.y = pack2(v[2], v[3]);
        *(uint2*)(o + (size_t)tok * ld + f) = w;
      }
    }
  }
};
struct EpiF32 {
  float* o; int ld;
  __device__ __forceinline__ void operator()(const f32x4 (&acc)[4][4], int tok0, int feat0, int fr, int fq) const {
#pragma unroll
    for (int n = 0; n < 4; ++n) {
      const int tok = tok0 + n * 16 + fr;
#pragma unroll
      for (int m = 0; m < 4; ++m) {
        const int f = feat0 + m * 16 + fq * 4;
        f32x4 v = acc[m][n];
        *(float4*)(o + (size_t)tok * ld + f) = make_float4(v[0], v[1], v[2], v[3]);
      }
    }
  }
};
struct EpiKvq {
  u16 *k16, *v16, *q16; const float2* rope; float* out;
  __device__ __forceinline__ void operator()(const f32x4 (&acc)[4][4], int tok0, int feat0, int fr, int fq) const {
#pragma unroll
    for (int n = 0; n < 4; ++n) {
      const int tok = tok0 + n * 16 + fr;
      int b, t, pi, orow; bool is_p = tok < NTP;
      if (is_p) { b = tok >> 11; t = tok & 2047; pi = t; orow = t - 1920; }
      else { int ts = tok - NTP; b = ts >> 3; t = ts & 7; pi = 2048 + t; orow = 120 + t; }
      if (feat0 >= 256 && feat0 < 512) {
        const int kvh = (feat0 - 256) >> 6;
#pragma unroll
        for (int m = 0; m < 4; ++m) {
          const int d = m * 16 + fq * 4;
          f32x4 v = acc[m][n];
          uint2 w; w.x = pack2(v[0], v[1]); w.y = pack2(v[2], v[3]);
          *(uint2*)(v16 + (size_t)tok * 256 + kvh * 64 + d) = w;
          if (orow >= 0) {
            float* dst = out + (is_p ? OUT_VP : OUT_VS) + ((size_t)(b * 128 + orow) * 4 + kvh) * 64 + d;
            *(float4*)dst = make_float4(v[0], v[1], v[2], v[3]);
          }
        }
      } else {
        const bool isk = feat0 < 256;
        const float sc = isk ? 1.f : 0.125f;
#pragma unroll
        for (int m = 0; m < 2; ++m) {
          const int d = m * 16 + fq * 4;
          f32x4 x1 = acc[m][n], x2 = acc[m + 2][n];
          const float2* rp = rope + pi * 32 + d;
          float o1[4], o2[4];
#pragma unroll
          for (int j = 0; j < 4; ++j) {
            float2 csn = rp[j];
            o1[j] = (x1[j] * csn.x - x2[j] * csn.y) * sc;
            o2[j] = (x2[j] * csn.x + x1[j] * csn.y) * sc;
          }
          uint2 w1, w2;
          w1.x = pack2(o1[0], o1[1]); w1.y = pack2(o1[2], o1[3]);
          w2.x = pack2(o2[0], o2[1]); w2.y = pack2(o2[2], o2[3]);
          if (isk) {
            const int kvh = feat0 >> 6;
            *(uint2*)(k16 + (size_t)tok * 256 + kvh * 64 + d) = w1;
            *(uint2*)(k16 + (size_t)tok * 256 + kvh * 64 + d + 32) = w2;
            if (orow >= 0) {
              float* dst = out + (is_p ? OUT_KP : OUT_KS) + ((size_t)(b * 128 + orow) * 4 + kvh) * 64 + d;
              *(float4*)dst = make_float4(o1[0], o1[1], o1[2], o1[3]);
              *(float4*)(dst + 32) = make_float4(o2[0], o2[1], o2[2], o2[3]);
            }
          } else {
            const int f = feat0 - 512;
            *(uint2*)(q16 + (size_t)tok * 1024 + f + d) = w1;
            *(uint2*)(q16 + (size_t)tok * 1024 + f + d + 32) = w2;
          }
        }
      }
    }
  }
};

__device__ void ph_conv(const Params& p) {
  const float* rec = (const float*)(p.ws + OFF_REC32);
  float* xc32 = (float*)(p.ws + OFF_XC32);
  u16* xc16 = (u16*)(p.ws + OFF_XC16);
  const int nunits = NTOK * 256;
  for (int idx = blockIdx.x * 256 + threadIdx.x; idx < nunits; idx += gridDim.x * 256) {
    const int tok = idx >> 8, c = (idx & 255) * 4;
    int b, t; const float* buf = nullptr;
    if (tok < NTP) { b = tok >> 11; t = tok & 2047; }
    else { int ts = tok - NTP; b = ts >> 3; t = ts & 7; buf = p.state_conv + (size_t)b * 3072; }
    float4 r[4];
    r[0] = *(const float4*)(rec + (size_t)tok * 1024 + c);
#pragma unroll
    for (int L = 1; L <= 3; ++L) {
      if (t - L >= 0) r[L] = *(const float4*)(rec + (size_t)(tok - L) * 1024 + c);
      else if (buf) r[L] = *(const float4*)(buf + (size_t)(3 + t - L) * 1024 + c);
      else r[L] = make_float4(0.f, 0.f, 0.f, 0.f);
    }
    float4 w0 = *(const float4*)(p.rg_conv_w + c), w1 = *(const float4*)(p.rg_conv_w + 1024 + c);
    float4 w2 = *(const float4*)(p.rg_conv_w + 2048 + c), w3 = *(const float4*)(p.rg_conv_w + 3072 + c);
    float4 cb = *(const float4*)(p.rg_conv_b + c);
    float4 o;
    o.x = cb.x + w3.x * r[0].x + w2.x * r[1].x + w1.x * r[2].x + w0.x * r[3].x;
    o.y = cb.y + w3.y * r[0].y + w2.y * r[1].y + w1.y * r[2].y + w0.y * r[3].y;
    o.z = cb.z + w3.z * r[0].z + w2.z * r[1].z + w1.z * r[2].z + w0.z * r[3].z;
    o.w = cb.w + w3.w * r[0].w + w2.w * r[1].w + w1.w * r[2].w + w0.w * r[3].w;
    *(float4*)(xc32 + (size_t)tok * 1024 + c) = o;
    uint2 w; w.x = pack2(o.x, o.y); w.y = pack2(o.z, o.w);
    *(uint2*)(xc16 + (size_t)tok * 1024 + c) = w;
    if (tok < NTP) {
      if (t >= 2045) *(float4*)(p.out + OUT_CONVP + ((size_t)b * 3 + (t - 2045)) * 1024 + c) = r[0];
    } else {
      if (t >= 5) *(float4*)(p.out + OUT_CONVS + ((size_t)b * 3 + (t - 5)) * 1024 + c) = r[0];
    }
  }
}

__device__ __forceinline__ void scan_step(const float* loga, const u16* ig16, const float* xc32, size_t off, float4& a, float4& bt) {
  float4 la = *(const float4*)(loga + off);
  uint2 gi = *(const uint2*)(ig16 + off);
  float4 xc = *(const float4*)(xc32 + off);
  a.x = __expf(la.x); a.y = __expf(la.y); a.z = __expf(la.z); a.w = __expf(la.w);
  bt.x = sqrtf(-expm1f(2.f * la.x)) * bflo(gi.x) * xc.x;
  bt.y = sqrtf(-expm1f(2.f * la.y)) * bfhi(gi.x) * xc.y;
  bt.z = sqrtf(-expm1f(2.f * la.z)) * bflo(gi.y) * xc.z;
  bt.w = sqrtf(-expm1f(2.f * la.w)) * bfhi(gi.y) * xc.w;
}
__device__ void ph_scanA(const Params& p) {
  const float* loga = (const float*)(p.ws + OFF_LOGA);
  const u16* ig16 = (const u16*)(p.ws + OFF_IG16);
  const float* xc32 = (const float*)(p.ws + OFF_XC32);
  float* aggA = (float*)(p.ws + OFF_AGGA);
  float* aggB = (float*)(p.ws + OFF_AGGB);
  const int c = threadIdx.x * 4;
  for (int item = blockIdx.x; item < 256; item += gridDim.x) {
    const int b = item >> 5, ch = item & 31;
    float4 A = make_float4(1.f, 1.f, 1.f, 1.f), B = make_float4(0.f, 0.f, 0.f, 0.f);
    const size_t tok0 = (size_t)b * 2048 + ch * 64;
#pragma unroll 4
    for (int s = 0; s < 64; ++s) {
      float4 a, bt;
      scan_step(loga, ig16, xc32, (tok0 + s) * 1024 + c, a, bt);
      A.x *= a.x; A.y *= a.y; A.z *= a.z; A.w *= a.w;
      B.x = a.x * B.x + bt.x; B.y = a.y * B.y + bt.y; B.z = a.z * B.z + bt.z; B.w = a.w * B.w + bt.w;
    }
    *(float4*)(aggA + (size_t)item * 1024 + c) = A;
    *(float4*)(aggB + (size_t)item * 1024 + c) = B;
  }
}
__device__ void ph_scanB(const Params& p) {
  const float* loga = (const float*)(p.ws + OFF_LOGA);
  const u16* ig16 = (const u16*)(p.ws + OFF_IG16);
  const float* xc32 = (const float*)(p.ws + OFF_XC32);
  const u16* gate16 = (const u16*)(p.ws + OFF_GATE16);
  u16* hg16 = (u16*)(p.ws + OFF_HG16);
  const float* aggA = (const float*)(p.ws + OFF_AGGA);
  const float* aggB = (const float*)(p.ws + OFF_AGGB);
  const int c = threadIdx.x * 4;
  for (int item = blockIdx.x; item < 384; item += gridDim.x) {
    float4 h = make_float4(0.f, 0.f, 0.f, 0.f);
    size_t tok0; int nsteps; float* hout = nullptr;
    if (item < 256) {
      const int b = item >> 5, ch = item & 31;
      for (int j = 0; j < ch; ++j) {
        float4 A = *(const float4*)(aggA + (size_t)(b * 32 + j) * 1024 + c);
        float4 B = *(const float4*)(aggB + (size_t)(b * 32 + j) * 1024 + c);
        h.x = A.x * h.x + B.x; h.y = A.y * h.y + B.y; h.z = A.z * h.z + B.z; h.w = A.w * h.w + B.w;
      }
      tok0 = (size_t)b * 2048 + ch * 64; nsteps = 64;
      if (ch == 31) hout = p.out + OUT_HP + (size_t)b * 1024 + c;
    } else {
      const int b = item - 256;
      h = *(const float4*)(p.state_h + (size_t)b * 1024 + c);
      tok0 = (size_t)NTP + b * 8; nsteps = 8;
      hout = p.out + OUT_HS + (size_t)b * 1024 + c;
    }
#pragma unroll 4
    for (int s = 0; s < nsteps; ++s) {
      float4 a, bt;
      const size_t off = (tok0 + s) * 1024 + c;
      scan_step(loga, ig16, xc32, off, a, bt);
      h.x = a.x * h.x + bt.x; h.y = a.y * h.y + bt.y; h.z = a.z * h.z + bt.z; h.w = a.w * h.w + bt.w;
      uint2 g = *(const uint2*)(gate16 + off);
      uint2 w; w.x = pack2(h.x * bflo(g.x), h.y * bfhi(g.x)); w.y = pack2(h.z * bflo(g.y), h.w * bfhi(g.y));
      *(uint2*)(hg16 + off) = w;
    }
    if (hout) *(float4*)hout = h;
  }
}

__device__ __forceinline__ int mkkey(float v, int n) {
  int i = __float_as_int(v);
  i ^= (i >> 31) & 0x7fffffff;
  return (i & ~127) | (127 - n);
}
__device__ __forceinline__ float keyval(int k) {
  int i = (k & ~127) | 64;
  i ^= (i >> 31) & 0x7fffffff;
  return __int_as_float(i);
}
__device__ __forceinline__ int keyidx(int k) { return 127 - (k & 127); }
#define CE(i, j) { int hi_ = max(k[i], k[j]); int lo_ = min(k[i], k[j]); k[i] = hi_; k[j] = lo_; }

__device__ void ph_topk(const Params& p, char* smem) {
  const int tid = threadIdx.x, lane = tid & 63, wid = tid >> 6, g = lane >> 4, li = lane & 15;
  const float* s32 = (const float*)(p.ws + OFF_S32);
  int* idx_out = (int*)(p.ws + OFF_IDX);
  float* gate_out = (float*)(p.ws + OFF_PGATE);
  int* tkey = (int*)smem + wid * 256;
  for (int tb = blockIdx.x; tb < 4352; tb += gridDim.x) {
    const int t = tb * 4 + wid;
    const float* srow = s32 + (size_t)t * 2048;
#pragma unroll 1
    for (int ps = 0; ps < 4; ++ps) {
      const int R = ps * 4 + g;
      const float* r = srow + R * 128;
      float4 v0 = *(const float4*)(r + li * 4), v1 = *(const float4*)(r + 64 + li * 4);
      int k[8];
      k[0] = mkkey(v0.x, li * 4 + 0); k[1] = mkkey(v0.y, li * 4 + 1); k[2] = mkkey(v0.z, li * 4 + 2); k[3] = mkkey(v0.w, li * 4 + 3);
      k[4] = mkkey(v1.x, 64 + li * 4 + 0); k[5] = mkkey(v1.y, 64 + li * 4 + 1); k[6] = mkkey(v1.z, 64 + li * 4 + 2); k[7] = mkkey(v1.w, 64 + li * 4 + 3);
      CE(0, 1) CE(2, 3) CE(4, 5) CE(6, 7)
      CE(0, 2) CE(1, 3) CE(4, 6) CE(5, 7)
      CE(1, 2) CE(5, 6)
      CE(0, 4) CE(1, 5) CE(2, 6) CE(3, 7)
      CE(2, 4) CE(3, 5)
      CE(1, 2) CE(3, 4) CE(5, 6)
      int res = (int)0x80000000;
#pragma unroll
      for (int it = 0; it < 16; ++it) {
        const int M = grp_max_i(k[0]);
        const bool win = (k[0] == M);
        if (li == it) res = M;
#pragma unroll
        for (int i = 0; i < 7; ++i) k[i] = win ? k[i + 1] : k[i];
        k[7] = win ? (int)0x80000000 : k[7];
      }
      tkey[R * 16 + li] = res;
    }
    __syncthreads();
#pragma unroll 1
    for (int ps2 = 0; ps2 < 2; ++ps2) {
      const int h = ps2 * 4 + g;
      const int* t0 = tkey + (h * 2) * 16;
      const int* t1 = t0 + 16;
      const float sv0 = keyval(t0[li]);
      int ptr = 0;
      float head = sv0 + keyval(t1[0]);
      float rv = 0.f; int rc = 0;
#pragma unroll 1
      for (int it = 0; it < 16; ++it) {
        const float M = grp_max_f(head);
        const unsigned long long bm = __ballot(head == M);
        const unsigned gm = (unsigned)(bm >> (g * 16)) & 0xffffu;
        const int wl = __ffs(gm) - 1;
        const bool win = (li == wl);
        const int C = grp_max_i(win ? (li * 16 + ptr) : -1);
        if (li == it) { rv = M; rc = C; }
        if (win) {
          ++ptr;
          head = (ptr < 16) ? sv0 + keyval(t1[ptr & 15]) : -3.0e38f;
        }
      }
      const int ia = keyidx(t0[rc >> 4]);
      const int ib = keyidx(t1[rc & 15]);
      const float mx = grp_max_f(rv);
      const float ex = __expf(rv - mx);
      const float sm = grp_sum_f(ex);
      idx_out[(size_t)t * 128 + h * 16 + li] = ia * 128 + ib;
      gate_out[(size_t)t * 128 + h * 16 + li] = ex / sm;
    }
    __syncthreads();
  }
}

typedef float v2f __attribute__((ext_vector_type(2)));
template <int CTRL>
__device__ __forceinline__ float dpp_f(float v) { return __int_as_float(__builtin_amdgcn_update_dpp(0, __float_as_int(v), CTRL, 0xf, 0xf, false)); }
__device__ __forceinline__ float dot16_fp8(uint4 u, const v2f* x2) {
  v2f acc = {0.f, 0.f};
  acc = __builtin_elementwise_fma(__builtin_amdgcn_cvt_pk_f32_fp8((int)u.x, false), x2[0], acc);
  acc = __builtin_elementwise_fma(__builtin_amdgcn_cvt_pk_f32_fp8((int)u.x, true), x2[1], acc);
  acc = __builtin_elementwise_fma(__builtin_amdgcn_cvt_pk_f32_fp8((int)u.y, false), x2[2], acc);
  acc = __builtin_elementwise_fma(__builtin_amdgcn_cvt_pk_f32_fp8((int)u.y, true), x2[3], acc);
  acc = __builtin_elementwise_fma(__builtin_amdgcn_cvt_pk_f32_fp8((int)u.z, false), x2[4], acc);
  acc = __builtin_elementwise_fma(__builtin_amdgcn_cvt_pk_f32_fp8((int)u.z, true), x2[5], acc);
  acc = __builtin_elementwise_fma(__builtin_amdgcn_cvt_pk_f32_fp8((int)u.w, false), x2[6], acc);
  acc = __builtin_elementwise_fma(__builtin_amdgcn_cvt_pk_f32_fp8((int)u.w, true), x2[7], acc);
  return acc.x + acc.y;
}
__device__ __forceinline__ void axpy16_fp8(float w, uint4 u, v2f* o2) {
  const v2f w2 = {w, w};
  o2[0] = __builtin_elementwise_fma(__builtin_amdgcn_cvt_pk_f32_fp8((int)u.x, false), w2, o2[0]);
  o2[1] = __builtin_elementwise_fma(__builtin_amdgcn_cvt_pk_f32_fp8((int)u.x, true), w2, o2[1]);
  o2[2] = __builtin_elementwise_fma(__builtin_amdgcn_cvt_pk_f32_fp8((int)u.y, false), w2, o2[2]);
  o2[3] = __builtin_elementwise_fma(__builtin_amdgcn_cvt_pk_f32_fp8((int)u.y, true), w2, o2[3]);
  o2[4] = __builtin_elementwise_fma(__builtin_amdgcn_cvt_pk_f32_fp8((int)u.z, false), w2, o2[4]);
  o2[5] = __builtin_elementwise_fma(__builtin_amdgcn_cvt_pk_f32_fp8((int)u.z, true), w2, o2[5]);
  o2[6] = __builtin_elementwise_fma(__builtin_amdgcn_cvt_pk_f32_fp8((int)u.w, false), w2, o2[6]);
  o2[7] = __builtin_elementwise_fma(__builtin_amdgcn_cvt_pk_f32_fp8((int)u.w, true), w2, o2[7]);
}
__device__ __forceinline__ float reduce4_row(float d0, float d1, float d2, float d3, int lane) {
  const bool b0 = lane & 1, b1 = lane & 2;
  const float k0 = b0 ? d1 : d0, s0 = b0 ? d0 : d1;
  const float k1 = b0 ? d3 : d2, s1 = b0 ? d2 : d3;
  const float r0 = k0 + dpp_f<0xB1>(s0);
  const float r1 = k1 + dpp_f<0xB1>(s1);
  const float kk = b1 ? r1 : r0, ss = b1 ? r0 : r1;
  float q = kk + dpp_f<0x4E>(ss);
  q += dpp_f<0x128>(q);
  q += dpp_f<0x124>(q);
  return q;
}
#define EXP_LOAD(dst, dsc, TAB, SC, kbase, esrc)                                     \
  _Pragma("unroll") for (int j = 0; j < 8; ++j) {                                   \
    const int e = __builtin_amdgcn_readlane(esrc, ((kbase) + j) & 63);              \
    dst[j] = ((const uint4*)(TAB + (size_t)e * 1024))[lane];                        \
    dsc[j] = SC[e];                                                                  \
  }
#define EXP_LOADV(dst, TAB, kbase, esrc)                                             \
  _Pragma("unroll") for (int j = 0; j < 8; ++j) {                                   \
    const int e = __builtin_amdgcn_readlane(esrc, ((kbase) + j) & 63);              \
    dst[j] = ((const uint4*)(TAB + (size_t)e * 1024))[lane];                        \
  }
#define EXP_UDOT(src, ssc, kbase)                                                    \
  {                                                                                  \
    float d[8];                                                                      \
    _Pragma("unroll") for (int j = 0; j < 8; ++j) d[j] = dot16_fp8(src[j], x2) * ssc[j]; \
    const float qa = reduce4_row(d[0], d[1], d[2], d[3], lane);                      \
    const float qb = reduce4_row(d[4], d[5], d[6], d[7], lane);                      \
    float q = (lane & 4) ? qb : qa;                                                  \
    q += __shfl_xor(q, 16);                                                          \
    q += __shfl_xor(q, 32);                                                          \
    if ((lane >> 3) == ((((kbase)) & 63) >> 3)) { if ((kbase) < 64) h_lo = q; else h_hi = q; } \
  }
#define EXP_VACC(src, kbase, wsrc)                                                   \
  _Pragma("unroll") for (int j = 0; j < 8; ++j) {                                   \
    const float w = __int_as_float(__builtin_amdgcn_readlane(__float_as_int(wsrc), ((kbase) + j) & 63)); \
    axpy16_fp8(w, src[j], o2);                                                       \
  }

__device__ void ph_expert(const Params& p, int layer) {
  const int lane = threadIdx.x & 63, wid = threadIdx.x >> 6;
  u16* xn16 = (u16*)(p.ws + OFF_XN);
  float* xres = (float*)(p.ws + OFF_X);
  const int* idxs = (const int*)(p.ws + OFF_IDX);
  const float* gates = (const float*)(p.ws + OFF_PGATE);
  const unsigned char* U = (const unsigned char*)(p.ws + OFF_U8);
  const unsigned char* V = (const unsigned char*)(p.ws + OFF_V8);
  const float* USC = (const float*)(p.ws + OFF_USC);
  const float* VSC = (const float*)(p.ws + OFF_VSC);
  for (int tb = blockIdx.x; tb < 4352; tb += gridDim.x) {
    const int t = tb * 4 + wid;
    v2f x2[8];
    {
      const uint4* xr = (const uint4*)(xn16 + (size_t)t * 1024 + lane * 16);
      uint4 xa = xr[0], xb = xr[1];
      x2[0] = v2f{bflo(xa.x), bfhi(xa.x)}; x2[1] = v2f{bflo(xa.y), bfhi(xa.y)};
      x2[2] = v2f{bflo(xa.z), bfhi(xa.z)}; x2[3] = v2f{bflo(xa.w), bfhi(xa.w)};
      x2[4] = v2f{bflo(xb.x), bfhi(xb.x)}; x2[5] = v2f{bflo(xb.y), bfhi(xb.y)};
      x2[6] = v2f{bflo(xb.z), bfhi(xb.z)}; x2[7] = v2f{bflo(xb.w), bfhi(xb.w)};
    }
    const int e_lo = idxs[(size_t)t * 128 + lane], e_hi = idxs[(size_t)t * 128 + 64 + lane];
    const float g_lo = gates[(size_t)t * 128 + lane], g_hi = gates[(size_t)t * 128 + 64 + lane];
    const float vs_lo = VSC[e_lo], vs_hi = VSC[e_hi];
    float h_lo = 0.f, h_hi = 0.f;
    {
      uint4 ba[8], bb[8]; float sa[8], sb[8];
      EXP_LOAD(ba, sa, U, USC, 0, e_lo)
#pragma unroll 1
      for (int kb = 0; kb < 64; kb += 16) {
        EXP_LOAD(bb, sb, U, USC, kb + 8, e_lo)
        EXP_UDOT(ba, sa, kb)
        if (kb + 16 < 64) { EXP_LOAD(ba, sa, U, USC, kb + 16, e_lo) } else { EXP_LOAD(ba, sa, U, USC, 0, e_hi) }
        EXP_UDOT(bb, sb, kb + 8)
      }
#pragma unroll 1
      for (int kb = 64; kb < 128; kb += 16) {
        EXP_LOAD(bb, sb, U, USC, kb + 8, e_hi)
        EXP_UDOT(ba, sa, kb)
        if (kb + 16 < 128) { EXP_LOAD(ba, sa, U, USC, kb + 16, e_hi) }
        EXP_UDOT(bb, sb, kb + 8)
      }
    }
    const float w_lo = 0.5f * h_lo * (1.f + erff(h_lo * 0.70710678118654752f)) * g_lo * vs_lo;
    const float w_hi = 0.5f * h_hi * (1.f + erff(h_hi * 0.70710678118654752f)) * g_hi * vs_hi;
    v2f o2[8];
#pragma unroll
    for (int i = 0; i < 8; ++i) o2[i] = v2f{0.f, 0.f};
    {
      uint4 ba[8], bb[8];
      EXP_LOADV(ba, V, 0, e_lo)
#pragma unroll 1
      for (int kb = 0; kb < 64; kb += 16) {
        EXP_LOADV(bb, V, kb + 8, e_lo)
        EXP_VACC(ba, kb, w_lo)
        if (kb + 16 < 64) { EXP_LOADV(ba, V, kb + 16, e_lo) } else { EXP_LOADV(ba, V, 0, e_hi) }
        EXP_VACC(bb, kb + 8, w_lo)
      }
#pragma unroll 1
      for (int kb = 64; kb < 128; kb += 16) {
        EXP_LOADV(bb, V, kb + 8, e_hi)
        EXP_VACC(ba, kb, w_hi)
        if (kb + 16 < 128) { EXP_LOADV(ba, V, kb + 16, e_hi) }
        EXP_VACC(bb, kb + 8, w_hi)
      }
    }
    float o[16];
#pragma unroll
    for (int i = 0; i < 8; ++i) { o[2 * i] = o2[i].x; o[2 * i + 1] = o2[i].y; }
    float* xr = xres + (size_t)t * 1024 + lane * 16;
    float ss = 0.f;
#pragma unroll
    for (int i = 0; i < 4; ++i) {
      float4 r = *(const float4*)(xr + i * 4);
      o[4 * i] += r.x; o[4 * i + 1] += r.y; o[4 * i + 2] += r.z; o[4 * i + 3] += r.w;
      ss += o[4 * i] * o[4 * i] + o[4 * i + 1] * o[4 * i + 1] + o[4 * i + 2] * o[4 * i + 2] + o[4 * i + 3] * o[4 * i + 3];
    }
    ss = wave_sum(ss);
    const float rs = rsqrtf(ss * (1.f / 1024.f) + 1e-6f);
    if (layer == 0) {
#pragma unroll
      for (int i = 0; i < 4; ++i) *(float4*)(xr + i * 4) = make_float4(o[4 * i], o[4 * i + 1], o[4 * i + 2], o[4 * i + 3]);
      uint4 wa, wb;
      wa.x = pack2(o[0] * rs, o[1] * rs); wa.y = pack2(o[2] * rs, o[3] * rs); wa.z = pack2(o[4] * rs, o[5] * rs); wa.w = pack2(o[6] * rs, o[7] * rs);
      wb.x = pack2(o[8] * rs, o[9] * rs); wb.y = pack2(o[10] * rs, o[11] * rs); wb.z = pack2(o[12] * rs, o[13] * rs); wb.w = pack2(o[14] * rs, o[15] * rs);
      uint4* xw = (uint4*)(xn16 + (size_t)t * 1024 + lane * 16);
      xw[0] = wa; xw[1] = wb;
    } else {
      const float* fg = p.final_norm + lane * 16;
      float* y = p.out + OUT_Y + (size_t)t * 1024 + lane * 16;
#pragma unroll
      for (int i = 0; i < 4; ++i) {
        float4 g = *(const float4*)(fg + i * 4);
        *(float4*)(y + i * 4) = make_float4(o[4 * i] * rs * g.x, o[4 * i + 1] * rs * g.y, o[4 * i + 2] * rs * g.z, o[4 * i + 3] * rs * g.w);
      }
    }
  }
}

__device__ void ph_attn(const Params& p, char* smem) {
  const int tid = threadIdx.x, lane = tid & 63, wid = tid >> 6, fr = lane & 15, fq = lane >> 4;
  const u16* k16 = (const u16*)(p.ws + OFF_K16);
  const u16* v16 = (const u16*)(p.ws + OFF_V16A);
  const u16* q16 = (const u16*)(p.ws + OFF_Q16);
  u16* o16 = (u16*)(p.ws + OFF_O16);
  u16* Ks = (u16*)smem;
  u16* Vt = (u16*)(smem + 27648);
  for (int item = blockIdx.x; item < 1536; item += gridDim.x) {
    const bool is_p = item < 1024;
    int b, kvh, q0 = 0, nsub, nvalid, kpos0, minpos, tokbase;
    if (is_p) { b = item >> 7; kvh = (item >> 5) & 3; q0 = (item & 31) * 64; nsub = 4; nvalid = 192; kpos0 = q0 - 128; minpos = 0; tokbase = b * 2048; }
    else { int it2 = item - 1024; b = it2 >> 2; kvh = it2 & 3; nsub = 1; nvalid = 136; kpos0 = -128; minpos = -100000; tokbase = NTP + b * 8; }
    __syncthreads();
    for (int c = tid; c < 1536; c += 256) {
      const int j = c >> 3, ch = c & 7;
      uint4 kk = make_uint4(0, 0, 0, 0), vv = make_uint4(0, 0, 0, 0);
      if (is_p) {
        const int kp = kpos0 + j;
        if (kp >= 0) {
          const size_t off = (size_t)(tokbase + kp) * 256 + kvh * 64 + ch * 8;
          kk = *(const uint4*)(k16 + off); vv = *(const uint4*)(v16 + off);
        }
      } else {
        if (j < 128) {
          const size_t off = ((size_t)(b * 128 + j) * 4 + kvh) * 64 + ch * 8;
          float4 a0 = *(const float4*)(p.cache_k + off), a1 = *(const float4*)(p.cache_k + off + 4);
          float4 c0 = *(const float4*)(p.cache_v + off), c1 = *(const float4*)(p.cache_v + off + 4);
          kk.x = pack2(a0.x, a0.y); kk.y = pack2(a0.z, a0.w); kk.z = pack2(a1.x, a1.y); kk.w = pack2(a1.z, a1.w);
          vv.x = pack2(c0.x, c0.y); vv.y = pack2(c0.z, c0.w); vv.z = pack2(c1.x, c1.y); vv.w = pack2(c1.z, c1.w);
        } else if (j < 136) {
          const size_t off = (size_t)(tokbase + j - 128) * 256 + kvh * 64 + ch * 8;
          kk = *(const uint4*)(k16 + off); vv = *(const uint4*)(v16 + off);
        }
      }
      *(uint4*)(Ks + j * 72 + ch * 8) = kk;
      u16* vd = Vt + (ch * 8) * 200 + j;
      vd[0] = (u16)(vv.x & 0xffff); vd[200] = (u16)(vv.x >> 16);
      vd[400] = (u16)(vv.y & 0xffff); vd[600] = (u16)(vv.y >> 16);
      vd[800] = (u16)(vv.z & 0xffff); vd[1000] = (u16)(vv.z >> 16);
      vd[1200] = (u16)(vv.w & 0xffff); vd[1400] = (u16)(vv.w >> 16);
    }
    __syncthreads();
    const int head = kvh * 4 + wid;
    const float sink = p.sinks[head];
#pragma unroll 1
    for (int sub = 0; sub < nsub; ++sub) {
      int qtok, qp;
      if (is_p) { qp = q0 + sub * 16 + fr; qtok = tokbase + qp; }
      else { qp = fr & 7; qtok = tokbase + (fr & 7); }
      const u16* qrow = q16 + (size_t)qtok * 1024 + head * 64;
      const bf16x8 qf0 = *(const bf16x8*)(qrow + fq * 8);
      const bf16x8 qf1 = *(const bf16x8*)(qrow + 32 + fq * 8);
      f32x4 s[12];
#pragma unroll
      for (int ks = 0; ks < 12; ++ks) {
        const bf16x8 kf0 = *(const bf16x8*)(Ks + (ks * 16 + fr) * 72 + fq * 8);
        const bf16x8 kf1 = *(const bf16x8*)(Ks + (ks * 16 + fr) * 72 + 32 + fq * 8);
        f32x4 z = {0.f, 0.f, 0.f, 0.f};
        z = __builtin_amdgcn_mfma_f32_16x16x32_bf16(kf0, qf0, z, 0, 0, 0);
        s[ks] = __builtin_amdgcn_mfma_f32_16x16x32_bf16(kf1, qf1, z, 0, 0, 0);
        if ((ks & 3) == 3) __builtin_amdgcn_sched_barrier(0);
      }
      float mx = sink;
#pragma unroll
      for (int ks = 0; ks < 12; ++ks)
#pragma unroll
        for (int j = 0; j < 4; ++j) {
          const int jj = ks * 16 + fq * 4 + j;
          const int kp = kpos0 + jj;
          const bool valid = (jj < nvalid) && (kp >= minpos) && (kp <= qp) && (qp - kp < 128);
          const float v = valid ? s[ks][j] : -1.0e30f;
          s[ks][j] = v;
          mx = fmaxf(mx, v);
        }
      mx = fmaxf(mx, __shfl_xor(mx, 16));
      mx = fmaxf(mx, __shfl_xor(mx, 32));
      float sum = 0.f;
#pragma unroll
      for (int ks = 0; ks < 12; ++ks)
#pragma unroll
        for (int j = 0; j < 4; ++j) {
          const float pv = (s[ks][j] > -1.0e29f) ? __expf(s[ks][j] - mx) : 0.f;
          s[ks][j] = pv;
          sum += pv;
        }
      sum += __shfl_xor(sum, 16);
      sum += __shfl_xor(sum, 32);
      sum += __expf(sink - mx);
      const float inv = 1.f / sum;
      f32x4 o[4];
#pragma unroll
      for (int d = 0; d < 4; ++d) o[d] = f32x4{0.f, 0.f, 0.f, 0.f};
#pragma unroll
      for (int kk = 0; kk < 6; ++kk) {
        union { bf16x8 v; unsigned u[4]; } pb;
        pb.u[0] = pack2(s[2 * kk][0], s[2 * kk][1]); pb.u[1] = pack2(s[2 * kk][2], s[2 * kk][3]);
        pb.u[2] = pack2(s[2 * kk + 1][0], s[2 * kk + 1][1]); pb.u[3] = pack2(s[2 * kk + 1][2], s[2 * kk + 1][3]);
#pragma unroll
        for (int d = 0; d < 4; ++d) {
          union { bf16x8 v; uint2 h[2]; } vf;
          const u16* vr = Vt + (d * 16 + fr) * 200 + fq * 4;
          vf.h[0] = *(const uint2*)(vr + (2 * kk) * 16);
          vf.h[1] = *(const uint2*)(vr + (2 * kk + 1) * 16);
          o[d] = __builtin_amdgcn_mfma_f32_16x16x32_bf16(vf.v, pb.v, o[d], 0, 0, 0);
        }
        __builtin_amdgcn_sched_barrier(0);
      }
      if (is_p || fr < 8) {
#pragma unroll
        for (int d = 0; d < 4; ++d) {
          uint2 w; w.x = pack2(o[d][0] * inv, o[d][1] * inv); w.y = pack2(o[d][2] * inv, o[d][3] * inv);
          *(uint2*)(o16 + (size_t)qtok * 1024 + head * 64 + d * 16 + fq * 4) = w;
        }
      }
    }
  }
}

template <int ph>
__device__ __forceinline__ void run_phase(const Params& p, char* smem) {
  char* ws = p.ws;
  switch (ph) {
    case 0: ph_convert0(p, smem); break;
    case 1: {
      EpiWin e{(u16*)(ws + OFF_GATE16), (float*)(ws + OFF_REC32)};
      gemm_tiles((const u16*)(ws + OFF_XN), 1024, (const u16*)(ws + OFF_WT_IN), 1024, 1024, 0, 16, e, smem);
    } break;
    case 2: ph_conv(p); break;
    case 3: {
      EpiBd e{(float*)(ws + OFF_LOGA), (u16*)(ws + OFF_IG16), p.rg_ba, p.rg_bx, p.rg_lambda};
      gemm_tiles((const u16*)(ws + OFF_XC16), 1024, (const u16*)(ws + OFF_WT_BD), 128, 128, 8, 16, e, smem);
    } break;
    case 4: ph_scanA(p); break;
    case 5: ph_scanB(p); break;
    case 6: {
      EpiResid e{&p, (float*)(ws + OFF_X), 1};
      gemm_tiles((const u16*)(ws + OFF_HG16), 1024, (const u16*)(ws + OFF_WT_OUT), 1024, 1024, 0, 8, e, smem);
      ph_cvt_tables(p, 0);
    } break;
    case 7: ph_rmsnorm(p, p.ffn_norm); break;
    case 8: case 16: {
      EpiBf16 e{(u16*)(ws + OFF_QP16), 2048};
      gemm_tiles((const u16*)(ws + OFF_XN), 1024, (const u16*)(ws + (ph == 8 ? OFF_WT_PQ0 : OFF_WT_PQ1)), 1024, 1024, 0, 16, e, smem);
    } break;
    case 9: case 17: {
      EpiF32 e{(float*)(ws + OFF_S32), 2048};
      gemm_tiles((const u16*)(ws + OFF_QP16), 2048, (const u16*)(ws + (ph == 9 ? OFF_WT_SK0 : OFF_WT_SK1)), 128, 128, 16, 16, e, smem);
    } break;
    case 10: case 18: ph_topk(p, smem); break;
    case 11: ph_expert(p, 0); break;
    case 12: {
      EpiKvq e{(u16*)(ws + OFF_K16), (u16*)(ws + OFF_V16A), (u16*)(ws + OFF_Q16), (const float2*)(ws + OFF_ROPE), p.out};
      gemm_tiles((const u16*)(ws + OFF_XN), 1024, (const u16*)(ws + OFF_WT_KVQ), 1024, 1024, 0, 12, e, smem);
      ph_cvt_tables(p, 1);
    } break;
    case 13: ph_attn(p, smem); break;
    case 14: {
      EpiResid e{&p, (float*)(ws + OFF_X), 0};
      gemm_tiles((const u16*)(ws + OFF_O16), 1024, (const u16*)(ws + OFF_WT_O), 1024, 1024, 0, 8, e, smem);
    } break;
    case 15: ph_rmsnorm(p, p.ffn_norm + 1024); break;
    case 19: ph_expert(p, 1); break;
    default: break;
  }
}

__global__ void __launch_bounds__(256, 2) yoco_megakernel(Params p) {
  __shared__ __attribute__((aligned(16))) char smem[73728];
  cg::grid_group grid = cg::this_grid();
#define PH(k) if (p.ph_begin <= k && k < p.ph_end) { run_phase<k>(p, smem); if (k + 1 < p.ph_end) grid.sync(); }
  PH(0) PH(1) PH(2) PH(3) PH(4) PH(5) PH(6) PH(7) PH(8) PH(9)
  PH(10) PH(11) PH(12) PH(13) PH(14) PH(15) PH(16) PH(17) PH(18) PH(19)
}

extern "C" void kernel_launch(void* const* d_in, const int* in_sizes, int n_in, void* d_out, int out_size,
                              void* d_ws, size_t ws_size, hipStream_t stream) {
  static int grid_blocks = 0;
  if (!grid_blocks) {
    int dev = 0, cus = 0, per_cu = 0;
    hipGetDevice(&dev);
    hipDeviceGetAttribute(&cus, hipDeviceAttributeMultiprocessorCount, dev);
    hipOccupancyMaxActiveBlocksPerMultiprocessor(&per_cu, yoco_megakernel, 256, 0);
    if (per_cu > 2) per_cu = 2;
    if (per_cu < 1) per_cu = 1;
    grid_blocks = cus * per_cu;
    if (ws_size < WS_NEEDED) fprintf(stderr, "workspace too small: %zu < %llu\n", ws_size, (unsigned long long)WS_NEEDED);
  }
  Params p{};
  const float** f = (const float**)&p;
  for (int i = 0; i < 28; ++i) f[i] = (const float*)d_in[i];
  p.out = (float*)d_out;
  p.ws = (char*)d_ws;
#if MULTI_LAUNCH
  for (int ph = 0; ph < NPHASE; ++ph) {
    p.ph_begin = ph; p.ph_end = ph + 1;
    hipLaunchKernelGGL(yoco_megakernel, dim3(grid_blocks), dim3(256), 0, stream, p);
  }
#else
  p.ph_begin = 0; p.ph_end = NPHASE;
  void* args[] = {&p};
  hipError_t e = hipLaunchCooperativeKernel((void*)yoco_megakernel, dim3(grid_blocks), dim3(256), args, 0, stream);
  if (e != hipSuccess) fprintf(stderr, "cooperative launch failed: %s (grid %d)\n", hipGetErrorString(e), grid_blocks);
#endif
}
```

```cpp
#include <hip/hip_runtime.h>
#include <hip/hip_cooperative_groups.h>
#include <cstdio>
#include <cstdint>
namespace cg = cooperative_groups;

typedef unsigned short u16;
typedef __attribute__((ext_vector_type(8))) short bf16x8;
typedef __attribute__((ext_vector_type(4))) float f32x4;

#define NTOK 17408
#define NTP 16384
#define MIB 1048576ull
#define NPHASE 20
#ifndef MULTI_LAUNCH
#define MULTI_LAUNCH 0
#endif

#define OFF_WT_IN   (0 * MIB)
#define OFF_WT_OUT  (4 * MIB)
#define OFF_WT_BD   (6 * MIB)
#define OFF_WT_PQ0  (7 * MIB)
#define OFF_WT_PQ1  (11 * MIB)
#define OFF_WT_KVQ  (15 * MIB)
#define OFF_WT_O    (18 * MIB)
#define OFF_WT_SK0  (20 * MIB)
#define OFF_WT_SK1  (20 * MIB + 524288ull)
#define OFF_ROPE    (21 * MIB)
#define OFF_USC     (21 * MIB + 655360ull)
#define OFF_VSC     (21 * MIB + 655360ull + 65536ull)
#define OFF_U8      (22 * MIB)
#define OFF_V8      (38 * MIB)
#define OFF_XN      (86 * MIB)
#define OFF_X       (120 * MIB)
#define OFF_GATE16  (188 * MIB)
#define OFF_REC32   (222 * MIB)
#define OFF_XC32    (290 * MIB)
#define OFF_XC16    (358 * MIB)
#define OFF_LOGA    (222 * MIB)
#define OFF_IG16    (22 * MIB)
#define OFF_AGGA    (56 * MIB)
#define OFF_AGGB    (57 * MIB)
#define OFF_HG16    (358 * MIB)
#define OFF_QP16    (188 * MIB)
#define OFF_S32     (256 * MIB)
#define OFF_IDX     (188 * MIB)
#define OFF_PGATE   (197 * MIB)
#define OFF_K16     (188 * MIB)
#define OFF_V16A    (197 * MIB)
#define OFF_Q16     (206 * MIB)
#define OFF_O16     (240 * MIB)
#define OFF_BAR     (392 * MIB)
#define WS_NEEDED   (392 * MIB + 16384ull)

#define OUT_Y      0
#define OUT_CONVP  17825792
#define OUT_HP     17850368
#define OUT_KP     17858560
#define OUT_VP     18120704
#define OUT_CONVS  18382848
#define OUT_HS     18776064
#define OUT_KS     18907136
#define OUT_VS     23101440

struct Params {
  const float *x_prompt, *x_sample, *state_conv, *state_h, *cache_k, *cache_v;
  const float *rg_norm, *rg_w_in, *rg_conv_w, *rg_conv_b, *rg_wa, *rg_ba, *rg_wx, *rg_bx, *rg_lambda, *rg_w_out;
  const float *kv_norm, *w_kv, *attn_norm, *w_q, *sinks, *w_o, *ffn_norm, *peer_wq, *peer_subkeys, *peer_u, *peer_v, *final_norm;
  float* out;
  char* ws;
  int ph_begin, ph_end;
};

__device__ __forceinline__ u16 f2bf(float f) {
  unsigned u = __float_as_uint(f);
  u += 0x7fffu + ((u >> 16) & 1u);
  return (u16)(u >> 16);
}
__device__ __forceinline__ float bf2f(u16 h) { return __uint_as_float(((unsigned)h) << 16); }
__device__ __forceinline__ unsigned pack2(float a, float b) { return (unsigned)f2bf(a) | ((unsigned)f2bf(b) << 16); }
__device__ __forceinline__ float bflo(unsigned u) { return __uint_as_float(u << 16); }
__device__ __forceinline__ float bfhi(unsigned u) { return __uint_as_float(u & 0xffff0000u); }
__device__ __forceinline__ float wave_sum(float v) {
#pragma unroll
  for (int o = 32; o > 0; o >>= 1) v += __shfl_xor(v, o);
  return v;
}
__device__ __forceinline__ const float* xin_row(const Params& p, int token) {
  return token < NTP ? p.x_prompt + (size_t)token * 1024 : p.x_sample + (size_t)(token - NTP) * 1024;
}
__device__ __forceinline__ float gelu_tanh(float x) {
  float u = 0.7978845608028654f * (x + 0.044715f * x * x * x);
  float e = __expf(2.f * u);
  float th = 1.f - 2.f / (e + 1.f);
  return 0.5f * x * (1.f + th);
}
__device__ __forceinline__ float sigmoidf_(float x) { return 1.f / (1.f + __expf(-x)); }

template <int CTRL>
__device__ __forceinline__ int dpp_i(int v) { return __builtin_amdgcn_update_dpp(v, v, CTRL, 0xf, 0xf, false); }
__device__ __forceinline__ int grp_max_i(int v) {
  v = max(v, dpp_i<0xB1>(v));
  v = max(v, dpp_i<0x4E>(v));
  v = max(v, dpp_i<0x141>(v));
  v = max(v, dpp_i<0x140>(v));
  return v;
}
__device__ __forceinline__ float grp_max_f(float v) {
  v = fmaxf(v, __int_as_float(dpp_i<0xB1>(__float_as_int(v))));
  v = fmaxf(v, __int_as_float(dpp_i<0x4E>(__float_as_int(v))));
  v = fmaxf(v, __int_as_float(dpp_i<0x141>(__float_as_int(v))));
  v = fmaxf(v, __int_as_float(dpp_i<0x140>(__float_as_int(v))));
  return v;
}
__device__ __forceinline__ float grp_sum_f(float v) {
  v += __int_as_float(dpp_i<0xB1>(__float_as_int(v)));
  v += __int_as_float(dpp_i<0x4E>(__float_as_int(v)));
  v += __int_as_float(dpp_i<0x141>(__float_as_int(v)));
  v += __int_as_float(dpp_i<0x140>(__float_as_int(v)));
  return v;
}

__device__ void transpose_unit(const float* __restrict__ src, int ld_src, u16* __restrict__ dst, int ld_dst,
                               int kt, int nt, const float* __restrict__ gain, float* lds) {
  const int tid = threadIdx.x;
#pragma unroll
  for (int j = 0; j < 4; ++j) {
    int idx = tid + j * 256;
    int k = idx >> 4, c4 = idx & 15;
    float4 v = *(const float4*)(src + (size_t)(kt * 64 + k) * ld_src + nt * 64 + c4 * 4);
    float g = gain ? gain[kt * 64 + k] : 1.f;
    float* d = lds + k * 65 + c4 * 4;
    d[0] = v.x * g; d[1] = v.y * g; d[2] = v.z * g; d[3] = v.w * g;
  }
  __syncthreads();
#pragma unroll
  for (int j = 0; j < 2; ++j) {
    int c = tid + j * 256;
    int n = c >> 3, kc = c & 7;
    uint4 o;
    o.x = pack2(lds[(kc * 8 + 0) * 65 + n], lds[(kc * 8 + 1) * 65 + n]);
    o.y = pack2(lds[(kc * 8 + 2) * 65 + n], lds[(kc * 8 + 3) * 65 + n]);
    o.z = pack2(lds[(kc * 8 + 4) * 65 + n], lds[(kc * 8 + 5) * 65 + n]);
    o.w = pack2(lds[(kc * 8 + 6) * 65 + n], lds[(kc * 8 + 7) * 65 + n]);
    *(uint4*)(dst + (size_t)(nt * 64 + n) * ld_dst + kt * 64 + kc * 8) = o;
  }
  __syncthreads();
}

__device__ void transpose_job(const Params& p, int u, float* lds) {
  char* ws = p.ws;
  if (u < 512) { transpose_unit(p.rg_w_in, 2048, (u16*)(ws + OFF_WT_IN), 1024, u >> 5, u & 31, nullptr, lds); return; }
  u -= 512;
  if (u < 256) { transpose_unit(p.rg_w_out, 1024, (u16*)(ws + OFF_WT_OUT), 1024, u >> 4, u & 15, nullptr, lds); return; }
  u -= 256;
  if (u < 64) {
    int which = u >> 5; int r = u & 31; int bi = r >> 2; int t = r & 3;
    const float* src = (which ? p.rg_wx : p.rg_wa) + (size_t)bi * 16384;
    u16* dst = (u16*)(ws + OFF_WT_BD) + (size_t)(which * 1024 + bi * 128) * 128;
    transpose_unit(src, 128, dst, 128, t >> 1, t & 1, nullptr, lds); return;
  }
  u -= 64;
  if (u < 1024) {
    int l = u >> 9; int r = u & 511;
    transpose_unit(p.peer_wq + (size_t)l * 2097152, 2048, (u16*)(ws + (l ? OFF_WT_PQ1 : OFF_WT_PQ0)), 1024, r >> 5, r & 31, nullptr, lds); return;
  }
  u -= 1024;
  if (u < 128) { transpose_unit(p.w_kv, 512, (u16*)(ws + OFF_WT_KVQ), 1024, u >> 3, u & 7, p.kv_norm, lds); return; }
  u -= 128;
  if (u < 256) { transpose_unit(p.w_q, 1024, (u16*)(ws + OFF_WT_KVQ) + (size_t)512 * 1024, 1024, u >> 4, u & 15, p.attn_norm, lds); return; }
  u -= 256;
  transpose_unit(p.w_o, 1024, (u16*)(ws + OFF_WT_O), 1024, u >> 4, u & 15, nullptr, lds);
}

__device__ __forceinline__ void cvt_unit(const float* __restrict__ src, u16* __restrict__ dst, size_t base) {
  const int tid = threadIdx.x;
#pragma unroll
  for (int j = 0; j < 2; ++j) {
    size_t o = base + j * 1024 + tid * 4;
    float4 v = *(const float4*)(src + o);
    uint2 w; w.x = pack2(v.x, v.y); w.y = pack2(v.z, v.w);
    *(uint2*)(dst + o) = w;
  }
}

__device__ __forceinline__ void rmsnorm_row(const float* __restrict__ x, const float* __restrict__ g, u16* __restrict__ o, int lane) {
  float4 v[4];
  float ss = 0.f;
#pragma unroll
  for (int i = 0; i < 4; ++i) {
    v[i] = *(const float4*)(x + i * 256 + lane * 4);
    ss += v[i].x * v[i].x + v[i].y * v[i].y + v[i].z * v[i].z + v[i].w * v[i].w;
  }
  ss = wave_sum(ss);
  float r = rsqrtf(ss * (1.f / 1024.f) + 1e-6f);
#pragma unroll
  for (int i = 0; i < 4; ++i) {
    float4 gg = *(const float4*)(g + i * 256 + lane * 4);
    uint2 w; w.x = pack2(v[i].x * r * gg.x, v[i].y * r * gg.y); w.y = pack2(v[i].z * r * gg.z, v[i].w * r * gg.w);
    *(uint2*)(o + i * 256 + lane * 4) = w;
  }
}

__device__ void ph_convert0(const Params& p, char* smem) {
  const int tid = threadIdx.x, lane = tid & 63, wid = tid >> 6;
  const int NT = 2496, NSK = 256, NROPE = 257, NRMS = 4352, NCACHE = 3840;
  const int total = NT + NSK + NROPE + NRMS + NCACHE;
  for (int u0 = blockIdx.x; u0 < total; u0 += gridDim.x) {
    int u = u0;
    if (u < NT) { transpose_job(p, u, (float*)smem); continue; }
    u -= NT;
    if (u < NSK) {
      int l = u >> 7; int r = u & 127;
      const float* src = p.peer_subkeys + (size_t)l * 32768;
      u16* dst = (u16*)(p.ws + (l ? OFF_WT_SK1 : OFF_WT_SK0));
#pragma unroll
      for (int j = 0; j < 2; ++j) {
        int i = r * 2048 + j * 1024 + tid * 4;
        int s = ((i >> 14) & 1) * 16384 + (i & 16383);
        float4 v = *(const float4*)(src + s);
        uint2 w; w.x = pack2(v.x, v.y); w.y = pack2(v.z, v.w);
        *(uint2*)(dst + i) = w;
      }
      continue;
    }
    u -= NSK;
    if (u < NROPE) {
      int i = u * 256 + tid;
      if (i < 2056 * 32) {
        int pi = i >> 5, d = i & 31;
        int pos = pi < 2048 ? pi : (16384 + pi - 2048);
        float inv = (float)pow(10000.0, -(double)d / 32.0);
        float ang = (float)pos * inv;
        double sn, cs;
        sincos((double)ang, &sn, &cs);
        float2* rt = (float2*)(p.ws + OFF_ROPE);
        rt[i] = make_float2((float)cs, (float)sn);
      }
      continue;
    }
    u -= NROPE;
    if (u < NRMS) {
      int t = u * 4 + wid;
      rmsnorm_row(xin_row(p, t), p.rg_norm, (u16*)(p.ws + OFF_XN) + (size_t)t * 1024, lane);
      continue;
    }
    u -= NRMS;
    {
      int which = u / 1920; int r = u - which * 1920;
      int b = r / 15, c = r - b * 15;
      const float* src = (which ? p.cache_v : p.cache_k) + (size_t)b * 32768 + 2048 + c * 2048;
      float* dst = p.out + (which ? OUT_VS : OUT_KS) + (size_t)b * 32768 + c * 2048;
#pragma unroll
      for (int j = 0; j < 2; ++j) {
        int o = j * 1024 + tid * 4;
        *(float4*)(dst + o) = *(const float4*)(src + o);
      }
    }
  }
}

__device__ void ph_cvt_tables(const Params& p, int layer) {
  const int lane = threadIdx.x & 63, wid = threadIdx.x >> 6;
  for (int u = blockIdx.x; u < 8192; u += gridDim.x) {
    const int which = u >> 12; const int row = (u & 4095) * 4 + wid;
    const float* src = (which ? p.peer_v : p.peer_u) + (size_t)layer * 16777216 + (size_t)row * 1024 + lane * 16;
    unsigned char* dst = (unsigned char*)(p.ws + (which ? OFF_V8 : OFF_U8)) + (size_t)row * 1024 + lane * 16;
    float* sc = (float*)(p.ws + (which ? OFF_VSC : OFF_USC));
    float4 a = *(const float4*)(src), b = *(const float4*)(src + 4), c = *(const float4*)(src + 8), d = *(const float4*)(src + 12);
    float m = fmaxf(fmaxf(fmaxf(fabsf(a.x), fabsf(a.y)), fmaxf(fabsf(a.z), fabsf(a.w))), fmaxf(fmaxf(fabsf(b.x), fabsf(b.y)), fmaxf(fabsf(b.z), fabsf(b.w))));
    m = fmaxf(m, fmaxf(fmaxf(fmaxf(fabsf(c.x), fabsf(c.y)), fmaxf(fabsf(c.z), fabsf(c.w))), fmaxf(fmaxf(fabsf(d.x), fabsf(d.y)), fmaxf(fabsf(d.z), fabsf(d.w)))));
#pragma unroll
    for (int o = 32; o > 0; o >>= 1) m = fmaxf(m, __shfl_xor(m, o));
    const float scl = m > 0.f ? 440.f / m : 1.f;
    uint4 w; int t;
    t = 0; t = __builtin_amdgcn_cvt_pk_fp8_f32(a.x * scl, a.y * scl, t, false); t = __builtin_amdgcn_cvt_pk_fp8_f32(a.z * scl, a.w * scl, t, true); w.x = (unsigned)t;
    t = 0; t = __builtin_amdgcn_cvt_pk_fp8_f32(b.x * scl, b.y * scl, t, false); t = __builtin_amdgcn_cvt_pk_fp8_f32(b.z * scl, b.w * scl, t, true); w.y = (unsigned)t;
    t = 0; t = __builtin_amdgcn_cvt_pk_fp8_f32(c.x * scl, c.y * scl, t, false); t = __builtin_amdgcn_cvt_pk_fp8_f32(c.z * scl, c.w * scl, t, true); w.z = (unsigned)t;
    t = 0; t = __builtin_amdgcn_cvt_pk_fp8_f32(d.x * scl, d.y * scl, t, false); t = __builtin_amdgcn_cvt_pk_fp8_f32(d.z * scl, d.w * scl, t, true); w.w = (unsigned)t;
    *(uint4*)dst = w;
    if (lane == 0) sc[row] = m > 0.f ? m / 440.f : 1.f;
  }
}

__device__ void ph_rmsnorm(const Params& p, const float* g) {
  const int lane = threadIdx.x & 63, wid = threadIdx.x >> 6;
  const float* x = (const float*)(p.ws + OFF_X);
  u16* xn = (u16*)(p.ws + OFF_XN);
  for (int u = blockIdx.x; u < 4352; u += gridDim.x) {
    int t = u * 4 + wid;
    rmsnorm_row(x + (size_t)t * 1024, g, xn + (size_t)t * 1024, lane);
  }
}

template <class Epi>
__device__ __forceinline__ void gemm_tiles(const u16* __restrict__ A, int lda, const u16* __restrict__ W, int ldw,
                                           int K, int kmod, int ntn, const Epi& epi, char* smem) {
  const int tid = threadIdx.x, lane = tid & 63, wid = tid >> 6;
  const int wr = wid >> 1, wc = wid & 1, fr = lane & 15, fq = lane >> 4;
  const int ld_row = tid >> 3, ld_ch = tid & 7;
  const int total = 136 * ntn;
  const int nk = K >> 6;
  for (int tile = blockIdx.x; tile < total; tile += gridDim.x) {
    const int tm = tile / ntn, tn = tile - tm * ntn;
    const u16* Ag = A + (size_t)(tm * 128 + ld_row) * lda + (kmod ? (tn % kmod) * 128 : 0) + ld_ch * 8;
    const u16* Wg = W + (size_t)(tn * 128 + ld_row) * ldw + ld_ch * 8;
    f32x4 acc[4][4];
#pragma unroll
    for (int m = 0; m < 4; ++m)
#pragma unroll
      for (int n = 0; n < 4; ++n) acc[m][n] = f32x4{0.f, 0.f, 0.f, 0.f};
    uint4 ra[4], rw[4];
#pragma unroll
    for (int i = 0; i < 4; ++i) {
      ra[i] = *(const uint4*)(Ag + (size_t)(i * 32) * lda);
      rw[i] = *(const uint4*)(Wg + (size_t)(i * 32) * ldw);
    }
    {
      char* sW = smem; char* sA = smem + 18432;
#pragma unroll
      for (int i = 0; i < 4; ++i) {
        *(uint4*)(sW + (ld_row + i * 32) * 144 + ld_ch * 16) = rw[i];
        *(uint4*)(sA + (ld_row + i * 32) * 144 + ld_ch * 16) = ra[i];
      }
    }
    __syncthreads();
    for (int kt = 0; kt < nk; ++kt) {
      const int cur = kt & 1;
      const bool more = (kt + 1 < nk);
      if (more) {
        const int k0 = (kt + 1) * 64;
#pragma unroll
        for (int i = 0; i < 4; ++i) {
          ra[i] = *(const uint4*)(Ag + (size_t)(i * 32) * lda + k0);
          rw[i] = *(const uint4*)(Wg + (size_t)(i * 32) * ldw + k0);
        }
      }
      __builtin_amdgcn_sched_barrier(0);
      const char* sW = smem + cur * 36864;
      const char* sA = sW + 18432;
#pragma unroll
      for (int ks = 0; ks < 2; ++ks) {
        bf16x8 a[4], b[4];
#pragma unroll
        for (int m = 0; m < 4; ++m) a[m] = *(const bf16x8*)(sW + (wr * 64 + m * 16 + fr) * 144 + ks * 64 + fq * 16);
#pragma unroll
        for (int n = 0; n < 4; ++n) b[n] = *(const bf16x8*)(sA + (wc * 64 + n * 16 + fr) * 144 + ks * 64 + fq * 16);
#pragma unroll
        for (int m = 0; m < 4; ++m)
#pragma unroll
          for (int n = 0; n < 4; ++n) acc[m][n] = __builtin_amdgcn_mfma_f32_16x16x32_bf16(a[m], b[n], acc[m][n], 0, 0, 0);
      }
      __builtin_amdgcn_sched_barrier(0);
      if (more) {
        char* dW = smem + (cur ^ 1) * 36864; char* dA = dW + 18432;
#pragma unroll
        for (int i = 0; i < 4; ++i) {
          *(uint4*)(dW + (ld_row + i * 32) * 144 + ld_ch * 16) = rw[i];
          *(uint4*)(dA + (ld_row + i * 32) * 144 + ld_ch * 16) = ra[i];
        }
      }
      __syncthreads();
    }
    epi(acc, tm * 128 + wc * 64, tn * 128 + wr * 64, fr, fq);
  }
}

struct EpiWin {
  u16* gate16; float* rec32;
  __device__ __forceinline__ void operator()(const f32x4 (&acc)[4][4], int tok0, int feat0, int fr, int fq) const {
#pragma unroll
    for (int n = 0; n < 4; ++n) {
      const int tok = tok0 + n * 16 + fr;
#pragma unroll
      for (int m = 0; m < 4; ++m) {
        const int f = feat0 + m * 16 + fq * 4;
        f32x4 v = acc[m][n];
        if (feat0 < 1024) {
          uint2 w; w.x = pack2(gelu_tanh(v[0]), gelu_tanh(v[1])); w.y = pack2(gelu_tanh(v[2]), gelu_tanh(v[3]));
          *(uint2*)(gate16 + (size_t)tok * 1024 + f) = w;
        } else {
          *(float4*)(rec32 + (size_t)tok * 1024 + (f - 1024)) = make_float4(v[0], v[1], v[2], v[3]);
        }
      }
    }
  }
};
struct EpiBd {
  float* loga; u16* ig16; const float *ba, *bx, *lam;
  __device__ __forceinline__ void operator()(const f32x4 (&acc)[4][4], int tok0, int feat0, int fr, int fq) const {
#pragma unroll
    for (int m = 0; m < 4; ++m) {
      const int f = feat0 + m * 16 + fq * 4;
      if (feat0 < 1024) {
        float4 b4 = *(const float4*)(ba + f);
        float4 l4 = *(const float4*)(lam + f);
        float sp0 = log1pf(__expf(-l4.x)), sp1 = log1pf(__expf(-l4.y)), sp2 = log1pf(__expf(-l4.z)), sp3 = log1pf(__expf(-l4.w));
#pragma unroll
        for (int n = 0; n < 4; ++n) {
          const int tok = tok0 + n * 16 + fr;
          f32x4 v = acc[m][n];
          float4 o;
          o.x = -8.f * sigmoidf_(v[0] + b4.x) * sp0;
          o.y = -8.f * sigmoidf_(v[1] + b4.y) * sp1;
          o.z = -8.f * sigmoidf_(v[2] + b4.z) * sp2;
          o.w = -8.f * sigmoidf_(v[3] + b4.w) * sp3;
          *(float4*)(loga + (size_t)tok * 1024 + f) = o;
        }
      } else {
        float4 b4 = *(const float4*)(bx + (f - 1024));
#pragma unroll
        for (int n = 0; n < 4; ++n) {
          const int tok = tok0 + n * 16 + fr;
          f32x4 v = acc[m][n];
          uint2 w;
          w.x = pack2(sigmoidf_(v[0] + b4.x), sigmoidf_(v[1] + b4.y));
          w.y = pack2(sigmoidf_(v[2] + b4.z), sigmoidf_(v[3] + b4.w));
          *(uint2*)(ig16 + (size_t)tok * 1024 + (f - 1024)) = w;
        }
      }
    }
  }
};
struct EpiResid {
  const Params* p; float* xres; int first;
  __device__ __forceinline__ void operator()(const f32x4 (&acc)[4][4], int tok0, int feat0, int fr, int fq) const {
#pragma unroll
    for (int n = 0; n < 4; ++n) {
      const int tok = tok0 + n * 16 + fr;
      const float* base = first ? xin_row(*p, tok) : (xres + (size_t)tok * 1024);
#pragma unroll
      for (int m = 0; m < 4; ++m) {
        const int f = feat0 + m * 16 + fq * 4;
        float4 b = *(const float4*)(base + f);
        f32x4 v = acc[m][n];
        *(float4*)(xres + (size_t)tok * 1024 + f) = make_float4(b.x + v[0], b.y + v[1], b.z + v[2], b.w + v[3]);
      }
    }
  }
};
struct EpiBf16 {
  u16* o; int ld;
  __device__ __forceinline__ void operator()(const f32x4 (&acc)[4][4], int tok0, int feat0, int fr, int fq) const {
#pragma unroll
    for (int n = 0; n < 4; ++n) {
      const int tok = tok0 + n * 16 + fr;
#pragma unroll
      for (int m = 0; m < 4; ++m) {
        const int f = feat0 + m * 16 + fq * 4;
        f32x4 v = acc[m][n];
        uint2 w; w.x = pack2(v[0], v[1]); w.y = pack2(v[2], v[3]);
        *(uint2*)(o + (size_t)tok * ld + f) = w;
      }
    }
  }
};
struct EpiF32 {
  float* o; int ld;
  __device__ __forceinline__ void operator()(const f32x4 (&acc)[4][4], int tok0, int feat0, int fr, int fq) const {
#pragma unroll
    for (int n = 0; n < 4; ++n) {
      const int tok = tok0 + n * 16 + fr;
#pragma unroll
      for (int m = 0; m < 4; ++m) {
        const int f = feat0 + m * 16 + fq * 4;
        f32x4 v = acc[m][n];
        *(float4*)(o + (size_t)tok * ld + f) = make_float4(v[0], v[1], v[2], v[3]);
      }
    }
  }
};
struct EpiKvq {
  u16 *k16, *v16, *q16; const float2* rope; float* out;
  __device__ __forceinline__ void operator()(const f32x4 (&acc)[4][4], int tok0, int feat0, int fr, int fq) const {
#pragma unroll
    for (int n = 0; n < 4; ++n) {
      const int tok = tok0 + n * 16 + fr;
      int b, t, pi, orow; bool is_p = tok < NTP;
      if (is_p) { b = tok >> 11; t = tok & 2047; pi = t; orow = t - 1920; }
      else { int ts = tok - NTP; b = ts >> 3; t = ts & 7; pi = 2048 + t; orow = 120 + t; }
      if (feat0 >= 256 && feat0 < 512) {
        const int kvh = (feat0 - 256) >> 6;
#pragma unroll
        for (int m = 0; m < 4; ++m) {
          const int d = m * 16 + fq * 4;
          f32x4 v = acc[m][n];
          uint2 w; w.x = pack2(v[0], v[1]); w.y = pack2(v[2], v[3]);
          *(uint2*)(v16 + (size_t)tok * 256 + kvh * 64 + d) = w;
          if (orow >= 0) {
            float* dst = out + (is_p ? OUT_VP : OUT_VS) + ((size_t)(b * 128 + orow) * 4 + kvh) * 64 + d;
            *(float4*)dst = make_float4(v[0], v[1], v[2], v[3]);
          }
        }
      } else {
        const bool isk = feat0 < 256;
        const float sc = isk ? 1.f : 0.125f;
#pragma unroll
        for (int m = 0; m < 2; ++m) {
          const int d = m * 16 + fq * 4;
          f32x4 x1 = acc[m][n], x2 = acc[m + 2][n];
          const float2* rp = rope + pi * 32 + d;
          float o1[4], o2[4];
#pragma unroll
          for (int j = 0; j < 4; ++j) {
            float2 csn = rp[j];
            o1[j] = (x1[j] * csn.x - x2[j] * csn.y) * sc;
            o2[j] = (x2[j] * csn.x + x1[j] * csn.y) * sc;
          }
          uint2 w1, w2;
          w1.x = pack2(o1[0], o1[1]); w1.y = pack2(o1[2], o1[3]);
          w2.x = pack2(o2[0], o2[1]); w2.y = pack2(o2[2], o2[3]);
          if (isk) {
            const int kvh = feat0 >> 6;
            *(uint2*)(k16 + (size_t)tok * 256 + kvh * 64 + d) = w1;
            *(uint2*)(k16 + (size_t)tok * 256 + kvh * 64 + d + 32) = w2;
            if (orow >= 0) {
              float* dst = out + (is_p ? OUT_KP : OUT_KS) + ((size_t)(b * 128 + orow) * 4 + kvh) * 64 + d;
              *(float4*)dst = make_float4(o1[0], o1[1], o1[2], o1[3]);
              *(float4*)(dst + 32) = make_float4(o2[0], o2[1], o2[2], o2[3]);
            }
          } else {
            const int f = feat0 - 512;
            *(uint2*)(q16 + (size_t)tok * 1024 + f + d) = w1;
            *(uint2*)(q16 + (size_t)tok * 1024 + f + d + 32) = w2;
          }
        }
      }
    }
  }
};

__device__ void ph_conv(const Params& p) {
  const float* rec = (const float*)(p.ws + OFF_REC32);
  float* xc32 = (float*)(p.ws + OFF_XC32);
  u16* xc16 = (u16*)(p.ws + OFF_XC16);
  const int nunits = NTOK * 256;
  for (int idx = blockIdx.x * 256 + threadIdx.x; idx < nunits; idx += gridDim.x * 256) {
    const int tok = idx >> 8, c = (idx & 255) * 4;
    int b, t; const float* buf = nullptr;
    if (tok < NTP) { b = tok >> 11; t = tok & 2047; }
    else { int ts = tok - NTP; b = ts >> 3; t = ts & 7; buf = p.state_conv + (size_t)b * 3072; }
    float4 r[4];
    r[0] = *(const float4*)(rec + (size_t)tok * 1024 + c);
#pragma unroll
    for (int L = 1; L <= 3; ++L) {
      if (t - L >= 0) r[L] = *(const float4*)(rec + (size_t)(tok - L) * 1024 + c);
      else if (buf) r[L] = *(const float4*)(buf + (size_t)(3 + t - L) * 1024 + c);
      else r[L] = make_float4(0.f, 0.f, 0.f, 0.f);
    }
    float4 w0 = *(const float4*)(p.rg_conv_w + c), w1 = *(const float4*)(p.rg_conv_w + 1024 + c);
    float4 w2 = *(const float4*)(p.rg_conv_w + 2048 + c), w3 = *(const float4*)(p.rg_conv_w + 3072 + c);
    float4 cb = *(const float4*)(p.rg_conv_b + c);
    float4 o;
    o.x = cb.x + w3.x * r[0].x + w2.x * r[1].x + w1.x * r[2].x + w0.x * r[3].x;
    o.y = cb.y + w3.y * r[0].y + w2.y * r[1].y + w1.y * r[2].y + w0.y * r[3].y;
    o.z = cb.z + w3.z * r[0].z + w2.z * r[1].z + w1.z * r[2].z + w0.z * r[3].z;
    o.w = cb.w + w3.w * r[0].w + w2.w * r[1].w + w1.w * r[2].w + w0.w * r[3].w;
    *(float4*)(xc32 + (size_t)tok * 1024 + c) = o;
    uint2 w; w.x = pack2(o.x, o.y); w.y = pack2(o.z, o.w);
    *(uint2*)(xc16 + (size_t)tok * 1024 + c) = w;
    if (tok < NTP) {
      if (t >= 2045) *(float4*)(p.out + OUT_CONVP + ((size_t)b * 3 + (t - 2045)) * 1024 + c) = r[0];
    } else {
      if (t >= 5) *(float4*)(p.out + OUT_CONVS + ((size_t)b * 3 + (t - 5)) * 1024 + c) = r[0];
    }
  }
}

__device__ __forceinline__ void scan_step(const float* loga, const u16* ig16, const float* xc32, size_t off, float4& a, float4& bt) {
  float4 la = *(const float4*)(loga + off);
  uint2 gi = *(const uint2*)(ig16 + off);
  float4 xc = *(const float4*)(xc32 + off);
  a.x = __expf(la.x); a.y = __expf(la.y); a.z = __expf(la.z); a.w = __expf(la.w);
  bt.x = sqrtf(-expm1f(2.f * la.x)) * bflo(gi.x) * xc.x;
  bt.y = sqrtf(-expm1f(2.f * la.y)) * bfhi(gi.x) * xc.y;
  bt.z = sqrtf(-expm1f(2.f * la.z)) * bflo(gi.y) * xc.z;
  bt.w = sqrtf(-expm1f(2.f * la.w)) * bfhi(gi.y) * xc.w;
}
__device__ void ph_scanA(const Params& p) {
  const float* loga = (const float*)(p.ws + OFF_LOGA);
  const u16* ig16 = (const u16*)(p.ws + OFF_IG16);
  const float* xc32 = (const float*)(p.ws + OFF_XC32);
  float* aggA = (float*)(p.ws + OFF_AGGA);
  float* aggB = (float*)(p.ws + OFF_AGGB);
  const int c = threadIdx.x * 4;
  for (int item = blockIdx.x; item < 256; item += gridDim.x) {
    const int b = item >> 5, ch = item & 31;
    float4 A = make_float4(1.f, 1.f, 1.f, 1.f), B = make_float4(0.f, 0.f, 0.f, 0.f);
    const size_t tok0 = (size_t)b * 2048 + ch * 64;
#pragma unroll 4
    for (int s = 0; s < 64; ++s) {
      float4 a, bt;
      scan_step(loga, ig16, xc32, (tok0 + s) * 1024 + c, a, bt);
      A.x *= a.x; A.y *= a.y; A.z *= a.z; A.w *= a.w;
      B.x = a.x * B.x + bt.x; B.y = a.y * B.y + bt.y; B.z = a.z * B.z + bt.z; B.w = a.w * B.w + bt.w;
    }
    *(float4*)(aggA + (size_t)item * 1024 + c) = A;
    *(float4*)(aggB + (size_t)item * 1024 + c) = B;
  }
}
__device__ void ph_scanB(const Params& p) {
  const float* loga = (const float*)(p.ws + OFF_LOGA);
  const u16* ig16 = (const u16*)(p.ws + OFF_IG16);
  const float* xc32 = (const float*)(p.ws + OFF_XC32);
  const u16* gate16 = (const u16*)(p.ws + OFF_GATE16);
  u16* hg16 = (u16*)(p.ws + OFF_HG16);
  const float* aggA = (const float*)(p.ws + OFF_AGGA);
  const float* aggB = (const float*)(p.ws + OFF_AGGB);
  const int c = threadIdx.x * 4;
  for (int item = blockIdx.x; item < 384; item += gridDim.x) {
    float4 h = make_float4(0.f, 0.f, 0.f, 0.f);
    size_t tok0; int nsteps; float* hout = nullptr;
    if (item < 256) {
      const int b = item >> 5, ch = item & 31;
      for (int j = 0; j < ch; ++j) {
        float4 A = *(const float4*)(aggA + (size_t)(b * 32 + j) * 1024 + c);
        float4 B = *(const float4*)(aggB + (size_t)(b * 32 + j) * 1024 + c);
        h.x = A.x * h.x + B.x; h.y = A.y * h.y + B.y; h.z = A.z * h.z + B.z; h.w = A.w * h.w + B.w;
      }
      tok0 = (size_t)b * 2048 + ch * 64; nsteps = 64;
      if (ch == 31) hout = p.out + OUT_HP + (size_t)b * 1024 + c;
    } else {
      const int b = item - 256;
      h = *(const float4*)(p.state_h + (size_t)b * 1024 + c);
      tok0 = (size_t)NTP + b * 8; nsteps = 8;
      hout = p.out + OUT_HS + (size_t)b * 1024 + c;
    }
#pragma unroll 4
    for (int s = 0; s < nsteps; ++s) {
      float4 a, bt;
      const size_t off = (tok0 + s) * 1024 + c;
      scan_step(loga, ig16, xc32, off, a, bt);
      h.x = a.x * h.x + bt.x; h.y = a.y * h.y + bt.y; h.z = a.z * h.z + bt.z; h.w = a.w * h.w + bt.w;
      uint2 g = *(const uint2*)(gate16 + off);
      uint2 w; w.x = pack2(h.x * bflo(g.x), h.y * bfhi(g.x)); w.y = pack2(h.z * bflo(g.y), h.w * bfhi(g.y));
      *(uint2*)(hg16 + off) = w;
    }
    if (hout) *(float4*)hout = h;
  }
}

__device__ __forceinline__ int mkkey(float v, int n) {
  int i = __float_as_int(v);
  i ^= (i >> 31) & 0x7fffffff;
  return (i & ~127) | (127 - n);
}
__device__ __forceinline__ float keyval(int k) {
  int i = (k & ~127) | 64;
  i ^= (i >> 31) & 0x7fffffff;
  return __int_as_float(i);
}
__device__ __forceinline__ int keyidx(int k) { return 127 - (k & 127); }
#define CE(i, j) { int hi_ = max(k[i], k[j]); int lo_ = min(k[i], k[j]); k[i] = hi_; k[j] = lo_; }

__device__ void ph_topk(const Params& p, char* smem) {
  const int tid = threadIdx.x, lane = tid & 63, wid = tid >> 6, g = lane >> 4, li = lane & 15;
  const float* s32 = (const float*)(p.ws + OFF_S32);
  int* idx_out = (int*)(p.ws + OFF_IDX);
  float* gate_out = (float*)(p.ws + OFF_PGATE);
  int* tkey = (int*)smem + wid * 256;
  for (int tb = blockIdx.x; tb < 4352; tb += gridDim.x) {
    const int t = tb * 4 + wid;
    const float* srow = s32 + (size_t)t * 2048;
#pragma unroll 1
    for (int ps = 0; ps < 4; ++ps) {
      const int R = ps * 4 + g;
      const float* r = srow + R * 128;
      float4 v0 = *(const float4*)(r + li * 4), v1 = *(const float4*)(r + 64 + li * 4);
      int k[8];
      k[0] = mkkey(v0.x, li * 4 + 0); k[1] = mkkey(v0.y, li * 4 + 1); k[2] = mkkey(v0.z, li * 4 + 2); k[3] = mkkey(v0.w, li * 4 + 3);
      k[4] = mkkey(v1.x, 64 + li * 4 + 0); k[5] = mkkey(v1.y, 64 + li * 4 + 1); k[6] = mkkey(v1.z, 64 + li * 4 + 2); k[7] = mkkey(v1.w, 64 + li * 4 + 3);
      CE(0, 1) CE(2, 3) CE(4, 5) CE(6, 7)
      CE(0, 2) CE(1, 3) CE(4, 6) CE(5, 7)
      CE(1, 2) CE(5, 6)
      CE(0, 4) CE(1, 5) CE(2, 6) CE(3, 7)
      CE(2, 4) CE(3, 5)
      CE(1, 2) CE(3, 4) CE(5, 6)
      int res = (int)0x80000000;
#pragma unroll
      for (int it = 0; it < 16; ++it) {
        const int M = grp_max_i(k[0]);
        const bool win = (k[0] == M);
        if (li == it) res = M;
#pragma unroll
        for (int i = 0; i < 7; ++i) k[i] = win ? k[i + 1] : k[i];
        k[7] = win ? (int)0x80000000 : k[7];
      }
      tkey[R * 16 + li] = res;
    }
    __syncthreads();
#pragma unroll 1
    for (int ps2 = 0; ps2 < 2; ++ps2) {
      const int h = ps2 * 4 + g;
      const int* t0 = tkey + (h * 2) * 16;
      const int* t1 = t0 + 16;
      const float sv0 = keyval(t0[li]);
      int ptr = 0;
      float head = sv0 + keyval(t1[0]);
      float rv = 0.f; int rc = 0;
#pragma unroll 1
      for (int it = 0; it < 16; ++it) {
        const float M = grp_max_f(head);
        const unsigned long long bm = __ballot(head == M);
        const unsigned gm = (unsigned)(bm >> (g * 16)) & 0xffffu;
        const int wl = __ffs(gm) - 1;
        const bool win = (li == wl);
        const int C = grp_max_i(win ? (li * 16 + ptr) : -1);
        if (li == it) { rv = M; rc = C; }
        if (win) {
          ++ptr;
          head = (ptr < 16) ? sv0 + keyval(t1[ptr & 15]) : -3.0e38f;
        }
      }
      const int ia = keyidx(t0[rc >> 4]);
      const int ib = keyidx(t1[rc & 15]);
      const float mx = grp_max_f(rv);
      const float ex = __expf(rv - mx);
      const float sm = grp_sum_f(ex);
      idx_out[(size_t)t * 128 + h * 16 + li] = ia * 128 + ib;
      gate_out[(size_t)t * 128 + h * 16 + li] = ex / sm;
    }
    __syncthreads();
  }
}

typedef float v2f __attribute__((ext_vector_type(2)));
template <int CTRL>
__device__ __forceinline__ float dpp_f(float v) { return __int_as_float(__builtin_amdgcn_update_dpp(0, __float_as_int(v), CTRL, 0xf, 0xf, false)); }
__device__ __forceinline__ float dot16_fp8(uint4 u, const v2f* x2) {
  v2f acc = {0.f, 0.f};
  acc = __builtin_elementwise_fma(__builtin_amdgcn_cvt_pk_f32_fp8((int)u.x, false), x2[0], acc);
  acc = __builtin_elementwise_fma(__builtin_amdgcn_cvt_pk_f32_fp8((int)u.x, true), x2[1], acc);
  acc = __builtin_elementwise_fma(__builtin_amdgcn_cvt_pk_f32_fp8((int)u.y, false), x2[2], acc);
  acc = __builtin_elementwise_fma(__builtin_amdgcn_cvt_pk_f32_fp8((int)u.y, true), x2[3], acc);
  acc = __builtin_elementwise_fma(__builtin_amdgcn_cvt_pk_f32_fp8((int)u.z, false), x2[4], acc);
  acc = __builtin_elementwise_fma(__builtin_amdgcn_cvt_pk_f32_fp8((int)u.z, true), x2[5], acc);
  acc = __builtin_elementwise_fma(__builtin_amdgcn_cvt_pk_f32_fp8((int)u.w, false), x2[6], acc);
  acc = __builtin_elementwise_fma(__builtin_amdgcn_cvt_pk_f32_fp8((int)u.w, true), x2[7], acc);
  return acc.x + acc.y;
}
__device__ __forceinline__ void axpy16_fp8(float w, uint4 u, v2f* o2) {
  const v2f w2 = {w, w};
  o2[0] = __builtin_elementwise_fma(__builtin_amdgcn_cvt_pk_f32_fp8((int)u.x, false), w2, o2[0]);
  o2[1] = __builtin_elementwise_fma(__builtin_amdgcn_cvt_pk_f32_fp8((int)u.x, true), w2, o2[1]);
  o2[2] = __builtin_elementwise_fma(__builtin_amdgcn_cvt_pk_f32_fp8((int)u.y, false), w2, o2[2]);
  o2[3] = __builtin_elementwise_fma(__builtin_amdgcn_cvt_pk_f32_fp8((int)u.y, true), w2, o2[3]);
  o2[4] = __builtin_elementwise_fma(__builtin_amdgcn_cvt_pk_f32_fp8((int)u.z, false), w2, o2[4]);
  o2[5] = __builtin_elementwise_fma(__builtin_amdgcn_cvt_pk_f32_fp8((int)u.z, true), w2, o2[5]);
  o2[6] = __builtin_elementwise_fma(__builtin_amdgcn_cvt_pk_f32_fp8((int)u.w, false), w2, o2[6]);
  o2[7] = __builtin_elementwise_fma(__builtin_amdgcn_cvt_pk_f32_fp8((int)u.w, true), w2, o2[7]);
}
__device__ __forceinline__ float reduce4_row(float d0, float d1, float d2, float d3, int lane) {
  const bool b0 = lane & 1, b1 = lane & 2;
  const float k0 = b0 ? d1 : d0, s0 = b0 ? d0 : d1;
  const float k1 = b0 ? d3 : d2, s1 = b0 ? d2 : d3;
  const float r0 = k0 + dpp_f<0xB1>(s0);
  const float r1 = k1 + dpp_f<0xB1>(s1);
  const float kk = b1 ? r1 : r0, ss = b1 ? r0 : r1;
  float q = kk + dpp_f<0x4E>(ss);
  q += dpp_f<0x128>(q);
  q += dpp_f<0x124>(q);
  return q;
}
#define EXP_LOAD(dst, dsc, TAB, SC, kbase, esrc)                                     \
  _Pragma("unroll") for (int j = 0; j < 8; ++j) {                                   \
    const int e = __builtin_amdgcn_readlane(esrc, ((kbase) + j) & 63);              \
    dst[j] = ((const uint4*)(TAB + (size_t)e * 1024))[lane];                        \
    dsc[j] = SC[e];                                                                  \
  }
#define EXP_LOADV(dst, TAB, kbase, esrc)                                             \
  _Pragma("unroll") for (int j = 0; j < 8; ++j) {                                   \
    const int e = __builtin_amdgcn_readlane(esrc, ((kbase) + j) & 63);              \
    dst[j] = ((const uint4*)(TAB + (size_t)e * 1024))[lane];                        \
  }
#define EXP_UDOT(src, ssc, kbase)                                                    \
  {                                                                                  \
    float d[8];                                                                      \
    _Pragma("unroll") for (int j = 0; j < 8; ++j) d[j] = dot16_fp8(src[j], x2) * ssc[j]; \
    const float qa = reduce4_row(d[0], d[1], d[2], d[3], lane);                      \
    const float qb = reduce4_row(d[4], d[5], d[6], d[7], lane);                      \
    float q = (lane & 4) ? qb : qa;                                                  \
    q += __shfl_xor(q, 16);                                                          \
    q += __shfl_xor(q, 32);                                                          \
    if ((lane >> 3) == ((((kbase)) & 63) >> 3)) { if ((kbase) < 64) h_lo = q; else h_hi = q; } \
  }
#define EXP_VACC(src, kbase, wsrc)                                                   \
  _Pragma("unroll") for (int j = 0; j < 8; ++j) {                                   \
    const float w = __int_as_float(__builtin_amdgcn_readlane(__float_as_int(wsrc), ((kbase) + j) & 63)); \
    axpy16_fp8(w, src[j], o2);                                                       \
  }

__device__ void ph_expert(const Params& p, int layer) {
  const int lane = threadIdx.x & 63, wid = threadIdx.x >> 6;
  u16* xn16 = (u16*)(p.ws + OFF_XN);
  float* xres = (float*)(p.ws + OFF_X);
  const int* idxs = (const int*)(p.ws + OFF_IDX);
  const float* gates = (const float*)(p.ws + OFF_PGATE);
  const unsigned char* U = (const unsigned char*)(p.ws + OFF_U8);
  const unsigned char* V = (const unsigned char*)(p.ws + OFF_V8);
  const float* USC = (const float*)(p.ws + OFF_USC);
  const float* VSC = (const float*)(p.ws + OFF_VSC);
  for (int tb = blockIdx.x; tb < 4352; tb += gridDim.x) {
    const int t = tb * 4 + wid;
    v2f x2[8];
    {
      const uint4* xr = (const uint4*)(xn16 + (size_t)t * 1024 + lane * 16);
      uint4 xa = xr[0], xb = xr[1];
      x2[0] = v2f{bflo(xa.x), bfhi(xa.x)}; x2[1] = v2f{bflo(xa.y), bfhi(xa.y)};
      x2[2] = v2f{bflo(xa.z), bfhi(xa.z)}; x2[3] = v2f{bflo(xa.w), bfhi(xa.w)};
      x2[4] = v2f{bflo(xb.x), bfhi(xb.x)}; x2[5] = v2f{bflo(xb.y), bfhi(xb.y)};
      x2[6] = v2f{bflo(xb.z), bfhi(xb.z)}; x2[7] = v2f{bflo(xb.w), bfhi(xb.w)};
    }
    const int e_lo = idxs[(size_t)t * 128 + lane], e_hi = idxs[(size_t)t * 128 + 64 + lane];
    const float g_lo = gates[(size_t)t * 128 + lane], g_hi = gates[(size_t)t * 128 + 64 + lane];
    const float vs_lo = VSC[e_lo], vs_hi = VSC[e_hi];
    float h_lo = 0.f, h_hi = 0.f;
    {
      uint4 ba[8], bb[8]; float sa[8], sb[8];
      EXP_LOAD(ba, sa, U, USC, 0, e_lo)
#pragma unroll 1
      for (int kb = 0; kb < 64; kb += 16) {
        EXP_LOAD(bb, sb, U, USC, kb + 8, e_lo)
        EXP_UDOT(ba, sa, kb)
        if (kb + 16 < 64) { EXP_LOAD(ba, sa, U, USC, kb + 16, e_lo) } else { EXP_LOAD(ba, sa, U, USC, 0, e_hi) }
        EXP_UDOT(bb, sb, kb + 8)
      }
#pragma unroll 1
      for (int kb = 64; kb < 128; kb += 16) {
        EXP_LOAD(bb, sb, U, USC, kb + 8, e_hi)
        EXP_UDOT(ba, sa, kb)
        if (kb + 16 < 128) { EXP_LOAD(ba, sa, U, USC, kb + 16, e_hi) }
        EXP_UDOT(bb, sb, kb + 8)
      }
    }
    const float w_lo = 0.5f * h_lo * (1.f + erff(h_lo * 0.70710678118654752f)) * g_lo * vs_lo;
    const float w_hi = 0.5f * h_hi * (1.f + erff(h_hi * 0.70710678118654752f)) * g_hi * vs_hi;
    v2f o2[8];
#pragma unroll
    for (int i = 0; i < 8; ++i) o2[i] = v2f{0.f, 0.f};
    {
      uint4 ba[8], bb[8];
      EXP_LOADV(ba, V, 0, e_lo)
#pragma unroll 1
      for (int kb = 0; kb < 64; kb += 16) {
        EXP_LOADV(bb, V, kb + 8, e_lo)
        EXP_VACC(ba, kb, w_lo)
        if (kb + 16 < 64) { EXP_LOADV(ba, V, kb + 16, e_lo) } else { EXP_LOADV(ba, V, 0, e_hi) }
        EXP_VACC(bb, kb + 8, w_lo)
      }
#pragma unroll 1
      for (int kb = 64; kb < 128; kb += 16) {
        EXP_LOADV(bb, V, kb + 8, e_hi)
        EXP_VACC(ba, kb, w_hi)
        if (kb + 16 < 128) { EXP_LOADV(ba, V, kb + 16, e_hi) }
        EXP_VACC(bb, kb + 8, w_hi)
      }
    }
    float o[16];
#pragma unroll
    for (int i = 0; i < 8; ++i) { o[2 * i] = o2[i].x; o[2 * i + 1] = o2[i].y; }
    float* xr = xres + (size_t)t * 1024 + lane * 16;
    float ss = 0.f;
#pragma unroll
    for (int i = 0; i < 4; ++i) {
      float4 r = *(const float4*)(xr + i * 4);
      o[4 * i] += r.x; o[4 * i + 1] += r.y; o[4 * i + 2] += r.z; o[4 * i + 3] += r.w;
      ss += o[4 * i] * o[4 * i] + o[4 * i + 1] * o[4 * i + 1] + o[4 * i + 2] * o[4 * i + 2] + o[4 * i + 3] * o[4 * i + 3];
    }
    ss = wave_sum(ss);
    const float rs = rsqrtf(ss * (1.f / 1024.f) + 1e-6f);
    if (layer == 0) {
#pragma unroll
      for (int i = 0; i < 4; ++i) *(float4*)(xr + i * 4) = make_float4(o[4 * i], o[4 * i + 1], o[4 * i + 2], o[4 * i + 3]);
      uint4 wa, wb;
      wa.x = pack2(o[0] * rs, o[1] * rs); wa.y = pack2(o[2] * rs, o[3] * rs); wa.z = pack2(o[4] * rs, o[5] * rs); wa.w = pack2(o[6] * rs, o[7] * rs);
      wb.x = pack2(o[8] * rs, o[9] * rs); wb.y = pack2(o[10] * rs, o[11] * rs); wb.z = pack2(o[12] * rs, o[13] * rs); wb.w = pack2(o[14] * rs, o[15] * rs);
      uint4* xw = (uint4*)(xn16 + (size_t)t * 1024 + lane * 16);
      xw[0] = wa; xw[1] = wb;
    } else {
      const float* fg = p.final_norm + lane * 16;
      float* y = p.out + OUT_Y + (size_t)t * 1024 + lane * 16;
#pragma unroll
      for (int i = 0; i < 4; ++i) {
        float4 g = *(const float4*)(fg + i * 4);
        *(float4*)(y + i * 4) = make_float4(o[4 * i] * rs * g.x, o[4 * i + 1] * rs * g.y, o[4 * i + 2] * rs * g.z, o[4 * i + 3] * rs * g.w);
      }
    }
  }
}

__device__ void ph_attn(const Params& p, char* smem) {
  const int tid = threadIdx.x, lane = tid & 63, wid = tid >> 6, fr = lane & 15, fq = lane >> 4;
  const u16* k16 = (const u16*)(p.ws + OFF_K16);
  const u16* v16 = (const u16*)(p.ws + OFF_V16A);
  const u16* q16 = (const u16*)(p.ws + OFF_Q16);
  u16* o16 = (u16*)(p.ws + OFF_O16);
  u16* Ks = (u16*)smem;
  u16* Vt = (u16*)(smem + 27648);
  for (int item = blockIdx.x; item < 1536; item += gridDim.x) {
    const bool is_p = item < 1024;
    int b, kvh, q0 = 0, nsub, nvalid, kpos0, minpos, tokbase;
    if (is_p) { b = item >> 7; kvh = (item >> 5) & 3; q0 = (item & 31) * 64; nsub = 4; nvalid = 192; kpos0 = q0 - 128; minpos = 0; tokbase = b * 2048; }
    else { int it2 = item - 1024; b = it2 >> 2; kvh = it2 & 3; nsub = 1; nvalid = 136; kpos0 = -128; minpos = -100000; tokbase = NTP + b * 8; }
    __syncthreads();
    for (int c = tid; c < 1536; c += 256) {
      const int j = c >> 3, ch = c & 7;
      uint4 kk = make_uint4(0, 0, 0, 0), vv = make_uint4(0, 0, 0, 0);
      if (is_p) {
        const int kp = kpos0 + j;
        if (kp >= 0) {
          const size_t off = (size_t)(tokbase + kp) * 256 + kvh * 64 + ch * 8;
          kk = *(const uint4*)(k16 + off); vv = *(const uint4*)(v16 + off);
        }
      } else {
        if (j < 128) {
          const size_t off = ((size_t)(b * 128 + j) * 4 + kvh) * 64 + ch * 8;
          float4 a0 = *(const float4*)(p.cache_k + off), a1 = *(const float4*)(p.cache_k + off + 4);
          float4 c0 = *(const float4*)(p.cache_v + off), c1 = *(const float4*)(p.cache_v + off + 4);
          kk.x = pack2(a0.x, a0.y); kk.y = pack2(a0.z, a0.w); kk.z = pack2(a1.x, a1.y); kk.w = pack2(a1.z, a1.w);
          vv.x = pack2(c0.x, c0.y); vv.y = pack2(c0.z, c0.w); vv.z = pack2(c1.x, c1.y); vv.w = pack2(c1.z, c1.w);
        } else if (j < 136) {
          const size_t off = (size_t)(tokbase + j - 128) * 256 + kvh * 64 + ch * 8;
          kk = *(const uint4*)(k16 + off); vv = *(const uint4*)(v16 + off);
        }
      }
      *(uint4*)(Ks + j * 72 + ch * 8) = kk;
      u16* vd = Vt + (ch * 8) * 200 + j;
      vd[0] = (u16)(vv.x & 0xffff); vd[200] = (u16)(vv.x >> 16);
      vd[400] = (u16)(vv.y & 0xffff); vd[600] = (u16)(vv.y >> 16);
      vd[800] = (u16)(vv.z & 0xffff); vd[1000] = (u16)(vv.z >> 16);
      vd[1200] = (u16)(vv.w & 0xffff); vd[1400] = (u16)(vv.w >> 16);
    }
    __syncthreads();
    const int head = kvh * 4 + wid;
    const float sink = p.sinks[head];
#pragma unroll 1
    for (int sub = 0; sub < nsub; ++sub) {
      int qtok, qp;
      if (is_p) { qp = q0 + sub * 16 + fr; qtok = tokbase + qp; }
      else { qp = fr & 7; qtok = tokbase + (fr & 7); }
      const u16* qrow = q16 + (size_t)qtok * 1024 + head * 64;
      const bf16x8 qf0 = *(const bf16x8*)(qrow + fq * 8);
      const bf16x8 qf1 = *(const bf16x8*)(qrow + 32 + fq * 8);
      f32x4 s[12];
#pragma unroll
      for (int ks = 0; ks < 12; ++ks) {
        const bf16x8 kf0 = *(const bf16x8*)(Ks + (ks * 16 + fr) * 72 + fq * 8);
        const bf16x8 kf1 = *(const bf16x8*)(Ks + (ks * 16 + fr) * 72 + 32 + fq * 8);
        f32x4 z = {0.f, 0.f, 0.f, 0.f};
        z = __builtin_amdgcn_mfma_f32_16x16x32_bf16(kf0, qf0, z, 0, 0, 0);
        s[ks] = __builtin_amdgcn_mfma_f32_16x16x32_bf16(kf1, qf1, z, 0, 0, 0);
        if ((ks & 3) == 3) __builtin_amdgcn_sched_barrier(0);
      }
      float mx = sink;
#pragma unroll
      for (int ks = 0; ks < 12; ++ks)
#pragma unroll
        for (int j = 0; j < 4; ++j) {
          const int jj = ks * 16 + fq * 4 + j;
          const int kp = kpos0 + jj;
          const bool valid = (jj < nvalid) && (kp >= minpos) && (kp <= qp) && (qp - kp < 128);
          const float v = valid ? s[ks][j] : -1.0e30f;
          s[ks][j] = v;
          mx = fmaxf(mx, v);
        }
      mx = fmaxf(mx, __shfl_xor(mx, 16));
      mx = fmaxf(mx, __shfl_xor(mx, 32));
      float sum = 0.f;
#pragma unroll
      for (int ks = 0; ks < 12; ++ks)
#pragma unroll
        for (int j = 0; j < 4; ++j) {
          const float pv = (s[ks][j] > -1.0e29f) ? __expf(s[ks][j] - mx) : 0.f;
          s[ks][j] = pv;
          sum += pv;
        }
      sum += __shfl_xor(sum, 16);
      sum += __shfl_xor(sum, 32);
      sum += __expf(sink - mx);
      const float inv = 1.f / sum;
      f32x4 o[4];
#pragma unroll
      for (int d = 0; d < 4; ++d) o[d] = f32x4{0.f, 0.f, 0.f, 0.f};
#pragma unroll
      for (int kk = 0; kk < 6; ++kk) {
        union { bf16x8 v; unsigned u[4]; } pb;
        pb.u[0] = pack2(s[2 * kk][0], s[2 * kk][1]); pb.u[1] = pack2(s[2 * kk][2], s[2 * kk][3]);
        pb.u[2] = pack2(s[2 * kk + 1][0], s[2 * kk + 1][1]); pb.u[3] = pack2(s[2 * kk + 1][2], s[2 * kk + 1][3]);
#pragma unroll
        for (int d = 0; d < 4; ++d) {
          union { bf16x8 v; uint2 h[2]; } vf;
          const u16* vr = Vt + (d * 16 + fr) * 200 + fq * 4;
          vf.h[0] = *(const uint2*)(vr + (2 * kk) * 16);
          vf.h[1] = *(const uint2*)(vr + (2 * kk + 1) * 16);
          o[d] = __builtin_amdgcn_mfma_f32_16x16x32_bf16(vf.v, pb.v, o[d], 0, 0, 0);
        }
        __builtin_amdgcn_sched_barrier(0);
      }
      if (is_p || fr < 8) {
#pragma unroll
        for (int d = 0; d < 4; ++d) {
          uint2 w; w.x = pack2(o[d][0] * inv, o[d][1] * inv); w.y = pack2(o[d][2] * inv, o[d][3] * inv);
          *(uint2*)(o16 + (size_t)qtok * 1024 + head * 64 + d * 16 + fq * 4) = w;
        }
      }
    }
  }
}


#define XB_TMO      128
#define XB_XCNT(j)  (256  + 64 * (j))
#define XB_XSUB(j)  (1280 + 64 * (j))
#define XB_XGEN(j)  (2304 + 64 * (j))
#define XB_TOP      3328
#define XB_TOPGEN   3392
#define XCD_BAR_WORDS 3456
#define XB_SPIN_CAP (1u << 20)
#define LAS __attribute__((address_space(3)))
__device__ __forceinline__ unsigned xb_ld(unsigned* p) { return __hip_atomic_load(p, __ATOMIC_RELAXED, __HIP_MEMORY_SCOPE_AGENT); }
__device__ __forceinline__ unsigned xb_add(unsigned* p, unsigned v) { return __hip_atomic_fetch_add(p, v, __ATOMIC_RELAXED, __HIP_MEMORY_SCOPE_AGENT); }
__device__ __forceinline__ unsigned xb_xcc_id() { return (unsigned)__builtin_amdgcn_s_getreg((3 << 11) | 20) & 0xFu; }
#define XB_SPIN(cond, bar) do { unsigned _sp = 0; while (cond) { __builtin_amdgcn_s_sleep(1); \
    if ((++_sp & 255u) == 0u) { if (xb_ld(&(bar)[XB_TMO])) break; if (_sp > XB_SPIN_CAP) { atomicAdd(&(bar)[XB_TMO], 1u); break; } } } } while (0)
struct XcdBarrier { unsigned* bar; unsigned x; volatile LAS unsigned* st; };
__device__ __forceinline__ XcdBarrier xcd_barrier_post(unsigned* bar, volatile LAS unsigned* st) {
  XcdBarrier b; b.bar = bar; b.x = xb_xcc_id(); b.st = st;
  if (threadIdx.x == 0) (void)xb_add(&bar[XB_XCNT(b.x)], 1u);
  return b;
}
__device__ __forceinline__ void xcd_barrier_complete(unsigned* bar, unsigned x, unsigned& nloc, unsigned& nx) {
  const unsigned G = gridDim.x * gridDim.y * gridDim.z;
  unsigned sum, cnt, mine, sp = 0u;
  for (;;) {
    sum = 0u; cnt = 0u; mine = 0u;
#pragma unroll
    for (unsigned j = 0; j < 16; ++j) { const unsigned c = xb_ld(&bar[XB_XCNT(j)]); sum += c; cnt += (c > 0u) ? 1u : 0u; mine = (j == x) ? c : mine; }
    if (sum == G) break;
    __builtin_amdgcn_s_sleep(1);
    if ((++sp & 255u) == 0u) { if (xb_ld(&bar[XB_TMO])) break; if (sp > XB_SPIN_CAP) { atomicAdd(&bar[XB_TMO], 1u); break; } }
  }
  nloc = mine > 0u ? mine : 1u; nx = cnt > 0u ? cnt : 1u;
}
__device__ __forceinline__ void xcd_barrier(const XcdBarrier& b) {
  asm volatile("s_waitcnt vmcnt(0)" ::: "memory");
  __syncthreads();
  if (threadIdx.x == 0) {
    unsigned* bar = b.bar;
    __builtin_amdgcn_s_waitcnt(0);
    unsigned nloc = b.st[0], nx = b.st[1];
    if (nloc == 0u) { xcd_barrier_complete(bar, b.x, nloc, nx); b.st[0] = nloc; b.st[1] = nx; }
    const unsigned old = xb_add(&bar[XB_XSUB(b.x)], 1u);
    const unsigned gen = old / nloc;
    if (old + 1u == (gen + 1u) * nloc) {
      __builtin_amdgcn_fence(__ATOMIC_RELEASE, "agent");
      asm volatile("s_waitcnt vmcnt(0)" ::: "memory");
      const unsigned og = xb_add(&bar[XB_TOP], 1u);
      const unsigned tg = og / nx;
      if (og + 1u == (tg + 1u) * nx) xb_add(&bar[XB_TOPGEN], 1u);
      else XB_SPIN(xb_ld(&bar[XB_TOPGEN]) == tg, bar);
      __builtin_amdgcn_fence(__ATOMIC_ACQUIRE, "agent");
      xb_add(&bar[XB_XGEN(b.x)], 1u);
      asm volatile("s_waitcnt vmcnt(0)" ::: "memory");
    } else {
      XB_SPIN(xb_ld(&bar[XB_XGEN(b.x)]) == gen, bar);
      __builtin_amdgcn_fence(__ATOMIC_ACQUIRE, "agent");
      asm volatile("s_waitcnt vmcnt(0)" ::: "memory");
    }
  }
  __syncthreads();
}

template <int ph>
__device__ __forceinline__ void run_phase(const Params& p, char* smem) {
  char* ws = p.ws;
  switch (ph) {
    case 0: ph_convert0(p, smem); break;
    case 1: {
      EpiWin e{(u16*)(ws + OFF_GATE16), (float*)(ws + OFF_REC32)};
      gemm_tiles((const u16*)(ws + OFF_XN), 1024, (const u16*)(ws + OFF_WT_IN), 1024, 1024, 0, 16, e, smem);
    } break;
    case 2: ph_conv(p); break;
    case 3: {
      EpiBd e{(float*)(ws + OFF_LOGA), (u16*)(ws + OFF_IG16), p.rg_ba, p.rg_bx, p.rg_lambda};
      gemm_tiles((const u16*)(ws + OFF_XC16), 1024, (const u16*)(ws + OFF_WT_BD), 128, 128, 8, 16, e, smem);
    } break;
    case 4: ph_scanA(p); break;
    case 5: ph_scanB(p); break;
    case 6: {
      EpiResid e{&p, (float*)(ws + OFF_X), 1};
      gemm_tiles((const u16*)(ws + OFF_HG16), 1024, (const u16*)(ws + OFF_WT_OUT), 1024, 1024, 0, 8, e, smem);
      ph_cvt_tables(p, 0);
    } break;
    case 7: ph_rmsnorm(p, p.ffn_norm); break;
    case 8: case 16: {
      EpiBf16 e{(u16*)(ws + OFF_QP16), 2048};
      gemm_tiles((const u16*)(ws + OFF_XN), 1024, (const u16*)(ws + (ph == 8 ? OFF_WT_PQ0 : OFF_WT_PQ1)), 1024, 1024, 0, 16, e, smem);
    } break;
    case 9: case 17: {
      EpiF32 e{(float*)(ws + OFF_S32), 2048};
      gemm_tiles((const u16*)(ws + OFF_QP16), 2048, (const u16*)(ws + (ph == 9 ? OFF_WT_SK0 : OFF_WT_SK1)), 128, 128, 16, 16, e, smem);
    } break;
    case 10: case 18: ph_topk(p, smem); break;
    case 11: ph_expert(p, 0); break;
    case 12: {
      EpiKvq e{(u16*)(ws + OFF_K16), (u16*)(ws + OFF_V16A), (u16*)(ws + OFF_Q16), (const float2*)(ws + OFF_ROPE), p.out};
      gemm_tiles((const u16*)(ws + OFF_XN), 1024, (const u16*)(ws + OFF_WT_KVQ), 1024, 1024, 0, 12, e, smem);
      ph_cvt_tables(p, 1);
    } break;
    case 13: ph_attn(p, smem); break;
    case 14: {
      EpiResid e{&p, (float*)(ws + OFF_X), 0};
      gemm_tiles((const u16*)(ws + OFF_O16), 1024, (const u16*)(ws + OFF_WT_O), 1024, 1024, 0, 8, e, smem);
    } break;
    case 15: ph_rmsnorm(p, p.ffn_norm + 1024); break;
    case 19: ph_expert(p, 1); break;
    default: break;
  }
}

__global__ void __launch_bounds__(256, 2) yoco_megakernel(Params p) {
  __shared__ __attribute__((aligned(16))) char smem[73728];
  __shared__ uint4 xb_words;
  cg::grid_group grid = cg::this_grid();
  if (threadIdx.x == 0) xb_words = make_uint4(0u, 0u, 0u, 0u);
  __syncthreads();
  XcdBarrier xb = xcd_barrier_post((unsigned*)(p.ws + OFF_BAR), (volatile LAS unsigned*)&xb_words);
  if (p.ph_end > 1000) grid.sync();
#define PH(k) if (p.ph_begin <= k && k < p.ph_end) { run_phase<k>(p, smem); if (k + 1 < p.ph_end) xcd_barrier(xb); }
  PH(0) PH(1) PH(2) PH(3) PH(4) PH(5) PH(6) PH(7) PH(8) PH(9)
  PH(10) PH(11) PH(12) PH(13) PH(14) PH(15) PH(16) PH(17) PH(18) PH(19)
}

extern "C" void kernel_launch(void* const* d_in, const int* in_sizes, int n_in, void* d_out, int out_size,
                              void* d_ws, size_t ws_size, hipStream_t stream) {
  static int grid_blocks = 0;
  if (!grid_blocks) {
    int dev = 0, cus = 0, per_cu = 0;
    hipGetDevice(&dev);
    hipDeviceGetAttribute(&cus, hipDeviceAttributeMultiprocessorCount, dev);
    hipOccupancyMaxActiveBlocksPerMultiprocessor(&per_cu, yoco_megakernel, 256, 0);
    if (per_cu > 2) per_cu = 2;
    if (per_cu < 1) per_cu = 1;
    grid_blocks = cus * per_cu;
    if (ws_size < WS_NEEDED) fprintf(stderr, "workspace too small: %zu < %llu\n", ws_size, (unsigned long long)WS_NEEDED);
  }
  Params p{};
  const float** f = (const float**)&p;
  for (int i = 0; i < 28; ++i) f[i] = (const float*)d_in[i];
  p.out = (float*)d_out;
  p.ws = (char*)d_ws;
  hipMemsetAsync((char*)d_ws + OFF_BAR, 0, XCD_BAR_WORDS * sizeof(unsigned), stream);
#if MULTI_LAUNCH
  for (int ph = 0; ph < NPHASE; ++ph) {
    p.ph_begin = ph; p.ph_end = ph + 1;
    hipLaunchKernelGGL(yoco_megakernel, dim3(grid_blocks), dim3(256), 0, stream, p);
  }
#else
  p.ph_begin = 0; p.ph_end = NPHASE;
  void* args[] = {&p};
  hipError_t e = hipLaunchCooperativeKernel((void*)yoco_megakernel, dim3(grid_blocks), dim3(256), args, 0, stream);
  if (e != hipSuccess) fprintf(stderr, "cooperative launch failed: %s (grid %d)\n", hipGetErrorString(e), grid_blocks);
#endif
}
```

```cpp
#include <hip/hip_runtime.h>
#include <hip/hip_cooperative_groups.h>
#include <cstdio>
#include <cstdint>
namespace cg = cooperative_groups;

typedef unsigned short u16;
typedef __attribute__((ext_vector_type(8))) short bf16x8;
typedef __attribute__((ext_vector_type(4))) float f32x4;

#define NTOK 17408
#define NTP 16384
#define MIB 1048576ull
#define NPHASE 20
#ifndef MULTI_LAUNCH
#define MULTI_LAUNCH 0
#endif

#define OFF_WT_IN   (0 * MIB)
#define OFF_WT_OUT  (4 * MIB)
#define OFF_WT_BD   (6 * MIB)
#define OFF_WT_PQ0  (7 * MIB)
#define OFF_WT_PQ1  (11 * MIB)
#define OFF_WT_KVQ  (15 * MIB)
#define OFF_WT_O    (18 * MIB)
#define OFF_WT_SK0  (20 * MIB)
#define OFF_WT_SK1  (20 * MIB + 524288ull)
#define OFF_ROPE    (21 * MIB)
#define OFF_USC     (21 * MIB + 655360ull)
#define OFF_VSC     (21 * MIB + 655360ull + 65536ull)
#define OFF_U8      (22 * MIB)
#define OFF_V8      (38 * MIB)
#define OFF_XN      (86 * MIB)
#define OFF_X       (120 * MIB)
#define OFF_GATE16  (188 * MIB)
#define OFF_REC32   (222 * MIB)
#define OFF_XC32    (290 * MIB)
#define OFF_XC16    (358 * MIB)
#define OFF_LOGA    (222 * MIB)
#define OFF_IG16    (22 * MIB)
#define OFF_AGGA    (56 * MIB)
#define OFF_AGGB    (60 * MIB)
#define OFF_HG16    (358 * MIB)
#define OFF_QP16    (188 * MIB)
#define OFF_S32     (256 * MIB)
#define OFF_IDX     (188 * MIB)
#define OFF_PGATE   (197 * MIB)
#define OFF_K16     (188 * MIB)
#define OFF_V16A    (197 * MIB)
#define OFF_Q16     (206 * MIB)
#define OFF_O16     (240 * MIB)
#define OFF_BAR     (392 * MIB)
#define WS_NEEDED   (392 * MIB + 16384ull)

#define OUT_Y      0
#define OUT_CONVP  17825792
#define OUT_HP     17850368
#define OUT_KP     17858560
#define OUT_VP     18120704
#define OUT_CONVS  18382848
#define OUT_HS     18776064
#define OUT_KS     18907136
#define OUT_VS     23101440

struct Params {
  const float *x_prompt, *x_sample, *state_conv, *state_h, *cache_k, *cache_v;
  const float *rg_norm, *rg_w_in, *rg_conv_w, *rg_conv_b, *rg_wa, *rg_ba, *rg_wx, *rg_bx, *rg_lambda, *rg_w_out;
  const float *kv_norm, *w_kv, *attn_norm, *w_q, *sinks, *w_o, *ffn_norm, *peer_wq, *peer_subkeys, *peer_u, *peer_v, *final_norm;
  float* out;
  char* ws;
  int ph_begin, ph_end;
};

__device__ __forceinline__ u16 f2bf(float f) {
  unsigned u = __float_as_uint(f);
  u += 0x7fffu + ((u >> 16) & 1u);
  return (u16)(u >> 16);
}
__device__ __forceinline__ float bf2f(u16 h) { return __uint_as_float(((unsigned)h) << 16); }
__device__ __forceinline__ unsigned pack2(float a, float b) { return (unsigned)f2bf(a) | ((unsigned)f2bf(b) << 16); }
__device__ __forceinline__ float bflo(unsigned u) { return __uint_as_float(u << 16); }
__device__ __forceinline__ float bfhi(unsigned u) { return __uint_as_float(u & 0xffff0000u); }
__device__ __forceinline__ float wave_sum(float v) {
#pragma unroll
  for (int o = 32; o > 0; o >>= 1) v += __shfl_xor(v, o);
  return v;
}
__device__ __forceinline__ const float* xin_row(const Params& p, int token) {
  return token < NTP ? p.x_prompt + (size_t)token * 1024 : p.x_sample + (size_t)(token - NTP) * 1024;
}
__device__ __forceinline__ float gelu_tanh(float x) {
  float u = 0.7978845608028654f * (x + 0.044715f * x * x * x);
  float e = __expf(2.f * u);
  float th = 1.f - 2.f / (e + 1.f);
  return 0.5f * x * (1.f + th);
}
__device__ __forceinline__ float sigmoidf_(float x) { return 1.f / (1.f + __expf(-x)); }

template <int CTRL>
__device__ __forceinline__ int dpp_i(int v) { return __builtin_amdgcn_update_dpp(v, v, CTRL, 0xf, 0xf, false); }
__device__ __forceinline__ int grp_max_i(int v) {
  v = max(v, dpp_i<0xB1>(v));
  v = max(v, dpp_i<0x4E>(v));
  v = max(v, dpp_i<0x141>(v));
  v = max(v, dpp_i<0x140>(v));
  return v;
}
__device__ __forceinline__ float grp_max_f(float v) {
  v = fmaxf(v, __int_as_float(dpp_i<0xB1>(__float_as_int(v))));
  v = fmaxf(v, __int_as_float(dpp_i<0x4E>(__float_as_int(v))));
  v = fmaxf(v, __int_as_float(dpp_i<0x141>(__float_as_int(v))));
  v = fmaxf(v, __int_as_float(dpp_i<0x140>(__float_as_int(v))));
  return v;
}
__device__ __forceinline__ float grp_sum_f(float v) {
  v += __int_as_float(dpp_i<0xB1>(__float_as_int(v)));
  v += __int_as_float(dpp_i<0x4E>(__float_as_int(v)));
  v += __int_as_float(dpp_i<0x141>(__float_as_int(v)));
  v += __int_as_float(dpp_i<0x140>(__float_as_int(v)));
  return v;
}

__device__ void transpose_unit(const float* __restrict__ src, int ld_src, u16* __restrict__ dst, int ld_dst,
                               int kt, int nt, const float* __restrict__ gain, float* lds) {
  const int tid = threadIdx.x;
#pragma unroll
  for (int j = 0; j < 4; ++j) {
    int idx = tid + j * 256;
    int k = idx >> 4, c4 = idx & 15;
    float4 v = *(const float4*)(src + (size_t)(kt * 64 + k) * ld_src + nt * 64 + c4 * 4);
    float g = gain ? gain[kt * 64 + k] : 1.f;
    float* d = lds + k * 65 + c4 * 4;
    d[0] = v.x * g; d[1] = v.y * g; d[2] = v.z * g; d[3] = v.w * g;
  }
  __syncthreads();
#pragma unroll
  for (int j = 0; j < 2; ++j) {
    int c = tid + j * 256;
    int n = c >> 3, kc = c & 7;
    uint4 o;
    o.x = pack2(lds[(kc * 8 + 0) * 65 + n], lds[(kc * 8 + 1) * 65 + n]);
    o.y = pack2(lds[(kc * 8 + 2) * 65 + n], lds[(kc * 8 + 3) * 65 + n]);
    o.z = pack2(lds[(kc * 8 + 4) * 65 + n], lds[(kc * 8 + 5) * 65 + n]);
    o.w = pack2(lds[(kc * 8 + 6) * 65 + n], lds[(kc * 8 + 7) * 65 + n]);
    *(uint4*)(dst + (size_t)(nt * 64 + n) * ld_dst + kt * 64 + kc * 8) = o;
  }
  __syncthreads();
}

__device__ void transpose_job(const Params& p, int u, float* lds) {
  char* ws = p.ws;
  if (u < 512) { transpose_unit(p.rg_w_in, 2048, (u16*)(ws + OFF_WT_IN), 1024, u >> 5, u & 31, nullptr, lds); return; }
  u -= 512;
  if (u < 256) { transpose_unit(p.rg_w_out, 1024, (u16*)(ws + OFF_WT_OUT), 1024, u >> 4, u & 15, nullptr, lds); return; }
  u -= 256;
  if (u < 64) {
    int which = u >> 5; int r = u & 31; int bi = r >> 2; int t = r & 3;
    const float* src = (which ? p.rg_wx : p.rg_wa) + (size_t)bi * 16384;
    u16* dst = (u16*)(ws + OFF_WT_BD) + (size_t)(which * 1024 + bi * 128) * 128;
    transpose_unit(src, 128, dst, 128, t >> 1, t & 1, nullptr, lds); return;
  }
  u -= 64;
  if (u < 1024) {
    int l = u >> 9; int r = u & 511;
    transpose_unit(p.peer_wq + (size_t)l * 2097152, 2048, (u16*)(ws + (l ? OFF_WT_PQ1 : OFF_WT_PQ0)), 1024, r >> 5, r & 31, nullptr, lds); return;
  }
  u -= 1024;
  if (u < 128) { transpose_unit(p.w_kv, 512, (u16*)(ws + OFF_WT_KVQ), 1024, u >> 3, u & 7, p.kv_norm, lds); return; }
  u -= 128;
  if (u < 256) { transpose_unit(p.w_q, 1024, (u16*)(ws + OFF_WT_KVQ) + (size_t)512 * 1024, 1024, u >> 4, u & 15, p.attn_norm, lds); return; }
  u -= 256;
  transpose_unit(p.w_o, 1024, (u16*)(ws + OFF_WT_O), 1024, u >> 4, u & 15, nullptr, lds);
}

__device__ __forceinline__ void cvt_unit(const float* __restrict__ src, u16* __restrict__ dst, size_t base) {
  const int tid = threadIdx.x;
#pragma unroll
  for (int j = 0; j < 2; ++j) {
    size_t o = base + j * 1024 + tid * 4;
    float4 v = *(const float4*)(src + o);
    uint2 w; w.x = pack2(v.x, v.y); w.y = pack2(v.z, v.w);
    *(uint2*)(dst + o) = w;
  }
}

__device__ __forceinline__ void rmsnorm_row(const float* __restrict__ x, const float* __restrict__ g, u16* __restrict__ o, int lane) {
  float4 v[4];
  float ss = 0.f;
#pragma unroll
  for (int i = 0; i < 4; ++i) {
    v[i] = *(const float4*)(x + i * 256 + lane * 4);
    ss += v[i].x * v[i].x + v[i].y * v[i].y + v[i].z * v[i].z + v[i].w * v[i].w;
  }
  ss = wave_sum(ss);
  float r = rsqrtf(ss * (1.f / 1024.f) + 1e-6f);
#pragma unroll
  for (int i = 0; i < 4; ++i) {
    float4 gg = *(const float4*)(g + i * 256 + lane * 4);
    uint2 w; w.x = pack2(v[i].x * r * gg.x, v[i].y * r * gg.y); w.y = pack2(v[i].z * r * gg.z, v[i].w * r * gg.w);
    *(uint2*)(o + i * 256 + lane * 4) = w;
  }
}

__device__ void ph_convert0(const Params& p, char* smem) {
  const int tid = threadIdx.x, lane = tid & 63, wid = tid >> 6;
  const int NT = 2496, NSK = 256, NROPE = 257, NRMS = 4352, NCACHE = 3840;
  const int total = NT + NSK + NROPE + NRMS + NCACHE;
  for (int u0 = blockIdx.x; u0 < total; u0 += gridDim.x) {
    int u = u0;
    if (u < NT) { transpose_job(p, u, (float*)smem); continue; }
    u -= NT;
    if (u < NSK) {
      int l = u >> 7; int r = u & 127;
      const float* src = p.peer_subkeys + (size_t)l * 32768;
      u16* dst = (u16*)(p.ws + (l ? OFF_WT_SK1 : OFF_WT_SK0));
#pragma unroll
      for (int j = 0; j < 2; ++j) {
        int i = r * 2048 + j * 1024 + tid * 4;
        int s = ((i >> 14) & 1) * 16384 + (i & 16383);
        float4 v = *(const float4*)(src + s);
        uint2 w; w.x = pack2(v.x, v.y); w.y = pack2(v.z, v.w);
        *(uint2*)(dst + i) = w;
      }
      continue;
    }
    u -= NSK;
    if (u < NROPE) {
      int i = u * 256 + tid;
      if (i < 2056 * 32) {
        int pi = i >> 5, d = i & 31;
        int pos = pi < 2048 ? pi : (16384 + pi - 2048);
        float inv = (float)pow(10000.0, -(double)d / 32.0);
        float ang = (float)pos * inv;
        double sn, cs;
        sincos((double)ang, &sn, &cs);
        float2* rt = (float2*)(p.ws + OFF_ROPE);
        rt[i] = make_float2((float)cs, (float)sn);
      }
      continue;
    }
    u -= NROPE;
    if (u < NRMS) {
      int t = u * 4 + wid;
      rmsnorm_row(xin_row(p, t), p.rg_norm, (u16*)(p.ws + OFF_XN) + (size_t)t * 1024, lane);
      continue;
    }
    u -= NRMS;
    {
      int which = u / 1920; int r = u - which * 1920;
      int b = r / 15, c = r - b * 15;
      const float* src = (which ? p.cache_v : p.cache_k) + (size_t)b * 32768 + 2048 + c * 2048;
      float* dst = p.out + (which ? OUT_VS : OUT_KS) + (size_t)b * 32768 + c * 2048;
#pragma unroll
      for (int j = 0; j < 2; ++j) {
        int o = j * 1024 + tid * 4;
        *(float4*)(dst + o) = *(const float4*)(src + o);
      }
    }
  }
}

__device__ void ph_cvt_tables(const Params& p, int layer) {
  const int lane = threadIdx.x & 63, wid = threadIdx.x >> 6;
  for (int u = blockIdx.x; u < 8192; u += gridDim.x) {
    const int which = u >> 12; const int row = (u & 4095) * 4 + wid;
    const float* src = (which ? p.peer_v : p.peer_u) + (size_t)layer * 16777216 + (size_t)row * 1024 + lane * 16;
    unsigned char* dst = (unsigned char*)(p.ws + (which ? OFF_V8 : OFF_U8)) + (size_t)row * 1024 + lane * 16;
    float* sc = (float*)(p.ws + (which ? OFF_VSC : OFF_USC));
    float4 a = *(const float4*)(src), b = *(const float4*)(src + 4), c = *(const float4*)(src + 8), d = *(const float4*)(src + 12);
    float m = fmaxf(fmaxf(fmaxf(fabsf(a.x), fabsf(a.y)), fmaxf(fabsf(a.z), fabsf(a.w))), fmaxf(fmaxf(fabsf(b.x), fabsf(b.y)), fmaxf(fabsf(b.z), fabsf(b.w))));
    m = fmaxf(m, fmaxf(fmaxf(fmaxf(fabsf(c.x), fabsf(c.y)), fmaxf(fabsf(c.z), fabsf(c.w))), fmaxf(fmaxf(fabsf(d.x), fabsf(d.y)), fmaxf(fabsf(d.z), fabsf(d.w)))));
#pragma unroll
    for (int o = 32; o > 0; o >>= 1) m = fmaxf(m, __shfl_xor(m, o));
    const float scl = m > 0.f ? 440.f / m : 1.f;
    uint4 w; int t;
    t = 0; t = __builtin_amdgcn_cvt_pk_fp8_f32(a.x * scl, a.y * scl, t, false); t = __builtin_amdgcn_cvt_pk_fp8_f32(a.z * scl, a.w * scl, t, true); w.x = (unsigned)t;
    t = 0; t = __builtin_amdgcn_cvt_pk_fp8_f32(b.x * scl, b.y * scl, t, false); t = __builtin_amdgcn_cvt_pk_fp8_f32(b.z * scl, b.w * scl, t, true); w.y = (unsigned)t;
    t = 0; t = __builtin_amdgcn_cvt_pk_fp8_f32(c.x * scl, c.y * scl, t, false); t = __builtin_amdgcn_cvt_pk_fp8_f32(c.z * scl, c.w * scl, t, true); w.z = (unsigned)t;
    t = 0; t = __builtin_amdgcn_cvt_pk_fp8_f32(d.x * scl, d.y * scl, t, false); t = __builtin_amdgcn_cvt_pk_fp8_f32(d.z * scl, d.w * scl, t, true); w.w = (unsigned)t;
    *(uint4*)dst = w;
    if (lane == 0) sc[row] = m > 0.f ? m / 440.f : 1.f;
  }
}

__device__ void ph_rmsnorm(const Params& p, const float* g) {
  const int lane = threadIdx.x & 63, wid = threadIdx.x >> 6;
  const float* x = (const float*)(p.ws + OFF_X);
  u16* xn = (u16*)(p.ws + OFF_XN);
  for (int u = blockIdx.x; u < 4352; u += gridDim.x) {
    int t = u * 4 + wid;
    rmsnorm_row(x + (size_t)t * 1024, g, xn + (size_t)t * 1024, lane);
  }
}

#define LASP __attribute__((address_space(3)))
template <class Epi>
__device__ __forceinline__ void gemm_tiles(const u16* __restrict__ A, int lda, const u16* __restrict__ W, int ldw,
                                           int K, int kmod, int ntn, const Epi& epi, char* smem_g) {
  LASP unsigned char* smem = (LASP unsigned char*)smem_g;
  const int tid = threadIdx.x, lane = tid & 63, wid = tid >> 6;
  const int wr = wid >> 1, wc = wid & 1, fr = lane & 15, fq = lane >> 4;
  const int total = 136 * ntn;
  const int nk = K >> 6;
  const int swz = (lane * 16) ^ ((lane >> 5) << 5);
  int offA[4], offW[4];
#pragma unroll
  for (int i = 0; i < 4; ++i) {
    const int st = i * 4 + wid;
    const int R = (st >> 1) * 16 + (swz >> 6), C = (st & 1) * 32 + ((swz & 63) >> 1);
    offA[i] = R * lda + C; offW[i] = R * ldw + C;
  }
  const int lane_off = (fr * 64 + fq * 16) ^ ((fr >> 3) << 5);
#define GEMM_STAGE(buf, Ag_, Wg_, k0_)                                                                          \
  _Pragma("unroll") for (int i = 0; i < 4; ++i) {                                                               \
    __builtin_amdgcn_global_load_lds((const unsigned*)((Wg_) + offW[i] + (k0_)), (LASP unsigned*)(smem + (buf) * 32768 + i * 4096 + wid * 1024), 16, 0, 0);         \
    __builtin_amdgcn_global_load_lds((const unsigned*)((Ag_) + offA[i] + (k0_)), (LASP unsigned*)(smem + (buf) * 32768 + 16384 + i * 4096 + wid * 1024), 16, 0, 0); \
  }
  for (int tile = blockIdx.x; tile < total; tile += gridDim.x) {
    const int tm = tile / ntn, tn = tile - tm * ntn;
    const u16* Ag = A + (size_t)(tm * 128) * lda + (kmod ? (tn % kmod) * 128 : 0);
    const u16* Wg = W + (size_t)(tn * 128) * ldw;
    f32x4 acc[4][4];
#pragma unroll
    for (int m = 0; m < 4; ++m)
#pragma unroll
      for (int n = 0; n < 4; ++n) acc[m][n] = f32x4{0.f, 0.f, 0.f, 0.f};
    __syncthreads();
    GEMM_STAGE(0, Ag, Wg, 0)
    for (int kt = 0; kt < nk; ++kt) {
      const int cur = kt & 1;
      asm volatile("s_waitcnt vmcnt(0)" ::: "memory");
      __syncthreads();
      const LASP unsigned char* sW = smem + cur * 32768;
      const LASP unsigned char* sA = sW + 16384;
      bf16x8 a[2][4], b[2][4];
#pragma unroll
      for (int ks = 0; ks < 2; ++ks) {
#pragma unroll
        for (int m = 0; m < 4; ++m) a[ks][m] = *(const LASP bf16x8*)(sW + (wr * 8 + m * 2 + ks) * 1024 + lane_off);
#pragma unroll
        for (int n = 0; n < 4; ++n) b[ks][n] = *(const LASP bf16x8*)(sA + (wc * 8 + n * 2 + ks) * 1024 + lane_off);
      }
      __builtin_amdgcn_sched_barrier(0);
      if (kt + 1 < nk) { GEMM_STAGE(cur ^ 1, Ag, Wg, (kt + 1) * 64) }
      __builtin_amdgcn_sched_barrier(0);
#pragma unroll
      for (int ks = 0; ks < 2; ++ks)
#pragma unroll
        for (int m = 0; m < 4; ++m)
#pragma unroll
          for (int n = 0; n < 4; ++n) acc[m][n] = __builtin_amdgcn_mfma_f32_16x16x32_bf16(a[ks][m], b[ks][n], acc[m][n], 0, 0, 0);
    }
    epi(acc, tm * 128 + wc * 64, tn * 128 + wr * 64, fr, fq);
  }
#undef GEMM_STAGE
}

struct EpiWin {
  u16* gate16; float* rec32;
  __device__ __forceinline__ void operator()(const f32x4 (&acc)[4][4], int tok0, int feat0, int fr, int fq) const {
#pragma unroll
    for (int n = 0; n < 4; ++n) {
      const int tok = tok0 + n * 16 + fr;
#pragma unroll
      for (int m = 0; m < 4; ++m) {
        const int f = feat0 + m * 16 + fq * 4;
        f32x4 v = acc[m][n];
        if (feat0 < 1024) {
          uint2 w; w.x = pack2(gelu_tanh(v[0]), gelu_tanh(v[1])); w.y = pack2(gelu_tanh(v[2]), gelu_tanh(v[3]));
          *(uint2*)(gate16 + (size_t)tok * 1024 + f) = w;
        } else {
          *(float4*)(rec32 + (size_t)tok * 1024 + (f - 1024)) = make_float4(v[0], v[1], v[2], v[3]);
        }
      }
    }
  }
};
struct EpiBd {
  float* loga; u16* ig16; const float *ba, *bx, *lam;
  __device__ __forceinline__ void operator()(const f32x4 (&acc)[4][4], int tok0, int feat0, int fr, int fq) const {
#pragma unroll
    for (int m = 0; m < 4; ++m) {
      const int f = feat0 + m * 16 + fq * 4;
      if (feat0 < 1024) {
        float4 b4 = *(const float4*)(ba + f);
        float4 l4 = *(const float4*)(lam + f);
        float sp0 = log1pf(__expf(-l4.x)), sp1 = log1pf(__expf(-l4.y)), sp2 = log1pf(__expf(-l4.z)), sp3 = log1pf(__expf(-l4.w));
#pragma unroll
        for (int n = 0; n < 4; ++n) {
          const int tok = tok0 + n * 16 + fr;
          f32x4 v = acc[m][n];
          float4 o;
          o.x = -8.f * sigmoidf_(v[0] + b4.x) * sp0;
          o.y = -8.f * sigmoidf_(v[1] + b4.y) * sp1;
          o.z = -8.f * sigmoidf_(v[2] + b4.z) * sp2;
          o.w = -8.f * sigmoidf_(v[3] + b4.w) * sp3;
          *(float4*)(loga + (size_t)tok * 1024 + f) = o;
        }
      } else {
        float4 b4 = *(const float4*)(bx + (f - 1024));
#pragma unroll
        for (int n = 0; n < 4; ++n) {
          const int tok = tok0 + n * 16 + fr;
          f32x4 v = acc[m][n];
          uint2 w;
          w.x = pack2(sigmoidf_(v[0] + b4.x), sigmoidf_(v[1] + b4.y));
          w.y = pack2(sigmoidf_(v[2] + b4.z), sigmoidf_(v[3] + b4.w));
          *(uint2*)(ig16 + (size_t)tok * 1024 + (f - 1024)) = w;
        }
      }
    }
  }
};
struct EpiResid {
  const Params* p; float* xres; int first;
  __device__ __forceinline__ void operator()(const f32x4 (&acc)[4][4], int tok0, int feat0, int fr, int fq) const {
#pragma unroll
    for (int n = 0; n < 4; ++n) {
      const int tok = tok0 + n * 16 + fr;
      const float* base = first ? xin_row(*p, tok) : (xres + (size_t)tok * 1024);
#pragma unroll
      for (int m = 0; m < 4; ++m) {
        const int f = feat0 + m * 16 + fq * 4;
        float4 b = *(const float4*)(base + f);
        f32x4 v = acc[m][n];
        *(float4*)(xres + (size_t)tok * 1024 + f) = make_float4(b.x + v[0], b.y + v[1], b.z + v[2], b.w + v[3]);
      }
    }
  }
};
struct EpiBf16 {
  u16* o; int ld;
  __device__ __forceinline__ void operator()(const f32x4 (&acc)[4][4], int tok0, int feat0, int fr, int fq) const {
#pragma unroll
    for (int n = 0; n < 4; ++n) {
      const int tok = tok0 + n * 16 + fr;
#pragma unroll
      for (int m = 0; m < 4; ++m) {
        const int f = feat0 + m * 16 + fq * 4;
        f32x4 v = acc[m][n];
        uint2 w; w.x = pack2(v[0], v[1]); w.y = pack2(v[2], v[3]);
        *(uint2*)(o + (size_t)tok * ld + f) = w;
      }
    }
  }
};
struct EpiF32 {
  float* o; int ld;
  __device__ __forceinline__ void operator()(const f32x4 (&acc)[4][4], int tok0, int feat0, int fr, int fq) const {
#pragma unroll
    for (int n = 0; n < 4; ++n) {
      const int tok = tok0 + n * 16 + fr;
#pragma unroll
      for (int m = 0; m < 4; ++m) {
        const int f = feat0 + m * 16 + fq * 4;
        f32x4 v = acc[m][n];
        *(float4*)(o + (size_t)tok * ld + f) = make_float4(v[0], v[1], v[2], v[3]);
      }
    }
  }
};
struct EpiKvq {
  u16 *k16, *v16, *q16; const float2* rope; float* out;
  __device__ __forceinline__ void operator()(const f32x4 (&acc)[4][4], int tok0, int feat0, int fr, int fq) const {
#pragma unroll
    for (int n = 0; n < 4; ++n) {
      const int tok = tok0 + n * 16 + fr;
      int b, t, pi, orow; bool is_p = tok < NTP;
      if (is_p) { b = tok >> 11; t = tok & 2047; pi = t; orow = t - 1920; }
      else { int ts = tok - NTP; b = ts >> 3; t = ts & 7; pi = 2048 + t; orow = 120 + t; }
      if (feat0 >= 256 && feat0 < 512) {
        const int kvh = (feat0 - 256) >> 6;
#pragma unroll
        for (int m = 0; m < 4; ++m) {
          const int d = m * 16 + fq * 4;
          f32x4 v = acc[m][n];
          uint2 w; w.x = pack2(v[0], v[1]); w.y = pack2(v[2], v[3]);
          *(uint2*)(v16 + (size_t)tok * 256 + kvh * 64 + d) = w;
          if (orow >= 0) {
            float* dst = out + (is_p ? OUT_VP : OUT_VS) + ((size_t)(b * 128 + orow) * 4 + kvh) * 64 + d;
            *(float4*)dst = make_float4(v[0], v[1], v[2], v[3]);
          }
        }
      } else {
        const bool isk = feat0 < 256;
        const float sc = isk ? 1.f : 0.125f;
#pragma unroll
        for (int m = 0; m < 2; ++m) {
          const int d = m * 16 + fq * 4;
          f32x4 x1 = acc[m][n], x2 = acc[m + 2][n];
          const float2* rp = rope + pi * 32 + d;
          float o1[4], o2[4];
#pragma unroll
          for (int j = 0; j < 4; ++j) {
            float2 csn = rp[j];
            o1[j] = (x1[j] * csn.x - x2[j] * csn.y) * sc;
            o2[j] = (x2[j] * csn.x + x1[j] * csn.y) * sc;
          }
          uint2 w1, w2;
          w1.x = pack2(o1[0], o1[1]); w1.y = pack2(o1[2], o1[3]);
          w2.x = pack2(o2[0], o2[1]); w2.y = pack2(o2[2], o2[3]);
          if (isk) {
            const int kvh = feat0 >> 6;
            *(uint2*)(k16 + (size_t)tok * 256 + kvh * 64 + d) = w1;
            *(uint2*)(k16 + (size_t)tok * 256 + kvh * 64 + d + 32) = w2;
            if (orow >= 0) {
              float* dst = out + (is_p ? OUT_KP : OUT_KS) + ((size_t)(b * 128 + orow) * 4 + kvh) * 64 + d;
              *(float4*)dst = make_float4(o1[0], o1[1], o1[2], o1[3]);
              *(float4*)(dst + 32) = make_float4(o2[0], o2[1], o2[2], o2[3]);
            }
          } else {
            const int f = feat0 - 512;
            *(uint2*)(q16 + (size_t)tok * 1024 + f + d) = w1;
            *(uint2*)(q16 + (size_t)tok * 1024 + f + d + 32) = w2;
          }
        }
      }
    }
  }
};

__device__ void ph_conv(const Params& p) {
  const float* rec = (const float*)(p.ws + OFF_REC32);
  float* xc32 = (float*)(p.ws + OFF_XC32);
  u16* xc16 = (u16*)(p.ws + OFF_XC16);
  const int nunits = NTOK * 256;
  for (int idx = blockIdx.x * 256 + threadIdx.x; idx < nunits; idx += gridDim.x * 256) {
    const int tok = idx >> 8, c = (idx & 255) * 4;
    int b, t; const float* buf = nullptr;
    if (tok < NTP) { b = tok >> 11; t = tok & 2047; }
    else { int ts = tok - NTP; b = ts >> 3; t = ts & 7; buf = p.state_conv + (size_t)b * 3072; }
    float4 r[4];
    r[0] = *(const float4*)(rec + (size_t)tok * 1024 + c);
#pragma unroll
    for (int L = 1; L <= 3; ++L) {
      if (t - L >= 0) r[L] = *(const float4*)(rec + (size_t)(tok - L) * 1024 + c);
      else if (buf) r[L] = *(const float4*)(buf + (size_t)(3 + t - L) * 1024 + c);
      else r[L] = make_float4(0.f, 0.f, 0.f, 0.f);
    }
    float4 w0 = *(const float4*)(p.rg_conv_w + c), w1 = *(const float4*)(p.rg_conv_w + 1024 + c);
    float4 w2 = *(const float4*)(p.rg_conv_w + 2048 + c), w3 = *(const float4*)(p.rg_conv_w + 3072 + c);
    float4 cb = *(const float4*)(p.rg_conv_b + c);
    float4 o;
    o.x = cb.x + w3.x * r[0].x + w2.x * r[1].x + w1.x * r[2].x + w0.x * r[3].x;
    o.y = cb.y + w3.y * r[0].y + w2.y * r[1].y + w1.y * r[2].y + w0.y * r[3].y;
    o.z = cb.z + w3.z * r[0].z + w2.z * r[1].z + w1.z * r[2].z + w0.z * r[3].z;
    o.w = cb.w + w3.w * r[0].w + w2.w * r[1].w + w1.w * r[2].w + w0.w * r[3].w;
    *(float4*)(xc32 + (size_t)tok * 1024 + c) = o;
    uint2 w; w.x = pack2(o.x, o.y); w.y = pack2(o.z, o.w);
    *(uint2*)(xc16 + (size_t)tok * 1024 + c) = w;
    if (tok < NTP) {
      if (t >= 2045) *(float4*)(p.out + OUT_CONVP + ((size_t)b * 3 + (t - 2045)) * 1024 + c) = r[0];
    } else {
      if (t >= 5) *(float4*)(p.out + OUT_CONVS + ((size_t)b * 3 + (t - 5)) * 1024 + c) = r[0];
    }
  }
}

__device__ __forceinline__ float rg_mult(float la) {
  const float t = 2.f * la;
  const float ser = -t * (1.f + t * (0.5f + t * (0.16666667f + t * (0.041666668f + t * 0.0083333333f))));
  const float dir = 1.f - __expf(t);
  return __builtin_amdgcn_sqrtf(t > -0.25f ? ser : dir);
}
__device__ __forceinline__ void scan_step(const float* loga, const u16* ig16, const float* xc32, size_t off, float4& a, float4& bt) {
  float4 la = *(const float4*)(loga + off);
  uint2 gi = *(const uint2*)(ig16 + off);
  float4 xc = *(const float4*)(xc32 + off);
  a.x = __expf(la.x); a.y = __expf(la.y); a.z = __expf(la.z); a.w = __expf(la.w);
  bt.x = rg_mult(la.x) * bflo(gi.x) * xc.x;
  bt.y = rg_mult(la.y) * bfhi(gi.x) * xc.y;
  bt.z = rg_mult(la.z) * bflo(gi.y) * xc.z;
  bt.w = rg_mult(la.w) * bfhi(gi.y) * xc.w;
}
__device__ void ph_scanA(const Params& p) {
  const float* loga = (const float*)(p.ws + OFF_LOGA);
  const u16* ig16 = (const u16*)(p.ws + OFF_IG16);
  const float* xc32 = (const float*)(p.ws + OFF_XC32);
  float* aggA = (float*)(p.ws + OFF_AGGA);
  float* aggB = (float*)(p.ws + OFF_AGGB);
  const int c = threadIdx.x * 4;
  for (int item = blockIdx.x; item < 1024; item += gridDim.x) {
    const int b = item >> 7, ch = item & 127;
    float4 A = make_float4(1.f, 1.f, 1.f, 1.f), B = make_float4(0.f, 0.f, 0.f, 0.f);
    const size_t tok0 = (size_t)b * 2048 + ch * 16;
#pragma unroll
    for (int s = 0; s < 16; ++s) {
      float4 a, bt;
      scan_step(loga, ig16, xc32, (tok0 + s) * 1024 + c, a, bt);
      A.x *= a.x; A.y *= a.y; A.z *= a.z; A.w *= a.w;
      B.x = a.x * B.x + bt.x; B.y = a.y * B.y + bt.y; B.z = a.z * B.z + bt.z; B.w = a.w * B.w + bt.w;
    }
    *(float4*)(aggA + (size_t)item * 1024 + c) = A;
    *(float4*)(aggB + (size_t)item * 1024 + c) = B;
  }
}
__device__ void ph_scanA2(const Params& p) {
  const float* aggA = (const float*)(p.ws + OFF_AGGA);
  float* aggB = (float*)(p.ws + OFF_AGGB);
  for (int u = blockIdx.x; u < 32; u += gridDim.x) {
    const int b = u >> 2, c = (u & 3) * 256 + threadIdx.x;
    float h = 0.f;
#pragma unroll 16
    for (int ch = 0; ch < 128; ++ch) {
      const size_t o = (size_t)(b * 128 + ch) * 1024 + c;
      const float A = aggA[o], B = aggB[o];
      aggB[o] = h;
      h = A * h + B;
    }
  }
}
__device__ void ph_scanB(const Params& p) {
  const float* loga = (const float*)(p.ws + OFF_LOGA);
  const u16* ig16 = (const u16*)(p.ws + OFF_IG16);
  const float* xc32 = (const float*)(p.ws + OFF_XC32);
  const u16* gate16 = (const u16*)(p.ws + OFF_GATE16);
  u16* hg16 = (u16*)(p.ws + OFF_HG16);
  const float* aggB = (const float*)(p.ws + OFF_AGGB);
  const int c = threadIdx.x * 4;
  for (int item = blockIdx.x; item < 1088; item += gridDim.x) {
    float4 h; size_t tok0; float* hout = nullptr;
    if (item < 1024) {
      const int b = item >> 7, ch = item & 127;
      h = *(const float4*)(aggB + (size_t)item * 1024 + c);
      tok0 = (size_t)b * 2048 + ch * 16;
      if (ch == 127) hout = p.out + OUT_HP + (size_t)b * 1024 + c;
    } else {
      tok0 = (size_t)NTP + (size_t)(item - 1024) * 16;
      h = make_float4(0.f, 0.f, 0.f, 0.f);
    }
#pragma unroll
    for (int s = 0; s < 16; ++s) {
      float4 a, bt;
      const size_t off = (tok0 + s) * 1024 + c;
      if (item >= 1024 && (s & 7) == 0) h = *(const float4*)(p.state_h + (size_t)((item - 1024) * 2 + (s >> 3)) * 1024 + c);
      scan_step(loga, ig16, xc32, off, a, bt);
      h.x = a.x * h.x + bt.x; h.y = a.y * h.y + bt.y; h.z = a.z * h.z + bt.z; h.w = a.w * h.w + bt.w;
      uint2 g = *(const uint2*)(gate16 + off);
      uint2 w; w.x = pack2(h.x * bflo(g.x), h.y * bfhi(g.x)); w.y = pack2(h.z * bflo(g.y), h.w * bfhi(g.y));
      *(uint2*)(hg16 + off) = w;
      if (item >= 1024 && (s & 7) == 7) *(float4*)(p.out + OUT_HS + (size_t)((item - 1024) * 2 + (s >> 3)) * 1024 + c) = h;
    }
    if (hout) *(float4*)hout = h;
  }
}

__device__ __forceinline__ int mkkey(float v, int n) {
  int i = __float_as_int(v);
  i ^= (i >> 31) & 0x7fffffff;
  return (i & ~127) | (127 - n);
}
__device__ __forceinline__ float keyval(int k) {
  int i = (k & ~127) | 64;
  i ^= (i >> 31) & 0x7fffffff;
  return __int_as_float(i);
}
__device__ __forceinline__ int keyidx(int k) { return 127 - (k & 127); }
#define CE(i, j) { int hi_ = max(k[i], k[j]); int lo_ = min(k[i], k[j]); k[i] = hi_; k[j] = lo_; }

__device__ void ph_topk(const Params& p, char* smem) {
  const int tid = threadIdx.x, lane = tid & 63, wid = tid >> 6, g = lane >> 4, li = lane & 15;
  const float* s32 = (const float*)(p.ws + OFF_S32);
  int* idx_out = (int*)(p.ws + OFF_IDX);
  float* gate_out = (float*)(p.ws + OFF_PGATE);
  int* tkey = (int*)smem + wid * 256;
  for (int tb = blockIdx.x; tb < 4352; tb += gridDim.x) {
    const int t = tb * 4 + wid;
    const float* srow = s32 + (size_t)t * 2048;
#pragma unroll 1
    for (int ps = 0; ps < 4; ++ps) {
      const int R = ps * 4 + g;
      const float* r = srow + R * 128;
      float4 v0 = *(const float4*)(r + li * 4), v1 = *(const float4*)(r + 64 + li * 4);
      int k[8];
      k[0] = mkkey(v0.x, li * 4 + 0); k[1] = mkkey(v0.y, li * 4 + 1); k[2] = mkkey(v0.z, li * 4 + 2); k[3] = mkkey(v0.w, li * 4 + 3);
      k[4] = mkkey(v1.x, 64 + li * 4 + 0); k[5] = mkkey(v1.y, 64 + li * 4 + 1); k[6] = mkkey(v1.z, 64 + li * 4 + 2); k[7] = mkkey(v1.w, 64 + li * 4 + 3);
      CE(0, 1) CE(2, 3) CE(4, 5) CE(6, 7)
      CE(0, 2) CE(1, 3) CE(4, 6) CE(5, 7)
      CE(1, 2) CE(5, 6)
      CE(0, 4) CE(1, 5) CE(2, 6) CE(3, 7)
      CE(2, 4) CE(3, 5)
      CE(1, 2) CE(3, 4) CE(5, 6)
      int res = (int)0x80000000;
#pragma unroll
      for (int it = 0; it < 16; ++it) {
        const int M = grp_max_i(k[0]);
        const bool win = (k[0] == M);
        if (li == it) res = M;
#pragma unroll
        for (int i = 0; i < 7; ++i) k[i] = win ? k[i + 1] : k[i];
        k[7] = win ? (int)0x80000000 : k[7];
      }
      tkey[R * 16 + li] = res;
    }
    __syncthreads();
#pragma unroll 1
    for (int ps2 = 0; ps2 < 2; ++ps2) {
      const int h = ps2 * 4 + g;
      const int* t0 = tkey + (h * 2) * 16;
      const int* t1 = t0 + 16;
      const float sv0 = keyval(t0[li]);
      int ptr = 0;
      float head = sv0 + keyval(t1[0]);
      float rv = 0.f; int rc = 0;
#pragma unroll 1
      for (int it = 0; it < 16; ++it) {
        const float M = grp_max_f(head);
        const unsigned long long bm = __ballot(head == M);
        const unsigned gm = (unsigned)(bm >> (g * 16)) & 0xffffu;
        const int wl = __ffs(gm) - 1;
        const bool win = (li == wl);
        const int C = grp_max_i(win ? (li * 16 + ptr) : -1);
        if (li == it) { rv = M; rc = C; }
        if (win) {
          ++ptr;
          head = (ptr < 16) ? sv0 + keyval(t1[ptr & 15]) : -3.0e38f;
        }
      }
      const int ia = keyidx(t0[rc >> 4]);
      const int ib = keyidx(t1[rc & 15]);
      const float mx = grp_max_f(rv);
      const float ex = __expf(rv - mx);
      const float sm = grp_sum_f(ex);
      idx_out[(size_t)t * 128 + h * 16 + li] = ia * 128 + ib;
      gate_out[(size_t)t * 128 + h * 16 + li] = ex / sm;
    }
    __syncthreads();
  }
}

typedef float v2f __attribute__((ext_vector_type(2)));
template <int CTRL>
__device__ __forceinline__ float dpp_f(float v) { return __int_as_float(__builtin_amdgcn_update_dpp(0, __float_as_int(v), CTRL, 0xf, 0xf, false)); }
__device__ __forceinline__ float dot16_fp8(uint4 u, const v2f* x2) {
  v2f acc = {0.f, 0.f};
  acc = __builtin_elementwise_fma(__builtin_amdgcn_cvt_pk_f32_fp8((int)u.x, false), x2[0], acc);
  acc = __builtin_elementwise_fma(__builtin_amdgcn_cvt_pk_f32_fp8((int)u.x, true), x2[1], acc);
  acc = __builtin_elementwise_fma(__builtin_amdgcn_cvt_pk_f32_fp8((int)u.y, false), x2[2], acc);
  acc = __builtin_elementwise_fma(__builtin_amdgcn_cvt_pk_f32_fp8((int)u.y, true), x2[3], acc);
  acc = __builtin_elementwise_fma(__builtin_amdgcn_cvt_pk_f32_fp8((int)u.z, false), x2[4], acc);
  acc = __builtin_elementwise_fma(__builtin_amdgcn_cvt_pk_f32_fp8((int)u.z, true), x2[5], acc);
  acc = __builtin_elementwise_fma(__builtin_amdgcn_cvt_pk_f32_fp8((int)u.w, false), x2[6], acc);
  acc = __builtin_elementwise_fma(__builtin_amdgcn_cvt_pk_f32_fp8((int)u.w, true), x2[7], acc);
  return acc.x + acc.y;
}
__device__ __forceinline__ void axpy16_fp8(float w, uint4 u, v2f* o2) {
  const v2f w2 = {w, w};
  o2[0] = __builtin_elementwise_fma(__builtin_amdgcn_cvt_pk_f32_fp8((int)u.x, false), w2, o2[0]);
  o2[1] = __builtin_elementwise_fma(__builtin_amdgcn_cvt_pk_f32_fp8((int)u.x, true), w2, o2[1]);
  o2[2] = __builtin_elementwise_fma(__builtin_amdgcn_cvt_pk_f32_fp8((int)u.y, false), w2, o2[2]);
  o2[3] = __builtin_elementwise_fma(__builtin_amdgcn_cvt_pk_f32_fp8((int)u.y, true), w2, o2[3]);
  o2[4] = __builtin_elementwise_fma(__builtin_amdgcn_cvt_pk_f32_fp8((int)u.z, false), w2, o2[4]);
  o2[5] = __builtin_elementwise_fma(__builtin_amdgcn_cvt_pk_f32_fp8((int)u.z, true), w2, o2[5]);
  o2[6] = __builtin_elementwise_fma(__builtin_amdgcn_cvt_pk_f32_fp8((int)u.w, false), w2, o2[6]);
  o2[7] = __builtin_elementwise_fma(__builtin_amdgcn_cvt_pk_f32_fp8((int)u.w, true), w2, o2[7]);
}
__device__ __forceinline__ float reduce4_row(float d0, float d1, float d2, float d3, int lane) {
  const bool b0 = lane & 1, b1 = lane & 2;
  const float k0 = b0 ? d1 : d0, s0 = b0 ? d0 : d1;
  const float k1 = b0 ? d3 : d2, s1 = b0 ? d2 : d3;
  const float r0 = k0 + dpp_f<0xB1>(s0);
  const float r1 = k1 + dpp_f<0xB1>(s1);
  const float kk = b1 ? r1 : r0, ss = b1 ? r0 : r1;
  float q = kk + dpp_f<0x4E>(ss);
  q += dpp_f<0x128>(q);
  q += dpp_f<0x124>(q);
  return q;
}
#define EXP_LOAD(dst, dsc, TAB, SC, kbase, esrc)                                     \
  _Pragma("unroll") for (int j = 0; j < 8; ++j) {                                   \
    const int e = __builtin_amdgcn_readlane(esrc, ((kbase) + j) & 63);              \
    dst[j] = ((const uint4*)(TAB + (size_t)e * 1024))[lane];                        \
    dsc[j] = SC[e];                                                                  \
  }
#define EXP_LOADV(dst, TAB, kbase, esrc)                                             \
  _Pragma("unroll") for (int j = 0; j < 8; ++j) {                                   \
    const int e = __builtin_amdgcn_readlane(esrc, ((kbase) + j) & 63);              \
    dst[j] = ((const uint4*)(TAB + (size_t)e * 1024))[lane];                        \
  }
#define EXP_UDOT(src, ssc, kbase)                                                    \
  {                                                                                  \
    float d[8];                                                                      \
    _Pragma("unroll") for (int j = 0; j < 8; ++j) d[j] = dot16_fp8(src[j], x2) * ssc[j]; \
    const float qa = reduce4_row(d[0], d[1], d[2], d[3], lane);                      \
    const float qb = reduce4_row(d[4], d[5], d[6], d[7], lane);                      \
    float q = (lane & 4) ? qb : qa;                                                  \
    q += __shfl_xor(q, 16);                                                          \
    q += __shfl_xor(q, 32);                                                          \
    if ((lane >> 3) == ((((kbase)) & 63) >> 3)) { if ((kbase) < 64) h_lo = q; else h_hi = q; } \
  }
#define EXP_VACC(src, kbase, wsrc)                                                   \
  _Pragma("unroll") for (int j = 0; j < 8; ++j) {                                   \
    const float w = __int_as_float(__builtin_amdgcn_readlane(__float_as_int(wsrc), ((kbase) + j) & 63)); \
    axpy16_fp8(w, src[j], o2);                                                       \
  }

__device__ void ph_expert(const Params& p, int layer) {
  const int lane = threadIdx.x & 63, wid = threadIdx.x >> 6;
  u16* xn16 = (u16*)(p.ws + OFF_XN);
  float* xres = (float*)(p.ws + OFF_X);
  const int* idxs = (const int*)(p.ws + OFF_IDX);
  const float* gates = (const float*)(p.ws + OFF_PGATE);
  const unsigned char* U = (const unsigned char*)(p.ws + OFF_U8);
  const unsigned char* V = (const unsigned char*)(p.ws + OFF_V8);
  const float* USC = (const float*)(p.ws + OFF_USC);
  const float* VSC = (const float*)(p.ws + OFF_VSC);
  for (int tb = blockIdx.x; tb < 4352; tb += gridDim.x) {
    const int t = tb * 4 + wid;
    v2f x2[8];
    {
      const uint4* xr = (const uint4*)(xn16 + (size_t)t * 1024 + lane * 16);
      uint4 xa = xr[0], xb = xr[1];
      x2[0] = v2f{bflo(xa.x), bfhi(xa.x)}; x2[1] = v2f{bflo(xa.y), bfhi(xa.y)};
      x2[2] = v2f{bflo(xa.z), bfhi(xa.z)}; x2[3] = v2f{bflo(xa.w), bfhi(xa.w)};
      x2[4] = v2f{bflo(xb.x), bfhi(xb.x)}; x2[5] = v2f{bflo(xb.y), bfhi(xb.y)};
      x2[6] = v2f{bflo(xb.z), bfhi(xb.z)}; x2[7] = v2f{bflo(xb.w), bfhi(xb.w)};
    }
    const int e_lo = idxs[(size_t)t * 128 + lane], e_hi = idxs[(size_t)t * 128 + 64 + lane];
    const float g_lo = gates[(size_t)t * 128 + lane], g_hi = gates[(size_t)t * 128 + 64 + lane];
    const float vs_lo = VSC[e_lo], vs_hi = VSC[e_hi];
    float h_lo = 0.f, h_hi = 0.f;
    {
      uint4 ba[8], bb[8]; float sa[8], sb[8];
      EXP_LOAD(ba, sa, U, USC, 0, e_lo)
#pragma unroll 1
      for (int kb = 0; kb < 64; kb += 16) {
        EXP_LOAD(bb, sb, U, USC, kb + 8, e_lo)
        EXP_UDOT(ba, sa, kb)
        if (kb + 16 < 64) { EXP_LOAD(ba, sa, U, USC, kb + 16, e_lo) } else { EXP_LOAD(ba, sa, U, USC, 0, e_hi) }
        EXP_UDOT(bb, sb, kb + 8)
      }
#pragma unroll 1
      for (int kb = 64; kb < 128; kb += 16) {
        EXP_LOAD(bb, sb, U, USC, kb + 8, e_hi)
        EXP_UDOT(ba, sa, kb)
        if (kb + 16 < 128) { EXP_LOAD(ba, sa, U, USC, kb + 16, e_hi) }
        EXP_UDOT(bb, sb, kb + 8)
      }
    }
    const float w_lo = 0.5f * h_lo * (1.f + erff(h_lo * 0.70710678118654752f)) * g_lo * vs_lo;
    const float w_hi = 0.5f * h_hi * (1.f + erff(h_hi * 0.70710678118654752f)) * g_hi * vs_hi;
    v2f o2[8];
#pragma unroll
    for (int i = 0; i < 8; ++i) o2[i] = v2f{0.f, 0.f};
    {
      uint4 ba[8], bb[8];
      EXP_LOADV(ba, V, 0, e_lo)
#pragma unroll 1
      for (int kb = 0; kb < 64; kb += 16) {
        EXP_LOADV(bb, V, kb + 8, e_lo)
        EXP_VACC(ba, kb, w_lo)
        if (kb + 16 < 64) { EXP_LOADV(ba, V, kb + 16, e_lo) } else { EXP_LOADV(ba, V, 0, e_hi) }
        EXP_VACC(bb, kb + 8, w_lo)
      }
#pragma unroll 1
      for (int kb = 64; kb < 128; kb += 16) {
        EXP_LOADV(bb, V, kb + 8, e_hi)
        EXP_VACC(ba, kb, w_hi)
        if (kb + 16 < 128) { EXP_LOADV(ba, V, kb + 16, e_hi) }
        EXP_VACC(bb, kb + 8, w_hi)
      }
    }
    float o[16];
#pragma unroll
    for (int i = 0; i < 8; ++i) { o[2 * i] = o2[i].x; o[2 * i + 1] = o2[i].y; }
    float* xr = xres + (size_t)t * 1024 + lane * 16;
    float ss = 0.f;
#pragma unroll
    for (int i = 0; i < 4; ++i) {
      float4 r = *(const float4*)(xr + i * 4);
      o[4 * i] += r.x; o[4 * i + 1] += r.y; o[4 * i + 2] += r.z; o[4 * i + 3] += r.w;
      ss += o[4 * i] * o[4 * i] + o[4 * i + 1] * o[4 * i + 1] + o[4 * i + 2] * o[4 * i + 2] + o[4 * i + 3] * o[4 * i + 3];
    }
    ss = wave_sum(ss);
    const float rs = rsqrtf(ss * (1.f / 1024.f) + 1e-6f);
    if (layer == 0) {
#pragma unroll
      for (int i = 0; i < 4; ++i) *(float4*)(xr + i * 4) = make_float4(o[4 * i], o[4 * i + 1], o[4 * i + 2], o[4 * i + 3]);
      uint4 wa, wb;
      wa.x = pack2(o[0] * rs, o[1] * rs); wa.y = pack2(o[2] * rs, o[3] * rs); wa.z = pack2(o[4] * rs, o[5] * rs); wa.w = pack2(o[6] * rs, o[7] * rs);
      wb.x = pack2(o[8] * rs, o[9] * rs); wb.y = pack2(o[10] * rs, o[11] * rs); wb.z = pack2(o[12] * rs, o[13] * rs); wb.w = pack2(o[14] * rs, o[15] * rs);
      uint4* xw = (uint4*)(xn16 + (size_t)t * 1024 + lane * 16);
      xw[0] = wa; xw[1] = wb;
    } else {
      const float* fg = p.final_norm + lane * 16;
      float* y = p.out + OUT_Y + (size_t)t * 1024 + lane * 16;
#pragma unroll
      for (int i = 0; i < 4; ++i) {
        float4 g = *(const float4*)(fg + i * 4);
        *(float4*)(y + i * 4) = make_float4(o[4 * i] * rs * g.x, o[4 * i + 1] * rs * g.y, o[4 * i + 2] * rs * g.z, o[4 * i + 3] * rs * g.w);
      }
    }
  }
}

__device__ void ph_attn(const Params& p, char* smem) {
  const int tid = threadIdx.x, lane = tid & 63, wid = tid >> 6, fr = lane & 15, fq = lane >> 4;
  const u16* k16 = (const u16*)(p.ws + OFF_K16);
  const u16* v16 = (const u16*)(p.ws + OFF_V16A);
  const u16* q16 = (const u16*)(p.ws + OFF_Q16);
  u16* o16 = (u16*)(p.ws + OFF_O16);
  u16* Ks = (u16*)smem;
  u16* Vt = (u16*)(smem + 27648);
  for (int item = blockIdx.x; item < 1536; item += gridDim.x) {
    const bool is_p = item < 1024;
    int b, kvh, q0 = 0, nsub, nvalid, kpos0, minpos, tokbase;
    if (is_p) { b = item >> 7; kvh = (item >> 5) & 3; q0 = (item & 31) * 64; nsub = 4; nvalid = 192; kpos0 = q0 - 128; minpos = 0; tokbase = b * 2048; }
    else { int it2 = item - 1024; b = it2 >> 2; kvh = it2 & 3; nsub = 1; nvalid = 136; kpos0 = -128; minpos = -100000; tokbase = NTP + b * 8; }
    __syncthreads();
    for (int c = tid; c < 1536; c += 256) {
      const int j = c >> 3, ch = c & 7;
      uint4 kk = make_uint4(0, 0, 0, 0), vv = make_uint4(0, 0, 0, 0);
      if (is_p) {
        const int kp = kpos0 + j;
        if (kp >= 0) {
          const size_t off = (size_t)(tokbase + kp) * 256 + kvh * 64 + ch * 8;
          kk = *(const uint4*)(k16 + off); vv = *(const uint4*)(v16 + off);
        }
      } else {
        if (j < 128) {
          const size_t off = ((size_t)(b * 128 + j) * 4 + kvh) * 64 + ch * 8;
          float4 a0 = *(const float4*)(p.cache_k + off), a1 = *(const float4*)(p.cache_k + off + 4);
          float4 c0 = *(const float4*)(p.cache_v + off), c1 = *(const float4*)(p.cache_v + off + 4);
          kk.x = pack2(a0.x, a0.y); kk.y = pack2(a0.z, a0.w); kk.z = pack2(a1.x, a1.y); kk.w = pack2(a1.z, a1.w);
          vv.x = pack2(c0.x, c0.y); vv.y = pack2(c0.z, c0.w); vv.z = pack2(c1.x, c1.y); vv.w = pack2(c1.z, c1.w);
        } else if (j < 136) {
          const size_t off = (size_t)(tokbase + j - 128) * 256 + kvh * 64 + ch * 8;
          kk = *(const uint4*)(k16 + off); vv = *(const uint4*)(v16 + off);
        }
      }
      *(uint4*)(Ks + j * 72 + ch * 8) = kk;
      u16* vd = Vt + (ch * 8) * 200 + j;
      vd[0] = (u16)(vv.x & 0xffff); vd[200] = (u16)(vv.x >> 16);
      vd[400] = (u16)(vv.y & 0xffff); vd[600] = (u16)(vv.y >> 16);
      vd[800] = (u16)(vv.z & 0xffff); vd[1000] = (u16)(vv.z >> 16);
      vd[1200] = (u16)(vv.w & 0xffff); vd[1400] = (u16)(vv.w >> 16);
    }
    __syncthreads();
    const int head = kvh * 4 + wid;
    const float sink = p.sinks[head];
#pragma unroll 1
    for (int sub = 0; sub < nsub; ++sub) {
      int qtok, qp;
      if (is_p) { qp = q0 + sub * 16 + fr; qtok = tokbase + qp; }
      else { qp = fr & 7; qtok = tokbase + (fr & 7); }
      const u16* qrow = q16 + (size_t)qtok * 1024 + head * 64;
      const bf16x8 qf0 = *(const bf16x8*)(qrow + fq * 8);
      const bf16x8 qf1 = *(const bf16x8*)(qrow + 32 + fq * 8);
      f32x4 s[12];
#pragma unroll
      for (int ks = 0; ks < 12; ++ks) {
        const bf16x8 kf0 = *(const bf16x8*)(Ks + (ks * 16 + fr) * 72 + fq * 8);
        const bf16x8 kf1 = *(const bf16x8*)(Ks + (ks * 16 + fr) * 72 + 32 + fq * 8);
        f32x4 z = {0.f, 0.f, 0.f, 0.f};
        z = __builtin_amdgcn_mfma_f32_16x16x32_bf16(kf0, qf0, z, 0, 0, 0);
        s[ks] = __builtin_amdgcn_mfma_f32_16x16x32_bf16(kf1, qf1, z, 0, 0, 0);
        if ((ks & 3) == 3) __builtin_amdgcn_sched_barrier(0);
      }
      float mx = sink;
#pragma unroll
      for (int ks = 0; ks < 12; ++ks)
#pragma unroll
        for (int j = 0; j < 4; ++j) {
          const int jj = ks * 16 + fq * 4 + j;
          const int kp = kpos0 + jj;
          const bool valid = (jj < nvalid) && (kp >= minpos) && (kp <= qp) && (qp - kp < 128);
          const float v = valid ? s[ks][j] : -1.0e30f;
          s[ks][j] = v;
          mx = fmaxf(mx, v);
        }
      mx = fmaxf(mx, __shfl_xor(mx, 16));
      mx = fmaxf(mx, __shfl_xor(mx, 32));
      float sum = 0.f;
#pragma unroll
      for (int ks = 0; ks < 12; ++ks)
#pragma unroll
        for (int j = 0; j < 4; ++j) {
          const float pv = (s[ks][j] > -1.0e29f) ? __expf(s[ks][j] - mx) : 0.f;
          s[ks][j] = pv;
          sum += pv;
        }
      sum += __shfl_xor(sum, 16);
      sum += __shfl_xor(sum, 32);
      sum += __expf(sink - mx);
      const float inv = 1.f / sum;
      f32x4 o[4];
#pragma unroll
      for (int d = 0; d < 4; ++d) o[d] = f32x4{0.f, 0.f, 0.f, 0.f};
#pragma unroll
      for (int kk = 0; kk < 6; ++kk) {
        union { bf16x8 v; unsigned u[4]; } pb;
        pb.u[0] = pack2(s[2 * kk][0], s[2 * kk][1]); pb.u[1] = pack2(s[2 * kk][2], s[2 * kk][3]);
        pb.u[2] = pack2(s[2 * kk + 1][0], s[2 * kk + 1][1]); pb.u[3] = pack2(s[2 * kk + 1][2], s[2 * kk + 1][3]);
#pragma unroll
        for (int d = 0; d < 4; ++d) {
          union { bf16x8 v; uint2 h[2]; } vf;
          const u16* vr = Vt + (d * 16 + fr) * 200 + fq * 4;
          vf.h[0] = *(const uint2*)(vr + (2 * kk) * 16);
          vf.h[1] = *(const uint2*)(vr + (2 * kk + 1) * 16);
          o[d] = __builtin_amdgcn_mfma_f32_16x16x32_bf16(vf.v, pb.v, o[d], 0, 0, 0);
        }
        __builtin_amdgcn_sched_barrier(0);
      }
      if (is_p || fr < 8) {
#pragma unroll
        for (int d = 0; d < 4; ++d) {
          uint2 w; w.x = pack2(o[d][0] * inv, o[d][1] * inv); w.y = pack2(o[d][2] * inv, o[d][3] * inv);
          *(uint2*)(o16 + (size_t)qtok * 1024 + head * 64 + d * 16 + fq * 4) = w;
        }
      }
    }
  }
}


#define XB_TMO      128
#define XB_XCNT(j)  (256  + 64 * (j))
#define XB_XSUB(j)  (1280 + 64 * (j))
#define XB_XGEN(j)  (2304 + 64 * (j))
#define XB_TOP      3328
#define XB_TOPGEN   3392
#define XCD_BAR_WORDS 3456
#define XB_SPIN_CAP (1u << 20)
#define LAS __attribute__((address_space(3)))
__device__ __forceinline__ unsigned xb_ld(unsigned* p) { return __hip_atomic_load(p, __ATOMIC_RELAXED, __HIP_MEMORY_SCOPE_AGENT); }
__device__ __forceinline__ unsigned xb_add(unsigned* p, unsigned v) { return __hip_atomic_fetch_add(p, v, __ATOMIC_RELAXED, __HIP_MEMORY_SCOPE_AGENT); }
__device__ __forceinline__ unsigned xb_xcc_id() { return (unsigned)__builtin_amdgcn_s_getreg((3 << 11) | 20) & 0xFu; }
#define XB_SPIN(cond, bar) do { unsigned _sp = 0; while (cond) { __builtin_amdgcn_s_sleep(1); \
    if ((++_sp & 255u) == 0u) { if (xb_ld(&(bar)[XB_TMO])) break; if (_sp > XB_SPIN_CAP) { atomicAdd(&(bar)[XB_TMO], 1u); break; } } } } while (0)
struct XcdBarrier { unsigned* bar; unsigned x; volatile LAS unsigned* st; };
__device__ __forceinline__ XcdBarrier xcd_barrier_post(unsigned* bar, volatile LAS unsigned* st) {
  XcdBarrier b; b.bar = bar; b.x = xb_xcc_id(); b.st = st;
  if (threadIdx.x == 0) (void)xb_add(&bar[XB_XCNT(b.x)], 1u);
  return b;
}
__device__ __forceinline__ void xcd_barrier_complete(unsigned* bar, unsigned x, unsigned& nloc, unsigned& nx) {
  const unsigned G = gridDim.x * gridDim.y * gridDim.z;
  unsigned sum, cnt, mine, sp = 0u;
  for (;;) {
    sum = 0u; cnt = 0u; mine = 0u;
#pragma unroll
    for (unsigned j = 0; j < 16; ++j) { const unsigned c = xb_ld(&bar[XB_XCNT(j)]); sum += c; cnt += (c > 0u) ? 1u : 0u; mine = (j == x) ? c : mine; }
    if (sum == G) break;
    __builtin_amdgcn_s_sleep(1);
    if ((++sp & 255u) == 0u) { if (xb_ld(&bar[XB_TMO])) break; if (sp > XB_SPIN_CAP) { atomicAdd(&bar[XB_TMO], 1u); break; } }
  }
  nloc = mine > 0u ? mine : 1u; nx = cnt > 0u ? cnt : 1u;
}
__device__ __forceinline__ void xcd_barrier(const XcdBarrier& b) {
  asm volatile("s_waitcnt vmcnt(0)" ::: "memory");
  __syncthreads();
  if (threadIdx.x == 0) {
    unsigned* bar = b.bar;
    __builtin_amdgcn_s_waitcnt(0);
    unsigned nloc = b.st[0], nx = b.st[1];
    if (nloc == 0u) { xcd_barrier_complete(bar, b.x, nloc, nx); b.st[0] = nloc; b.st[1] = nx; }
    const unsigned old = xb_add(&bar[XB_XSUB(b.x)], 1u);
    const unsigned gen = old / nloc;
    if (old + 1u == (gen + 1u) * nloc) {
      __builtin_amdgcn_fence(__ATOMIC_RELEASE, "agent");
      asm volatile("s_waitcnt vmcnt(0)" ::: "memory");
      const unsigned og = xb_add(&bar[XB_TOP], 1u);
      const unsigned tg = og / nx;
      if (og + 1u == (tg + 1u) * nx) xb_add(&bar[XB_TOPGEN], 1u);
      else XB_SPIN(xb_ld(&bar[XB_TOPGEN]) == tg, bar);
      __builtin_amdgcn_fence(__ATOMIC_ACQUIRE, "agent");
      xb_add(&bar[XB_XGEN(b.x)], 1u);
      asm volatile("s_waitcnt vmcnt(0)" ::: "memory");
    } else {
      XB_SPIN(xb_ld(&bar[XB_XGEN(b.x)]) == gen, bar);
      __builtin_amdgcn_fence(__ATOMIC_ACQUIRE, "agent");
      asm volatile("s_waitcnt vmcnt(0)" ::: "memory");
    }
  }
  __syncthreads();
}

template <int ph>
__device__ __forceinline__ void run_phase(const Params& p, char* smem) {
  char* ws = p.ws;
  switch (ph) {
    case 0: ph_convert0(p, smem); break;
    case 1: {
      EpiWin e{(u16*)(ws + OFF_GATE16), (float*)(ws + OFF_REC32)};
      gemm_tiles((const u16*)(ws + OFF_XN), 1024, (const u16*)(ws + OFF_WT_IN), 1024, 1024, 0, 16, e, smem);
    } break;
    case 2: ph_conv(p); break;
    case 3: {
      EpiBd e{(float*)(ws + OFF_LOGA), (u16*)(ws + OFF_IG16), p.rg_ba, p.rg_bx, p.rg_lambda};
      gemm_tiles((const u16*)(ws + OFF_XC16), 1024, (const u16*)(ws + OFF_WT_BD), 128, 128, 8, 16, e, smem);
    } break;
    case 4: ph_scanA(p); break;
    case 20: ph_scanA2(p); break;
    case 5: ph_scanB(p); break;
    case 6: {
      EpiResid e{&p, (float*)(ws + OFF_X), 1};
      gemm_tiles((const u16*)(ws + OFF_HG16), 1024, (const u16*)(ws + OFF_WT_OUT), 1024, 1024, 0, 8, e, smem);
      ph_cvt_tables(p, 0);
    } break;
    case 7: ph_rmsnorm(p, p.ffn_norm); break;
    case 8: case 16: {
      EpiBf16 e{(u16*)(ws + OFF_QP16), 2048};
      gemm_tiles((const u16*)(ws + OFF_XN), 1024, (const u16*)(ws + (ph == 8 ? OFF_WT_PQ0 : OFF_WT_PQ1)), 1024, 1024, 0, 16, e, smem);
    } break;
    case 9: case 17: {
      EpiF32 e{(float*)(ws + OFF_S32), 2048};
      gemm_tiles((const u16*)(ws + OFF_QP16), 2048, (const u16*)(ws + (ph == 9 ? OFF_WT_SK0 : OFF_WT_SK1)), 128, 128, 16, 16, e, smem);
    } break;
    case 10: case 18: ph_topk(p, smem); break;
    case 11: ph_expert(p, 0); break;
    case 12: {
      EpiKvq e{(u16*)(ws + OFF_K16), (u16*)(ws + OFF_V16A), (u16*)(ws + OFF_Q16), (const float2*)(ws + OFF_ROPE), p.out};
      gemm_tiles((const u16*)(ws + OFF_XN), 1024, (const u16*)(ws + OFF_WT_KVQ), 1024, 1024, 0, 12, e, smem);
      ph_cvt_tables(p, 1);
    } break;
    case 13: ph_attn(p, smem); break;
    case 14: {
      EpiResid e{&p, (float*)(ws + OFF_X), 0};
      gemm_tiles((const u16*)(ws + OFF_O16), 1024, (const u16*)(ws + OFF_WT_O), 1024, 1024, 0, 8, e, smem);
    } break;
    case 15: ph_rmsnorm(p, p.ffn_norm + 1024); break;
    case 19: ph_expert(p, 1); break;
    default: break;
  }
}

__global__ void __launch_bounds__(256, 2) yoco_megakernel(Params p) {
  __shared__ __attribute__((aligned(16))) char smem[73728];
  __shared__ uint4 xb_words;
  cg::grid_group grid = cg::this_grid();
  if (threadIdx.x == 0) xb_words = make_uint4(0u, 0u, 0u, 0u);
  __syncthreads();
  XcdBarrier xb = xcd_barrier_post((unsigned*)(p.ws + OFF_BAR), (volatile LAS unsigned*)&xb_words);
  if (p.ph_end > 1000) grid.sync();
#define PH(k) run_phase<k>(p, smem); xcd_barrier(xb);
  PH(0) PH(1) PH(2) PH(3) PH(4) PH(20) PH(5) PH(6) PH(7) PH(8) PH(9)
  PH(10) PH(11) PH(12) PH(13) PH(14) PH(15) PH(16) PH(17) PH(18)
  run_phase<19>(p, smem);
}

extern "C" void kernel_launch(void* const* d_in, const int* in_sizes, int n_in, void* d_out, int out_size,
                              void* d_ws, size_t ws_size, hipStream_t stream) {
  static int grid_blocks = 0;
  if (!grid_blocks) {
    int dev = 0, cus = 0, per_cu = 0;
    hipGetDevice(&dev);
    hipDeviceGetAttribute(&cus, hipDeviceAttributeMultiprocessorCount, dev);
    hipOccupancyMaxActiveBlocksPerMultiprocessor(&per_cu, yoco_megakernel, 256, 0);
    if (per_cu > 2) per_cu = 2;
    if (per_cu < 1) per_cu = 1;
    grid_blocks = cus * per_cu;
    if (ws_size < WS_NEEDED) fprintf(stderr, "workspace too small: %zu < %llu\n", ws_size, (unsigned long long)WS_NEEDED);
  }
  Params p{};
  const float** f = (const float**)&p;
  for (int i = 0; i < 28; ++i) f[i] = (const float*)d_in[i];
  p.out = (float*)d_out;
  p.ws = (char*)d_ws;
  hipMemsetAsync((char*)d_ws + OFF_BAR, 0, XCD_BAR_WORDS * sizeof(unsigned), stream);
#if MULTI_LAUNCH
  for (int ph = 0; ph < NPHASE; ++ph) {
    p.ph_begin = ph; p.ph_end = ph + 1;
    hipLaunchKernelGGL(yoco_megakernel, dim3(grid_blocks), dim3(256), 0, stream, p);
  }
#else
  p.ph_begin = 0; p.ph_end = NPHASE;
  void* args[] = {&p};
  hipError_t e = hipLaunchCooperativeKernel((void*)yoco_megakernel, dim3(grid_blocks), dim3(256), args, 0, stream);
  if (e != hipSuccess) fprintf(stderr, "cooperative launch failed: %s (grid %d)\n", hipGetErrorString(e), grid_blocks);
#endif
}
```

```cpp
#include <hip/hip_runtime.h>
#include <hip/hip_cooperative_groups.h>
#include <cstdio>
#include <cstdint>
namespace cg = cooperative_groups;

typedef unsigned short u16;
typedef __attribute__((ext_vector_type(8))) short bf16x8;
typedef __attribute__((ext_vector_type(4))) float f32x4;

#define NTOK 17408
#define NTP 16384
#define MIB 1048576ull
#define NPHASE 20
#ifndef MULTI_LAUNCH
#define MULTI_LAUNCH 0
#endif

#define OFF_WT_IN   (0 * MIB)
#define OFF_WT_OUT  (4 * MIB)
#define OFF_WT_BD   (6 * MIB)
#define OFF_WT_PQ0  (7 * MIB)
#define OFF_WT_PQ1  (11 * MIB)
#define OFF_WT_KVQ  (15 * MIB)
#define OFF_WT_O    (18 * MIB)
#define OFF_WT_SK0  (20 * MIB)
#define OFF_WT_SK1  (20 * MIB + 524288ull)
#define OFF_ROPE    (21 * MIB)
#define OFF_USC     (21 * MIB + 655360ull)
#define OFF_VSC     (21 * MIB + 655360ull + 65536ull)
#define OFF_U8      (22 * MIB)
#define OFF_V8      (38 * MIB)
#define OFF_XN      (86 * MIB)
#define OFF_X       (120 * MIB)
#define OFF_GATE16  (188 * MIB)
#define OFF_REC32   (222 * MIB)
#define OFF_XC32    (290 * MIB)
#define OFF_XC16    (358 * MIB)
#define OFF_LOGA    (222 * MIB)
#define OFF_IG16    (22 * MIB)
#define OFF_AGGA    (56 * MIB)
#define OFF_AGGB    (60 * MIB)
#define OFF_HG16    (358 * MIB)
#define OFF_QP16    (188 * MIB)
#define OFF_S32     (256 * MIB)
#define OFF_PH      (256 * MIB)
#define OFF_IDX     (188 * MIB)
#define OFF_PGATE   (197 * MIB)
#define OFF_K16     (188 * MIB)
#define OFF_V16A    (197 * MIB)
#define OFF_Q16     (206 * MIB)
#define OFF_O16     (240 * MIB)
#define OFF_BAR     (392 * MIB)
#define WS_NEEDED   (392 * MIB + 16384ull)

#define OUT_Y      0
#define OUT_CONVP  17825792
#define OUT_HP     17850368
#define OUT_KP     17858560
#define OUT_VP     18120704
#define OUT_CONVS  18382848
#define OUT_HS     18776064
#define OUT_KS     18907136
#define OUT_VS     23101440

struct Params {
  const float *x_prompt, *x_sample, *state_conv, *state_h, *cache_k, *cache_v;
  const float *rg_norm, *rg_w_in, *rg_conv_w, *rg_conv_b, *rg_wa, *rg_ba, *rg_wx, *rg_bx, *rg_lambda, *rg_w_out;
  const float *kv_norm, *w_kv, *attn_norm, *w_q, *sinks, *w_o, *ffn_norm, *peer_wq, *peer_subkeys, *peer_u, *peer_v, *final_norm;
  float* out;
  char* ws;
  int ph_begin, ph_end;
};

__device__ __forceinline__ u16 f2bf(float f) {
  unsigned u = __float_as_uint(f);
  u += 0x7fffu + ((u >> 16) & 1u);
  return (u16)(u >> 16);
}
__device__ __forceinline__ float bf2f(u16 h) { return __uint_as_float(((unsigned)h) << 16); }
__device__ __forceinline__ unsigned pack2(float a, float b) { return (unsigned)f2bf(a) | ((unsigned)f2bf(b) << 16); }
__device__ __forceinline__ float bflo(unsigned u) { return __uint_as_float(u << 16); }
__device__ __forceinline__ float bfhi(unsigned u) { return __uint_as_float(u & 0xffff0000u); }
__device__ __forceinline__ float wave_sum(float v) {
#pragma unroll
  for (int o = 32; o > 0; o >>= 1) v += __shfl_xor(v, o);
  return v;
}
__device__ __forceinline__ const float* xin_row(const Params& p, int token) {
  return token < NTP ? p.x_prompt + (size_t)token * 1024 : p.x_sample + (size_t)(token - NTP) * 1024;
}
__device__ __forceinline__ float gelu_tanh(float x) {
  float u = 0.7978845608028654f * (x + 0.044715f * x * x * x);
  float e = __expf(2.f * u);
  float th = 1.f - 2.f / (e + 1.f);
  return 0.5f * x * (1.f + th);
}
__device__ __forceinline__ float sigmoidf_(float x) { return 1.f / (1.f + __expf(-x)); }

template <int CTRL>
__device__ __forceinline__ int dpp_i(int v) { return __builtin_amdgcn_update_dpp(v, v, CTRL, 0xf, 0xf, false); }
__device__ __forceinline__ int grp_max_i(int v) {
  v = max(v, dpp_i<0xB1>(v));
  v = max(v, dpp_i<0x4E>(v));
  v = max(v, dpp_i<0x141>(v));
  v = max(v, dpp_i<0x140>(v));
  return v;
}
__device__ __forceinline__ float grp_max_f(float v) {
  v = fmaxf(v, __int_as_float(dpp_i<0xB1>(__float_as_int(v))));
  v = fmaxf(v, __int_as_float(dpp_i<0x4E>(__float_as_int(v))));
  v = fmaxf(v, __int_as_float(dpp_i<0x141>(__float_as_int(v))));
  v = fmaxf(v, __int_as_float(dpp_i<0x140>(__float_as_int(v))));
  return v;
}
__device__ __forceinline__ float grp_sum_f(float v) {
  v += __int_as_float(dpp_i<0xB1>(__float_as_int(v)));
  v += __int_as_float(dpp_i<0x4E>(__float_as_int(v)));
  v += __int_as_float(dpp_i<0x141>(__float_as_int(v)));
  v += __int_as_float(dpp_i<0x140>(__float_as_int(v)));
  return v;
}

__device__ __forceinline__ void transpose_unit(const float* __restrict__ src, int ld_src, u16* __restrict__ dst, int ld_dst,
                               int kt, int nt, const float* __restrict__ gain, float* lds) {
  const int tid = threadIdx.x;
#pragma unroll
  for (int j = 0; j < 4; ++j) {
    int idx = tid + j * 256;
    int k = idx >> 4, c4 = idx & 15;
    float4 v = *(const float4*)(src + (size_t)(kt * 64 + k) * ld_src + nt * 64 + c4 * 4);
    float g = gain ? gain[kt * 64 + k] : 1.f;
    float* d = lds + k * 65 + c4 * 4;
    d[0] = v.x * g; d[1] = v.y * g; d[2] = v.z * g; d[3] = v.w * g;
  }
  __syncthreads();
#pragma unroll
  for (int j = 0; j < 2; ++j) {
    int c = tid + j * 256;
    int n = c >> 3, kc = c & 7;
    uint4 o;
    o.x = pack2(lds[(kc * 8 + 0) * 65 + n], lds[(kc * 8 + 1) * 65 + n]);
    o.y = pack2(lds[(kc * 8 + 2) * 65 + n], lds[(kc * 8 + 3) * 65 + n]);
    o.z = pack2(lds[(kc * 8 + 4) * 65 + n], lds[(kc * 8 + 5) * 65 + n]);
    o.w = pack2(lds[(kc * 8 + 6) * 65 + n], lds[(kc * 8 + 7) * 65 + n]);
    *(uint4*)(dst + (size_t)(nt * 64 + n) * ld_dst + kt * 64 + kc * 8) = o;
  }
  __syncthreads();
}

__device__ __forceinline__ void transpose_job(const Params& p, int u, float* lds) {
  char* ws = p.ws;
  if (u < 512) { transpose_unit(p.rg_w_in, 2048, (u16*)(ws + OFF_WT_IN), 1024, u >> 5, u & 31, nullptr, lds); return; }
  u -= 512;
  if (u < 256) { transpose_unit(p.rg_w_out, 1024, (u16*)(ws + OFF_WT_OUT), 1024, u >> 4, u & 15, nullptr, lds); return; }
  u -= 256;
  if (u < 64) {
    int which = u >> 5; int r = u & 31; int bi = r >> 2; int t = r & 3;
    const float* src = (which ? p.rg_wx : p.rg_wa) + (size_t)bi * 16384;
    u16* dst = (u16*)(ws + OFF_WT_BD) + (size_t)(which * 1024 + bi * 128) * 128;
    transpose_unit(src, 128, dst, 128, t >> 1, t & 1, nullptr, lds); return;
  }
  u -= 64;
  if (u < 1024) {
    int l = u >> 9; int r = u & 511;
    transpose_unit(p.peer_wq + (size_t)l * 2097152, 2048, (u16*)(ws + (l ? OFF_WT_PQ1 : OFF_WT_PQ0)), 1024, r >> 5, r & 31, nullptr, lds); return;
  }
  u -= 1024;
  if (u < 128) { transpose_unit(p.w_kv, 512, (u16*)(ws + OFF_WT_KVQ), 1024, u >> 3, u & 7, p.kv_norm, lds); return; }
  u -= 128;
  if (u < 256) { transpose_unit(p.w_q, 1024, (u16*)(ws + OFF_WT_KVQ) + (size_t)512 * 1024, 1024, u >> 4, u & 15, p.attn_norm, lds); return; }
  u -= 256;
  transpose_unit(p.w_o, 1024, (u16*)(ws + OFF_WT_O), 1024, u >> 4, u & 15, nullptr, lds);
}

__device__ __forceinline__ void cvt_unit(const float* __restrict__ src, u16* __restrict__ dst, size_t base) {
  const int tid = threadIdx.x;
#pragma unroll
  for (int j = 0; j < 2; ++j) {
    size_t o = base + j * 1024 + tid * 4;
    float4 v = *(const float4*)(src + o);
    uint2 w; w.x = pack2(v.x, v.y); w.y = pack2(v.z, v.w);
    *(uint2*)(dst + o) = w;
  }
}

__device__ __forceinline__ void rmsnorm_row(const float* __restrict__ x, const float* __restrict__ g, u16* __restrict__ o, int lane) {
  float4 v[4];
  float ss = 0.f;
#pragma unroll
  for (int i = 0; i < 4; ++i) {
    v[i] = *(const float4*)(x + i * 256 + lane * 4);
    ss += v[i].x * v[i].x + v[i].y * v[i].y + v[i].z * v[i].z + v[i].w * v[i].w;
  }
  ss = wave_sum(ss);
  float r = rsqrtf(ss * (1.f / 1024.f) + 1e-6f);
#pragma unroll
  for (int i = 0; i < 4; ++i) {
    float4 gg = *(const float4*)(g + i * 256 + lane * 4);
    uint2 w; w.x = pack2(v[i].x * r * gg.x, v[i].y * r * gg.y); w.y = pack2(v[i].z * r * gg.z, v[i].w * r * gg.w);
    *(uint2*)(o + i * 256 + lane * 4) = w;
  }
}

__device__ __forceinline__ void ph_convert0(const Params& p, char* smem) {
  const int tid = threadIdx.x, lane = tid & 63, wid = tid >> 6;
  const int NT = 2496, NSK = 256, NROPE = 257, NRMS = 4352, NCACHE = 3840;
  const int total = NT + NSK + NROPE + NRMS + NCACHE;
  for (int u0 = blockIdx.x; u0 < total; u0 += gridDim.x) {
    int u = u0;
    if (u < NT) { transpose_job(p, u, (float*)smem); continue; }
    u -= NT;
    if (u < NSK) {
      int l = u >> 7; int r = u & 127;
      const float* src = p.peer_subkeys + (size_t)l * 32768;
      u16* dst = (u16*)(p.ws + (l ? OFF_WT_SK1 : OFF_WT_SK0));
#pragma unroll
      for (int j = 0; j < 2; ++j) {
        int i = r * 2048 + j * 1024 + tid * 4;
        int s = ((i >> 14) & 1) * 16384 + (i & 16383);
        float4 v = *(const float4*)(src + s);
        uint2 w; w.x = pack2(v.x, v.y); w.y = pack2(v.z, v.w);
        *(uint2*)(dst + i) = w;
      }
      continue;
    }
    u -= NSK;
    if (u < NROPE) {
      int i = u * 256 + tid;
      if (i < 2056 * 32) {
        int pi = i >> 5, d = i & 31;
        int pos = pi < 2048 ? pi : (16384 + pi - 2048);
        float inv = (float)pow(10000.0, -(double)d / 32.0);
        float ang = (float)pos * inv;
        double sn, cs;
        sincos((double)ang, &sn, &cs);
        float2* rt = (float2*)(p.ws + OFF_ROPE);
        rt[i] = make_float2((float)cs, (float)sn);
      }
      continue;
    }
    u -= NROPE;
    if (u < NRMS) {
      int t = u * 4 + wid;
      rmsnorm_row(xin_row(p, t), p.rg_norm, (u16*)(p.ws + OFF_XN) + (size_t)t * 1024, lane);
      continue;
    }
    u -= NRMS;
    {
      int which = u / 1920; int r = u - which * 1920;
      int b = r / 15, c = r - b * 15;
      const float* src = (which ? p.cache_v : p.cache_k) + (size_t)b * 32768 + 2048 + c * 2048;
      float* dst = p.out + (which ? OUT_VS : OUT_KS) + (size_t)b * 32768 + c * 2048;
#pragma unroll
      for (int j = 0; j < 2; ++j) {
        int o = j * 1024 + tid * 4;
        *(float4*)(dst + o) = *(const float4*)(src + o);
      }
    }
  }
}

__device__ __forceinline__ void ph_cvt_tables(const Params& p, int layer) {
  const int lane = threadIdx.x & 63, wid = threadIdx.x >> 6;
  for (int u = blockIdx.x; u < 8192; u += gridDim.x) {
    const int which = u >> 12; const int row = (u & 4095) * 4 + wid;
    const float* src = (which ? p.peer_v : p.peer_u) + (size_t)layer * 16777216 + (size_t)row * 1024 + lane * 16;
    unsigned char* dst = (unsigned char*)(p.ws + (which ? OFF_V8 : OFF_U8)) + (size_t)(lane >> 3) * 2097152 + (size_t)row * 128 + (lane & 7) * 16;
    float* sc = (float*)(p.ws + (which ? OFF_VSC : OFF_USC));
    float4 a = *(const float4*)(src), b = *(const float4*)(src + 4), c = *(const float4*)(src + 8), d = *(const float4*)(src + 12);
    float m = fmaxf(fmaxf(fmaxf(fabsf(a.x), fabsf(a.y)), fmaxf(fabsf(a.z), fabsf(a.w))), fmaxf(fmaxf(fabsf(b.x), fabsf(b.y)), fmaxf(fabsf(b.z), fabsf(b.w))));
    m = fmaxf(m, fmaxf(fmaxf(fmaxf(fabsf(c.x), fabsf(c.y)), fmaxf(fabsf(c.z), fabsf(c.w))), fmaxf(fmaxf(fabsf(d.x), fabsf(d.y)), fmaxf(fabsf(d.z), fabsf(d.w)))));
#pragma unroll
    for (int o = 32; o > 0; o >>= 1) m = fmaxf(m, __shfl_xor(m, o));
    const float scl = m > 0.f ? 440.f / m : 1.f;
    uint4 w; int t;
    t = 0; t = __builtin_amdgcn_cvt_pk_fp8_f32(a.x * scl, a.y * scl, t, false); t = __builtin_amdgcn_cvt_pk_fp8_f32(a.z * scl, a.w * scl, t, true); w.x = (unsigned)t;
    t = 0; t = __builtin_amdgcn_cvt_pk_fp8_f32(b.x * scl, b.y * scl, t, false); t = __builtin_amdgcn_cvt_pk_fp8_f32(b.z * scl, b.w * scl, t, true); w.y = (unsigned)t;
    t = 0; t = __builtin_amdgcn_cvt_pk_fp8_f32(c.x * scl, c.y * scl, t, false); t = __builtin_amdgcn_cvt_pk_fp8_f32(c.z * scl, c.w * scl, t, true); w.z = (unsigned)t;
    t = 0; t = __builtin_amdgcn_cvt_pk_fp8_f32(d.x * scl, d.y * scl, t, false); t = __builtin_amdgcn_cvt_pk_fp8_f32(d.z * scl, d.w * scl, t, true); w.w = (unsigned)t;
    *(uint4*)dst = w;
    if (lane == 0) sc[row] = m > 0.f ? m / 440.f : 1.f;
  }
}

__device__ __forceinline__ void ph_rmsnorm(const Params& p, const float* g) {
  const int lane = threadIdx.x & 63, wid = threadIdx.x >> 6;
  const float* x = (const float*)(p.ws + OFF_X);
  u16* xn = (u16*)(p.ws + OFF_XN);
  for (int u = blockIdx.x; u < 4352; u += gridDim.x) {
    int t = u * 4 + wid;
    rmsnorm_row(x + (size_t)t * 1024, g, xn + (size_t)t * 1024, lane);
  }
}

#define LASP __attribute__((address_space(3)))
template <class Epi>
__device__ __forceinline__ void gemm_tiles(const u16* __restrict__ A, int lda, const u16* __restrict__ W, int ldw,
                                           int K, int kmod, int ntn, const Epi& epi, char* smem_g) {
  LASP unsigned char* smem = (LASP unsigned char*)smem_g;
  const int tid = threadIdx.x, lane = tid & 63, wid = tid >> 6;
  const int wr = wid >> 1, wc = wid & 1, fr = lane & 15, fq = lane >> 4;
  const int total = 136 * ntn;
  const int nk = K >> 6;
  const int swz = (lane * 16) ^ ((lane >> 5) << 5);
  int offA[4], offW[4];
#pragma unroll
  for (int i = 0; i < 4; ++i) {
    const int st = i * 4 + wid;
    const int R = (st >> 1) * 16 + (swz >> 6), C = (st & 1) * 32 + ((swz & 63) >> 1);
    offA[i] = R * lda + C; offW[i] = R * ldw + C;
  }
  const int lane_off = (fr * 64 + fq * 16) ^ ((fr >> 3) << 5);
#define GEMM_STAGE(buf, Ag_, Wg_, k0_)                                                                          \
  _Pragma("unroll") for (int i = 0; i < 4; ++i) {                                                               \
    __builtin_amdgcn_global_load_lds((const unsigned*)((Wg_) + offW[i] + (k0_)), (LASP unsigned*)(smem + (buf) * 32768 + i * 4096 + wid * 1024), 16, 0, 0);         \
    __builtin_amdgcn_global_load_lds((const unsigned*)((Ag_) + offA[i] + (k0_)), (LASP unsigned*)(smem + (buf) * 32768 + 16384 + i * 4096 + wid * 1024), 16, 0, 0); \
  }
  for (int tile = blockIdx.x; tile < total; tile += gridDim.x) {
    const int tm = tile / ntn, tn = tile - tm * ntn;
    const u16* Ag = A + (size_t)(tm * 128) * lda + (kmod ? (tn % kmod) * 128 : 0);
    const u16* Wg = W + (size_t)(tn * 128) * ldw;
    f32x4 acc[4][4];
#pragma unroll
    for (int m = 0; m < 4; ++m)
#pragma unroll
      for (int n = 0; n < 4; ++n) acc[m][n] = f32x4{0.f, 0.f, 0.f, 0.f};
    __syncthreads();
    GEMM_STAGE(0, Ag, Wg, 0)
    for (int kt = 0; kt < nk; ++kt) {
      const int cur = kt & 1;
      asm volatile("s_waitcnt vmcnt(0)" ::: "memory");
      __syncthreads();
      const LASP unsigned char* sW = smem + cur * 32768;
      const LASP unsigned char* sA = sW + 16384;
      bf16x8 a[2][4], b[2][4];
#pragma unroll
      for (int ks = 0; ks < 2; ++ks) {
#pragma unroll
        for (int m = 0; m < 4; ++m) a[ks][m] = *(const LASP bf16x8*)(sW + (wr * 8 + m * 2 + ks) * 1024 + lane_off);
#pragma unroll
        for (int n = 0; n < 4; ++n) b[ks][n] = *(const LASP bf16x8*)(sA + (wc * 8 + n * 2 + ks) * 1024 + lane_off);
      }
      __builtin_amdgcn_sched_barrier(0);
      if (kt + 1 < nk) { GEMM_STAGE(cur ^ 1, Ag, Wg, (kt + 1) * 64) }
      __builtin_amdgcn_sched_barrier(0);
#pragma unroll
      for (int ks = 0; ks < 2; ++ks)
#pragma unroll
        for (int m = 0; m < 4; ++m)
#pragma unroll
          for (int n = 0; n < 4; ++n) acc[m][n] = __builtin_amdgcn_mfma_f32_16x16x32_bf16(a[ks][m], b[ks][n], acc[m][n], 0, 0, 0);
    }
    epi(acc, tm * 128 + wc * 64, tn * 128 + wr * 64, fr, fq);
  }
#undef GEMM_STAGE
}

struct EpiWin {
  u16* gate16; float* rec32;
  __device__ __forceinline__ void operator()(const f32x4 (&acc)[4][4], int tok0, int feat0, int fr, int fq) const {
#pragma unroll
    for (int n = 0; n < 4; ++n) {
      const int tok = tok0 + n * 16 + fr;
#pragma unroll
      for (int m = 0; m < 4; ++m) {
        const int f = feat0 + m * 16 + fq * 4;
        f32x4 v = acc[m][n];
        if (feat0 < 1024) {
          uint2 w; w.x = pack2(gelu_tanh(v[0]), gelu_tanh(v[1])); w.y = pack2(gelu_tanh(v[2]), gelu_tanh(v[3]));
          *(uint2*)(gate16 + (size_t)tok * 1024 + f) = w;
        } else {
          *(float4*)(rec32 + (size_t)tok * 1024 + (f - 1024)) = make_float4(v[0], v[1], v[2], v[3]);
        }
      }
    }
  }
};
struct EpiBd {
  float* loga; u16* ig16; const float *ba, *bx, *lam;
  __device__ __forceinline__ void operator()(const f32x4 (&acc)[4][4], int tok0, int feat0, int fr, int fq) const {
#pragma unroll
    for (int m = 0; m < 4; ++m) {
      const int f = feat0 + m * 16 + fq * 4;
      if (feat0 < 1024) {
        float4 b4 = *(const float4*)(ba + f);
        float4 l4 = *(const float4*)(lam + f);
        float sp0 = log1pf(__expf(-l4.x)), sp1 = log1pf(__expf(-l4.y)), sp2 = log1pf(__expf(-l4.z)), sp3 = log1pf(__expf(-l4.w));
#pragma unroll
        for (int n = 0; n < 4; ++n) {
          const int tok = tok0 + n * 16 + fr;
          f32x4 v = acc[m][n];
          float4 o;
          o.x = -8.f * sigmoidf_(v[0] + b4.x) * sp0;
          o.y = -8.f * sigmoidf_(v[1] + b4.y) * sp1;
          o.z = -8.f * sigmoidf_(v[2] + b4.z) * sp2;
          o.w = -8.f * sigmoidf_(v[3] + b4.w) * sp3;
          *(float4*)(loga + (size_t)tok * 1024 + f) = o;
        }
      } else {
        float4 b4 = *(const float4*)(bx + (f - 1024));
#pragma unroll
        for (int n = 0; n < 4; ++n) {
          const int tok = tok0 + n * 16 + fr;
          f32x4 v = acc[m][n];
          uint2 w;
          w.x = pack2(sigmoidf_(v[0] + b4.x), sigmoidf_(v[1] + b4.y));
          w.y = pack2(sigmoidf_(v[2] + b4.z), sigmoidf_(v[3] + b4.w));
          *(uint2*)(ig16 + (size_t)tok * 1024 + (f - 1024)) = w;
        }
      }
    }
  }
};
struct EpiResid {
  const float* xp; const float* xs; float* xres; int first;
  __device__ __forceinline__ void operator()(const f32x4 (&acc)[4][4], int tok0, int feat0, int fr, int fq) const {
#pragma unroll
    for (int n = 0; n < 4; ++n) {
      const int tok = tok0 + n * 16 + fr;
      const float* base = first ? (tok < NTP ? xp + (size_t)tok * 1024 : xs + (size_t)(tok - NTP) * 1024) : (xres + (size_t)tok * 1024);
#pragma unroll
      for (int m = 0; m < 4; ++m) {
        const int f = feat0 + m * 16 + fq * 4;
        float4 b = *(const float4*)(base + f);
        f32x4 v = acc[m][n];
        *(float4*)(xres + (size_t)tok * 1024 + f) = make_float4(b.x + v[0], b.y + v[1], b.z + v[2], b.w + v[3]);
      }
    }
  }
};
struct EpiBf16 {
  u16* o; int ld;
  __device__ __forceinline__ void operator()(const f32x4 (&acc)[4][4], int tok0, int feat0, int fr, int fq) const {
#pragma unroll
    for (int n = 0; n < 4; ++n) {
      const int tok = tok0 + n * 16 + fr;
#pragma unroll
      for (int m = 0; m < 4; ++m) {
        const int f = feat0 + m * 16 + fq * 4;
        f32x4 v = acc[m][n];
        uint2 w; w.x = pack2(v[0], v[1]); w.y = pack2(v[2], v[3]);
        *(uint2*)(o + (size_t)tok * ld + f) = w;
      }
    }
  }
};
struct EpiF32 {
  float* o; int ld;
  __device__ __forceinline__ void operator()(const f32x4 (&acc)[4][4], int tok0, int feat0, int fr, int fq) const {
#pragma unroll
    for (int n = 0; n < 4; ++n) {
      const int tok = tok0 + n * 16 + fr;
#pragma unroll
      for (int m = 0; m < 4; ++m) {
        const int f = feat0 + m * 16 + fq * 4;
        f32x4 v = acc[m][n];
        *(float4*)(o + (size_t)tok * ld + f) = make_float4(v[0], v[1], v[2], v[3]);
      }
    }
  }
};
struct EpiKvq {
  u16 *k16, *v16, *q16; const float2* rope; float* out;
  __device__ __forceinline__ void operator()(const f32x4 (&acc)[4][4], int tok0, int feat0, int fr, int fq) const {
#pragma unroll
    for (int n = 0; n < 4; ++n) {
      const int tok = tok0 + n * 16 + fr;
      int b, t, pi, orow; bool is_p = tok < NTP;
      if (is_p) { b = tok >> 11; t = tok & 2047; pi = t; orow = t - 1920; }
      else { int ts = tok - NTP; b = ts >> 3; t = ts & 7; pi = 2048 + t; orow = 120 + t; }
      if (feat0 >= 256 && feat0 < 512) {
        const int kvh = (feat0 - 256) >> 6;
#pragma unroll
        for (int m = 0; m < 4; ++m) {
          const int d = m * 16 + fq * 4;
          f32x4 v = acc[m][n];
          uint2 w; w.x = pack2(v[0], v[1]); w.y = pack2(v[2], v[3]);
          *(uint2*)(v16 + (size_t)tok * 256 + kvh * 64 + d) = w;
          if (orow >= 0) {
            float* dst = out + (is_p ? OUT_VP : OUT_VS) + ((size_t)(b * 128 + orow) * 4 + kvh) * 64 + d;
            *(float4*)dst = make_float4(v[0], v[1], v[2], v[3]);
          }
        }
      } else {
        const bool isk = feat0 < 256;
        const float sc = isk ? 1.f : 0.125f;
#pragma unroll
        for (int m = 0; m < 2; ++m) {
          const int d = m * 16 + fq * 4;
          f32x4 x1 = acc[m][n], x2 = acc[m + 2][n];
          const float2* rp = rope + pi * 32 + d;
          float o1[4], o2[4];
#pragma unroll
          for (int j = 0; j < 4; ++j) {
            float2 csn = rp[j];
            o1[j] = (x1[j] * csn.x - x2[j] * csn.y) * sc;
            o2[j] = (x2[j] * csn.x + x1[j] * csn.y) * sc;
          }
          uint2 w1, w2;
          w1.x = pack2(o1[0], o1[1]); w1.y = pack2(o1[2], o1[3]);
          w2.x = pack2(o2[0], o2[1]); w2.y = pack2(o2[2], o2[3]);
          if (isk) {
            const int kvh = feat0 >> 6;
            *(uint2*)(k16 + (size_t)tok * 256 + kvh * 64 + d) = w1;
            *(uint2*)(k16 + (size_t)tok * 256 + kvh * 64 + d + 32) = w2;
            if (orow >= 0) {
              float* dst = out + (is_p ? OUT_KP : OUT_KS) + ((size_t)(b * 128 + orow) * 4 + kvh) * 64 + d;
              *(float4*)dst = make_float4(o1[0], o1[1], o1[2], o1[3]);
              *(float4*)(dst + 32) = make_float4(o2[0], o2[1], o2[2], o2[3]);
            }
          } else {
            const int f = feat0 - 512;
            *(uint2*)(q16 + (size_t)tok * 1024 + f + d) = w1;
            *(uint2*)(q16 + (size_t)tok * 1024 + f + d + 32) = w2;
          }
        }
      }
    }
  }
};

__device__ __forceinline__ void ph_conv(const Params& p) {
  const float* rec = (const float*)(p.ws + OFF_REC32);
  float* xc32 = (float*)(p.ws + OFF_XC32);
  u16* xc16 = (u16*)(p.ws + OFF_XC16);
  const int nunits = NTOK * 256;
  for (int idx = blockIdx.x * 256 + threadIdx.x; idx < nunits; idx += gridDim.x * 256) {
    const int tok = idx >> 8, c = (idx & 255) * 4;
    int b, t; const float* buf = nullptr;
    if (tok < NTP) { b = tok >> 11; t = tok & 2047; }
    else { int ts = tok - NTP; b = ts >> 3; t = ts & 7; buf = p.state_conv + (size_t)b * 3072; }
    float4 r[4];
    r[0] = *(const float4*)(rec + (size_t)tok * 1024 + c);
#pragma unroll
    for (int L = 1; L <= 3; ++L) {
      if (t - L >= 0) r[L] = *(const float4*)(rec + (size_t)(tok - L) * 1024 + c);
      else if (buf) r[L] = *(const float4*)(buf + (size_t)(3 + t - L) * 1024 + c);
      else r[L] = make_float4(0.f, 0.f, 0.f, 0.f);
    }
    float4 w0 = *(const float4*)(p.rg_conv_w + c), w1 = *(const float4*)(p.rg_conv_w + 1024 + c);
    float4 w2 = *(const float4*)(p.rg_conv_w + 2048 + c), w3 = *(const float4*)(p.rg_conv_w + 3072 + c);
    float4 cb = *(const float4*)(p.rg_conv_b + c);
    float4 o;
    o.x = cb.x + w3.x * r[0].x + w2.x * r[1].x + w1.x * r[2].x + w0.x * r[3].x;
    o.y = cb.y + w3.y * r[0].y + w2.y * r[1].y + w1.y * r[2].y + w0.y * r[3].y;
    o.z = cb.z + w3.z * r[0].z + w2.z * r[1].z + w1.z * r[2].z + w0.z * r[3].z;
    o.w = cb.w + w3.w * r[0].w + w2.w * r[1].w + w1.w * r[2].w + w0.w * r[3].w;
    *(float4*)(xc32 + (size_t)tok * 1024 + c) = o;
    uint2 w; w.x = pack2(o.x, o.y); w.y = pack2(o.z, o.w);
    *(uint2*)(xc16 + (size_t)tok * 1024 + c) = w;
    if (tok < NTP) {
      if (t >= 2045) *(float4*)(p.out + OUT_CONVP + ((size_t)b * 3 + (t - 2045)) * 1024 + c) = r[0];
    } else {
      if (t >= 5) *(float4*)(p.out + OUT_CONVS + ((size_t)b * 3 + (t - 5)) * 1024 + c) = r[0];
    }
  }
}

__device__ __forceinline__ float rg_mult(float la) {
  const float t = 2.f * la;
  const float ser = -t * (1.f + t * (0.5f + t * (0.16666667f + t * (0.041666668f + t * 0.0083333333f))));
  const float dir = 1.f - __expf(t);
  return __builtin_amdgcn_sqrtf(t > -0.25f ? ser : dir);
}
__device__ __forceinline__ void scan_step(const float* loga, const u16* ig16, const float* xc32, size_t off, float4& a, float4& bt) {
  float4 la = *(const float4*)(loga + off);
  uint2 gi = *(const uint2*)(ig16 + off);
  float4 xc = *(const float4*)(xc32 + off);
  a.x = __expf(la.x); a.y = __expf(la.y); a.z = __expf(la.z); a.w = __expf(la.w);
  bt.x = rg_mult(la.x) * bflo(gi.x) * xc.x;
  bt.y = rg_mult(la.y) * bfhi(gi.x) * xc.y;
  bt.z = rg_mult(la.z) * bflo(gi.y) * xc.z;
  bt.w = rg_mult(la.w) * bfhi(gi.y) * xc.w;
}
__device__ __forceinline__ void ph_scanA(const Params& p) {
  const float* loga = (const float*)(p.ws + OFF_LOGA);
  const u16* ig16 = (const u16*)(p.ws + OFF_IG16);
  const float* xc32 = (const float*)(p.ws + OFF_XC32);
  float* aggA = (float*)(p.ws + OFF_AGGA);
  float* aggB = (float*)(p.ws + OFF_AGGB);
  const int c = threadIdx.x * 4;
  for (int item = blockIdx.x; item < 1024; item += gridDim.x) {
    const int b = item >> 7, ch = item & 127;
    float4 A = make_float4(1.f, 1.f, 1.f, 1.f), B = make_float4(0.f, 0.f, 0.f, 0.f);
    const size_t tok0 = (size_t)b * 2048 + ch * 16;
#pragma unroll 8
    for (int s = 0; s < 16; ++s) {
      float4 a, bt;
      scan_step(loga, ig16, xc32, (tok0 + s) * 1024 + c, a, bt);
      A.x *= a.x; A.y *= a.y; A.z *= a.z; A.w *= a.w;
      B.x = a.x * B.x + bt.x; B.y = a.y * B.y + bt.y; B.z = a.z * B.z + bt.z; B.w = a.w * B.w + bt.w;
    }
    *(float4*)(aggA + (size_t)item * 1024 + c) = A;
    *(float4*)(aggB + (size_t)item * 1024 + c) = B;
  }
}
__device__ __forceinline__ void ph_scanA2(const Params& p) {
  const float* aggA = (const float*)(p.ws + OFF_AGGA);
  float* aggB = (float*)(p.ws + OFF_AGGB);
  for (int u = blockIdx.x; u < 32; u += gridDim.x) {
    const int b = u >> 2, c = (u & 3) * 256 + threadIdx.x;
    float h = 0.f;
#pragma unroll 16
    for (int ch = 0; ch < 128; ++ch) {
      const size_t o = (size_t)(b * 128 + ch) * 1024 + c;
      const float A = aggA[o], B = aggB[o];
      aggB[o] = h;
      h = A * h + B;
    }
  }
}
__device__ __forceinline__ void ph_scanB(const Params& p) {
  const float* loga = (const float*)(p.ws + OFF_LOGA);
  const u16* ig16 = (const u16*)(p.ws + OFF_IG16);
  const float* xc32 = (const float*)(p.ws + OFF_XC32);
  const u16* gate16 = (const u16*)(p.ws + OFF_GATE16);
  u16* hg16 = (u16*)(p.ws + OFF_HG16);
  const float* aggB = (const float*)(p.ws + OFF_AGGB);
  const int c = threadIdx.x * 4;
  for (int item = blockIdx.x; item < 1088; item += gridDim.x) {
    float4 h; size_t tok0; float* hout = nullptr;
    if (item < 1024) {
      const int b = item >> 7, ch = item & 127;
      h = *(const float4*)(aggB + (size_t)item * 1024 + c);
      tok0 = (size_t)b * 2048 + ch * 16;
      if (ch == 127) hout = p.out + OUT_HP + (size_t)b * 1024 + c;
    } else {
      tok0 = (size_t)NTP + (size_t)(item - 1024) * 16;
      h = make_float4(0.f, 0.f, 0.f, 0.f);
    }
#pragma unroll 8
    for (int s = 0; s < 16; ++s) {
      float4 a, bt;
      const size_t off = (tok0 + s) * 1024 + c;
      if (item >= 1024 && (s & 7) == 0) h = *(const float4*)(p.state_h + (size_t)((item - 1024) * 2 + (s >> 3)) * 1024 + c);
      scan_step(loga, ig16, xc32, off, a, bt);
      h.x = a.x * h.x + bt.x; h.y = a.y * h.y + bt.y; h.z = a.z * h.z + bt.z; h.w = a.w * h.w + bt.w;
      uint2 g = *(const uint2*)(gate16 + off);
      uint2 w; w.x = pack2(h.x * bflo(g.x), h.y * bfhi(g.x)); w.y = pack2(h.z * bflo(g.y), h.w * bfhi(g.y));
      *(uint2*)(hg16 + off) = w;
      if (item >= 1024 && (s & 7) == 7) *(float4*)(p.out + OUT_HS + (size_t)((item - 1024) * 2 + (s >> 3)) * 1024 + c) = h;
    }
    if (hout) *(float4*)hout = h;
  }
}

__device__ __forceinline__ int mkkey(float v, int n) {
  int i = __float_as_int(v);
  i ^= (i >> 31) & 0x7fffffff;
  return (i & ~127) | (127 - n);
}
__device__ __forceinline__ float keyval(int k) {
  int i = (k & ~127) | 64;
  i ^= (i >> 31) & 0x7fffffff;
  return __int_as_float(i);
}
__device__ __forceinline__ int keyidx(int k) { return 127 - (k & 127); }
#define CE(i, j) { int hi_ = max(k[i], k[j]); int lo_ = min(k[i], k[j]); k[i] = hi_; k[j] = lo_; }

__device__ __forceinline__ void ph_topk(const Params& p, char* smem) {
  const int tid = threadIdx.x, lane = tid & 63, wid = tid >> 6, g = lane >> 4, li = lane & 15;
  const float* s32 = (const float*)(p.ws + OFF_S32);
  int* idx_out = (int*)(p.ws + OFF_IDX);
  float* gate_out = (float*)(p.ws + OFF_PGATE);
  int* tkey = (int*)smem + wid * 256;
  for (int tb = blockIdx.x; tb < 4352; tb += gridDim.x) {
    const int t = tb * 4 + wid;
    const float* srow = s32 + (size_t)t * 2048;
#pragma unroll 1
    for (int ps = 0; ps < 4; ++ps) {
      const int R = ps * 4 + g;
      const float* r = srow + R * 128;
      float4 v0 = *(const float4*)(r + li * 4), v1 = *(const float4*)(r + 64 + li * 4);
      int k[8];
      k[0] = mkkey(v0.x, li * 4 + 0); k[1] = mkkey(v0.y, li * 4 + 1); k[2] = mkkey(v0.z, li * 4 + 2); k[3] = mkkey(v0.w, li * 4 + 3);
      k[4] = mkkey(v1.x, 64 + li * 4 + 0); k[5] = mkkey(v1.y, 64 + li * 4 + 1); k[6] = mkkey(v1.z, 64 + li * 4 + 2); k[7] = mkkey(v1.w, 64 + li * 4 + 3);
      CE(0, 1) CE(2, 3) CE(4, 5) CE(6, 7)
      CE(0, 2) CE(1, 3) CE(4, 6) CE(5, 7)
      CE(1, 2) CE(5, 6)
      CE(0, 4) CE(1, 5) CE(2, 6) CE(3, 7)
      CE(2, 4) CE(3, 5)
      CE(1, 2) CE(3, 4) CE(5, 6)
      int res = (int)0x80000000;
#pragma unroll
      for (int it = 0; it < 16; ++it) {
        const int M = grp_max_i(k[0]);
        const bool win = (k[0] == M);
        if (li == it) res = M;
#pragma unroll
        for (int i = 0; i < 7; ++i) k[i] = win ? k[i + 1] : k[i];
        k[7] = win ? (int)0x80000000 : k[7];
      }
      tkey[R * 16 + li] = res;
    }
    __syncthreads();
#pragma unroll 1
    for (int ps2 = 0; ps2 < 2; ++ps2) {
      const int h = ps2 * 4 + g;
      const int* t0 = tkey + (h * 2) * 16;
      const int* t1 = t0 + 16;
      const float sv0 = keyval(t0[li]);
      int ptr = 0;
      float head = sv0 + keyval(t1[0]);
      float rv = 0.f; int rc = 0;
#pragma unroll 1
      for (int it = 0; it < 16; ++it) {
        const float M = grp_max_f(head);
        const unsigned long long bm = __ballot(head == M);
        const unsigned gm = (unsigned)(bm >> (g * 16)) & 0xffffu;
        const int wl = __ffs(gm) - 1;
        const bool win = (li == wl);
        const int C = grp_max_i(win ? (li * 16 + ptr) : -1);
        if (li == it) { rv = M; rc = C; }
        if (win) {
          ++ptr;
          head = (ptr < 16) ? sv0 + keyval(t1[ptr & 15]) : -3.0e38f;
        }
      }
      const int ia = keyidx(t0[rc >> 4]);
      const int ib = keyidx(t1[rc & 15]);
      const float mx = grp_max_f(rv);
      const float ex = __expf(rv - mx);
      const float sm = grp_sum_f(ex);
      idx_out[(size_t)t * 128 + h * 16 + li] = ia * 128 + ib;
      gate_out[(size_t)t * 128 + h * 16 + li] = ex / sm;
    }
    __syncthreads();
  }
}

typedef float v2f __attribute__((ext_vector_type(2)));
template <int CTRL>
__device__ __forceinline__ float dpp_f(float v) { return __int_as_float(__builtin_amdgcn_update_dpp(0, __float_as_int(v), CTRL, 0xf, 0xf, false)); }
__device__ __forceinline__ float dot16_fp8(uint4 u, const v2f* x2) {
  v2f acc = {0.f, 0.f};
  acc = __builtin_elementwise_fma(__builtin_amdgcn_cvt_pk_f32_fp8((int)u.x, false), x2[0], acc);
  acc = __builtin_elementwise_fma(__builtin_amdgcn_cvt_pk_f32_fp8((int)u.x, true), x2[1], acc);
  acc = __builtin_elementwise_fma(__builtin_amdgcn_cvt_pk_f32_fp8((int)u.y, false), x2[2], acc);
  acc = __builtin_elementwise_fma(__builtin_amdgcn_cvt_pk_f32_fp8((int)u.y, true), x2[3], acc);
  acc = __builtin_elementwise_fma(__builtin_amdgcn_cvt_pk_f32_fp8((int)u.z, false), x2[4], acc);
  acc = __builtin_elementwise_fma(__builtin_amdgcn_cvt_pk_f32_fp8((int)u.z, true), x2[5], acc);
  acc = __builtin_elementwise_fma(__builtin_amdgcn_cvt_pk_f32_fp8((int)u.w, false), x2[6], acc);
  acc = __builtin_elementwise_fma(__builtin_amdgcn_cvt_pk_f32_fp8((int)u.w, true), x2[7], acc);
  return acc.x + acc.y;
}
__device__ __forceinline__ void axpy16_fp8(float w, uint4 u, v2f* o2) {
  const v2f w2 = {w, w};
  o2[0] = __builtin_elementwise_fma(__builtin_amdgcn_cvt_pk_f32_fp8((int)u.x, false), w2, o2[0]);
  o2[1] = __builtin_elementwise_fma(__builtin_amdgcn_cvt_pk_f32_fp8((int)u.x, true), w2, o2[1]);
  o2[2] = __builtin_elementwise_fma(__builtin_amdgcn_cvt_pk_f32_fp8((int)u.y, false), w2, o2[2]);
  o2[3] = __builtin_elementwise_fma(__builtin_amdgcn_cvt_pk_f32_fp8((int)u.y, true), w2, o2[3]);
  o2[4] = __builtin_elementwise_fma(__builtin_amdgcn_cvt_pk_f32_fp8((int)u.z, false), w2, o2[4]);
  o2[5] = __builtin_elementwise_fma(__builtin_amdgcn_cvt_pk_f32_fp8((int)u.z, true), w2, o2[5]);
  o2[6] = __builtin_elementwise_fma(__builtin_amdgcn_cvt_pk_f32_fp8((int)u.w, false), w2, o2[6]);
  o2[7] = __builtin_elementwise_fma(__builtin_amdgcn_cvt_pk_f32_fp8((int)u.w, true), w2, o2[7]);
}
__device__ __forceinline__ float reduce4_row(float d0, float d1, float d2, float d3, int lane) {
  const bool b0 = lane & 1, b1 = lane & 2;
  const float k0 = b0 ? d1 : d0, s0 = b0 ? d0 : d1;
  const float k1 = b0 ? d3 : d2, s1 = b0 ? d2 : d3;
  const float r0 = k0 + dpp_f<0xB1>(s0);
  const float r1 = k1 + dpp_f<0xB1>(s1);
  const float kk = b1 ? r1 : r0, ss = b1 ? r0 : r1;
  float q = kk + dpp_f<0x4E>(ss);
  q += dpp_f<0x128>(q);
  q += dpp_f<0x124>(q);
  return q;
}
#define EXP_LOAD(dst, dsc, TAB, SC, kbase, esrc)                                     \
  _Pragma("unroll") for (int j = 0; j < 8; ++j) {                                   \
    const int e = __builtin_amdgcn_readlane(esrc, ((kbase) + j) & 63);              \
    dst[j] = ((const uint4*)(TAB + (size_t)e * 1024))[lane];                        \
    dsc[j] = SC[e];                                                                  \
  }
#define EXP_LOADV(dst, TAB, kbase, esrc)                                             \
  _Pragma("unroll") for (int j = 0; j < 8; ++j) {                                   \
    const int e = __builtin_amdgcn_readlane(esrc, ((kbase) + j) & 63);              \
    dst[j] = ((const uint4*)(TAB + (size_t)e * 1024))[lane];                        \
  }
#define EXP_UDOT(src, ssc, kbase)                                                    \
  {                                                                                  \
    float d[8];                                                                      \
    _Pragma("unroll") for (int j = 0; j < 8; ++j) d[j] = dot16_fp8(src[j], x2) * ssc[j]; \
    const float qa = reduce4_row(d[0], d[1], d[2], d[3], lane);                      \
    const float qb = reduce4_row(d[4], d[5], d[6], d[7], lane);                      \
    float q = (lane & 4) ? qb : qa;                                                  \
    q += __shfl_xor(q, 16);                                                          \
    q += __shfl_xor(q, 32);                                                          \
    if ((lane >> 3) == ((((kbase)) & 63) >> 3)) { if ((kbase) < 64) h_lo = q; else h_hi = q; } \
  }
#define EXP_VACC(src, kbase, wsrc)                                                   \
  _Pragma("unroll") for (int j = 0; j < 8; ++j) {                                   \
    const float w = __int_as_float(__builtin_amdgcn_readlane(__float_as_int(wsrc), ((kbase) + j) & 63)); \
    axpy16_fp8(w, src[j], o2);                                                       \
  }

__device__ __forceinline__ void ph_expert(const Params& p, int layer) {
  const int lane = threadIdx.x & 63, wid = threadIdx.x >> 6;
  u16* xn16 = (u16*)(p.ws + OFF_XN);
  float* xres = (float*)(p.ws + OFF_X);
  const int* idxs = (const int*)(p.ws + OFF_IDX);
  const float* gates = (const float*)(p.ws + OFF_PGATE);
  const unsigned char* U = (const unsigned char*)(p.ws + OFF_U8);
  const unsigned char* V = (const unsigned char*)(p.ws + OFF_V8);
  const float* USC = (const float*)(p.ws + OFF_USC);
  const float* VSC = (const float*)(p.ws + OFF_VSC);
  for (int tb = blockIdx.x; tb < 4352; tb += gridDim.x) {
    const int t = tb * 4 + wid;
    v2f x2[8];
    {
      const uint4* xr = (const uint4*)(xn16 + (size_t)t * 1024 + lane * 16);
      uint4 xa = xr[0], xb = xr[1];
      x2[0] = v2f{bflo(xa.x), bfhi(xa.x)}; x2[1] = v2f{bflo(xa.y), bfhi(xa.y)};
      x2[2] = v2f{bflo(xa.z), bfhi(xa.z)}; x2[3] = v2f{bflo(xa.w), bfhi(xa.w)};
      x2[4] = v2f{bflo(xb.x), bfhi(xb.x)}; x2[5] = v2f{bflo(xb.y), bfhi(xb.y)};
      x2[6] = v2f{bflo(xb.z), bfhi(xb.z)}; x2[7] = v2f{bflo(xb.w), bfhi(xb.w)};
    }
    const int e_lo = idxs[(size_t)t * 128 + lane], e_hi = idxs[(size_t)t * 128 + 64 + lane];
    const float g_lo = gates[(size_t)t * 128 + lane], g_hi = gates[(size_t)t * 128 + 64 + lane];
    const float vs_lo = VSC[e_lo], vs_hi = VSC[e_hi];
    float h_lo = 0.f, h_hi = 0.f;
    {
      uint4 ba[8], bb[8]; float sa[8], sb[8];
      EXP_LOAD(ba, sa, U, USC, 0, e_lo)
#pragma unroll 1
      for (int kb = 0; kb < 64; kb += 16) {
        EXP_LOAD(bb, sb, U, USC, kb + 8, e_lo)
        EXP_UDOT(ba, sa, kb)
        if (kb + 16 < 64) { EXP_LOAD(ba, sa, U, USC, kb + 16, e_lo) } else { EXP_LOAD(ba, sa, U, USC, 0, e_hi) }
        EXP_UDOT(bb, sb, kb + 8)
      }
#pragma unroll 1
      for (int kb = 64; kb < 128; kb += 16) {
        EXP_LOAD(bb, sb, U, USC, kb + 8, e_hi)
        EXP_UDOT(ba, sa, kb)
        if (kb + 16 < 128) { EXP_LOAD(ba, sa, U, USC, kb + 16, e_hi) }
        EXP_UDOT(bb, sb, kb + 8)
      }
    }
    const float w_lo = 0.5f * h_lo * (1.f + erff(h_lo * 0.70710678118654752f)) * g_lo * vs_lo;
    const float w_hi = 0.5f * h_hi * (1.f + erff(h_hi * 0.70710678118654752f)) * g_hi * vs_hi;
    v2f o2[8];
#pragma unroll
    for (int i = 0; i < 8; ++i) o2[i] = v2f{0.f, 0.f};
    {
      uint4 ba[8], bb[8];
      EXP_LOADV(ba, V, 0, e_lo)
#pragma unroll 1
      for (int kb = 0; kb < 64; kb += 16) {
        EXP_LOADV(bb, V, kb + 8, e_lo)
        EXP_VACC(ba, kb, w_lo)
        if (kb + 16 < 64) { EXP_LOADV(ba, V, kb + 16, e_lo) } else { EXP_LOADV(ba, V, 0, e_hi) }
        EXP_VACC(bb, kb + 8, w_lo)
      }
#pragma unroll 1
      for (int kb = 64; kb < 128; kb += 16) {
        EXP_LOADV(bb, V, kb + 8, e_hi)
        EXP_VACC(ba, kb, w_hi)
        if (kb + 16 < 128) { EXP_LOADV(ba, V, kb + 16, e_hi) }
        EXP_VACC(bb, kb + 8, w_hi)
      }
    }
    float o[16];
#pragma unroll
    for (int i = 0; i < 8; ++i) { o[2 * i] = o2[i].x; o[2 * i + 1] = o2[i].y; }
    float* xr = xres + (size_t)t * 1024 + lane * 16;
    float ss = 0.f;
#pragma unroll
    for (int i = 0; i < 4; ++i) {
      float4 r = *(const float4*)(xr + i * 4);
      o[4 * i] += r.x; o[4 * i + 1] += r.y; o[4 * i + 2] += r.z; o[4 * i + 3] += r.w;
      ss += o[4 * i] * o[4 * i] + o[4 * i + 1] * o[4 * i + 1] + o[4 * i + 2] * o[4 * i + 2] + o[4 * i + 3] * o[4 * i + 3];
    }
    ss = wave_sum(ss);
    const float rs = rsqrtf(ss * (1.f / 1024.f) + 1e-6f);
    if (layer == 0) {
#pragma unroll
      for (int i = 0; i < 4; ++i) *(float4*)(xr + i * 4) = make_float4(o[4 * i], o[4 * i + 1], o[4 * i + 2], o[4 * i + 3]);
      uint4 wa, wb;
      wa.x = pack2(o[0] * rs, o[1] * rs); wa.y = pack2(o[2] * rs, o[3] * rs); wa.z = pack2(o[4] * rs, o[5] * rs); wa.w = pack2(o[6] * rs, o[7] * rs);
      wb.x = pack2(o[8] * rs, o[9] * rs); wb.y = pack2(o[10] * rs, o[11] * rs); wb.z = pack2(o[12] * rs, o[13] * rs); wb.w = pack2(o[14] * rs, o[15] * rs);
      uint4* xw = (uint4*)(xn16 + (size_t)t * 1024 + lane * 16);
      xw[0] = wa; xw[1] = wb;
    } else {
      const float* fg = p.final_norm + lane * 16;
      float* y = p.out + OUT_Y + (size_t)t * 1024 + lane * 16;
#pragma unroll
      for (int i = 0; i < 4; ++i) {
        float4 g = *(const float4*)(fg + i * 4);
        *(float4*)(y + i * 4) = make_float4(o[4 * i] * rs * g.x, o[4 * i + 1] * rs * g.y, o[4 * i + 2] * rs * g.z, o[4 * i + 3] * rs * g.w);
      }
    }
  }
}

struct XInfo { int nloc, nx, rank, xr; };
__device__ __forceinline__ float reduce8(float v) {
  v += dpp_f<0xB1>(v); v += dpp_f<0x4E>(v); v += dpp_f<0x141>(v);
  return v;
}
__device__ __forceinline__ void ph_expert_u(const Params& p, const XInfo xi) {
  const int lane = threadIdx.x & 63, wid = threadIdx.x >> 6, g = lane >> 3, i8 = lane & 7;
  const u16* xn16 = (const u16*)(p.ws + OFF_XN);
  const int* idxs = (const int*)(p.ws + OFF_IDX);
  float* ph = (float*)(p.ws + OFF_PH);
  for (int c = xi.xr; c < 8; c += xi.nx) {
    const unsigned char* Us = (const unsigned char*)(p.ws + OFF_U8) + (size_t)c * 2097152;
    const unsigned lo = (unsigned)i8 * 16u;
    int t = xi.rank * 4 + wid;
    int e[16];
    {
      const int t0 = min(t, NTOK - 1);
      const int4* ip = (const int4*)(idxs + (size_t)t0 * 128 + g * 16);
#pragma unroll
      for (int j = 0; j < 4; ++j) { int4 q = ip[j]; e[4 * j] = q.x; e[4 * j + 1] = q.y; e[4 * j + 2] = q.z; e[4 * j + 3] = q.w; }
    }
    for (; t < NTOK; t += xi.nloc * 4) {
      uint4 seg[16];
#pragma unroll
      for (int j = 0; j < 16; ++j) seg[j] = *(const uint4*)(Us + ((unsigned)e[j] * 128u + lo));
      v2f x2[8];
      {
        const uint4* xr = (const uint4*)(xn16 + (size_t)t * 1024 + c * 128 + i8 * 16);
        uint4 xa = xr[0], xb = xr[1];
        x2[0] = v2f{bflo(xa.x), bfhi(xa.x)}; x2[1] = v2f{bflo(xa.y), bfhi(xa.y)};
        x2[2] = v2f{bflo(xa.z), bfhi(xa.z)}; x2[3] = v2f{bflo(xa.w), bfhi(xa.w)};
        x2[4] = v2f{bflo(xb.x), bfhi(xb.x)}; x2[5] = v2f{bflo(xb.y), bfhi(xb.y)};
        x2[6] = v2f{bflo(xb.z), bfhi(xb.z)}; x2[7] = v2f{bflo(xb.w), bfhi(xb.w)};
      }
      {
        const int tn = min(t + xi.nloc * 4, NTOK - 1);
        const int4* ip = (const int4*)(idxs + (size_t)tn * 128 + g * 16);
#pragma unroll
        for (int j = 0; j < 4; ++j) { int4 q = ip[j]; e[4 * j] = q.x; e[4 * j + 1] = q.y; e[4 * j + 2] = q.z; e[4 * j + 3] = q.w; }
      }
      float d[16];
#pragma unroll
      for (int j = 0; j < 16; ++j) d[j] = reduce8(dot16_fp8(seg[j], x2));
      if (i8 == 0) {
        float* o = ph + ((size_t)c * NTOK + t) * 128 + g * 16;
#pragma unroll
        for (int j = 0; j < 4; ++j) *(float4*)(o + 4 * j) = make_float4(d[4 * j], d[4 * j + 1], d[4 * j + 2], d[4 * j + 3]);
      }
    }
  }
}
__device__ __forceinline__ void ph_expert_combine(const Params& p) {
  const int* idxs = (const int*)(p.ws + OFF_IDX);
  float* gates = (float*)(p.ws + OFF_PGATE);
  const float* ph = (const float*)(p.ws + OFF_PH);
  const float* USC = (const float*)(p.ws + OFF_USC);
  const float* VSC = (const float*)(p.ws + OFF_VSC);
  for (int i = blockIdx.x * 256 + threadIdx.x; i < NTOK * 128; i += gridDim.x * 256) {
    float s = 0.f;
#pragma unroll
    for (int c = 0; c < 8; ++c) s += ph[(size_t)c * NTOK * 128 + i];
    const int e = idxs[i];
    const float h = s * USC[e];
    gates[i] = 0.5f * h * (1.f + erff(h * 0.70710678118654752f)) * gates[i] * VSC[e];
  }
}
__device__ __forceinline__ void ph_expert_v(const Params& p, const XInfo xi) {
  const int lane = threadIdx.x & 63, wid = threadIdx.x >> 6, g = lane >> 3, i8 = lane & 7;
  const int* idxs = (const int*)(p.ws + OFF_IDX);
  const float* wts = (const float*)(p.ws + OFF_PGATE);
  float* xres = (float*)(p.ws + OFF_X);
  for (int c = xi.xr; c < 8; c += xi.nx) {
    const unsigned char* Vs = (const unsigned char*)(p.ws + OFF_V8) + (size_t)c * 2097152;
    const unsigned lo = (unsigned)i8 * 16u;
    int t = xi.rank * 4 + wid;
    int e[16]; float w[16];
    {
      const int t0 = min(t, NTOK - 1);
      const int4* ip = (const int4*)(idxs + (size_t)t0 * 128 + g * 16);
      const float4* wp = (const float4*)(wts + (size_t)t0 * 128 + g * 16);
#pragma unroll
      for (int j = 0; j < 4; ++j) { int4 q = ip[j]; float4 r = wp[j]; e[4 * j] = q.x; e[4 * j + 1] = q.y; e[4 * j + 2] = q.z; e[4 * j + 3] = q.w; w[4 * j] = r.x; w[4 * j + 1] = r.y; w[4 * j + 2] = r.z; w[4 * j + 3] = r.w; }
    }
    for (; t < NTOK; t += xi.nloc * 4) {
      v2f o2[8];
#pragma unroll
      for (int i = 0; i < 8; ++i) o2[i] = v2f{0.f, 0.f};
      {
        uint4 seg[16];
#pragma unroll
        for (int j = 0; j < 16; ++j) seg[j] = *(const uint4*)(Vs + ((unsigned)e[j] * 128u + lo));
#pragma unroll
        for (int j = 0; j < 16; ++j) axpy16_fp8(w[j], seg[j], o2);
      }
      __builtin_amdgcn_sched_barrier(0);
      {
        const int tn = min(t + xi.nloc * 4, NTOK - 1);
        const int4* ip = (const int4*)(idxs + (size_t)tn * 128 + g * 16);
        const float4* wp = (const float4*)(wts + (size_t)tn * 128 + g * 16);
#pragma unroll
        for (int j = 0; j < 4; ++j) { int4 q = ip[j]; float4 r = wp[j]; e[4 * j] = q.x; e[4 * j + 1] = q.y; e[4 * j + 2] = q.z; e[4 * j + 3] = q.w; w[4 * j] = r.x; w[4 * j + 1] = r.y; w[4 * j + 2] = r.z; w[4 * j + 3] = r.w; }
      }
      float o[16];
#pragma unroll
      for (int i = 0; i < 8; ++i) { o[2 * i] = o2[i].x; o[2 * i + 1] = o2[i].y; }
#pragma unroll
      for (int i = 0; i < 16; ++i) {
        float v = o[i];
        v += dpp_f<0x128>(v);
        v += __shfl_xor(v, 16);
        v += __shfl_xor(v, 32);
        o[i] = v;
        if ((i & 3) == 3) __builtin_amdgcn_sched_barrier(0);
      }
      if (g == 0) {
        float* xr = xres + (size_t)t * 1024 + c * 128 + i8 * 16;
#pragma unroll
        for (int i = 0; i < 4; ++i) {
          float4 r = *(const float4*)(xr + i * 4);
          *(float4*)(xr + i * 4) = make_float4(r.x + o[4 * i], r.y + o[4 * i + 1], r.z + o[4 * i + 2], r.w + o[4 * i + 3]);
        }
      }
    }
  }
}
__device__ __forceinline__ void ph_post_norm(const Params& p, int layer) {
  const int lane = threadIdx.x & 63, wid = threadIdx.x >> 6;
  const float* xres = (const float*)(p.ws + OFF_X);
  u16* xn16 = (u16*)(p.ws + OFF_XN);
  for (int u = blockIdx.x; u < 4352; u += gridDim.x) {
    const int t = u * 4 + wid;
    const float* x = xres + (size_t)t * 1024;
    float4 v[4]; float ss = 0.f;
#pragma unroll
    for (int i = 0; i < 4; ++i) {
      v[i] = *(const float4*)(x + i * 256 + lane * 4);
      ss += v[i].x * v[i].x + v[i].y * v[i].y + v[i].z * v[i].z + v[i].w * v[i].w;
    }
    ss = wave_sum(ss);
    const float r = rsqrtf(ss * (1.f / 1024.f) + 1e-6f);
    if (layer == 0) {
#pragma unroll
      for (int i = 0; i < 4; ++i) {
        uint2 w; w.x = pack2(v[i].x * r, v[i].y * r); w.y = pack2(v[i].z * r, v[i].w * r);
        *(uint2*)(xn16 + (size_t)t * 1024 + i * 256 + lane * 4) = w;
      }
    } else {
      float* y = p.out + OUT_Y + (size_t)t * 1024;
#pragma unroll
      for (int i = 0; i < 4; ++i) {
        float4 gg = *(const float4*)(p.final_norm + i * 256 + lane * 4);
        *(float4*)(y + i * 256 + lane * 4) = make_float4(v[i].x * r * gg.x, v[i].y * r * gg.y, v[i].z * r * gg.z, v[i].w * r * gg.w);
      }
    }
  }
}

__device__ __forceinline__ void ph_attn(const Params& p, char* smem) {
  const int tid = threadIdx.x, lane = tid & 63, wid = tid >> 6, fr = lane & 15, fq = lane >> 4;
  const u16* k16 = (const u16*)(p.ws + OFF_K16);
  const u16* v16 = (const u16*)(p.ws + OFF_V16A);
  const u16* q16 = (const u16*)(p.ws + OFF_Q16);
  u16* o16 = (u16*)(p.ws + OFF_O16);
  u16* Ks = (u16*)smem;
  u16* Vt = (u16*)(smem + 27648);
  for (int item = blockIdx.x; item < 1536; item += gridDim.x) {
    const bool is_p = item < 1024;
    int b, kvh, q0 = 0, nsub, nvalid, kpos0, minpos, tokbase;
    if (is_p) { b = item >> 7; kvh = (item >> 5) & 3; q0 = (item & 31) * 64; nsub = 4; nvalid = 192; kpos0 = q0 - 128; minpos = 0; tokbase = b * 2048; }
    else { int it2 = item - 1024; b = it2 >> 2; kvh = it2 & 3; nsub = 1; nvalid = 136; kpos0 = -128; minpos = -100000; tokbase = NTP + b * 8; }
    __syncthreads();
    for (int c = tid; c < 1536; c += 256) {
      const int j = c >> 3, ch = c & 7;
      uint4 kk = make_uint4(0, 0, 0, 0), vv = make_uint4(0, 0, 0, 0);
      if (is_p) {
        const int kp = kpos0 + j;
        if (kp >= 0) {
          const size_t off = (size_t)(tokbase + kp) * 256 + kvh * 64 + ch * 8;
          kk = *(const uint4*)(k16 + off); vv = *(const uint4*)(v16 + off);
        }
      } else {
        if (j < 128) {
          const size_t off = ((size_t)(b * 128 + j) * 4 + kvh) * 64 + ch * 8;
          float4 a0 = *(const float4*)(p.cache_k + off), a1 = *(const float4*)(p.cache_k + off + 4);
          float4 c0 = *(const float4*)(p.cache_v + off), c1 = *(const float4*)(p.cache_v + off + 4);
          kk.x = pack2(a0.x, a0.y); kk.y = pack2(a0.z, a0.w); kk.z = pack2(a1.x, a1.y); kk.w = pack2(a1.z, a1.w);
          vv.x = pack2(c0.x, c0.y); vv.y = pack2(c0.z, c0.w); vv.z = pack2(c1.x, c1.y); vv.w = pack2(c1.z, c1.w);
        } else if (j < 136) {
          const size_t off = (size_t)(tokbase + j - 128) * 256 + kvh * 64 + ch * 8;
          kk = *(const uint4*)(k16 + off); vv = *(const uint4*)(v16 + off);
        }
      }
      *(uint4*)(Ks + j * 72 + ch * 8) = kk;
      u16* vd = Vt + (ch * 8) * 200 + j;
      vd[0] = (u16)(vv.x & 0xffff); vd[200] = (u16)(vv.x >> 16);
      vd[400] = (u16)(vv.y & 0xffff); vd[600] = (u16)(vv.y >> 16);
      vd[800] = (u16)(vv.z & 0xffff); vd[1000] = (u16)(vv.z >> 16);
      vd[1200] = (u16)(vv.w & 0xffff); vd[1400] = (u16)(vv.w >> 16);
    }
    __syncthreads();
    const int head = kvh * 4 + wid;
    const float sink = p.sinks[head];
#pragma unroll 1
    for (int sub = 0; sub < nsub; ++sub) {
      int qtok, qp;
      if (is_p) { qp = q0 + sub * 16 + fr; qtok = tokbase + qp; }
      else { qp = fr & 7; qtok = tokbase + (fr & 7); }
      const u16* qrow = q16 + (size_t)qtok * 1024 + head * 64;
      const bf16x8 qf0 = *(const bf16x8*)(qrow + fq * 8);
      const bf16x8 qf1 = *(const bf16x8*)(qrow + 32 + fq * 8);
      f32x4 s[12];
#pragma unroll
      for (int ks = 0; ks < 12; ++ks) {
        const bf16x8 kf0 = *(const bf16x8*)(Ks + (ks * 16 + fr) * 72 + fq * 8);
        const bf16x8 kf1 = *(const bf16x8*)(Ks + (ks * 16 + fr) * 72 + 32 + fq * 8);
        f32x4 z = {0.f, 0.f, 0.f, 0.f};
        z = __builtin_amdgcn_mfma_f32_16x16x32_bf16(kf0, qf0, z, 0, 0, 0);
        s[ks] = __builtin_amdgcn_mfma_f32_16x16x32_bf16(kf1, qf1, z, 0, 0, 0);
        if ((ks & 3) == 3) __builtin_amdgcn_sched_barrier(0);
      }
      float mx = sink;
      const int lo_ = max(minpos, qp - 127), hi_ = min(qp, kpos0 + nvalid - 1);
      const unsigned span_ = (unsigned)(hi_ - lo_);
      const int kp0_ = kpos0 + fq * 4 - lo_;
#pragma unroll
      for (int ks = 0; ks < 12; ++ks)
#pragma unroll
        for (int j = 0; j < 4; ++j) {
          const bool valid = (unsigned)(kp0_ + ks * 16 + j) <= span_;
          const float v = valid ? s[ks][j] : -1.0e30f;
          s[ks][j] = v;
          mx = fmaxf(mx, v);
          if (j == 3) __builtin_amdgcn_sched_barrier(0);
        }
      mx = fmaxf(mx, __shfl_xor(mx, 16));
      mx = fmaxf(mx, __shfl_xor(mx, 32));
      float sum = 0.f;
#pragma unroll
      for (int ks = 0; ks < 12; ++ks)
#pragma unroll
        for (int j = 0; j < 4; ++j) {
          const float pv = (s[ks][j] > -1.0e29f) ? __expf(s[ks][j] - mx) : 0.f;
          s[ks][j] = pv;
          sum += pv;
          if (j == 3) __builtin_amdgcn_sched_barrier(0);
        }
      sum += __shfl_xor(sum, 16);
      sum += __shfl_xor(sum, 32);
      sum += __expf(sink - mx);
      const float inv = 1.f / sum;
      f32x4 o[4];
#pragma unroll
      for (int d = 0; d < 4; ++d) o[d] = f32x4{0.f, 0.f, 0.f, 0.f};
#pragma unroll
      for (int kk = 0; kk < 6; ++kk) {
        union { bf16x8 v; unsigned u[4]; } pb;
        pb.u[0] = pack2(s[2 * kk][0], s[2 * kk][1]); pb.u[1] = pack2(s[2 * kk][2], s[2 * kk][3]);
        pb.u[2] = pack2(s[2 * kk + 1][0], s[2 * kk + 1][1]); pb.u[3] = pack2(s[2 * kk + 1][2], s[2 * kk + 1][3]);
#pragma unroll
        for (int d = 0; d < 4; ++d) {
          union { bf16x8 v; uint2 h[2]; } vf;
          const u16* vr = Vt + (d * 16 + fr) * 200 + fq * 4;
          vf.h[0] = *(const uint2*)(vr + (2 * kk) * 16);
          vf.h[1] = *(const uint2*)(vr + (2 * kk + 1) * 16);
          o[d] = __builtin_amdgcn_mfma_f32_16x16x32_bf16(vf.v, pb.v, o[d], 0, 0, 0);
        }
        __builtin_amdgcn_sched_barrier(0);
      }
      if (is_p || fr < 8) {
#pragma unroll
        for (int d = 0; d < 4; ++d) {
          uint2 w; w.x = pack2(o[d][0] * inv, o[d][1] * inv); w.y = pack2(o[d][2] * inv, o[d][3] * inv);
          *(uint2*)(o16 + (size_t)qtok * 1024 + head * 64 + d * 16 + fq * 4) = w;
        }
      }
    }
  }
}


#define XB_TMO      128
#define XB_XCNT(j)  (256  + 64 * (j))
#define XB_XSUB(j)  (1280 + 64 * (j))
#define XB_XGEN(j)  (2304 + 64 * (j))
#define XB_TOP      3328
#define XB_TOPGEN   3392
#define XCD_BAR_WORDS 3456
#define XB_SPIN_CAP (1u << 20)
#define LAS __attribute__((address_space(3)))
__device__ __forceinline__ unsigned xb_ld(unsigned* p) { return __hip_atomic_load(p, __ATOMIC_RELAXED, __HIP_MEMORY_SCOPE_AGENT); }
__device__ __forceinline__ unsigned xb_add(unsigned* p, unsigned v) { return __hip_atomic_fetch_add(p, v, __ATOMIC_RELAXED, __HIP_MEMORY_SCOPE_AGENT); }
__device__ __forceinline__ unsigned xb_xcc_id() { return (unsigned)__builtin_amdgcn_s_getreg((3 << 11) | 20) & 0xFu; }
#define XB_SPIN(cond, bar) do { unsigned _sp = 0; while (cond) { __builtin_amdgcn_s_sleep(1); \
    if ((++_sp & 255u) == 0u) { if (xb_ld(&(bar)[XB_TMO])) break; if (_sp > XB_SPIN_CAP) { atomicAdd(&(bar)[XB_TMO], 1u); break; } } } } while (0)
struct XcdBarrier { unsigned* bar; unsigned x; volatile LAS unsigned* st; };
__device__ __forceinline__ XcdBarrier xcd_barrier_post(unsigned* bar, volatile LAS unsigned* st) {
  XcdBarrier b; b.bar = bar; b.x = xb_xcc_id(); b.st = st;
  if (threadIdx.x == 0) st[2] = xb_add(&bar[XB_XCNT(b.x)], 1u);
  return b;
}
__device__ __forceinline__ void xcd_barrier_complete(unsigned* bar, unsigned x, unsigned& nloc, unsigned& nx, unsigned& xr) {
  const unsigned G = gridDim.x * gridDim.y * gridDim.z;
  unsigned sum, cnt, mine, below, sp = 0u;
  for (;;) {
    sum = 0u; cnt = 0u; mine = 0u; below = 0u;
#pragma unroll
    for (unsigned j = 0; j < 16; ++j) { const unsigned c = xb_ld(&bar[XB_XCNT(j)]); sum += c; cnt += (c > 0u) ? 1u : 0u; mine = (j == x) ? c : mine; below += (j < x && c > 0u) ? 1u : 0u; }
    if (sum == G) break;
    __builtin_amdgcn_s_sleep(1);
    if ((++sp & 255u) == 0u) { if (xb_ld(&bar[XB_TMO])) break; if (sp > XB_SPIN_CAP) { atomicAdd(&bar[XB_TMO], 1u); break; } }
  }
  nloc = mine > 0u ? mine : 1u; nx = cnt > 0u ? cnt : 1u; xr = below;
}
__device__ __forceinline__ void xcd_barrier(const XcdBarrier& b) {
  asm volatile("s_waitcnt vmcnt(0)" ::: "memory");
  __syncthreads();
  if (threadIdx.x == 0) {
    unsigned* bar = b.bar;
    __builtin_amdgcn_s_waitcnt(0);
    unsigned nloc = b.st[0], nx = b.st[1];
    if (nloc == 0u) { unsigned xr; xcd_barrier_complete(bar, b.x, nloc, nx, xr); b.st[0] = nloc; b.st[1] = nx; b.st[3] = xr; }
    const unsigned old = xb_add(&bar[XB_XSUB(b.x)], 1u);
    const unsigned gen = old / nloc;
    if (old + 1u == (gen + 1u) * nloc) {
      __builtin_amdgcn_fence(__ATOMIC_RELEASE, "agent");
      asm volatile("s_waitcnt vmcnt(0)" ::: "memory");
      const unsigned og = xb_add(&bar[XB_TOP], 1u);
      const unsigned tg = og / nx;
      if (og + 1u == (tg + 1u) * nx) xb_add(&bar[XB_TOPGEN], 1u);
      else XB_SPIN(xb_ld(&bar[XB_TOPGEN]) == tg, bar);
      __builtin_amdgcn_fence(__ATOMIC_ACQUIRE, "agent");
      xb_add(&bar[XB_XGEN(b.x)], 1u);
      asm volatile("s_waitcnt vmcnt(0)" ::: "memory");
    } else {
      XB_SPIN(xb_ld(&bar[XB_XGEN(b.x)]) == gen, bar);
      __builtin_amdgcn_fence(__ATOMIC_ACQUIRE, "agent");
      asm volatile("s_waitcnt vmcnt(0)" ::: "memory");
    }
  }
  __syncthreads();
}

typedef const Params __attribute__((address_space(4))) CParams;
__device__ __forceinline__ Params load_params(CParams* q) {
  Params r;
  r.x_prompt = q->x_prompt;
  r.x_sample = q->x_sample;
  r.state_conv = q->state_conv;
  r.state_h = q->state_h;
  r.cache_k = q->cache_k;
  r.cache_v = q->cache_v;
  r.rg_norm = q->rg_norm;
  r.rg_w_in = q->rg_w_in;
  r.rg_conv_w = q->rg_conv_w;
  r.rg_conv_b = q->rg_conv_b;
  r.rg_wa = q->rg_wa;
  r.rg_ba = q->rg_ba;
  r.rg_wx = q->rg_wx;
  r.rg_bx = q->rg_bx;
  r.rg_lambda = q->rg_lambda;
  r.rg_w_out = q->rg_w_out;
  r.kv_norm = q->kv_norm;
  r.w_kv = q->w_kv;
  r.attn_norm = q->attn_norm;
  r.w_q = q->w_q;
  r.sinks = q->sinks;
  r.w_o = q->w_o;
  r.ffn_norm = q->ffn_norm;
  r.peer_wq = q->peer_wq;
  r.peer_subkeys = q->peer_subkeys;
  r.peer_u = q->peer_u;
  r.peer_v = q->peer_v;
  r.final_norm = q->final_norm;
  r.out = q->out;
  r.ws = q->ws;
  r.ph_begin = q->ph_begin;
  r.ph_end = q->ph_end;
  return r;
}

template <int ph>
__device__ __forceinline__ void run_phase(const Params& p, char* smem, const XInfo xi) {
  char* ws = p.ws;
  switch (ph) {
    case 0: ph_convert0(p, smem); break;
    case 1: {
      EpiWin e{(u16*)(ws + OFF_GATE16), (float*)(ws + OFF_REC32)};
      gemm_tiles((const u16*)(ws + OFF_XN), 1024, (const u16*)(ws + OFF_WT_IN), 1024, 1024, 0, 16, e, smem);
    } break;
    case 2: ph_conv(p); break;
    case 3: {
      EpiBd e{(float*)(ws + OFF_LOGA), (u16*)(ws + OFF_IG16), p.rg_ba, p.rg_bx, p.rg_lambda};
      gemm_tiles((const u16*)(ws + OFF_XC16), 1024, (const u16*)(ws + OFF_WT_BD), 128, 128, 8, 16, e, smem);
    } break;
    case 4: ph_scanA(p); break;
    case 20: ph_scanA2(p); break;
    case 5: ph_scanB(p); break;
    case 6: {
      EpiResid e{p.x_prompt, p.x_sample, (float*)(ws + OFF_X), 1};
      gemm_tiles((const u16*)(ws + OFF_HG16), 1024, (const u16*)(ws + OFF_WT_OUT), 1024, 1024, 0, 8, e, smem);
      ph_cvt_tables(p, 0);
    } break;
    case 7: ph_rmsnorm(p, p.ffn_norm); break;
    case 8: case 16: {
      EpiBf16 e{(u16*)(ws + OFF_QP16), 2048};
      gemm_tiles((const u16*)(ws + OFF_XN), 1024, (const u16*)(ws + (ph == 8 ? OFF_WT_PQ0 : OFF_WT_PQ1)), 1024, 1024, 0, 16, e, smem);
    } break;
    case 9: case 17: {
      EpiF32 e{(float*)(ws + OFF_S32), 2048};
      gemm_tiles((const u16*)(ws + OFF_QP16), 2048, (const u16*)(ws + (ph == 9 ? OFF_WT_SK0 : OFF_WT_SK1)), 128, 128, 16, 16, e, smem);
    } break;
    case 10: case 18: ph_topk(p, smem); break;
    case 11: case 19: ph_expert_u(p, xi); break;
    case 21: case 24: ph_expert_combine(p); break;
    case 22: case 25: ph_expert_v(p, xi); break;
    case 23: ph_post_norm(p, 0); break;
    case 26: ph_post_norm(p, 1); break;
    case 12: {
      EpiKvq e{(u16*)(ws + OFF_K16), (u16*)(ws + OFF_V16A), (u16*)(ws + OFF_Q16), (const float2*)(ws + OFF_ROPE), p.out};
      gemm_tiles((const u16*)(ws + OFF_XN), 1024, (const u16*)(ws + OFF_WT_KVQ), 1024, 1024, 0, 12, e, smem);
      ph_cvt_tables(p, 1);
    } break;
    case 13: ph_attn(p, smem); break;
    case 14: {
      EpiResid e{p.x_prompt, p.x_sample, (float*)(ws + OFF_X), 0};
      gemm_tiles((const u16*)(ws + OFF_O16), 1024, (const u16*)(ws + OFF_WT_O), 1024, 1024, 0, 8, e, smem);
    } break;
    case 15: ph_rmsnorm(p, p.ffn_norm + 1024); break;
    default: break;
  }
}

__global__ void __launch_bounds__(256, 2) yoco_megakernel(Params p) {
  __shared__ __attribute__((aligned(16))) char smem[73728];
  __shared__ uint4 xb_words;
  cg::grid_group grid = cg::this_grid();
  if (threadIdx.x == 0) xb_words = make_uint4(0u, 0u, 0u, 0u);
  __syncthreads();
  XcdBarrier xb = xcd_barrier_post((unsigned*)(p.ws + OFF_BAR), (volatile LAS unsigned*)&xb_words);
  if (p.ph_end > 1000) grid.sync();
#define LAUNDER(q) CParams* q = (CParams*)__builtin_amdgcn_kernarg_segment_ptr(); asm volatile("" : "+s"(q));
#define PH(k) run_phase<k>(p, smem, xi); xcd_barrier(xb);
  XInfo xi; xi.nloc = 1; xi.nx = 1; xi.rank = 0; xi.xr = 0;
  PH(0)
  { volatile LAS unsigned* st = (volatile LAS unsigned*)&xb_words; xi.nloc = __builtin_amdgcn_readfirstlane((int)st[0]); xi.nx = __builtin_amdgcn_readfirstlane((int)st[1]); xi.rank = __builtin_amdgcn_readfirstlane((int)st[2]); xi.xr = __builtin_amdgcn_readfirstlane((int)st[3]); }
  PH(1) PH(2) PH(3) PH(4) PH(20) PH(5) PH(6) PH(7) PH(8) PH(9)
  PH(10) PH(11) PH(21) PH(22) PH(23) PH(12) PH(13) PH(14) PH(15) PH(16) PH(17) PH(18) PH(19) PH(24) PH(25)
  run_phase<26>(p, smem, xi);
}

extern "C" void kernel_launch(void* const* d_in, const int* in_sizes, int n_in, void* d_out, int out_size,
                              void* d_ws, size_t ws_size, hipStream_t stream) {
  static int grid_blocks = 0;
  if (!grid_blocks) {
    int dev = 0, cus = 0, per_cu = 0;
    hipGetDevice(&dev);
    hipDeviceGetAttribute(&cus, hipDeviceAttributeMultiprocessorCount, dev);
    hipOccupancyMaxActiveBlocksPerMultiprocessor(&per_cu, yoco_megakernel, 256, 0);
    if (per_cu > 2) per_cu = 2;
    if (per_cu < 1) per_cu = 1;
    grid_blocks = cus * per_cu;
    if (ws_size < WS_NEEDED) fprintf(stderr, "workspace too small: %zu < %llu\n", ws_size, (unsigned long long)WS_NEEDED);
  }
  Params p{};
  const float** f = (const float**)&p;
  for (int i = 0; i < 28; ++i) f[i] = (const float*)d_in[i];
  p.out = (float*)d_out;
  p.ws = (char*)d_ws;
  hipMemsetAsync((char*)d_ws + OFF_BAR, 0, XCD_BAR_WORDS * sizeof(unsigned), stream);
#if MULTI_LAUNCH
  for (int ph = 0; ph < NPHASE; ++ph) {
    p.ph_begin = ph; p.ph_end = ph + 1;
    hipLaunchKernelGGL(yoco_megakernel, dim3(grid_blocks), dim3(256), 0, stream, p);
  }
#else
  p.ph_begin = 0; p.ph_end = NPHASE;
  void* args[] = {&p};
  hipError_t e = hipLaunchCooperativeKernel((void*)yoco_megakernel, dim3(grid_blocks), dim3(256), args, 0, stream);
  if (e != hipSuccess) fprintf(stderr, "cooperative launch failed: %s (grid %d)\n", hipGetErrorString(e), grid_blocks);
#endif
}
```

```cpp
#include <hip/hip_runtime.h>
#include <hip/hip_cooperative_groups.h>
#include <cstdio>
#include <cstdint>
namespace cg = cooperative_groups;

typedef unsigned short u16;
typedef __attribute__((ext_vector_type(8))) short bf16x8;
typedef __attribute__((ext_vector_type(4))) float f32x4;

#define NTOK 17408
#define NTP 16384
#define MIB 1048576ull
#define NPHASE 20
#ifndef MULTI_LAUNCH
#define MULTI_LAUNCH 0
#endif

#define OFF_WT_IN   (0 * MIB)
#define OFF_WT_OUT  (4 * MIB)
#define OFF_WT_BD   (6 * MIB)
#define OFF_WT_PQ0  (7 * MIB)
#define OFF_WT_PQ1  (11 * MIB)
#define OFF_WT_KVQ  (15 * MIB)
#define OFF_WT_O    (18 * MIB)
#define OFF_WT_SK0  (20 * MIB)
#define OFF_WT_SK1  (20 * MIB + 524288ull)
#define OFF_ROPE    (21 * MIB)
#define OFF_USC     (21 * MIB + 655360ull)
#define OFF_VSC     (21 * MIB + 655360ull + 65536ull)
#define OFF_U8      (22 * MIB)
#define OFF_V8      (38 * MIB)
#define OFF_XN      (86 * MIB)
#define OFF_X       (120 * MIB)
#define OFF_GATE16  (188 * MIB)
#define OFF_REC32   (222 * MIB)
#define OFF_XC32    (290 * MIB)
#define OFF_XC16    (358 * MIB)
#define OFF_LOGA    (222 * MIB)
#define OFF_IG16    (22 * MIB)
#define OFF_AGGA    (56 * MIB)
#define OFF_AGGB    (60 * MIB)
#define OFF_HG16    (358 * MIB)
#define OFF_QP16    (188 * MIB)
#define OFF_S32     (256 * MIB)
#define OFF_PH      (256 * MIB)
#define OFF_TKEY    (256 * MIB)
#define OFF_IDX     (188 * MIB)
#define OFF_PGATE   (197 * MIB)
#define OFF_K16     (188 * MIB)
#define OFF_V16A    (197 * MIB)
#define OFF_Q16     (206 * MIB)
#define OFF_O16     (240 * MIB)
#define OFF_BAR     (392 * MIB)
#define WS_NEEDED   (392 * MIB + 16384ull)

#define OUT_Y      0
#define OUT_CONVP  17825792
#define OUT_HP     17850368
#define OUT_KP     17858560
#define OUT_VP     18120704
#define OUT_CONVS  18382848
#define OUT_HS     18776064
#define OUT_KS     18907136
#define OUT_VS     23101440

struct Params {
  const float *x_prompt, *x_sample, *state_conv, *state_h, *cache_k, *cache_v;
  const float *rg_norm, *rg_w_in, *rg_conv_w, *rg_conv_b, *rg_wa, *rg_ba, *rg_wx, *rg_bx, *rg_lambda, *rg_w_out;
  const float *kv_norm, *w_kv, *attn_norm, *w_q, *sinks, *w_o, *ffn_norm, *peer_wq, *peer_subkeys, *peer_u, *peer_v, *final_norm;
  float* out;
  char* ws;
  int ph_begin, ph_end;
};

__device__ __forceinline__ u16 f2bf(float f) {
  unsigned u = __float_as_uint(f);
  u += 0x7fffu + ((u >> 16) & 1u);
  return (u16)(u >> 16);
}
__device__ __forceinline__ float bf2f(u16 h) { return __uint_as_float(((unsigned)h) << 16); }
__device__ __forceinline__ unsigned pack2(float a, float b) { return (unsigned)f2bf(a) | ((unsigned)f2bf(b) << 16); }
__device__ __forceinline__ float bflo(unsigned u) { return __uint_as_float(u << 16); }
__device__ __forceinline__ float bfhi(unsigned u) { return __uint_as_float(u & 0xffff0000u); }
__device__ __forceinline__ float wave_sum(float v) {
#pragma unroll
  for (int o = 32; o > 0; o >>= 1) v += __shfl_xor(v, o);
  return v;
}
__device__ __forceinline__ const float* xin_row(const Params& p, int token) {
  return token < NTP ? p.x_prompt + (size_t)token * 1024 : p.x_sample + (size_t)(token - NTP) * 1024;
}
__device__ __forceinline__ float gelu_tanh(float x) {
  float u = 0.7978845608028654f * (x + 0.044715f * x * x * x);
  float e = __expf(2.f * u);
  float th = 1.f - 2.f / (e + 1.f);
  return 0.5f * x * (1.f + th);
}
__device__ __forceinline__ float sigmoidf_(float x) { return 1.f / (1.f + __expf(-x)); }

template <int CTRL>
__device__ __forceinline__ int dpp_i(int v) { return __builtin_amdgcn_update_dpp(v, v, CTRL, 0xf, 0xf, false); }
__device__ __forceinline__ int grp_max_i(int v) {
  v = max(v, dpp_i<0xB1>(v));
  v = max(v, dpp_i<0x4E>(v));
  v = max(v, dpp_i<0x141>(v));
  v = max(v, dpp_i<0x140>(v));
  return v;
}
__device__ __forceinline__ float grp_max_f(float v) {
  v = fmaxf(v, __int_as_float(dpp_i<0xB1>(__float_as_int(v))));
  v = fmaxf(v, __int_as_float(dpp_i<0x4E>(__float_as_int(v))));
  v = fmaxf(v, __int_as_float(dpp_i<0x141>(__float_as_int(v))));
  v = fmaxf(v, __int_as_float(dpp_i<0x140>(__float_as_int(v))));
  return v;
}
__device__ __forceinline__ float grp_sum_f(float v) {
  v += __int_as_float(dpp_i<0xB1>(__float_as_int(v)));
  v += __int_as_float(dpp_i<0x4E>(__float_as_int(v)));
  v += __int_as_float(dpp_i<0x141>(__float_as_int(v)));
  v += __int_as_float(dpp_i<0x140>(__float_as_int(v)));
  return v;
}

__device__ __forceinline__ void transpose_unit(const float* __restrict__ src, int ld_src, u16* __restrict__ dst, int ld_dst,
                               int kt, int nt, const float* __restrict__ gain, float* lds) {
  const int tid = threadIdx.x;
#pragma unroll
  for (int j = 0; j < 4; ++j) {
    int idx = tid + j * 256;
    int k = idx >> 4, c4 = idx & 15;
    float4 v = *(const float4*)(src + (size_t)(kt * 64 + k) * ld_src + nt * 64 + c4 * 4);
    float g = gain ? gain[kt * 64 + k] : 1.f;
    float* d = lds + k * 65 + c4 * 4;
    d[0] = v.x * g; d[1] = v.y * g; d[2] = v.z * g; d[3] = v.w * g;
  }
  __syncthreads();
#pragma unroll
  for (int j = 0; j < 2; ++j) {
    int c = tid + j * 256;
    int n = c >> 3, kc = c & 7;
    uint4 o;
    o.x = pack2(lds[(kc * 8 + 0) * 65 + n], lds[(kc * 8 + 1) * 65 + n]);
    o.y = pack2(lds[(kc * 8 + 2) * 65 + n], lds[(kc * 8 + 3) * 65 + n]);
    o.z = pack2(lds[(kc * 8 + 4) * 65 + n], lds[(kc * 8 + 5) * 65 + n]);
    o.w = pack2(lds[(kc * 8 + 6) * 65 + n], lds[(kc * 8 + 7) * 65 + n]);
    *(uint4*)(dst + (size_t)(nt * 64 + n) * ld_dst + kt * 64 + kc * 8) = o;
  }
  __syncthreads();
}

__device__ __forceinline__ void transpose_job(const Params& p, int u, float* lds) {
  char* ws = p.ws;
  if (u < 512) { transpose_unit(p.rg_w_in, 2048, (u16*)(ws + OFF_WT_IN), 1024, u >> 5, u & 31, nullptr, lds); return; }
  u -= 512;
  if (u < 256) { transpose_unit(p.rg_w_out, 1024, (u16*)(ws + OFF_WT_OUT), 1024, u >> 4, u & 15, nullptr, lds); return; }
  u -= 256;
  if (u < 64) {
    int which = u >> 5; int r = u & 31; int bi = r >> 2; int t = r & 3;
    const float* src = (which ? p.rg_wx : p.rg_wa) + (size_t)bi * 16384;
    u16* dst = (u16*)(ws + OFF_WT_BD) + (size_t)(which * 1024 + bi * 128) * 128;
    transpose_unit(src, 128, dst, 128, t >> 1, t & 1, nullptr, lds); return;
  }
  u -= 64;
  if (u < 1024) {
    int l = u >> 9; int r = u & 511;
    transpose_unit(p.peer_wq + (size_t)l * 2097152, 2048, (u16*)(ws + (l ? OFF_WT_PQ1 : OFF_WT_PQ0)), 1024, r >> 5, r & 31, nullptr, lds); return;
  }
  u -= 1024;
  if (u < 128) { transpose_unit(p.w_kv, 512, (u16*)(ws + OFF_WT_KVQ), 1024, u >> 3, u & 7, p.kv_norm, lds); return; }
  u -= 128;
  if (u < 256) { transpose_unit(p.w_q, 1024, (u16*)(ws + OFF_WT_KVQ) + (size_t)512 * 1024, 1024, u >> 4, u & 15, p.attn_norm, lds); return; }
  u -= 256;
  transpose_unit(p.w_o, 1024, (u16*)(ws + OFF_WT_O), 1024, u >> 4, u & 15, nullptr, lds);
}

__device__ __forceinline__ void cvt_unit(const float* __restrict__ src, u16* __restrict__ dst, size_t base) {
  const int tid = threadIdx.x;
#pragma unroll
  for (int j = 0; j < 2; ++j) {
    size_t o = base + j * 1024 + tid * 4;
    float4 v = *(const float4*)(src + o);
    uint2 w; w.x = pack2(v.x, v.y); w.y = pack2(v.z, v.w);
    *(uint2*)(dst + o) = w;
  }
}

__device__ __forceinline__ void rmsnorm_row(const float* __restrict__ x, const float* __restrict__ g, u16* __restrict__ o, int lane) {
  float4 v[4];
  float ss = 0.f;
#pragma unroll
  for (int i = 0; i < 4; ++i) {
    v[i] = *(const float4*)(x + i * 256 + lane * 4);
    ss += v[i].x * v[i].x + v[i].y * v[i].y + v[i].z * v[i].z + v[i].w * v[i].w;
  }
  ss = wave_sum(ss);
  float r = rsqrtf(ss * (1.f / 1024.f) + 1e-6f);
#pragma unroll
  for (int i = 0; i < 4; ++i) {
    float4 gg = *(const float4*)(g + i * 256 + lane * 4);
    uint2 w; w.x = pack2(v[i].x * r * gg.x, v[i].y * r * gg.y); w.y = pack2(v[i].z * r * gg.z, v[i].w * r * gg.w);
    *(uint2*)(o + i * 256 + lane * 4) = w;
  }
}

__device__ __forceinline__ void ph_convert0(const Params& p, char* smem) {
  const int tid = threadIdx.x, lane = tid & 63, wid = tid >> 6;
  const int NT = 2496, NSK = 256, NROPE = 257, NRMS = 4352, NCACHE = 3840;
  const int total = NT + NSK + NROPE + NRMS + NCACHE;
  for (int u0 = blockIdx.x; u0 < total; u0 += gridDim.x) {
    int u = u0;
    if (u < NT) { transpose_job(p, u, (float*)smem); continue; }
    u -= NT;
    if (u < NSK) {
      int l = u >> 7; int r = u & 127;
      const float* src = p.peer_subkeys + (size_t)l * 32768;
      u16* dst = (u16*)(p.ws + (l ? OFF_WT_SK1 : OFF_WT_SK0));
#pragma unroll
      for (int j = 0; j < 2; ++j) {
        int i = r * 2048 + j * 1024 + tid * 4;
        int s = ((i >> 14) & 1) * 16384 + (i & 16383);
        float4 v = *(const float4*)(src + s);
        uint2 w; w.x = pack2(v.x, v.y); w.y = pack2(v.z, v.w);
        *(uint2*)(dst + i) = w;
      }
      continue;
    }
    u -= NSK;
    if (u < NROPE) {
      int i = u * 256 + tid;
      if (i < 2056 * 32) {
        int pi = i >> 5, d = i & 31;
        int pos = pi < 2048 ? pi : (16384 + pi - 2048);
        float inv = (float)pow(10000.0, -(double)d / 32.0);
        float ang = (float)pos * inv;
        double sn, cs;
        sincos((double)ang, &sn, &cs);
        float2* rt = (float2*)(p.ws + OFF_ROPE);
        rt[i] = make_float2((float)cs, (float)sn);
      }
      continue;
    }
    u -= NROPE;
    if (u < NRMS) {
      int t = u * 4 + wid;
      rmsnorm_row(xin_row(p, t), p.rg_norm, (u16*)(p.ws + OFF_XN) + (size_t)t * 1024, lane);
      continue;
    }
    u -= NRMS;
    {
      int which = u / 1920; int r = u - which * 1920;
      int b = r / 15, c = r - b * 15;
      const float* src = (which ? p.cache_v : p.cache_k) + (size_t)b * 32768 + 2048 + c * 2048;
      float* dst = p.out + (which ? OUT_VS : OUT_KS) + (size_t)b * 32768 + c * 2048;
#pragma unroll
      for (int j = 0; j < 2; ++j) {
        int o = j * 1024 + tid * 4;
        *(float4*)(dst + o) = *(const float4*)(src + o);
      }
    }
  }
}

__device__ __forceinline__ void ph_cvt_tables(const Params& p, int layer) {
  const int lane = threadIdx.x & 63, wid = threadIdx.x >> 6;
  for (int u = blockIdx.x; u < 8192; u += gridDim.x) {
    const int which = u >> 12; const int row = (u & 4095) * 4 + wid;
    const float* src = (which ? p.peer_v : p.peer_u) + (size_t)layer * 16777216 + (size_t)row * 1024 + lane * 16;
    unsigned char* dst = (unsigned char*)(p.ws + (which ? OFF_V8 : OFF_U8)) + (size_t)(lane >> 3) * 2097152 + (size_t)row * 128 + (lane & 7) * 16;
    float* sc = (float*)(p.ws + (which ? OFF_VSC : OFF_USC));
    float4 a = *(const float4*)(src), b = *(const float4*)(src + 4), c = *(const float4*)(src + 8), d = *(const float4*)(src + 12);
    float m = fmaxf(fmaxf(fmaxf(fabsf(a.x), fabsf(a.y)), fmaxf(fabsf(a.z), fabsf(a.w))), fmaxf(fmaxf(fabsf(b.x), fabsf(b.y)), fmaxf(fabsf(b.z), fabsf(b.w))));
    m = fmaxf(m, fmaxf(fmaxf(fmaxf(fabsf(c.x), fabsf(c.y)), fmaxf(fabsf(c.z), fabsf(c.w))), fmaxf(fmaxf(fabsf(d.x), fabsf(d.y)), fmaxf(fabsf(d.z), fabsf(d.w)))));
#pragma unroll
    for (int o = 32; o > 0; o >>= 1) m = fmaxf(m, __shfl_xor(m, o));
    const float scl = m > 0.f ? 440.f / m : 1.f;
    uint4 w; int t;
    t = 0; t = __builtin_amdgcn_cvt_pk_fp8_f32(a.x * scl, a.y * scl, t, false); t = __builtin_amdgcn_cvt_pk_fp8_f32(a.z * scl, a.w * scl, t, true); w.x = (unsigned)t;
    t = 0; t = __builtin_amdgcn_cvt_pk_fp8_f32(b.x * scl, b.y * scl, t, false); t = __builtin_amdgcn_cvt_pk_fp8_f32(b.z * scl, b.w * scl, t, true); w.y = (unsigned)t;
    t = 0; t = __builtin_amdgcn_cvt_pk_fp8_f32(c.x * scl, c.y * scl, t, false); t = __builtin_amdgcn_cvt_pk_fp8_f32(c.z * scl, c.w * scl, t, true); w.z = (unsigned)t;
    t = 0; t = __builtin_amdgcn_cvt_pk_fp8_f32(d.x * scl, d.y * scl, t, false); t = __builtin_amdgcn_cvt_pk_fp8_f32(d.z * scl, d.w * scl, t, true); w.w = (unsigned)t;
    *(uint4*)dst = w;
    if (lane == 0) sc[row] = m > 0.f ? m / 440.f : 1.f;
  }
}

__device__ __forceinline__ void ph_rmsnorm(const Params& p, const float* g) {
  const int lane = threadIdx.x & 63, wid = threadIdx.x >> 6;
  const float* x = (const float*)(p.ws + OFF_X);
  u16* xn = (u16*)(p.ws + OFF_XN);
  for (int u = blockIdx.x; u < 4352; u += gridDim.x) {
    int t = u * 4 + wid;
    rmsnorm_row(x + (size_t)t * 1024, g, xn + (size_t)t * 1024, lane);
  }
}

#define LASP __attribute__((address_space(3)))
template <class Epi>
__device__ __forceinline__ void gemm_tiles(const u16* __restrict__ A, int lda, const u16* __restrict__ W, int ldw,
                                           int K, int kmod, int ntn, const Epi& epi, char* smem_g) {
  LASP unsigned char* smem = (LASP unsigned char*)smem_g;
  const int tid = threadIdx.x, lane = tid & 63, wid = tid >> 6;
  const int wr = wid >> 1, wc = wid & 1, fr = lane & 15, fq = lane >> 4;
  const int total = 136 * ntn;
  const int nk = K >> 6;
  const int swz = (lane * 16) ^ ((lane >> 5) << 5);
  int offA[4], offW[4];
#pragma unroll
  for (int i = 0; i < 4; ++i) {
    const int st = i * 4 + wid;
    const int R = (st >> 1) * 16 + (swz >> 6), C = (st & 1) * 32 + ((swz & 63) >> 1);
    offA[i] = R * lda + C; offW[i] = R * ldw + C;
  }
  const int lane_off = (fr * 64 + fq * 16) ^ ((fr >> 3) << 5);
#define GEMM_STAGE(buf, Ag_, Wg_, k0_)                                                                          \
  _Pragma("unroll") for (int i = 0; i < 4; ++i) {                                                               \
    __builtin_amdgcn_global_load_lds((const unsigned*)((Wg_) + offW[i] + (k0_)), (LASP unsigned*)(smem + (buf) * 32768 + i * 4096 + wid * 1024), 16, 0, 0);         \
    __builtin_amdgcn_global_load_lds((const unsigned*)((Ag_) + offA[i] + (k0_)), (LASP unsigned*)(smem + (buf) * 32768 + 16384 + i * 4096 + wid * 1024), 16, 0, 0); \
  }
  for (int tile = blockIdx.x; tile < total; tile += gridDim.x) {
    const int tm = tile / ntn, tn = tile - tm * ntn;
    const u16* Ag = A + (size_t)(tm * 128) * lda + (kmod ? (tn % kmod) * 128 : 0);
    const u16* Wg = W + (size_t)(tn * 128) * ldw;
    f32x4 acc[4][4];
#pragma unroll
    for (int m = 0; m < 4; ++m)
#pragma unroll
      for (int n = 0; n < 4; ++n) acc[m][n] = f32x4{0.f, 0.f, 0.f, 0.f};
    __syncthreads();
    GEMM_STAGE(0, Ag, Wg, 0)
    for (int kt = 0; kt < nk; ++kt) {
      const int cur = kt & 1;
      asm volatile("s_waitcnt vmcnt(0)" ::: "memory");
      __syncthreads();
      const LASP unsigned char* sW = smem + cur * 32768;
      const LASP unsigned char* sA = sW + 16384;
      bf16x8 a[2][4], b[2][4];
#pragma unroll
      for (int ks = 0; ks < 2; ++ks) {
#pragma unroll
        for (int m = 0; m < 4; ++m) a[ks][m] = *(const LASP bf16x8*)(sW + (wr * 8 + m * 2 + ks) * 1024 + lane_off);
#pragma unroll
        for (int n = 0; n < 4; ++n) b[ks][n] = *(const LASP bf16x8*)(sA + (wc * 8 + n * 2 + ks) * 1024 + lane_off);
      }
      __builtin_amdgcn_sched_barrier(0);
      if (kt + 1 < nk) { GEMM_STAGE(cur ^ 1, Ag, Wg, (kt + 1) * 64) }
      __builtin_amdgcn_sched_barrier(0);
#pragma unroll
      for (int ks = 0; ks < 2; ++ks)
#pragma unroll
        for (int m = 0; m < 4; ++m)
#pragma unroll
          for (int n = 0; n < 4; ++n) acc[m][n] = __builtin_amdgcn_mfma_f32_16x16x32_bf16(a[ks][m], b[ks][n], acc[m][n], 0, 0, 0);
    }
    epi(acc, tm * 128 + wc * 64, tn * 128 + wr * 64, fr, fq);
  }
#undef GEMM_STAGE
}

struct EpiWin {
  u16* gate16; float* rec32;
  __device__ __forceinline__ void operator()(const f32x4 (&acc)[4][4], int tok0, int feat0, int fr, int fq) const {
#pragma unroll
    for (int n = 0; n < 4; ++n) {
      const int tok = tok0 + n * 16 + fr;
#pragma unroll
      for (int m = 0; m < 4; ++m) {
        const int f = feat0 + m * 16 + fq * 4;
        f32x4 v = acc[m][n];
        if (feat0 < 1024) {
          uint2 w; w.x = pack2(gelu_tanh(v[0]), gelu_tanh(v[1])); w.y = pack2(gelu_tanh(v[2]), gelu_tanh(v[3]));
          *(uint2*)(gate16 + (size_t)tok * 1024 + f) = w;
        } else {
          *(float4*)(rec32 + (size_t)tok * 1024 + (f - 1024)) = make_float4(v[0], v[1], v[2], v[3]);
        }
      }
    }
  }
};
struct EpiBd {
  float* loga; u16* ig16; const float *ba, *bx, *lam;
  __device__ __forceinline__ void operator()(const f32x4 (&acc)[4][4], int tok0, int feat0, int fr, int fq) const {
#pragma unroll
    for (int m = 0; m < 4; ++m) {
      const int f = feat0 + m * 16 + fq * 4;
      if (feat0 < 1024) {
        float4 b4 = *(const float4*)(ba + f);
        float4 l4 = *(const float4*)(lam + f);
        float sp0 = log1pf(__expf(-l4.x)), sp1 = log1pf(__expf(-l4.y)), sp2 = log1pf(__expf(-l4.z)), sp3 = log1pf(__expf(-l4.w));
#pragma unroll
        for (int n = 0; n < 4; ++n) {
          const int tok = tok0 + n * 16 + fr;
          f32x4 v = acc[m][n];
          float4 o;
          o.x = -8.f * sigmoidf_(v[0] + b4.x) * sp0;
          o.y = -8.f * sigmoidf_(v[1] + b4.y) * sp1;
          o.z = -8.f * sigmoidf_(v[2] + b4.z) * sp2;
          o.w = -8.f * sigmoidf_(v[3] + b4.w) * sp3;
          *(float4*)(loga + (size_t)tok * 1024 + f) = o;
        }
      } else {
        float4 b4 = *(const float4*)(bx + (f - 1024));
#pragma unroll
        for (int n = 0; n < 4; ++n) {
          const int tok = tok0 + n * 16 + fr;
          f32x4 v = acc[m][n];
          uint2 w;
          w.x = pack2(sigmoidf_(v[0] + b4.x), sigmoidf_(v[1] + b4.y));
          w.y = pack2(sigmoidf_(v[2] + b4.z), sigmoidf_(v[3] + b4.w));
          *(uint2*)(ig16 + (size_t)tok * 1024 + (f - 1024)) = w;
        }
      }
    }
  }
};
struct EpiResid {
  const float* xp; const float* xs; float* xres; int first;
  __device__ __forceinline__ void operator()(const f32x4 (&acc)[4][4], int tok0, int feat0, int fr, int fq) const {
#pragma unroll
    for (int n = 0; n < 4; ++n) {
      const int tok = tok0 + n * 16 + fr;
      const float* base = first ? (tok < NTP ? xp + (size_t)tok * 1024 : xs + (size_t)(tok - NTP) * 1024) : (xres + (size_t)tok * 1024);
#pragma unroll
      for (int m = 0; m < 4; ++m) {
        const int f = feat0 + m * 16 + fq * 4;
        float4 b = *(const float4*)(base + f);
        f32x4 v = acc[m][n];
        *(float4*)(xres + (size_t)tok * 1024 + f) = make_float4(b.x + v[0], b.y + v[1], b.z + v[2], b.w + v[3]);
      }
    }
  }
};
struct EpiBf16 {
  u16* o; int ld;
  __device__ __forceinline__ void operator()(const f32x4 (&acc)[4][4], int tok0, int feat0, int fr, int fq) const {
#pragma unroll
    for (int n = 0; n < 4; ++n) {
      const int tok = tok0 + n * 16 + fr;
#pragma unroll
      for (int m = 0; m < 4; ++m) {
        const int f = feat0 + m * 16 + fq * 4;
        f32x4 v = acc[m][n];
        uint2 w; w.x = pack2(v[0], v[1]); w.y = pack2(v[2], v[3]);
        *(uint2*)(o + (size_t)tok * ld + f) = w;
      }
    }
  }
};
struct EpiF32 {
  float* o; int ld;
  __device__ __forceinline__ void operator()(const f32x4 (&acc)[4][4], int tok0, int feat0, int fr, int fq) const {
#pragma unroll
    for (int n = 0; n < 4; ++n) {
      const int tok = tok0 + n * 16 + fr;
#pragma unroll
      for (int m = 0; m < 4; ++m) {
        const int f = feat0 + m * 16 + fq * 4;
        f32x4 v = acc[m][n];
        *(float4*)(o + (size_t)tok * ld + f) = make_float4(v[0], v[1], v[2], v[3]);
      }
    }
  }
};
__device__ __forceinline__ int mkkey(float v, int n) {
  int i = __float_as_int(v);
  i ^= (i >> 31) & 0x7fffffff;
  return (i & ~127) | (127 - n);
}
__device__ __forceinline__ float keyval(int k) {
  int i = (k & ~127) | 64;
  i ^= (i >> 31) & 0x7fffffff;
  return __int_as_float(i);
}
__device__ __forceinline__ int keyidx(int k) { return 127 - (k & 127); }
#define CE(i, j) { int hi_ = max(k[i], k[j]); int lo_ = min(k[i], k[j]); k[i] = hi_; k[j] = lo_; }

struct EpiTopk {
  int* tkey; char* smem;
  __device__ __forceinline__ void operator()(const f32x4 (&acc)[4][4], int tok0, int feat0, int fr, int fq) const {
    float* S = (float*)smem;
    const int tid = threadIdx.x, lane = tid & 63, wid = tid >> 6, g = lane >> 4, li = lane & 15;
    const int wc64 = tok0 & 127, wr64 = feat0 & 127;
    __syncthreads();
#pragma unroll
    for (int n = 0; n < 4; ++n)
#pragma unroll
      for (int m = 0; m < 4; ++m) {
        f32x4 v = acc[m][n];
        *(float4*)(S + (wc64 + n * 16 + fr) * 132 + wr64 + m * 16 + fq * 4) = make_float4(v[0], v[1], v[2], v[3]);
      }
    __syncthreads();
    const int tokbase = tok0 - wc64, hp = feat0 >> 7;
#pragma unroll 1
    for (int pass = 0; pass < 8; ++pass) {
      const int row = pass * 16 + wid * 4 + g;
      const float* r = S + row * 132;
      float4 v0 = *(const float4*)(r + li * 4), v1 = *(const float4*)(r + 64 + li * 4);
      int k[8];
      k[0] = mkkey(v0.x, li * 4 + 0); k[1] = mkkey(v0.y, li * 4 + 1); k[2] = mkkey(v0.z, li * 4 + 2); k[3] = mkkey(v0.w, li * 4 + 3);
      k[4] = mkkey(v1.x, 64 + li * 4 + 0); k[5] = mkkey(v1.y, 64 + li * 4 + 1); k[6] = mkkey(v1.z, 64 + li * 4 + 2); k[7] = mkkey(v1.w, 64 + li * 4 + 3);
      CE(0, 1) CE(2, 3) CE(4, 5) CE(6, 7)
      CE(0, 2) CE(1, 3) CE(4, 6) CE(5, 7)
      CE(1, 2) CE(5, 6)
      CE(0, 4) CE(1, 5) CE(2, 6) CE(3, 7)
      CE(2, 4) CE(3, 5)
      CE(1, 2) CE(3, 4) CE(5, 6)
      int res = (int)0x80000000;
#pragma unroll
      for (int it = 0; it < 16; ++it) {
        const int M = grp_max_i(k[0]);
        const bool win = (k[0] == M);
        if (li == it) res = M;
#pragma unroll
        for (int i = 0; i < 7; ++i) k[i] = win ? k[i + 1] : k[i];
        k[7] = win ? (int)0x80000000 : k[7];
      }
      tkey[((size_t)(tokbase + row) * 16 + hp) * 16 + li] = res;
    }
  }
};
struct EpiScoresTopk {
  const u16* sk; int* tkey; char* smem_g;
  __device__ __forceinline__ void operator()(const f32x4 (&acc)[4][4], int tok0, int feat0, int fr, int fq) const {
    LASP unsigned char* smem = (LASP unsigned char*)smem_g;
    const int tid = threadIdx.x, lane = tid & 63, wid = tid >> 6, wr = wid >> 1, wc = wid & 1;
    const int tn = feat0 >> 7;
    __syncthreads();
    {
      const int swz = (lane * 16) ^ ((lane >> 5) << 5);
#pragma unroll
      for (int i = 0; i < 4; ++i) {
        const int st = i * 4 + wid;
        const int R = (st >> 1) * 16 + (swz >> 6), C = (st & 1) * 32 + ((swz & 63) >> 1);
        const u16* src = sk + (size_t)(tn * 128 + R) * 128 + C;
        __builtin_amdgcn_global_load_lds((const unsigned*)src, (LASP unsigned*)(smem + i * 4096 + wid * 1024), 16, 0, 0);
        __builtin_amdgcn_global_load_lds((const unsigned*)(src + 64), (LASP unsigned*)(smem + 32768 + i * 4096 + wid * 1024), 16, 0, 0);
      }
    }
#pragma unroll
    for (int n = 0; n < 4; ++n)
#pragma unroll
      for (int m = 0; m < 4; ++m) {
        const int r = wc * 64 + n * 16 + fr, c = m * 16 + fq * 4;
        int ob = (r & 15) * 64 + (c & 31) * 2;
        ob ^= ((ob >> 9) & 1) << 5;
        const int off = wr * 32768 + 16384 + ((r >> 4) * 2 + (c >> 5)) * 1024 + ob;
        f32x4 v = acc[m][n];
        typedef unsigned u32x2_t __attribute__((ext_vector_type(2)));
        u32x2_t w; w.x = pack2(v[0], v[1]); w.y = pack2(v[2], v[3]);
        *(LASP u32x2_t*)(smem + off) = w;
      }
    asm volatile("s_waitcnt vmcnt(0)" ::: "memory");
    __syncthreads();
    f32x4 acc2[4][4];
#pragma unroll
    for (int m = 0; m < 4; ++m)
#pragma unroll
      for (int n = 0; n < 4; ++n) acc2[m][n] = f32x4{0.f, 0.f, 0.f, 0.f};
    const int lane_off = (fr * 64 + fq * 16) ^ ((fr >> 3) << 5);
#pragma unroll
    for (int kt2 = 0; kt2 < 2; ++kt2) {
      const LASP unsigned char* sW = smem + kt2 * 32768;
      const LASP unsigned char* sA = sW + 16384;
#pragma unroll
      for (int ks = 0; ks < 2; ++ks) {
        bf16x8 a[4], b[4];
#pragma unroll
        for (int m = 0; m < 4; ++m) a[m] = *(const LASP bf16x8*)(sW + (wr * 8 + m * 2 + ks) * 1024 + lane_off);
#pragma unroll
        for (int n = 0; n < 4; ++n) b[n] = *(const LASP bf16x8*)(sA + (wc * 8 + n * 2 + ks) * 1024 + lane_off);
#pragma unroll
        for (int m = 0; m < 4; ++m)
#pragma unroll
          for (int n = 0; n < 4; ++n) acc2[m][n] = __builtin_amdgcn_mfma_f32_16x16x32_bf16(a[m], b[n], acc2[m][n], 0, 0, 0);
      }
    }
    EpiTopk e{tkey, smem_g};
    e(acc2, tok0, feat0, fr, fq);
  }
};
struct EpiKvq {
  u16 *k16, *v16, *q16; const float2* rope; float* out;
  __device__ __forceinline__ void operator()(const f32x4 (&acc)[4][4], int tok0, int feat0, int fr, int fq) const {
#pragma unroll
    for (int n = 0; n < 4; ++n) {
      const int tok = tok0 + n * 16 + fr;
      int b, t, pi, orow; bool is_p = tok < NTP;
      if (is_p) { b = tok >> 11; t = tok & 2047; pi = t; orow = t - 1920; }
      else { int ts = tok - NTP; b = ts >> 3; t = ts & 7; pi = 2048 + t; orow = 120 + t; }
      if (feat0 >= 256 && feat0 < 512) {
        const int kvh = (feat0 - 256) >> 6;
#pragma unroll
        for (int m = 0; m < 4; ++m) {
          const int d = m * 16 + fq * 4;
          f32x4 v = acc[m][n];
          uint2 w; w.x = pack2(v[0], v[1]); w.y = pack2(v[2], v[3]);
          *(uint2*)(v16 + (size_t)tok * 256 + kvh * 64 + d) = w;
          if (orow >= 0) {
            float* dst = out + (is_p ? OUT_VP : OUT_VS) + ((size_t)(b * 128 + orow) * 4 + kvh) * 64 + d;
            *(float4*)dst = make_float4(v[0], v[1], v[2], v[3]);
          }
        }
      } else {
        const bool isk = feat0 < 256;
        const float sc = isk ? 1.f : 0.125f;
#pragma unroll
        for (int m = 0; m < 2; ++m) {
          const int d = m * 16 + fq * 4;
          f32x4 x1 = acc[m][n], x2 = acc[m + 2][n];
          const float2* rp = rope + pi * 32 + d;
          float o1[4], o2[4];
#pragma unroll
          for (int j = 0; j < 4; ++j) {
            float2 csn = rp[j];
            o1[j] = (x1[j] * csn.x - x2[j] * csn.y) * sc;
            o2[j] = (x2[j] * csn.x + x1[j] * csn.y) * sc;
          }
          uint2 w1, w2;
          w1.x = pack2(o1[0], o1[1]); w1.y = pack2(o1[2], o1[3]);
          w2.x = pack2(o2[0], o2[1]); w2.y = pack2(o2[2], o2[3]);
          if (isk) {
            const int kvh = feat0 >> 6;
            *(uint2*)(k16 + (size_t)tok * 256 + kvh * 64 + d) = w1;
            *(uint2*)(k16 + (size_t)tok * 256 + kvh * 64 + d + 32) = w2;
            if (orow >= 0) {
              float* dst = out + (is_p ? OUT_KP : OUT_KS) + ((size_t)(b * 128 + orow) * 4 + kvh) * 64 + d;
              *(float4*)dst = make_float4(o1[0], o1[1], o1[2], o1[3]);
              *(float4*)(dst + 32) = make_float4(o2[0], o2[1], o2[2], o2[3]);
            }
          } else {
            const int f = feat0 - 512;
            *(uint2*)(q16 + (size_t)tok * 1024 + f + d) = w1;
            *(uint2*)(q16 + (size_t)tok * 1024 + f + d + 32) = w2;
          }
        }
      }
    }
  }
};

__device__ __forceinline__ void ph_conv(const Params& p) {
  const float* rec = (const float*)(p.ws + OFF_REC32);
  float* xc32 = (float*)(p.ws + OFF_XC32);
  u16* xc16 = (u16*)(p.ws + OFF_XC16);
  const int nunits = NTOK * 256;
  for (int idx = blockIdx.x * 256 + threadIdx.x; idx < nunits; idx += gridDim.x * 256) {
    const int tok = idx >> 8, c = (idx & 255) * 4;
    int b, t; const float* buf = nullptr;
    if (tok < NTP) { b = tok >> 11; t = tok & 2047; }
    else { int ts = tok - NTP; b = ts >> 3; t = ts & 7; buf = p.state_conv + (size_t)b * 3072; }
    float4 r[4];
    r[0] = *(const float4*)(rec + (size_t)tok * 1024 + c);
#pragma unroll
    for (int L = 1; L <= 3; ++L) {
      if (t - L >= 0) r[L] = *(const float4*)(rec + (size_t)(tok - L) * 1024 + c);
      else if (buf) r[L] = *(const float4*)(buf + (size_t)(3 + t - L) * 1024 + c);
      else r[L] = make_float4(0.f, 0.f, 0.f, 0.f);
    }
    float4 w0 = *(const float4*)(p.rg_conv_w + c), w1 = *(const float4*)(p.rg_conv_w + 1024 + c);
    float4 w2 = *(const float4*)(p.rg_conv_w + 2048 + c), w3 = *(const float4*)(p.rg_conv_w + 3072 + c);
    float4 cb = *(const float4*)(p.rg_conv_b + c);
    float4 o;
    o.x = cb.x + w3.x * r[0].x + w2.x * r[1].x + w1.x * r[2].x + w0.x * r[3].x;
    o.y = cb.y + w3.y * r[0].y + w2.y * r[1].y + w1.y * r[2].y + w0.y * r[3].y;
    o.z = cb.z + w3.z * r[0].z + w2.z * r[1].z + w1.z * r[2].z + w0.z * r[3].z;
    o.w = cb.w + w3.w * r[0].w + w2.w * r[1].w + w1.w * r[2].w + w0.w * r[3].w;
    *(float4*)(xc32 + (size_t)tok * 1024 + c) = o;
    uint2 w; w.x = pack2(o.x, o.y); w.y = pack2(o.z, o.w);
    *(uint2*)(xc16 + (size_t)tok * 1024 + c) = w;
    if (tok < NTP) {
      if (t >= 2045) *(float4*)(p.out + OUT_CONVP + ((size_t)b * 3 + (t - 2045)) * 1024 + c) = r[0];
    } else {
      if (t >= 5) *(float4*)(p.out + OUT_CONVS + ((size_t)b * 3 + (t - 5)) * 1024 + c) = r[0];
    }
  }
}

__device__ __forceinline__ float rg_mult(float la) {
  const float t = 2.f * la;
  const float ser = -t * (1.f + t * (0.5f + t * (0.16666667f + t * (0.041666668f + t * 0.0083333333f))));
  const float dir = 1.f - __expf(t);
  return __builtin_amdgcn_sqrtf(t > -0.25f ? ser : dir);
}
__device__ __forceinline__ void scan_step(const float* loga, const u16* ig16, const float* xc32, size_t off, float4& a, float4& bt) {
  float4 la = *(const float4*)(loga + off);
  uint2 gi = *(const uint2*)(ig16 + off);
  float4 xc = *(const float4*)(xc32 + off);
  a.x = __expf(la.x); a.y = __expf(la.y); a.z = __expf(la.z); a.w = __expf(la.w);
  bt.x = rg_mult(la.x) * bflo(gi.x) * xc.x;
  bt.y = rg_mult(la.y) * bfhi(gi.x) * xc.y;
  bt.z = rg_mult(la.z) * bflo(gi.y) * xc.z;
  bt.w = rg_mult(la.w) * bfhi(gi.y) * xc.w;
}
__device__ __forceinline__ void ph_scanA(const Params& p) {
  const float* loga = (const float*)(p.ws + OFF_LOGA);
  const u16* ig16 = (const u16*)(p.ws + OFF_IG16);
  const float* xc32 = (const float*)(p.ws + OFF_XC32);
  float* aggA = (float*)(p.ws + OFF_AGGA);
  float* aggB = (float*)(p.ws + OFF_AGGB);
  const int c = threadIdx.x * 4;
  for (int item = blockIdx.x; item < 1024; item += gridDim.x) {
    const int b = item >> 7, ch = item & 127;
    float4 A = make_float4(1.f, 1.f, 1.f, 1.f), B = make_float4(0.f, 0.f, 0.f, 0.f);
    const size_t tok0 = (size_t)b * 2048 + ch * 16;
#pragma unroll 8
    for (int s = 0; s < 16; ++s) {
      float4 a, bt;
      scan_step(loga, ig16, xc32, (tok0 + s) * 1024 + c, a, bt);
      A.x *= a.x; A.y *= a.y; A.z *= a.z; A.w *= a.w;
      B.x = a.x * B.x + bt.x; B.y = a.y * B.y + bt.y; B.z = a.z * B.z + bt.z; B.w = a.w * B.w + bt.w;
    }
    *(float4*)(aggA + (size_t)item * 1024 + c) = A;
    *(float4*)(aggB + (size_t)item * 1024 + c) = B;
  }
}
__device__ __forceinline__ void ph_scanA2(const Params& p) {
  const float* aggA = (const float*)(p.ws + OFF_AGGA);
  float* aggB = (float*)(p.ws + OFF_AGGB);
  for (int u = blockIdx.x; u < 32; u += gridDim.x) {
    const int b = u >> 2, c = (u & 3) * 256 + threadIdx.x;
    float h = 0.f;
#pragma unroll 16
    for (int ch = 0; ch < 128; ++ch) {
      const size_t o = (size_t)(b * 128 + ch) * 1024 + c;
      const float A = aggA[o], B = aggB[o];
      aggB[o] = h;
      h = A * h + B;
    }
  }
}
__device__ __forceinline__ void ph_scanB(const Params& p) {
  const float* loga = (const float*)(p.ws + OFF_LOGA);
  const u16* ig16 = (const u16*)(p.ws + OFF_IG16);
  const float* xc32 = (const float*)(p.ws + OFF_XC32);
  const u16* gate16 = (const u16*)(p.ws + OFF_GATE16);
  u16* hg16 = (u16*)(p.ws + OFF_HG16);
  const float* aggB = (const float*)(p.ws + OFF_AGGB);
  const int c = threadIdx.x * 4;
  for (int item = blockIdx.x; item < 1088; item += gridDim.x) {
    float4 h; size_t tok0; float* hout = nullptr;
    if (item < 1024) {
      const int b = item >> 7, ch = item & 127;
      h = *(const float4*)(aggB + (size_t)item * 1024 + c);
      tok0 = (size_t)b * 2048 + ch * 16;
      if (ch == 127) hout = p.out + OUT_HP + (size_t)b * 1024 + c;
    } else {
      tok0 = (size_t)NTP + (size_t)(item - 1024) * 16;
      h = make_float4(0.f, 0.f, 0.f, 0.f);
    }
#pragma unroll 8
    for (int s = 0; s < 16; ++s) {
      float4 a, bt;
      const size_t off = (tok0 + s) * 1024 + c;
      if (item >= 1024 && (s & 7) == 0) h = *(const float4*)(p.state_h + (size_t)((item - 1024) * 2 + (s >> 3)) * 1024 + c);
      scan_step(loga, ig16, xc32, off, a, bt);
      h.x = a.x * h.x + bt.x; h.y = a.y * h.y + bt.y; h.z = a.z * h.z + bt.z; h.w = a.w * h.w + bt.w;
      uint2 g = *(const uint2*)(gate16 + off);
      uint2 w; w.x = pack2(h.x * bflo(g.x), h.y * bfhi(g.x)); w.y = pack2(h.z * bflo(g.y), h.w * bfhi(g.y));
      *(uint2*)(hg16 + off) = w;
      if (item >= 1024 && (s & 7) == 7) *(float4*)(p.out + OUT_HS + (size_t)((item - 1024) * 2 + (s >> 3)) * 1024 + c) = h;
    }
    if (hout) *(float4*)hout = h;
  }
}

__device__ __forceinline__ void ph_topk(const Params& p, char* smem) {
  const int tid = threadIdx.x, lane = tid & 63, wid = tid >> 6, g = lane >> 4, li = lane & 15;
  const int* tkg = (const int*)(p.ws + OFF_TKEY);
  int* idx_out = (int*)(p.ws + OFF_IDX);
  float* gate_out = (float*)(p.ws + OFF_PGATE);
  int* tkey = (int*)smem + wid * 256;
  for (int tb = blockIdx.x; tb < 4352; tb += gridDim.x) {
    const int t = tb * 4 + wid;
    ((int4*)tkey)[lane] = ((const int4*)(tkg + (size_t)t * 256))[lane];
    __syncthreads();
#pragma unroll 1
    for (int ps2 = 0; ps2 < 2; ++ps2) {
      const int h = ps2 * 4 + g;
      const int* t0 = tkey + (h * 2) * 16;
      const int* t1 = t0 + 16;
      const float sv0 = keyval(t0[li]);
      int ptr = 0;
      float head = sv0 + keyval(t1[0]);
      float rv = 0.f; int rc = 0;
#pragma unroll 1
      for (int it = 0; it < 16; ++it) {
        const float M = grp_max_f(head);
        const unsigned long long bm = __ballot(head == M);
        const unsigned gm = (unsigned)(bm >> (g * 16)) & 0xffffu;
        const int wl = __ffs(gm) - 1;
        const bool win = (li == wl);
        const int C = grp_max_i(win ? (li * 16 + ptr) : -1);
        if (li == it) { rv = M; rc = C; }
        if (win) {
          ++ptr;
          head = (ptr < 16) ? sv0 + keyval(t1[ptr & 15]) : -3.0e38f;
        }
      }
      const int ia = keyidx(t0[rc >> 4]);
      const int ib = keyidx(t1[rc & 15]);
      const float mx = grp_max_f(rv);
      const float ex = __expf(rv - mx);
      const float sm = grp_sum_f(ex);
      idx_out[(size_t)t * 128 + h * 16 + li] = ia * 128 + ib;
      gate_out[(size_t)t * 128 + h * 16 + li] = ex / sm;
    }
    __syncthreads();
  }
}

typedef float v2f __attribute__((ext_vector_type(2)));
template <int CTRL>
__device__ __forceinline__ float dpp_f(float v) { return __int_as_float(__builtin_amdgcn_update_dpp(0, __float_as_int(v), CTRL, 0xf, 0xf, false)); }
__device__ __forceinline__ float dot16_fp8(uint4 u, const v2f* x2) {
  v2f acc = {0.f, 0.f};
  acc = __builtin_elementwise_fma(__builtin_amdgcn_cvt_pk_f32_fp8((int)u.x, false), x2[0], acc);
  acc = __builtin_elementwise_fma(__builtin_amdgcn_cvt_pk_f32_fp8((int)u.x, true), x2[1], acc);
  acc = __builtin_elementwise_fma(__builtin_amdgcn_cvt_pk_f32_fp8((int)u.y, false), x2[2], acc);
  acc = __builtin_elementwise_fma(__builtin_amdgcn_cvt_pk_f32_fp8((int)u.y, true), x2[3], acc);
  acc = __builtin_elementwise_fma(__builtin_amdgcn_cvt_pk_f32_fp8((int)u.z, false), x2[4], acc);
  acc = __builtin_elementwise_fma(__builtin_amdgcn_cvt_pk_f32_fp8((int)u.z, true), x2[5], acc);
  acc = __builtin_elementwise_fma(__builtin_amdgcn_cvt_pk_f32_fp8((int)u.w, false), x2[6], acc);
  acc = __builtin_elementwise_fma(__builtin_amdgcn_cvt_pk_f32_fp8((int)u.w, true), x2[7], acc);
  return acc.x + acc.y;
}
__device__ __forceinline__ void axpy16_fp8(float w, uint4 u, v2f* o2) {
  const v2f w2 = {w, w};
  o2[0] = __builtin_elementwise_fma(__builtin_amdgcn_cvt_pk_f32_fp8((int)u.x, false), w2, o2[0]);
  o2[1] = __builtin_elementwise_fma(__builtin_amdgcn_cvt_pk_f32_fp8((int)u.x, true), w2, o2[1]);
  o2[2] = __builtin_elementwise_fma(__builtin_amdgcn_cvt_pk_f32_fp8((int)u.y, false), w2, o2[2]);
  o2[3] = __builtin_elementwise_fma(__builtin_amdgcn_cvt_pk_f32_fp8((int)u.y, true), w2, o2[3]);
  o2[4] = __builtin_elementwise_fma(__builtin_amdgcn_cvt_pk_f32_fp8((int)u.z, false), w2, o2[4]);
  o2[5] = __builtin_elementwise_fma(__builtin_amdgcn_cvt_pk_f32_fp8((int)u.z, true), w2, o2[5]);
  o2[6] = __builtin_elementwise_fma(__builtin_amdgcn_cvt_pk_f32_fp8((int)u.w, false), w2, o2[6]);
  o2[7] = __builtin_elementwise_fma(__builtin_amdgcn_cvt_pk_f32_fp8((int)u.w, true), w2, o2[7]);
}
__device__ __forceinline__ float reduce4_row(float d0, float d1, float d2, float d3, int lane) {
  const bool b0 = lane & 1, b1 = lane & 2;
  const float k0 = b0 ? d1 : d0, s0 = b0 ? d0 : d1;
  const float k1 = b0 ? d3 : d2, s1 = b0 ? d2 : d3;
  const float r0 = k0 + dpp_f<0xB1>(s0);
  const float r1 = k1 + dpp_f<0xB1>(s1);
  const float kk = b1 ? r1 : r0, ss = b1 ? r0 : r1;
  float q = kk + dpp_f<0x4E>(ss);
  q += dpp_f<0x128>(q);
  q += dpp_f<0x124>(q);
  return q;
}
#define EXP_LOAD(dst, dsc, TAB, SC, kbase, esrc)                                     \
  _Pragma("unroll") for (int j = 0; j < 8; ++j) {                                   \
    const int e = __builtin_amdgcn_readlane(esrc, ((kbase) + j) & 63);              \
    dst[j] = ((const uint4*)(TAB + (size_t)e * 1024))[lane];                        \
    dsc[j] = SC[e];                                                                  \
  }
#define EXP_LOADV(dst, TAB, kbase, esrc)                                             \
  _Pragma("unroll") for (int j = 0; j < 8; ++j) {                                   \
    const int e = __builtin_amdgcn_readlane(esrc, ((kbase) + j) & 63);              \
    dst[j] = ((const uint4*)(TAB + (size_t)e * 1024))[lane];                        \
  }
#define EXP_UDOT(src, ssc, kbase)                                                    \
  {                                                                                  \
    float d[8];                                                                      \
    _Pragma("unroll") for (int j = 0; j < 8; ++j) d[j] = dot16_fp8(src[j], x2) * ssc[j]; \
    const float qa = reduce4_row(d[0], d[1], d[2], d[3], lane);                      \
    const float qb = reduce4_row(d[4], d[5], d[6], d[7], lane);                      \
    float q = (lane & 4) ? qb : qa;                                                  \
    q += __shfl_xor(q, 16);                                                          \
    q += __shfl_xor(q, 32);                                                          \
    if ((lane >> 3) == ((((kbase)) & 63) >> 3)) { if ((kbase) < 64) h_lo = q; else h_hi = q; } \
  }
#define EXP_VACC(src, kbase, wsrc)                                                   \
  _Pragma("unroll") for (int j = 0; j < 8; ++j) {                                   \
    const float w = __int_as_float(__builtin_amdgcn_readlane(__float_as_int(wsrc), ((kbase) + j) & 63)); \
    axpy16_fp8(w, src[j], o2);                                                       \
  }

__device__ __forceinline__ void ph_expert(const Params& p, int layer) {
  const int lane = threadIdx.x & 63, wid = threadIdx.x >> 6;
  u16* xn16 = (u16*)(p.ws + OFF_XN);
  float* xres = (float*)(p.ws + OFF_X);
  const int* idxs = (const int*)(p.ws + OFF_IDX);
  const float* gates = (const float*)(p.ws + OFF_PGATE);
  const unsigned char* U = (const unsigned char*)(p.ws + OFF_U8);
  const unsigned char* V = (const unsigned char*)(p.ws + OFF_V8);
  const float* USC = (const float*)(p.ws + OFF_USC);
  const float* VSC = (const float*)(p.ws + OFF_VSC);
  for (int tb = blockIdx.x; tb < 4352; tb += gridDim.x) {
    const int t = tb * 4 + wid;
    v2f x2[8];
    {
      const uint4* xr = (const uint4*)(xn16 + (size_t)t * 1024 + lane * 16);
      uint4 xa = xr[0], xb = xr[1];
      x2[0] = v2f{bflo(xa.x), bfhi(xa.x)}; x2[1] = v2f{bflo(xa.y), bfhi(xa.y)};
      x2[2] = v2f{bflo(xa.z), bfhi(xa.z)}; x2[3] = v2f{bflo(xa.w), bfhi(xa.w)};
      x2[4] = v2f{bflo(xb.x), bfhi(xb.x)}; x2[5] = v2f{bflo(xb.y), bfhi(xb.y)};
      x2[6] = v2f{bflo(xb.z), bfhi(xb.z)}; x2[7] = v2f{bflo(xb.w), bfhi(xb.w)};
    }
    const int e_lo = idxs[(size_t)t * 128 + lane], e_hi = idxs[(size_t)t * 128 + 64 + lane];
    const float g_lo = gates[(size_t)t * 128 + lane], g_hi = gates[(size_t)t * 128 + 64 + lane];
    const float vs_lo = VSC[e_lo], vs_hi = VSC[e_hi];
    float h_lo = 0.f, h_hi = 0.f;
    {
      uint4 ba[8], bb[8]; float sa[8], sb[8];
      EXP_LOAD(ba, sa, U, USC, 0, e_lo)
#pragma unroll 1
      for (int kb = 0; kb < 64; kb += 16) {
        EXP_LOAD(bb, sb, U, USC, kb + 8, e_lo)
        EXP_UDOT(ba, sa, kb)
        if (kb + 16 < 64) { EXP_LOAD(ba, sa, U, USC, kb + 16, e_lo) } else { EXP_LOAD(ba, sa, U, USC, 0, e_hi) }
        EXP_UDOT(bb, sb, kb + 8)
      }
#pragma unroll 1
      for (int kb = 64; kb < 128; kb += 16) {
        EXP_LOAD(bb, sb, U, USC, kb + 8, e_hi)
        EXP_UDOT(ba, sa, kb)
        if (kb + 16 < 128) { EXP_LOAD(ba, sa, U, USC, kb + 16, e_hi) }
        EXP_UDOT(bb, sb, kb + 8)
      }
    }
    const float w_lo = 0.5f * h_lo * (1.f + erff(h_lo * 0.70710678118654752f)) * g_lo * vs_lo;
    const float w_hi = 0.5f * h_hi * (1.f + erff(h_hi * 0.70710678118654752f)) * g_hi * vs_hi;
    v2f o2[8];
#pragma unroll
    for (int i = 0; i < 8; ++i) o2[i] = v2f{0.f, 0.f};
    {
      uint4 ba[8], bb[8];
      EXP_LOADV(ba, V, 0, e_lo)
#pragma unroll 1
      for (int kb = 0; kb < 64; kb += 16) {
        EXP_LOADV(bb, V, kb + 8, e_lo)
        EXP_VACC(ba, kb, w_lo)
        if (kb + 16 < 64) { EXP_LOADV(ba, V, kb + 16, e_lo) } else { EXP_LOADV(ba, V, 0, e_hi) }
        EXP_VACC(bb, kb + 8, w_lo)
      }
#pragma unroll 1
      for (int kb = 64; kb < 128; kb += 16) {
        EXP_LOADV(bb, V, kb + 8, e_hi)
        EXP_VACC(ba, kb, w_hi)
        if (kb + 16 < 128) { EXP_LOADV(ba, V, kb + 16, e_hi) }
        EXP_VACC(bb, kb + 8, w_hi)
      }
    }
    float o[16];
#pragma unroll
    for (int i = 0; i < 8; ++i) { o[2 * i] = o2[i].x; o[2 * i + 1] = o2[i].y; }
    float* xr = xres + (size_t)t * 1024 + lane * 16;
    float ss = 0.f;
#pragma unroll
    for (int i = 0; i < 4; ++i) {
      float4 r = *(const float4*)(xr + i * 4);
      o[4 * i] += r.x; o[4 * i + 1] += r.y; o[4 * i + 2] += r.z; o[4 * i + 3] += r.w;
      ss += o[4 * i] * o[4 * i] + o[4 * i + 1] * o[4 * i + 1] + o[4 * i + 2] * o[4 * i + 2] + o[4 * i + 3] * o[4 * i + 3];
    }
    ss = wave_sum(ss);
    const float rs = rsqrtf(ss * (1.f / 1024.f) + 1e-6f);
    if (layer == 0) {
#pragma unroll
      for (int i = 0; i < 4; ++i) *(float4*)(xr + i * 4) = make_float4(o[4 * i], o[4 * i + 1], o[4 * i + 2], o[4 * i + 3]);
      uint4 wa, wb;
      wa.x = pack2(o[0] * rs, o[1] * rs); wa.y = pack2(o[2] * rs, o[3] * rs); wa.z = pack2(o[4] * rs, o[5] * rs); wa.w = pack2(o[6] * rs, o[7] * rs);
      wb.x = pack2(o[8] * rs, o[9] * rs); wb.y = pack2(o[10] * rs, o[11] * rs); wb.z = pack2(o[12] * rs, o[13] * rs); wb.w = pack2(o[14] * rs, o[15] * rs);
      uint4* xw = (uint4*)(xn16 + (size_t)t * 1024 + lane * 16);
      xw[0] = wa; xw[1] = wb;
    } else {
      const float* fg = p.final_norm + lane * 16;
      float* y = p.out + OUT_Y + (size_t)t * 1024 + lane * 16;
#pragma unroll
      for (int i = 0; i < 4; ++i) {
        float4 g = *(const float4*)(fg + i * 4);
        *(float4*)(y + i * 4) = make_float4(o[4 * i] * rs * g.x, o[4 * i + 1] * rs * g.y, o[4 * i + 2] * rs * g.z, o[4 * i + 3] * rs * g.w);
      }
    }
  }
}

struct XInfo { int nloc, nx, rank, xr; };
__device__ __forceinline__ float reduce8(float v) {
  v += dpp_f<0xB1>(v); v += dpp_f<0x4E>(v); v += dpp_f<0x141>(v);
  return v;
}
__device__ __forceinline__ void ph_expert_u(const Params& p, const XInfo xi) {
  const int lane = threadIdx.x & 63, wid = threadIdx.x >> 6, g = lane >> 3, i8 = lane & 7;
  const u16* xn16 = (const u16*)(p.ws + OFF_XN);
  const int* idxs = (const int*)(p.ws + OFF_IDX);
  float* ph = (float*)(p.ws + OFF_PH);
  for (int c = xi.xr; c < 8; c += xi.nx) {
    const unsigned char* Us = (const unsigned char*)(p.ws + OFF_U8) + (size_t)c * 2097152;
    const unsigned lo = (unsigned)i8 * 16u;
    int t = xi.rank * 4 + wid;
    int e[16];
    {
      const int t0 = min(t, NTOK - 1);
      const int4* ip = (const int4*)(idxs + (size_t)t0 * 128 + g * 16);
#pragma unroll
      for (int j = 0; j < 4; ++j) { int4 q = ip[j]; e[4 * j] = q.x; e[4 * j + 1] = q.y; e[4 * j + 2] = q.z; e[4 * j + 3] = q.w; }
    }
    for (; t < NTOK; t += xi.nloc * 4) {
      uint4 seg[16];
#pragma unroll
      for (int j = 0; j < 16; ++j) seg[j] = *(const uint4*)(Us + ((unsigned)e[j] * 128u + lo));
      v2f x2[8];
      {
        const uint4* xr = (const uint4*)(xn16 + (size_t)t * 1024 + c * 128 + i8 * 16);
        uint4 xa = xr[0], xb = xr[1];
        x2[0] = v2f{bflo(xa.x), bfhi(xa.x)}; x2[1] = v2f{bflo(xa.y), bfhi(xa.y)};
        x2[2] = v2f{bflo(xa.z), bfhi(xa.z)}; x2[3] = v2f{bflo(xa.w), bfhi(xa.w)};
        x2[4] = v2f{bflo(xb.x), bfhi(xb.x)}; x2[5] = v2f{bflo(xb.y), bfhi(xb.y)};
        x2[6] = v2f{bflo(xb.z), bfhi(xb.z)}; x2[7] = v2f{bflo(xb.w), bfhi(xb.w)};
      }
      {
        const int tn = min(t + xi.nloc * 4, NTOK - 1);
        const int4* ip = (const int4*)(idxs + (size_t)tn * 128 + g * 16);
#pragma unroll
        for (int j = 0; j < 4; ++j) { int4 q = ip[j]; e[4 * j] = q.x; e[4 * j + 1] = q.y; e[4 * j + 2] = q.z; e[4 * j + 3] = q.w; }
      }
      float d[16];
#pragma unroll
      for (int j = 0; j < 16; ++j) d[j] = reduce8(dot16_fp8(seg[j], x2));
      if (i8 == 0) {
        float* o = ph + ((size_t)c * NTOK + t) * 128 + g * 16;
#pragma unroll
        for (int j = 0; j < 4; ++j) *(float4*)(o + 4 * j) = make_float4(d[4 * j], d[4 * j + 1], d[4 * j + 2], d[4 * j + 3]);
      }
    }
  }
}
__device__ __forceinline__ void ph_expert_combine(const Params& p) {
  const int* idxs = (const int*)(p.ws + OFF_IDX);
  float* gates = (float*)(p.ws + OFF_PGATE);
  const float* ph = (const float*)(p.ws + OFF_PH);
  const float* USC = (const float*)(p.ws + OFF_USC);
  const float* VSC = (const float*)(p.ws + OFF_VSC);
  for (int i = blockIdx.x * 256 + threadIdx.x; i < NTOK * 128; i += gridDim.x * 256) {
    float s = 0.f;
#pragma unroll
    for (int c = 0; c < 8; ++c) s += ph[(size_t)c * NTOK * 128 + i];
    const int e = idxs[i];
    const float h = s * USC[e];
    gates[i] = 0.5f * h * (1.f + erff(h * 0.70710678118654752f)) * gates[i] * VSC[e];
  }
}
__device__ __forceinline__ void ph_expert_v(const Params& p, const XInfo xi) {
  const int lane = threadIdx.x & 63, wid = threadIdx.x >> 6, g = lane >> 3, i8 = lane & 7;
  const int* idxs = (const int*)(p.ws + OFF_IDX);
  const float* wts = (const float*)(p.ws + OFF_PGATE);
  float* xres = (float*)(p.ws + OFF_X);
  for (int c = xi.xr; c < 8; c += xi.nx) {
    const unsigned char* Vs = (const unsigned char*)(p.ws + OFF_V8) + (size_t)c * 2097152;
    const unsigned lo = (unsigned)i8 * 16u;
    int t = xi.rank * 4 + wid;
    int e[16]; float w[16];
    {
      const int t0 = min(t, NTOK - 1);
      const int4* ip = (const int4*)(idxs + (size_t)t0 * 128 + g * 16);
      const float4* wp = (const float4*)(wts + (size_t)t0 * 128 + g * 16);
#pragma unroll
      for (int j = 0; j < 4; ++j) { int4 q = ip[j]; float4 r = wp[j]; e[4 * j] = q.x; e[4 * j + 1] = q.y; e[4 * j + 2] = q.z; e[4 * j + 3] = q.w; w[4 * j] = r.x; w[4 * j + 1] = r.y; w[4 * j + 2] = r.z; w[4 * j + 3] = r.w; }
    }
    for (; t < NTOK; t += xi.nloc * 4) {
      v2f o2[8];
#pragma unroll
      for (int i = 0; i < 8; ++i) o2[i] = v2f{0.f, 0.f};
      {
        uint4 seg[16];
#pragma unroll
        for (int j = 0; j < 16; ++j) seg[j] = *(const uint4*)(Vs + ((unsigned)e[j] * 128u + lo));
#pragma unroll
        for (int j = 0; j < 16; ++j) axpy16_fp8(w[j], seg[j], o2);
      }
      __builtin_amdgcn_sched_barrier(0);
      {
        const int tn = min(t + xi.nloc * 4, NTOK - 1);
        const int4* ip = (const int4*)(idxs + (size_t)tn * 128 + g * 16);
        const float4* wp = (const float4*)(wts + (size_t)tn * 128 + g * 16);
#pragma unroll
        for (int j = 0; j < 4; ++j) { int4 q = ip[j]; float4 r = wp[j]; e[4 * j] = q.x; e[4 * j + 1] = q.y; e[4 * j + 2] = q.z; e[4 * j + 3] = q.w; w[4 * j] = r.x; w[4 * j + 1] = r.y; w[4 * j + 2] = r.z; w[4 * j + 3] = r.w; }
      }
      float o[16];
#pragma unroll
      for (int i = 0; i < 8; ++i) { o[2 * i] = o2[i].x; o[2 * i + 1] = o2[i].y; }
#pragma unroll
      for (int i = 0; i < 16; ++i) {
        float v = o[i];
        v += dpp_f<0x128>(v);
        v += __shfl_xor(v, 16);
        v += __shfl_xor(v, 32);
        o[i] = v;
        if ((i & 3) == 3) __builtin_amdgcn_sched_barrier(0);
      }
      if (g == 0) {
        float* xr = xres + (size_t)t * 1024 + c * 128 + i8 * 16;
#pragma unroll
        for (int i = 0; i < 4; ++i) {
          float4 r = *(const float4*)(xr + i * 4);
          *(float4*)(xr + i * 4) = make_float4(r.x + o[4 * i], r.y + o[4 * i + 1], r.z + o[4 * i + 2], r.w + o[4 * i + 3]);
        }
      }
    }
  }
}
__device__ __forceinline__ void ph_post_norm(const Params& p, int layer) {
  const int lane = threadIdx.x & 63, wid = threadIdx.x >> 6;
  const float* xres = (const float*)(p.ws + OFF_X);
  u16* xn16 = (u16*)(p.ws + OFF_XN);
  for (int u = blockIdx.x; u < 4352; u += gridDim.x) {
    const int t = u * 4 + wid;
    const float* x = xres + (size_t)t * 1024;
    float4 v[4]; float ss = 0.f;
#pragma unroll
    for (int i = 0; i < 4; ++i) {
      v[i] = *(const float4*)(x + i * 256 + lane * 4);
      ss += v[i].x * v[i].x + v[i].y * v[i].y + v[i].z * v[i].z + v[i].w * v[i].w;
    }
    ss = wave_sum(ss);
    const float r = rsqrtf(ss * (1.f / 1024.f) + 1e-6f);
    if (layer == 0) {
#pragma unroll
      for (int i = 0; i < 4; ++i) {
        uint2 w; w.x = pack2(v[i].x * r, v[i].y * r); w.y = pack2(v[i].z * r, v[i].w * r);
        *(uint2*)(xn16 + (size_t)t * 1024 + i * 256 + lane * 4) = w;
      }
    } else {
      float* y = p.out + OUT_Y + (size_t)t * 1024;
#pragma unroll
      for (int i = 0; i < 4; ++i) {
        float4 gg = *(const float4*)(p.final_norm + i * 256 + lane * 4);
        *(float4*)(y + i * 256 + lane * 4) = make_float4(v[i].x * r * gg.x, v[i].y * r * gg.y, v[i].z * r * gg.z, v[i].w * r * gg.w);
      }
    }
  }
}

__device__ __forceinline__ void ph_attn(const Params& p, char* smem) {
  const int tid = threadIdx.x, lane = tid & 63, wid = tid >> 6, fr = lane & 15, fq = lane >> 4;
  const u16* k16 = (const u16*)(p.ws + OFF_K16);
  const u16* v16 = (const u16*)(p.ws + OFF_V16A);
  const u16* q16 = (const u16*)(p.ws + OFF_Q16);
  u16* o16 = (u16*)(p.ws + OFF_O16);
  u16* Ks = (u16*)smem;
  u16* Vt = (u16*)(smem + 27648);
  for (int item = blockIdx.x; item < 1536; item += gridDim.x) {
    const bool is_p = item < 1024;
    int b, kvh, q0 = 0, nsub, nvalid, kpos0, minpos, tokbase;
    if (is_p) { b = item >> 7; kvh = (item >> 5) & 3; q0 = (item & 31) * 64; nsub = 4; nvalid = 192; kpos0 = q0 - 128; minpos = 0; tokbase = b * 2048; }
    else { int it2 = item - 1024; b = it2 >> 2; kvh = it2 & 3; nsub = 1; nvalid = 136; kpos0 = -128; minpos = -100000; tokbase = NTP + b * 8; }
    __syncthreads();
    for (int c = tid; c < 1536; c += 256) {
      const int j = c >> 3, ch = c & 7;
      uint4 kk = make_uint4(0, 0, 0, 0), vv = make_uint4(0, 0, 0, 0);
      if (is_p) {
        const int kp = kpos0 + j;
        if (kp >= 0) {
          const size_t off = (size_t)(tokbase + kp) * 256 + kvh * 64 + ch * 8;
          kk = *(const uint4*)(k16 + off); vv = *(const uint4*)(v16 + off);
        }
      } else {
        if (j < 128) {
          const size_t off = ((size_t)(b * 128 + j) * 4 + kvh) * 64 + ch * 8;
          float4 a0 = *(const float4*)(p.cache_k + off), a1 = *(const float4*)(p.cache_k + off + 4);
          float4 c0 = *(const float4*)(p.cache_v + off), c1 = *(const float4*)(p.cache_v + off + 4);
          kk.x = pack2(a0.x, a0.y); kk.y = pack2(a0.z, a0.w); kk.z = pack2(a1.x, a1.y); kk.w = pack2(a1.z, a1.w);
          vv.x = pack2(c0.x, c0.y); vv.y = pack2(c0.z, c0.w); vv.z = pack2(c1.x, c1.y); vv.w = pack2(c1.z, c1.w);
        } else if (j < 136) {
          const size_t off = (size_t)(tokbase + j - 128) * 256 + kvh * 64 + ch * 8;
          kk = *(const uint4*)(k16 + off); vv = *(const uint4*)(v16 + off);
        }
      }
      *(uint4*)(Ks + j * 72 + ch * 8) = kk;
      u16* vd = Vt + (ch * 8) * 200 + j;
      vd[0] = (u16)(vv.x & 0xffff); vd[200] = (u16)(vv.x >> 16);
      vd[400] = (u16)(vv.y & 0xffff); vd[600] = (u16)(vv.y >> 16);
      vd[800] = (u16)(vv.z & 0xffff); vd[1000] = (u16)(vv.z >> 16);
      vd[1200] = (u16)(vv.w & 0xffff); vd[1400] = (u16)(vv.w >> 16);
    }
    __syncthreads();
    const int head = kvh * 4 + wid;
    const float sink = p.sinks[head];
#pragma unroll 1
    for (int sub = 0; sub < nsub; ++sub) {
      int qtok, qp;
      if (is_p) { qp = q0 + sub * 16 + fr; qtok = tokbase + qp; }
      else { qp = fr & 7; qtok = tokbase + (fr & 7); }
      const u16* qrow = q16 + (size_t)qtok * 1024 + head * 64;
      const bf16x8 qf0 = *(const bf16x8*)(qrow + fq * 8);
      const bf16x8 qf1 = *(const bf16x8*)(qrow + 32 + fq * 8);
      f32x4 s[12];
#pragma unroll
      for (int ks = 0; ks < 12; ++ks) {
        const bf16x8 kf0 = *(const bf16x8*)(Ks + (ks * 16 + fr) * 72 + fq * 8);
        const bf16x8 kf1 = *(const bf16x8*)(Ks + (ks * 16 + fr) * 72 + 32 + fq * 8);
        f32x4 z = {0.f, 0.f, 0.f, 0.f};
        z = __builtin_amdgcn_mfma_f32_16x16x32_bf16(kf0, qf0, z, 0, 0, 0);
        s[ks] = __builtin_amdgcn_mfma_f32_16x16x32_bf16(kf1, qf1, z, 0, 0, 0);
        if ((ks & 3) == 3) __builtin_amdgcn_sched_barrier(0);
      }
      float mx = sink;
      const int lo_ = max(minpos, qp - 127), hi_ = min(qp, kpos0 + nvalid - 1);
      const unsigned span_ = (unsigned)(hi_ - lo_);
      const int kp0_ = kpos0 + fq * 4 - lo_;
#pragma unroll
      for (int ks = 0; ks < 12; ++ks)
#pragma unroll
        for (int j = 0; j < 4; ++j) {
          const bool valid = (unsigned)(kp0_ + ks * 16 + j) <= span_;
          const float v = valid ? s[ks][j] : -1.0e30f;
          s[ks][j] = v;
          mx = fmaxf(mx, v);
          if (j == 3) __builtin_amdgcn_sched_barrier(0);
        }
      mx = fmaxf(mx, __shfl_xor(mx, 16));
      mx = fmaxf(mx, __shfl_xor(mx, 32));
      float sum = 0.f;
#pragma unroll
      for (int ks = 0; ks < 12; ++ks)
#pragma unroll
        for (int j = 0; j < 4; ++j) {
          const float pv = (s[ks][j] > -1.0e29f) ? __expf(s[ks][j] - mx) : 0.f;
          s[ks][j] = pv;
          sum += pv;
          if (j == 3) __builtin_amdgcn_sched_barrier(0);
        }
      sum += __shfl_xor(sum, 16);
      sum += __shfl_xor(sum, 32);
      sum += __expf(sink - mx);
      const float inv = 1.f / sum;
      f32x4 o[4];
#pragma unroll
      for (int d = 0; d < 4; ++d) o[d] = f32x4{0.f, 0.f, 0.f, 0.f};
#pragma unroll
      for (int kk = 0; kk < 6; ++kk) {
        union { bf16x8 v; unsigned u[4]; } pb;
        pb.u[0] = pack2(s[2 * kk][0], s[2 * kk][1]); pb.u[1] = pack2(s[2 * kk][2], s[2 * kk][3]);
        pb.u[2] = pack2(s[2 * kk + 1][0], s[2 * kk + 1][1]); pb.u[3] = pack2(s[2 * kk + 1][2], s[2 * kk + 1][3]);
#pragma unroll
        for (int d = 0; d < 4; ++d) {
          union { bf16x8 v; uint2 h[2]; } vf;
          const u16* vr = Vt + (d * 16 + fr) * 200 + fq * 4;
          vf.h[0] = *(const uint2*)(vr + (2 * kk) * 16);
          vf.h[1] = *(const uint2*)(vr + (2 * kk + 1) * 16);
          o[d] = __builtin_amdgcn_mfma_f32_16x16x32_bf16(vf.v, pb.v, o[d], 0, 0, 0);
        }
        __builtin_amdgcn_sched_barrier(0);
      }
      if (is_p || fr < 8) {
#pragma unroll
        for (int d = 0; d < 4; ++d) {
          uint2 w; w.x = pack2(o[d][0] * inv, o[d][1] * inv); w.y = pack2(o[d][2] * inv, o[d][3] * inv);
          *(uint2*)(o16 + (size_t)qtok * 1024 + head * 64 + d * 16 + fq * 4) = w;
        }
      }
    }
  }
}


#define XB_TMO      128
#define XB_XCNT(j)  (256  + 64 * (j))
#define XB_XSUB(j)  (1280 + 64 * (j))
#define XB_XGEN(j)  (2304 + 64 * (j))
#define XB_TOP      3328
#define XB_TOPGEN   3392
#define XCD_BAR_WORDS 3456
#define XB_SPIN_CAP (1u << 20)
#define LAS __attribute__((address_space(3)))
__device__ __forceinline__ unsigned xb_ld(unsigned* p) { return __hip_atomic_load(p, __ATOMIC_RELAXED, __HIP_MEMORY_SCOPE_AGENT); }
__device__ __forceinline__ unsigned xb_add(unsigned* p, unsigned v) { return __hip_atomic_fetch_add(p, v, __ATOMIC_RELAXED, __HIP_MEMORY_SCOPE_AGENT); }
__device__ __forceinline__ unsigned xb_xcc_id() { return (unsigned)__builtin_amdgcn_s_getreg((3 << 11) | 20) & 0xFu; }
#define XB_SPIN(cond, bar) do { unsigned _sp = 0; while (cond) { __builtin_amdgcn_s_sleep(1); \
    if ((++_sp & 255u) == 0u) { if (xb_ld(&(bar)[XB_TMO])) break; if (_sp > XB_SPIN_CAP) { atomicAdd(&(bar)[XB_TMO], 1u); break; } } } } while (0)
struct XcdBarrier { unsigned* bar; unsigned x; volatile LAS unsigned* st; };
__device__ __forceinline__ XcdBarrier xcd_barrier_post(unsigned* bar, volatile LAS unsigned* st) {
  XcdBarrier b; b.bar = bar; b.x = xb_xcc_id(); b.st = st;
  if (threadIdx.x == 0) st[2] = xb_add(&bar[XB_XCNT(b.x)], 1u);
  return b;
}
__device__ __forceinline__ void xcd_barrier_complete(unsigned* bar, unsigned x, unsigned& nloc, unsigned& nx, unsigned& xr) {
  const unsigned G = gridDim.x * gridDim.y * gridDim.z;
  unsigned sum, cnt, mine, below, sp = 0u;
  for (;;) {
    sum = 0u; cnt = 0u; mine = 0u; below = 0u;
#pragma unroll
    for (unsigned j = 0; j < 16; ++j) { const unsigned c = xb_ld(&bar[XB_XCNT(j)]); sum += c; cnt += (c > 0u) ? 1u : 0u; mine = (j == x) ? c : mine; below += (j < x && c > 0u) ? 1u : 0u; }
    if (sum == G) break;
    __builtin_amdgcn_s_sleep(1);
    if ((++sp & 255u) == 0u) { if (xb_ld(&bar[XB_TMO])) break; if (sp > XB_SPIN_CAP) { atomicAdd(&bar[XB_TMO], 1u); break; } }
  }
  nloc = mine > 0u ? mine : 1u; nx = cnt > 0u ? cnt : 1u; xr = below;
}
__device__ __forceinline__ void xcd_barrier(const XcdBarrier& b) {
  asm volatile("s_waitcnt vmcnt(0)" ::: "memory");
  __syncthreads();
  if (threadIdx.x == 0) {
    unsigned* bar = b.bar;
    __builtin_amdgcn_s_waitcnt(0);
    unsigned nloc = b.st[0], nx = b.st[1];
    if (nloc == 0u) { unsigned xr; xcd_barrier_complete(bar, b.x, nloc, nx, xr); b.st[0] = nloc; b.st[1] = nx; b.st[3] = xr; }
    const unsigned old = xb_add(&bar[XB_XSUB(b.x)], 1u);
    const unsigned gen = old / nloc;
    if (old + 1u == (gen + 1u) * nloc) {
      __builtin_amdgcn_fence(__ATOMIC_RELEASE, "agent");
      asm volatile("s_waitcnt vmcnt(0)" ::: "memory");
      const unsigned og = xb_add(&bar[XB_TOP], 1u);
      const unsigned tg = og / nx;
      if (og + 1u == (tg + 1u) * nx) xb_add(&bar[XB_TOPGEN], 1u);
      else XB_SPIN(xb_ld(&bar[XB_TOPGEN]) == tg, bar);
      __builtin_amdgcn_fence(__ATOMIC_ACQUIRE, "agent");
      xb_add(&bar[XB_XGEN(b.x)], 1u);
      asm volatile("s_waitcnt vmcnt(0)" ::: "memory");
    } else {
      XB_SPIN(xb_ld(&bar[XB_XGEN(b.x)]) == gen, bar);
      __builtin_amdgcn_fence(__ATOMIC_ACQUIRE, "agent");
      asm volatile("s_waitcnt vmcnt(0)" ::: "memory");
    }
  }
  __syncthreads();
}

typedef const Params __attribute__((address_space(4))) CParams;
__device__ __forceinline__ Params load_params(CParams* q) {
  Params r;
  r.x_prompt = q->x_prompt;
  r.x_sample = q->x_sample;
  r.state_conv = q->state_conv;
  r.state_h = q->state_h;
  r.cache_k = q->cache_k;
  r.cache_v = q->cache_v;
  r.rg_norm = q->rg_norm;
  r.rg_w_in = q->rg_w_in;
  r.rg_conv_w = q->rg_conv_w;
  r.rg_conv_b = q->rg_conv_b;
  r.rg_wa = q->rg_wa;
  r.rg_ba = q->rg_ba;
  r.rg_wx = q->rg_wx;
  r.rg_bx = q->rg_bx;
  r.rg_lambda = q->rg_lambda;
  r.rg_w_out = q->rg_w_out;
  r.kv_norm = q->kv_norm;
  r.w_kv = q->w_kv;
  r.attn_norm = q->attn_norm;
  r.w_q = q->w_q;
  r.sinks = q->sinks;
  r.w_o = q->w_o;
  r.ffn_norm = q->ffn_norm;
  r.peer_wq = q->peer_wq;
  r.peer_subkeys = q->peer_subkeys;
  r.peer_u = q->peer_u;
  r.peer_v = q->peer_v;
  r.final_norm = q->final_norm;
  r.out = q->out;
  r.ws = q->ws;
  r.ph_begin = q->ph_begin;
  r.ph_end = q->ph_end;
  return r;
}

template <int ph>
__device__ __forceinline__ void run_phase(const Params& p, char* smem, const XInfo xi) {
  char* ws = p.ws;
  switch (ph) {
    case 0: ph_convert0(p, smem); break;
    case 1: {
      EpiWin e{(u16*)(ws + OFF_GATE16), (float*)(ws + OFF_REC32)};
      gemm_tiles((const u16*)(ws + OFF_XN), 1024, (const u16*)(ws + OFF_WT_IN), 1024, 1024, 0, 16, e, smem);
    } break;
    case 2: ph_conv(p); break;
    case 3: {
      EpiBd e{(float*)(ws + OFF_LOGA), (u16*)(ws + OFF_IG16), p.rg_ba, p.rg_bx, p.rg_lambda};
      gemm_tiles((const u16*)(ws + OFF_XC16), 1024, (const u16*)(ws + OFF_WT_BD), 128, 128, 8, 16, e, smem);
    } break;
    case 4: ph_scanA(p); break;
    case 20: ph_scanA2(p); break;
    case 5: ph_scanB(p); break;
    case 6: {
      EpiResid e{p.x_prompt, p.x_sample, (float*)(ws + OFF_X), 1};
      gemm_tiles((const u16*)(ws + OFF_HG16), 1024, (const u16*)(ws + OFF_WT_OUT), 1024, 1024, 0, 8, e, smem);
      ph_cvt_tables(p, 0);
    } break;
    case 7: ph_rmsnorm(p, p.ffn_norm); break;
    case 8: case 16: {
      EpiScoresTopk e{(const u16*)(ws + (ph == 8 ? OFF_WT_SK0 : OFF_WT_SK1)), (int*)(ws + OFF_TKEY), smem};
      gemm_tiles((const u16*)(ws + OFF_XN), 1024, (const u16*)(ws + (ph == 8 ? OFF_WT_PQ0 : OFF_WT_PQ1)), 1024, 1024, 0, 16, e, smem);
    } break;
    case 9: case 17: {
      EpiTopk e{(int*)(ws + OFF_TKEY), smem};
      gemm_tiles((const u16*)(ws + OFF_QP16), 2048, (const u16*)(ws + (ph == 9 ? OFF_WT_SK0 : OFF_WT_SK1)), 128, 128, 16, 16, e, smem);
    } break;
    case 10: case 18: ph_topk(p, smem); break;
    case 11: case 19: ph_expert_u(p, xi); break;
    case 21: case 24: ph_expert_combine(p); break;
    case 22: case 25: ph_expert_v(p, xi); break;
    case 23: ph_post_norm(p, 0); break;
    case 26: ph_post_norm(p, 1); break;
    case 12: {
      EpiKvq e{(u16*)(ws + OFF_K16), (u16*)(ws + OFF_V16A), (u16*)(ws + OFF_Q16), (const float2*)(ws + OFF_ROPE), p.out};
      gemm_tiles((const u16*)(ws + OFF_XN), 1024, (const u16*)(ws + OFF_WT_KVQ), 1024, 1024, 0, 12, e, smem);
      ph_cvt_tables(p, 1);
    } break;
    case 13: ph_attn(p, smem); break;
    case 14: {
      EpiResid e{p.x_prompt, p.x_sample, (float*)(ws + OFF_X), 0};
      gemm_tiles((const u16*)(ws + OFF_O16), 1024, (const u16*)(ws + OFF_WT_O), 1024, 1024, 0, 8, e, smem);
    } break;
    case 15: ph_rmsnorm(p, p.ffn_norm + 1024); break;
    default: break;
  }
}

__global__ void __launch_bounds__(256, 2) yoco_megakernel(Params p) {
  __shared__ __attribute__((aligned(16))) char smem[73728];
  __shared__ uint4 xb_words;
  cg::grid_group grid = cg::this_grid();
  if (threadIdx.x == 0) xb_words = make_uint4(0u, 0u, 0u, 0u);
  __syncthreads();
  XcdBarrier xb = xcd_barrier_post((unsigned*)(p.ws + OFF_BAR), (volatile LAS unsigned*)&xb_words);
  if (p.ph_end > 1000) grid.sync();
#define LAUNDER(q) CParams* q = (CParams*)__builtin_amdgcn_kernarg_segment_ptr(); asm volatile("" : "+s"(q));
#define PH(k) run_phase<k>(p, smem, xi); xcd_barrier(xb);
  XInfo xi; xi.nloc = 1; xi.nx = 1; xi.rank = 0; xi.xr = 0;
  PH(0)
  { volatile LAS unsigned* st = (volatile LAS unsigned*)&xb_words; xi.nloc = __builtin_amdgcn_readfirstlane((int)st[0]); xi.nx = __builtin_amdgcn_readfirstlane((int)st[1]); xi.rank = __builtin_amdgcn_readfirstlane((int)st[2]); xi.xr = __builtin_amdgcn_readfirstlane((int)st[3]); }
  PH(1) PH(2) PH(3) PH(4) PH(20) PH(5) PH(6) PH(7) PH(8)
  PH(10) PH(11) PH(21) PH(22) PH(23) PH(12) PH(13) PH(14) PH(15) PH(16) PH(18) PH(19) PH(24) PH(25)
  run_phase<26>(p, smem, xi);
}

extern "C" void kernel_launch(void* const* d_in, const int* in_sizes, int n_in, void* d_out, int out_size,
                              void* d_ws, size_t ws_size, hipStream_t stream) {
  static int grid_blocks = 0;
  if (!grid_blocks) {
    int dev = 0, cus = 0, per_cu = 0;
    hipGetDevice(&dev);
    hipDeviceGetAttribute(&cus, hipDeviceAttributeMultiprocessorCount, dev);
    hipOccupancyMaxActiveBlocksPerMultiprocessor(&per_cu, yoco_megakernel, 256, 0);
    if (per_cu > 2) per_cu = 2;
    if (per_cu < 1) per_cu = 1;
    grid_blocks = cus * per_cu;
    if (ws_size < WS_NEEDED) fprintf(stderr, "workspace too small: %zu < %llu\n", ws_size, (unsigned long long)WS_NEEDED);
  }
  Params p{};
  const float** f = (const float**)&p;
  for (int i = 0; i < 28; ++i) f[i] = (const float*)d_in[i];
  p.out = (float*)d_out;
  p.ws = (char*)d_ws;
  hipMemsetAsync((char*)d_ws + OFF_BAR, 0, XCD_BAR_WORDS * sizeof(unsigned), stream);
#if MULTI_LAUNCH
  for (int ph = 0; ph < NPHASE; ++ph) {
    p.ph_begin = ph; p.ph_end = ph + 1;
    hipLaunchKernelGGL(yoco_megakernel, dim3(grid_blocks), dim3(256), 0, stream, p);
  }
#else
  p.ph_begin = 0; p.ph_end = NPHASE;
  void* args[] = {&p};
  hipError_t e = hipLaunchCooperativeKernel((void*)yoco_megakernel, dim3(grid_blocks), dim3(256), args, 0, stream);
  if (e != hipSuccess) fprintf(stderr, "cooperative launch failed: %s (grid %d)\n", hipGetErrorString(e), grid_blocks);
#endif
}
```

```cpp
#include <hip/hip_runtime.h>
#include <hip/hip_cooperative_groups.h>
#include <cstdio>
#include <cstdint>
namespace cg = cooperative_groups;

typedef unsigned short u16;
typedef __attribute__((ext_vector_type(8))) short bf16x8;
typedef __attribute__((ext_vector_type(4))) float f32x4;

#define NTOK 17408
#define NTP 16384
#define MIB 1048576ull
#define NPHASE 20
#ifndef MULTI_LAUNCH
#define MULTI_LAUNCH 0
#endif

#define OFF_WT_IN   (0 * MIB)
#define OFF_WT_OUT  (4 * MIB)
#define OFF_WT_BD   (6 * MIB)
#define OFF_WT_PQ0  (7 * MIB)
#define OFF_WT_PQ1  (11 * MIB)
#define OFF_WT_KVQ  (15 * MIB)
#define OFF_WT_O    (18 * MIB)
#define OFF_WT_SK0  (20 * MIB)
#define OFF_WT_SK1  (20 * MIB + 524288ull)
#define OFF_ROPE    (21 * MIB)
#define OFF_USC     (21 * MIB + 655360ull)
#define OFF_VSC     (21 * MIB + 655360ull + 65536ull)
#define OFF_U8      (22 * MIB)
#define OFF_V8      (38 * MIB)
#define OFF_XN      (86 * MIB)
#define OFF_X       (120 * MIB)
#define OFF_GATE16  (188 * MIB)
#define OFF_REC32   (222 * MIB)
#define OFF_XC32    (290 * MIB)
#define OFF_XC16    (358 * MIB)
#define OFF_LOGA    (222 * MIB)
#define OFF_IG16    (22 * MIB)
#define OFF_AGGA    (56 * MIB)
#define OFF_AGGB    (60 * MIB)
#define OFF_HG16    (358 * MIB)
#define OFF_QP16    (188 * MIB)
#define OFF_S32     (256 * MIB)
#define OFF_PH      (256 * MIB)
#define OFF_TKEY    (256 * MIB)
#define OFF_IDX     (188 * MIB)
#define OFF_PGATE   (197 * MIB)
#define OFF_K16     (188 * MIB)
#define OFF_V16A    (197 * MIB)
#define OFF_Q16     (206 * MIB)
#define OFF_O16     (240 * MIB)
#define OFF_BAR     (392 * MIB)
#define WS_NEEDED   (392 * MIB + 16384ull)

#define OUT_Y      0
#define OUT_CONVP  17825792
#define OUT_HP     17850368
#define OUT_KP     17858560
#define OUT_VP     18120704
#define OUT_CONVS  18382848
#define OUT_HS     18776064
#define OUT_KS     18907136
#define OUT_VS     23101440

struct Params {
  const float *x_prompt, *x_sample, *state_conv, *state_h, *cache_k, *cache_v;
  const float *rg_norm, *rg_w_in, *rg_conv_w, *rg_conv_b, *rg_wa, *rg_ba, *rg_wx, *rg_bx, *rg_lambda, *rg_w_out;
  const float *kv_norm, *w_kv, *attn_norm, *w_q, *sinks, *w_o, *ffn_norm, *peer_wq, *peer_subkeys, *peer_u, *peer_v, *final_norm;
  float* out;
  char* ws;
  int ph_begin, ph_end;
};

__device__ __forceinline__ u16 f2bf(float f) {
  unsigned u = __float_as_uint(f);
  u += 0x7fffu + ((u >> 16) & 1u);
  return (u16)(u >> 16);
}
__device__ __forceinline__ float bf2f(u16 h) { return __uint_as_float(((unsigned)h) << 16); }
__device__ __forceinline__ unsigned pack2(float a, float b) { return (unsigned)f2bf(a) | ((unsigned)f2bf(b) << 16); }
__device__ __forceinline__ float bflo(unsigned u) { return __uint_as_float(u << 16); }
__device__ __forceinline__ float bfhi(unsigned u) { return __uint_as_float(u & 0xffff0000u); }
__device__ __forceinline__ float wave_sum(float v) {
#pragma unroll
  for (int o = 32; o > 0; o >>= 1) v += __shfl_xor(v, o);
  return v;
}
__device__ __forceinline__ const float* xin_row(const Params& p, int token) {
  return token < NTP ? p.x_prompt + (size_t)token * 1024 : p.x_sample + (size_t)(token - NTP) * 1024;
}
__device__ __forceinline__ float gelu_tanh(float x) {
  float u = 0.7978845608028654f * (x + 0.044715f * x * x * x);
  float e = __expf(2.f * u);
  float th = 1.f - 2.f / (e + 1.f);
  return 0.5f * x * (1.f + th);
}
__device__ __forceinline__ float sigmoidf_(float x) { return 1.f / (1.f + __expf(-x)); }

template <int CTRL>
__device__ __forceinline__ int dpp_i(int v) { return __builtin_amdgcn_update_dpp(v, v, CTRL, 0xf, 0xf, false); }
__device__ __forceinline__ int grp_max_i(int v) {
  v = max(v, dpp_i<0xB1>(v));
  v = max(v, dpp_i<0x4E>(v));
  v = max(v, dpp_i<0x141>(v));
  v = max(v, dpp_i<0x140>(v));
  return v;
}
__device__ __forceinline__ float grp_max_f(float v) {
  v = fmaxf(v, __int_as_float(dpp_i<0xB1>(__float_as_int(v))));
  v = fmaxf(v, __int_as_float(dpp_i<0x4E>(__float_as_int(v))));
  v = fmaxf(v, __int_as_float(dpp_i<0x141>(__float_as_int(v))));
  v = fmaxf(v, __int_as_float(dpp_i<0x140>(__float_as_int(v))));
  return v;
}
__device__ __forceinline__ float grp_sum_f(float v) {
  v += __int_as_float(dpp_i<0xB1>(__float_as_int(v)));
  v += __int_as_float(dpp_i<0x4E>(__float_as_int(v)));
  v += __int_as_float(dpp_i<0x141>(__float_as_int(v)));
  v += __int_as_float(dpp_i<0x140>(__float_as_int(v)));
  return v;
}

__device__ __forceinline__ void transpose_unit(const float* __restrict__ src, int ld_src, u16* __restrict__ dst, int ld_dst,
                               int kt, int nt, const float* __restrict__ gain, float* lds) {
  const int tid = threadIdx.x;
#pragma unroll
  for (int j = 0; j < 4; ++j) {
    int idx = tid + j * 256;
    int k = idx >> 4, c4 = idx & 15;
    float4 v = *(const float4*)(src + (size_t)(kt * 64 + k) * ld_src + nt * 64 + c4 * 4);
    float g = gain ? gain[kt * 64 + k] : 1.f;
    float* d = lds + k * 65 + c4 * 4;
    d[0] = v.x * g; d[1] = v.y * g; d[2] = v.z * g; d[3] = v.w * g;
  }
  __syncthreads();
#pragma unroll
  for (int j = 0; j < 2; ++j) {
    int c = tid + j * 256;
    int n = c >> 3, kc = c & 7;
    uint4 o;
    o.x = pack2(lds[(kc * 8 + 0) * 65 + n], lds[(kc * 8 + 1) * 65 + n]);
    o.y = pack2(lds[(kc * 8 + 2) * 65 + n], lds[(kc * 8 + 3) * 65 + n]);
    o.z = pack2(lds[(kc * 8 + 4) * 65 + n], lds[(kc * 8 + 5) * 65 + n]);
    o.w = pack2(lds[(kc * 8 + 6) * 65 + n], lds[(kc * 8 + 7) * 65 + n]);
    *(uint4*)(dst + (size_t)(nt * 64 + n) * ld_dst + kt * 64 + kc * 8) = o;
  }
  __syncthreads();
}

__device__ __forceinline__ void transpose_job(const Params& p, int u, float* lds) {
  char* ws = p.ws;
  if (u < 512) { transpose_unit(p.rg_w_in, 2048, (u16*)(ws + OFF_WT_IN), 1024, u >> 5, u & 31, nullptr, lds); return; }
  u -= 512;
  if (u < 256) { transpose_unit(p.rg_w_out, 1024, (u16*)(ws + OFF_WT_OUT), 1024, u >> 4, u & 15, nullptr, lds); return; }
  u -= 256;
  if (u < 64) {
    int which = u >> 5; int r = u & 31; int bi = r >> 2; int t = r & 3;
    const float* src = (which ? p.rg_wx : p.rg_wa) + (size_t)bi * 16384;
    u16* dst = (u16*)(ws + OFF_WT_BD) + (size_t)(which * 1024 + bi * 128) * 128;
    transpose_unit(src, 128, dst, 128, t >> 1, t & 1, nullptr, lds); return;
  }
  u -= 64;
  if (u < 1024) {
    int l = u >> 9; int r = u & 511;
    transpose_unit(p.peer_wq + (size_t)l * 2097152, 2048, (u16*)(ws + (l ? OFF_WT_PQ1 : OFF_WT_PQ0)), 1024, r >> 5, r & 31, nullptr, lds); return;
  }
  u -= 1024;
  if (u < 128) { transpose_unit(p.w_kv, 512, (u16*)(ws + OFF_WT_KVQ), 1024, u >> 3, u & 7, p.kv_norm, lds); return; }
  u -= 128;
  if (u < 256) { transpose_unit(p.w_q, 1024, (u16*)(ws + OFF_WT_KVQ) + (size_t)512 * 1024, 1024, u >> 4, u & 15, p.attn_norm, lds); return; }
  u -= 256;
  transpose_unit(p.w_o, 1024, (u16*)(ws + OFF_WT_O), 1024, u >> 4, u & 15, nullptr, lds);
}

__device__ __forceinline__ void cvt_unit(const float* __restrict__ src, u16* __restrict__ dst, size_t base) {
  const int tid = threadIdx.x;
#pragma unroll
  for (int j = 0; j < 2; ++j) {
    size_t o = base + j * 1024 + tid * 4;
    float4 v = *(const float4*)(src + o);
    uint2 w; w.x = pack2(v.x, v.y); w.y = pack2(v.z, v.w);
    *(uint2*)(dst + o) = w;
  }
}

__device__ __forceinline__ void rmsnorm_row(const float* __restrict__ x, const float* __restrict__ g, u16* __restrict__ o, int lane) {
  float4 v[4];
  float ss = 0.f;
#pragma unroll
  for (int i = 0; i < 4; ++i) {
    v[i] = *(const float4*)(x + i * 256 + lane * 4);
    ss += v[i].x * v[i].x + v[i].y * v[i].y + v[i].z * v[i].z + v[i].w * v[i].w;
  }
  ss = wave_sum(ss);
  float r = rsqrtf(ss * (1.f / 1024.f) + 1e-6f);
#pragma unroll
  for (int i = 0; i < 4; ++i) {
    float4 gg = *(const float4*)(g + i * 256 + lane * 4);
    uint2 w; w.x = pack2(v[i].x * r * gg.x, v[i].y * r * gg.y); w.y = pack2(v[i].z * r * gg.z, v[i].w * r * gg.w);
    *(uint2*)(o + i * 256 + lane * 4) = w;
  }
}

__device__ __forceinline__ void ph_convert0(const Params& p, char* smem) {
  const int tid = threadIdx.x, lane = tid & 63, wid = tid >> 6;
  const int NT = 2496, NSK = 256, NROPE = 257, NRMS = 4352, NCACHE = 3840;
  const int total = NT + NSK + NROPE + NRMS + NCACHE;
  for (int u0 = blockIdx.x; u0 < total; u0 += gridDim.x) {
    int u = u0;
    if (u < NT) { transpose_job(p, u, (float*)smem); continue; }
    u -= NT;
    if (u < NSK) {
      int l = u >> 7; int r = u & 127;
      const float* src = p.peer_subkeys + (size_t)l * 32768;
      u16* dst = (u16*)(p.ws + (l ? OFF_WT_SK1 : OFF_WT_SK0));
#pragma unroll
      for (int j = 0; j < 2; ++j) {
        int i = r * 2048 + j * 1024 + tid * 4;
        int s = ((i >> 14) & 1) * 16384 + (i & 16383);
        float4 v = *(const float4*)(src + s);
        uint2 w; w.x = pack2(v.x, v.y); w.y = pack2(v.z, v.w);
        *(uint2*)(dst + i) = w;
      }
      continue;
    }
    u -= NSK;
    if (u < NROPE) {
      int i = u * 256 + tid;
      if (i < 2056 * 32) {
        int pi = i >> 5, d = i & 31;
        int pos = pi < 2048 ? pi : (16384 + pi - 2048);
        float inv = (float)pow(10000.0, -(double)d / 32.0);
        float ang = (float)pos * inv;
        double sn, cs;
        sincos((double)ang, &sn, &cs);
        float2* rt = (float2*)(p.ws + OFF_ROPE);
        rt[i] = make_float2((float)cs, (float)sn);
      }
      continue;
    }
    u -= NROPE;
    if (u < NRMS) {
      int t = u * 4 + wid;
      rmsnorm_row(xin_row(p, t), p.rg_norm, (u16*)(p.ws + OFF_XN) + (size_t)t * 1024, lane);
      continue;
    }
    u -= NRMS;
    {
      int which = u / 1920; int r = u - which * 1920;
      int b = r / 15, c = r - b * 15;
      const float* src = (which ? p.cache_v : p.cache_k) + (size_t)b * 32768 + 2048 + c * 2048;
      float* dst = p.out + (which ? OUT_VS : OUT_KS) + (size_t)b * 32768 + c * 2048;
#pragma unroll
      for (int j = 0; j < 2; ++j) {
        int o = j * 1024 + tid * 4;
        *(float4*)(dst + o) = *(const float4*)(src + o);
      }
    }
  }
}

__device__ __forceinline__ void ph_cvt_tables(const Params& p, int layer) {
  const int lane = threadIdx.x & 63, wid = threadIdx.x >> 6;
  for (int u = blockIdx.x; u < 8192; u += gridDim.x) {
    const int which = u >> 12; const int row = (u & 4095) * 4 + wid;
    const float* src = (which ? p.peer_v : p.peer_u) + (size_t)layer * 16777216 + (size_t)row * 1024 + lane * 16;
    unsigned char* dst = (unsigned char*)(p.ws + (which ? OFF_V8 : OFF_U8)) + (size_t)(lane >> 3) * 2097152 + (size_t)row * 128 + (lane & 7) * 16;
    float* sc = (float*)(p.ws + (which ? OFF_VSC : OFF_USC));
    float4 a = *(const float4*)(src), b = *(const float4*)(src + 4), c = *(const float4*)(src + 8), d = *(const float4*)(src + 12);
    float m = fmaxf(fmaxf(fmaxf(fabsf(a.x), fabsf(a.y)), fmaxf(fabsf(a.z), fabsf(a.w))), fmaxf(fmaxf(fabsf(b.x), fabsf(b.y)), fmaxf(fabsf(b.z), fabsf(b.w))));
    m = fmaxf(m, fmaxf(fmaxf(fmaxf(fabsf(c.x), fabsf(c.y)), fmaxf(fabsf(c.z), fabsf(c.w))), fmaxf(fmaxf(fabsf(d.x), fabsf(d.y)), fmaxf(fabsf(d.z), fabsf(d.w)))));
#pragma unroll
    for (int o = 32; o > 0; o >>= 1) m = fmaxf(m, __shfl_xor(m, o));
    const float scl = m > 0.f ? 440.f / m : 1.f;
    uint4 w; int t;
    t = 0; t = __builtin_amdgcn_cvt_pk_fp8_f32(a.x * scl, a.y * scl, t, false); t = __builtin_amdgcn_cvt_pk_fp8_f32(a.z * scl, a.w * scl, t, true); w.x = (unsigned)t;
    t = 0; t = __builtin_amdgcn_cvt_pk_fp8_f32(b.x * scl, b.y * scl, t, false); t = __builtin_amdgcn_cvt_pk_fp8_f32(b.z * scl, b.w * scl, t, true); w.y = (unsigned)t;
    t = 0; t = __builtin_amdgcn_cvt_pk_fp8_f32(c.x * scl, c.y * scl, t, false); t = __builtin_amdgcn_cvt_pk_fp8_f32(c.z * scl, c.w * scl, t, true); w.z = (unsigned)t;
    t = 0; t = __builtin_amdgcn_cvt_pk_fp8_f32(d.x * scl, d.y * scl, t, false); t = __builtin_amdgcn_cvt_pk_fp8_f32(d.z * scl, d.w * scl, t, true); w.w = (unsigned)t;
    *(uint4*)dst = w;
    if (lane == 0) sc[row] = m > 0.f ? m / 440.f : 1.f;
  }
}

__device__ __forceinline__ void ph_rmsnorm(const Params& p, const float* g) {
  const int lane = threadIdx.x & 63, wid = threadIdx.x >> 6;
  const float* x = (const float*)(p.ws + OFF_X);
  u16* xn = (u16*)(p.ws + OFF_XN);
  for (int u = blockIdx.x; u < 4352; u += gridDim.x) {
    int t = u * 4 + wid;
    rmsnorm_row(x + (size_t)t * 1024, g, xn + (size_t)t * 1024, lane);
  }
}

#define LASP __attribute__((address_space(3)))
template <class Epi>
__device__ __forceinline__ void gemm_tiles(const u16* __restrict__ A, int lda, const u16* __restrict__ W, int ldw,
                                           int K, int kmod, int ntn, const Epi& epi, char* smem_g) {
  LASP unsigned char* smem = (LASP unsigned char*)smem_g;
  const int tid = threadIdx.x, lane = tid & 63, wid = tid >> 6;
  const int wr = wid >> 1, wc = wid & 1, fr = lane & 15, fq = lane >> 4;
  const int total = 136 * ntn;
  const int nk = K >> 6;
  int offA[4], offW[4];
#pragma unroll
  for (int i = 0; i < 4; ++i) {
    const int R = (i * 4 + wid) * 8 + (lane >> 3), C = ((lane & 7) ^ (lane >> 3)) * 8;
    offA[i] = R * lda + C; offW[i] = R * ldw + C;
  }
  const int lo0 = (fr >> 3) * 1024 + (fr & 7) * 128 + ((fq ^ (fr & 7)) * 16);
  const int lo1 = (fr >> 3) * 1024 + (fr & 7) * 128 + (((4 + fq) ^ (fr & 7)) * 16);
#define GEMM_STAGE(buf, Ag_, Wg_, k0_)                                                                          \
  _Pragma("unroll") for (int i = 0; i < 4; ++i) {                                                               \
    __builtin_amdgcn_global_load_lds((const unsigned*)((Wg_) + offW[i] + (k0_)), (LASP unsigned*)(smem + (buf) * 32768 + i * 4096 + wid * 1024), 16, 0, 0);         \
    __builtin_amdgcn_global_load_lds((const unsigned*)((Ag_) + offA[i] + (k0_)), (LASP unsigned*)(smem + (buf) * 32768 + 16384 + i * 4096 + wid * 1024), 16, 0, 0); \
  }
  for (int tile = blockIdx.x; tile < total; tile += gridDim.x) {
    const int tm = tile / ntn, tn = tile - tm * ntn;
    const u16* Ag = A + (size_t)(tm * 128) * lda + (kmod ? (tn % kmod) * 128 : 0);
    const u16* Wg = W + (size_t)(tn * 128) * ldw;
    f32x4 acc[4][4];
#pragma unroll
    for (int m = 0; m < 4; ++m)
#pragma unroll
      for (int n = 0; n < 4; ++n) acc[m][n] = f32x4{0.f, 0.f, 0.f, 0.f};
    __syncthreads();
    GEMM_STAGE(0, Ag, Wg, 0)
    for (int kt = 0; kt < nk; ++kt) {
      const int cur = kt & 1;
      asm volatile("s_waitcnt vmcnt(0)" ::: "memory");
      __syncthreads();
      const LASP unsigned char* sW = smem + cur * 32768 + wr * 8192;
      const LASP unsigned char* sA = smem + cur * 32768 + 16384 + wc * 8192;
      bf16x8 a[2][4], b[2][4];
#pragma unroll
      for (int m = 0; m < 4; ++m) { a[0][m] = *(const LASP bf16x8*)(sW + m * 2048 + lo0); a[1][m] = *(const LASP bf16x8*)(sW + m * 2048 + lo1); }
#pragma unroll
      for (int n = 0; n < 4; ++n) { b[0][n] = *(const LASP bf16x8*)(sA + n * 2048 + lo0); b[1][n] = *(const LASP bf16x8*)(sA + n * 2048 + lo1); }
      __builtin_amdgcn_sched_barrier(0);
      if (kt + 1 < nk) { GEMM_STAGE(cur ^ 1, Ag, Wg, (kt + 1) * 64) }
      __builtin_amdgcn_sched_barrier(0);
#pragma unroll
      for (int ks = 0; ks < 2; ++ks)
#pragma unroll
        for (int m = 0; m < 4; ++m)
#pragma unroll
          for (int n = 0; n < 4; ++n) acc[m][n] = __builtin_amdgcn_mfma_f32_16x16x32_bf16(a[ks][m], b[ks][n], acc[m][n], 0, 0, 0);
    }
    epi(acc, tm * 128 + wc * 64, tn * 128 + wr * 64, fr, fq);
  }
#undef GEMM_STAGE
}

struct EpiWin {
  u16* gate16; float* rec32;
  __device__ __forceinline__ void operator()(const f32x4 (&acc)[4][4], int tok0, int feat0, int fr, int fq) const {
#pragma unroll
    for (int n = 0; n < 4; ++n) {
      const int tok = tok0 + n * 16 + fr;
#pragma unroll
      for (int m = 0; m < 4; ++m) {
        const int f = feat0 + m * 16 + fq * 4;
        f32x4 v = acc[m][n];
        if (feat0 < 1024) {
          uint2 w; w.x = pack2(gelu_tanh(v[0]), gelu_tanh(v[1])); w.y = pack2(gelu_tanh(v[2]), gelu_tanh(v[3]));
          *(uint2*)(gate16 + (size_t)tok * 1024 + f) = w;
        } else {
          *(float4*)(rec32 + (size_t)tok * 1024 + (f - 1024)) = make_float4(v[0], v[1], v[2], v[3]);
        }
      }
    }
  }
};
struct EpiBd {
  float* loga; u16* ig16; const float *ba, *bx, *lam;
  __device__ __forceinline__ void operator()(const f32x4 (&acc)[4][4], int tok0, int feat0, int fr, int fq) const {
#pragma unroll
    for (int m = 0; m < 4; ++m) {
      const int f = feat0 + m * 16 + fq * 4;
      if (feat0 < 1024) {
        float4 b4 = *(const float4*)(ba + f);
        float4 l4 = *(const float4*)(lam + f);
        float sp0 = log1pf(__expf(-l4.x)), sp1 = log1pf(__expf(-l4.y)), sp2 = log1pf(__expf(-l4.z)), sp3 = log1pf(__expf(-l4.w));
#pragma unroll
        for (int n = 0; n < 4; ++n) {
          const int tok = tok0 + n * 16 + fr;
          f32x4 v = acc[m][n];
          float4 o;
          o.x = -8.f * sigmoidf_(v[0] + b4.x) * sp0;
          o.y = -8.f * sigmoidf_(v[1] + b4.y) * sp1;
          o.z = -8.f * sigmoidf_(v[2] + b4.z) * sp2;
          o.w = -8.f * sigmoidf_(v[3] + b4.w) * sp3;
          *(float4*)(loga + (size_t)tok * 1024 + f) = o;
        }
      } else {
        float4 b4 = *(const float4*)(bx + (f - 1024));
#pragma unroll
        for (int n = 0; n < 4; ++n) {
          const int tok = tok0 + n * 16 + fr;
          f32x4 v = acc[m][n];
          uint2 w;
          w.x = pack2(sigmoidf_(v[0] + b4.x), sigmoidf_(v[1] + b4.y));
          w.y = pack2(sigmoidf_(v[2] + b4.z), sigmoidf_(v[3] + b4.w));
          *(uint2*)(ig16 + (size_t)tok * 1024 + (f - 1024)) = w;
        }
      }
    }
  }
};
struct EpiResid {
  const float* xp; const float* xs; float* xres; int first;
  __device__ __forceinline__ void operator()(const f32x4 (&acc)[4][4], int tok0, int feat0, int fr, int fq) const {
#pragma unroll
    for (int n = 0; n < 4; ++n) {
      const int tok = tok0 + n * 16 + fr;
      const float* base = first ? (tok < NTP ? xp + (size_t)tok * 1024 : xs + (size_t)(tok - NTP) * 1024) : (xres + (size_t)tok * 1024);
#pragma unroll
      for (int m = 0; m < 4; ++m) {
        const int f = feat0 + m * 16 + fq * 4;
        float4 b = *(const float4*)(base + f);
        f32x4 v = acc[m][n];
        *(float4*)(xres + (size_t)tok * 1024 + f) = make_float4(b.x + v[0], b.y + v[1], b.z + v[2], b.w + v[3]);
      }
    }
  }
};
struct EpiBf16 {
  u16* o; int ld;
  __device__ __forceinline__ void operator()(const f32x4 (&acc)[4][4], int tok0, int feat0, int fr, int fq) const {
#pragma unroll
    for (int n = 0; n < 4; ++n) {
      const int tok = tok0 + n * 16 + fr;
#pragma unroll
      for (int m = 0; m < 4; ++m) {
        const int f = feat0 + m * 16 + fq * 4;
        f32x4 v = acc[m][n];
        uint2 w; w.x = pack2(v[0], v[1]); w.y = pack2(v[2], v[3]);
        *(uint2*)(o + (size_t)tok * ld + f) = w;
      }
    }
  }
};
struct EpiF32 {
  float* o; int ld;
  __device__ __forceinline__ void operator()(const f32x4 (&acc)[4][4], int tok0, int feat0, int fr, int fq) const {
#pragma unroll
    for (int n = 0; n < 4; ++n) {
      const int tok = tok0 + n * 16 + fr;
#pragma unroll
      for (int m = 0; m < 4; ++m) {
        const int f = feat0 + m * 16 + fq * 4;
        f32x4 v = acc[m][n];
        *(float4*)(o + (size_t)tok * ld + f) = make_float4(v[0], v[1], v[2], v[3]);
      }
    }
  }
};
__device__ __forceinline__ int mkkey(float v, int n) {
  int i = __float_as_int(v);
  i ^= (i >> 31) & 0x7fffffff;
  return (i & ~127) | (127 - n);
}
__device__ __forceinline__ float keyval(int k) {
  int i = (k & ~127) | 64;
  i ^= (i >> 31) & 0x7fffffff;
  return __int_as_float(i);
}
__device__ __forceinline__ int keyidx(int k) { return 127 - (k & 127); }
#define CE(i, j) { int hi_ = max(k[i], k[j]); int lo_ = min(k[i], k[j]); k[i] = hi_; k[j] = lo_; }

struct EpiTopk {
  int* tkey; char* smem;
  __device__ __forceinline__ void operator()(const f32x4 (&acc)[4][4], int tok0, int feat0, int fr, int fq) const {
    float* S = (float*)smem;
    const int tid = threadIdx.x, lane = tid & 63, wid = tid >> 6, g = lane >> 4, li = lane & 15;
    const int wc64 = tok0 & 127, wr64 = feat0 & 127;
    __syncthreads();
#pragma unroll
    for (int n = 0; n < 4; ++n)
#pragma unroll
      for (int m = 0; m < 4; ++m) {
        f32x4 v = acc[m][n];
        *(float4*)(S + (wc64 + n * 16 + fr) * 132 + wr64 + m * 16 + fq * 4) = make_float4(v[0], v[1], v[2], v[3]);
      }
    __syncthreads();
    const int tokbase = tok0 - wc64, hp = feat0 >> 7;
#pragma unroll 1
    for (int pass = 0; pass < 8; ++pass) {
      const int row = pass * 16 + wid * 4 + g;
      const float* r = S + row * 132;
      float4 v0 = *(const float4*)(r + li * 4), v1 = *(const float4*)(r + 64 + li * 4);
      int k[8];
      k[0] = mkkey(v0.x, li * 4 + 0); k[1] = mkkey(v0.y, li * 4 + 1); k[2] = mkkey(v0.z, li * 4 + 2); k[3] = mkkey(v0.w, li * 4 + 3);
      k[4] = mkkey(v1.x, 64 + li * 4 + 0); k[5] = mkkey(v1.y, 64 + li * 4 + 1); k[6] = mkkey(v1.z, 64 + li * 4 + 2); k[7] = mkkey(v1.w, 64 + li * 4 + 3);
      CE(0, 1) CE(2, 3) CE(4, 5) CE(6, 7)
      CE(0, 2) CE(1, 3) CE(4, 6) CE(5, 7)
      CE(1, 2) CE(5, 6)
      CE(0, 4) CE(1, 5) CE(2, 6) CE(3, 7)
      CE(2, 4) CE(3, 5)
      CE(1, 2) CE(3, 4) CE(5, 6)
      int res = (int)0x80000000;
#pragma unroll
      for (int it = 0; it < 16; ++it) {
        const int M = grp_max_i(k[0]);
        const bool win = (k[0] == M);
        if (li == it) res = M;
#pragma unroll
        for (int i = 0; i < 7; ++i) k[i] = win ? k[i + 1] : k[i];
        k[7] = win ? (int)0x80000000 : k[7];
      }
      tkey[((size_t)(tokbase + row) * 16 + hp) * 16 + li] = res;
    }
  }
};
struct EpiScoresTopk {
  const u16* sk; int* tkey; char* smem_g;
  __device__ __forceinline__ void operator()(const f32x4 (&acc)[4][4], int tok0, int feat0, int fr, int fq) const {
    LASP unsigned char* smem = (LASP unsigned char*)smem_g;
    const int tid = threadIdx.x, lane = tid & 63, wid = tid >> 6, wr = wid >> 1, wc = wid & 1;
    const int tn = feat0 >> 7;
    __syncthreads();
    {
      const int swz = (lane * 16) ^ ((lane >> 5) << 5);
#pragma unroll
      for (int i = 0; i < 4; ++i) {
        const int st = i * 4 + wid;
        const int R = (st >> 1) * 16 + (swz >> 6), C = (st & 1) * 32 + ((swz & 63) >> 1);
        const u16* src = sk + (size_t)(tn * 128 + R) * 128 + C;
        __builtin_amdgcn_global_load_lds((const unsigned*)src, (LASP unsigned*)(smem + i * 4096 + wid * 1024), 16, 0, 0);
        __builtin_amdgcn_global_load_lds((const unsigned*)(src + 64), (LASP unsigned*)(smem + 32768 + i * 4096 + wid * 1024), 16, 0, 0);
      }
    }
#pragma unroll
    for (int n = 0; n < 4; ++n)
#pragma unroll
      for (int m = 0; m < 4; ++m) {
        const int r = wc * 64 + n * 16 + fr, c = m * 16 + fq * 4;
        int ob = (r & 15) * 64 + (c & 31) * 2;
        ob ^= ((ob >> 9) & 1) << 5;
        const int off = wr * 32768 + 16384 + ((r >> 4) * 2 + (c >> 5)) * 1024 + ob;
        f32x4 v = acc[m][n];
        typedef unsigned u32x2_t __attribute__((ext_vector_type(2)));
        u32x2_t w; w.x = pack2(v[0], v[1]); w.y = pack2(v[2], v[3]);
        *(LASP u32x2_t*)(smem + off) = w;
      }
    asm volatile("s_waitcnt vmcnt(0)" ::: "memory");
    __syncthreads();
    f32x4 acc2[4][4];
#pragma unroll
    for (int m = 0; m < 4; ++m)
#pragma unroll
      for (int n = 0; n < 4; ++n) acc2[m][n] = f32x4{0.f, 0.f, 0.f, 0.f};
    const int lane_off = (fr * 64 + fq * 16) ^ ((fr >> 3) << 5);
#pragma unroll
    for (int kt2 = 0; kt2 < 2; ++kt2) {
      const LASP unsigned char* sW = smem + kt2 * 32768;
      const LASP unsigned char* sA = sW + 16384;
#pragma unroll
      for (int ks = 0; ks < 2; ++ks) {
        bf16x8 a[4], b[4];
#pragma unroll
        for (int m = 0; m < 4; ++m) a[m] = *(const LASP bf16x8*)(sW + (wr * 8 + m * 2 + ks) * 1024 + lane_off);
#pragma unroll
        for (int n = 0; n < 4; ++n) b[n] = *(const LASP bf16x8*)(sA + (wc * 8 + n * 2 + ks) * 1024 + lane_off);
#pragma unroll
        for (int m = 0; m < 4; ++m)
#pragma unroll
          for (int n = 0; n < 4; ++n) acc2[m][n] = __builtin_amdgcn_mfma_f32_16x16x32_bf16(a[m], b[n], acc2[m][n], 0, 0, 0);
      }
    }
    EpiTopk e{tkey, smem_g};
    e(acc2, tok0, feat0, fr, fq);
  }
};
struct EpiKvq {
  u16 *k16, *v16, *q16; const float2* rope; float* out;
  __device__ __forceinline__ void operator()(const f32x4 (&acc)[4][4], int tok0, int feat0, int fr, int fq) const {
#pragma unroll
    for (int n = 0; n < 4; ++n) {
      const int tok = tok0 + n * 16 + fr;
      int b, t, pi, orow; bool is_p = tok < NTP;
      if (is_p) { b = tok >> 11; t = tok & 2047; pi = t; orow = t - 1920; }
      else { int ts = tok - NTP; b = ts >> 3; t = ts & 7; pi = 2048 + t; orow = 120 + t; }
      if (feat0 >= 256 && feat0 < 512) {
        const int kvh = (feat0 - 256) >> 6;
#pragma unroll
        for (int m = 0; m < 4; ++m) {
          const int d = m * 16 + fq * 4;
          f32x4 v = acc[m][n];
          uint2 w; w.x = pack2(v[0], v[1]); w.y = pack2(v[2], v[3]);
          *(uint2*)(v16 + (size_t)tok * 256 + kvh * 64 + d) = w;
          if (orow >= 0) {
            float* dst = out + (is_p ? OUT_VP : OUT_VS) + ((size_t)(b * 128 + orow) * 4 + kvh) * 64 + d;
            *(float4*)dst = make_float4(v[0], v[1], v[2], v[3]);
          }
        }
      } else {
        const bool isk = feat0 < 256;
        const float sc = isk ? 1.f : 0.125f;
#pragma unroll
        for (int m = 0; m < 2; ++m) {
          const int d = m * 16 + fq * 4;
          f32x4 x1 = acc[m][n], x2 = acc[m + 2][n];
          const float2* rp = rope + pi * 32 + d;
          float o1[4], o2[4];
#pragma unroll
          for (int j = 0; j < 4; ++j) {
            float2 csn = rp[j];
            o1[j] = (x1[j] * csn.x - x2[j] * csn.y) * sc;
            o2[j] = (x2[j] * csn.x + x1[j] * csn.y) * sc;
          }
          uint2 w1, w2;
          w1.x = pack2(o1[0], o1[1]); w1.y = pack2(o1[2], o1[3]);
          w2.x = pack2(o2[0], o2[1]); w2.y = pack2(o2[2], o2[3]);
          if (isk) {
            const int kvh = feat0 >> 6;
            *(uint2*)(k16 + (size_t)tok * 256 + kvh * 64 + d) = w1;
            *(uint2*)(k16 + (size_t)tok * 256 + kvh * 64 + d + 32) = w2;
            if (orow >= 0) {
              float* dst = out + (is_p ? OUT_KP : OUT_KS) + ((size_t)(b * 128 + orow) * 4 + kvh) * 64 + d;
              *(float4*)dst = make_float4(o1[0], o1[1], o1[2], o1[3]);
              *(float4*)(dst + 32) = make_float4(o2[0], o2[1], o2[2], o2[3]);
            }
          } else {
            const int f = feat0 - 512;
            *(uint2*)(q16 + (size_t)tok * 1024 + f + d) = w1;
            *(uint2*)(q16 + (size_t)tok * 1024 + f + d + 32) = w2;
          }
        }
      }
    }
  }
};

__device__ __forceinline__ void ph_conv(const Params& p) {
  const float* rec = (const float*)(p.ws + OFF_REC32);
  float* xc32 = (float*)(p.ws + OFF_XC32);
  u16* xc16 = (u16*)(p.ws + OFF_XC16);
  const int c = threadIdx.x * 4;
  const float4 w0 = *(const float4*)(p.rg_conv_w + c), w1 = *(const float4*)(p.rg_conv_w + 1024 + c);
  const float4 w2 = *(const float4*)(p.rg_conv_w + 2048 + c), w3 = *(const float4*)(p.rg_conv_w + 3072 + c);
  const float4 cb = *(const float4*)(p.rg_conv_b + c);
  for (int u = blockIdx.x; u < NTOK / 8; u += gridDim.x) {
    const int tok0 = u * 8;
    int b, t0; const float* buf = nullptr;
    if (tok0 < NTP) { b = tok0 >> 11; t0 = tok0 & 2047; }
    else { b = (tok0 - NTP) >> 3; t0 = 0; buf = p.state_conv + (size_t)b * 3072; }
    float4 r1, r2, r3;
    const float4 z = make_float4(0.f, 0.f, 0.f, 0.f);
    if (t0 >= 3) {
      r1 = *(const float4*)(rec + (size_t)(tok0 - 1) * 1024 + c);
      r2 = *(const float4*)(rec + (size_t)(tok0 - 2) * 1024 + c);
      r3 = *(const float4*)(rec + (size_t)(tok0 - 3) * 1024 + c);
    } else if (buf) {
      r1 = *(const float4*)(buf + 2048 + c); r2 = *(const float4*)(buf + 1024 + c); r3 = *(const float4*)(buf + c);
    } else { r1 = z; r2 = z; r3 = z; }
    float4 r0[8];
#pragma unroll
    for (int s = 0; s < 8; ++s) r0[s] = *(const float4*)(rec + (size_t)(tok0 + s) * 1024 + c);
#pragma unroll
    for (int s = 0; s < 8; ++s) {
      const float4 x = r0[s];
      float4 o;
      o.x = cb.x + w3.x * x.x + w2.x * r1.x + w1.x * r2.x + w0.x * r3.x;
      o.y = cb.y + w3.y * x.y + w2.y * r1.y + w1.y * r2.y + w0.y * r3.y;
      o.z = cb.z + w3.z * x.z + w2.z * r1.z + w1.z * r2.z + w0.z * r3.z;
      o.w = cb.w + w3.w * x.w + w2.w * r1.w + w1.w * r2.w + w0.w * r3.w;
      const size_t off = (size_t)(tok0 + s) * 1024 + c;
      *(float4*)(xc32 + off) = o;
      uint2 w; w.x = pack2(o.x, o.y); w.y = pack2(o.z, o.w);
      *(uint2*)(xc16 + off) = w;
      const int t = t0 + s;
      if (tok0 < NTP) {
        if (t >= 2045) *(float4*)(p.out + OUT_CONVP + ((size_t)b * 3 + (t - 2045)) * 1024 + c) = x;
      } else {
        if (t >= 5) *(float4*)(p.out + OUT_CONVS + ((size_t)b * 3 + (t - 5)) * 1024 + c) = x;
      }
      r3 = r2; r2 = r1; r1 = x;
    }
  }
}

__device__ __forceinline__ float rg_mult(float la) {
  const float t = 2.f * la;
  const float ser = -t * (1.f + t * (0.5f + t * (0.16666667f + t * (0.041666668f + t * 0.0083333333f))));
  const float dir = 1.f - __expf(t);
  return __builtin_amdgcn_sqrtf(t > -0.25f ? ser : dir);
}
__device__ __forceinline__ void scan_step(const float* loga, const u16* ig16, const float* xc32, size_t off, float4& a, float4& bt) {
  float4 la = *(const float4*)(loga + off);
  uint2 gi = *(const uint2*)(ig16 + off);
  float4 xc = *(const float4*)(xc32 + off);
  a.x = __expf(la.x); a.y = __expf(la.y); a.z = __expf(la.z); a.w = __expf(la.w);
  bt.x = rg_mult(la.x) * bflo(gi.x) * xc.x;
  bt.y = rg_mult(la.y) * bfhi(gi.x) * xc.y;
  bt.z = rg_mult(la.z) * bflo(gi.y) * xc.z;
  bt.w = rg_mult(la.w) * bfhi(gi.y) * xc.w;
}
__device__ __forceinline__ void ph_scanA(const Params& p) {
  const float* loga = (const float*)(p.ws + OFF_LOGA);
  const u16* ig16 = (const u16*)(p.ws + OFF_IG16);
  const float* xc32 = (const float*)(p.ws + OFF_XC32);
  float* aggA = (float*)(p.ws + OFF_AGGA);
  float* aggB = (float*)(p.ws + OFF_AGGB);
  const int c = threadIdx.x * 4;
  for (int item = blockIdx.x; item < 1024; item += gridDim.x) {
    const int b = item >> 7, ch = item & 127;
    float4 A = make_float4(1.f, 1.f, 1.f, 1.f), B = make_float4(0.f, 0.f, 0.f, 0.f);
    const size_t tok0 = (size_t)b * 2048 + ch * 16;
#pragma unroll 8
    for (int s = 0; s < 16; ++s) {
      float4 a, bt;
      scan_step(loga, ig16, xc32, (tok0 + s) * 1024 + c, a, bt);
      A.x *= a.x; A.y *= a.y; A.z *= a.z; A.w *= a.w;
      B.x = a.x * B.x + bt.x; B.y = a.y * B.y + bt.y; B.z = a.z * B.z + bt.z; B.w = a.w * B.w + bt.w;
    }
    *(float4*)(aggA + (size_t)item * 1024 + c) = A;
    *(float4*)(aggB + (size_t)item * 1024 + c) = B;
  }
}
__device__ __forceinline__ void ph_scanA2(const Params& p) {
  const float* aggA = (const float*)(p.ws + OFF_AGGA);
  float* aggB = (float*)(p.ws + OFF_AGGB);
  for (int u = blockIdx.x; u < 32; u += gridDim.x) {
    const int b = u >> 2, c = (u & 3) * 256 + threadIdx.x;
    float h = 0.f;
#pragma unroll 16
    for (int ch = 0; ch < 128; ++ch) {
      const size_t o = (size_t)(b * 128 + ch) * 1024 + c;
      const float A = aggA[o], B = aggB[o];
      aggB[o] = h;
      h = A * h + B;
    }
  }
}
__device__ __forceinline__ void ph_scanB(const Params& p) {
  const float* loga = (const float*)(p.ws + OFF_LOGA);
  const u16* ig16 = (const u16*)(p.ws + OFF_IG16);
  const float* xc32 = (const float*)(p.ws + OFF_XC32);
  const u16* gate16 = (const u16*)(p.ws + OFF_GATE16);
  u16* hg16 = (u16*)(p.ws + OFF_HG16);
  const float* aggB = (const float*)(p.ws + OFF_AGGB);
  const int c = threadIdx.x * 4;
  for (int item = blockIdx.x; item < 1088; item += gridDim.x) {
    float4 h; size_t tok0; float* hout = nullptr;
    if (item < 1024) {
      const int b = item >> 7, ch = item & 127;
      h = *(const float4*)(aggB + (size_t)item * 1024 + c);
      tok0 = (size_t)b * 2048 + ch * 16;
      if (ch == 127) hout = p.out + OUT_HP + (size_t)b * 1024 + c;
    } else {
      tok0 = (size_t)NTP + (size_t)(item - 1024) * 16;
      h = make_float4(0.f, 0.f, 0.f, 0.f);
    }
#pragma unroll 8
    for (int s = 0; s < 16; ++s) {
      float4 a, bt;
      const size_t off = (tok0 + s) * 1024 + c;
      if (item >= 1024 && (s & 7) == 0) h = *(const float4*)(p.state_h + (size_t)((item - 1024) * 2 + (s >> 3)) * 1024 + c);
      scan_step(loga, ig16, xc32, off, a, bt);
      h.x = a.x * h.x + bt.x; h.y = a.y * h.y + bt.y; h.z = a.z * h.z + bt.z; h.w = a.w * h.w + bt.w;
      uint2 g = *(const uint2*)(gate16 + off);
      uint2 w; w.x = pack2(h.x * bflo(g.x), h.y * bfhi(g.x)); w.y = pack2(h.z * bflo(g.y), h.w * bfhi(g.y));
      *(uint2*)(hg16 + off) = w;
      if (item >= 1024 && (s & 7) == 7) *(float4*)(p.out + OUT_HS + (size_t)((item - 1024) * 2 + (s >> 3)) * 1024 + c) = h;
    }
    if (hout) *(float4*)hout = h;
  }
}

__device__ __forceinline__ void ph_topk(const Params& p, char* smem) {
  const int tid = threadIdx.x, lane = tid & 63, wid = tid >> 6, g = lane >> 4, li = lane & 15;
  const int* tkg = (const int*)(p.ws + OFF_TKEY);
  int* idx_out = (int*)(p.ws + OFF_IDX);
  float* gate_out = (float*)(p.ws + OFF_PGATE);
  int* tkey = (int*)smem + wid * 512;
  for (int tb = blockIdx.x; tb < 2176; tb += gridDim.x) {
    const int tbase = tb * 8 + wid * 2;
    ((int4*)tkey)[lane] = ((const int4*)(tkg + (size_t)tbase * 256))[lane];
    ((int4*)tkey)[64 + lane] = ((const int4*)(tkg + (size_t)tbase * 256))[64 + lane];
    __syncthreads();
    const int* t0[4]; const int* t1[4];
    float sv0[4], head[4], rv[4]; int ptr[4], rc[4];
#pragma unroll
    for (int q = 0; q < 4; ++q) {
      const int h = (q & 1) * 4 + g;
      t0[q] = tkey + (q >> 1) * 256 + (h * 2) * 16;
      t1[q] = t0[q] + 16;
      sv0[q] = keyval(t0[q][li]);
      ptr[q] = 0; rv[q] = 0.f; rc[q] = 0;
      head[q] = sv0[q] + keyval(t1[q][0]);
    }
#pragma unroll 1
    for (int it = 0; it < 16; ++it) {
#pragma unroll
      for (int q = 0; q < 4; ++q) {
        const float M = grp_max_f(head[q]);
        const unsigned long long bm = __ballot(head[q] == M);
        const unsigned gm = (unsigned)(bm >> (g * 16)) & 0xffffu;
        const int wl = __ffs(gm) - 1;
        const bool win = (li == wl);
        const int C = grp_max_i(win ? (li * 16 + ptr[q]) : -1);
        if (li == it) { rv[q] = M; rc[q] = C; }
        const int np = win ? ptr[q] + 1 : ptr[q];
        const float nh = (np < 16) ? sv0[q] + keyval(t1[q][np & 15]) : -3.0e38f;
        head[q] = win ? nh : head[q];
        ptr[q] = np;
      }
    }
#pragma unroll
    for (int q = 0; q < 4; ++q) {
      const int h = (q & 1) * 4 + g;
      const int t = tbase + (q >> 1);
      const int ia = keyidx(t0[q][rc[q] >> 4]);
      const int ib = keyidx(t1[q][rc[q] & 15]);
      const float mx = grp_max_f(rv[q]);
      const float ex = __expf(rv[q] - mx);
      const float sm = grp_sum_f(ex);
      idx_out[(size_t)t * 128 + h * 16 + li] = ia * 128 + ib;
      gate_out[(size_t)t * 128 + h * 16 + li] = ex / sm;
    }
    __syncthreads();
  }
}

typedef float v2f __attribute__((ext_vector_type(2)));
template <int CTRL>
__device__ __forceinline__ float dpp_f(float v) { return __int_as_float(__builtin_amdgcn_update_dpp(0, __float_as_int(v), CTRL, 0xf, 0xf, false)); }
__device__ __forceinline__ float dot16_fp8(uint4 u, const v2f* x2) {
  v2f acc = {0.f, 0.f};
  acc = __builtin_elementwise_fma(__builtin_amdgcn_cvt_pk_f32_fp8((int)u.x, false), x2[0], acc);
  acc = __builtin_elementwise_fma(__builtin_amdgcn_cvt_pk_f32_fp8((int)u.x, true), x2[1], acc);
  acc = __builtin_elementwise_fma(__builtin_amdgcn_cvt_pk_f32_fp8((int)u.y, false), x2[2], acc);
  acc = __builtin_elementwise_fma(__builtin_amdgcn_cvt_pk_f32_fp8((int)u.y, true), x2[3], acc);
  acc = __builtin_elementwise_fma(__builtin_amdgcn_cvt_pk_f32_fp8((int)u.z, false), x2[4], acc);
  acc = __builtin_elementwise_fma(__builtin_amdgcn_cvt_pk_f32_fp8((int)u.z, true), x2[5], acc);
  acc = __builtin_elementwise_fma(__builtin_amdgcn_cvt_pk_f32_fp8((int)u.w, false), x2[6], acc);
  acc = __builtin_elementwise_fma(__builtin_amdgcn_cvt_pk_f32_fp8((int)u.w, true), x2[7], acc);
  return acc.x + acc.y;
}
__device__ __forceinline__ void axpy16_fp8(float w, uint4 u, v2f* o2) {
  const v2f w2 = {w, w};
  o2[0] = __builtin_elementwise_fma(__builtin_amdgcn_cvt_pk_f32_fp8((int)u.x, false), w2, o2[0]);
  o2[1] = __builtin_elementwise_fma(__builtin_amdgcn_cvt_pk_f32_fp8((int)u.x, true), w2, o2[1]);
  o2[2] = __builtin_elementwise_fma(__builtin_amdgcn_cvt_pk_f32_fp8((int)u.y, false), w2, o2[2]);
  o2[3] = __builtin_elementwise_fma(__builtin_amdgcn_cvt_pk_f32_fp8((int)u.y, true), w2, o2[3]);
  o2[4] = __builtin_elementwise_fma(__builtin_amdgcn_cvt_pk_f32_fp8((int)u.z, false), w2, o2[4]);
  o2[5] = __builtin_elementwise_fma(__builtin_amdgcn_cvt_pk_f32_fp8((int)u.z, true), w2, o2[5]);
  o2[6] = __builtin_elementwise_fma(__builtin_amdgcn_cvt_pk_f32_fp8((int)u.w, false), w2, o2[6]);
  o2[7] = __builtin_elementwise_fma(__builtin_amdgcn_cvt_pk_f32_fp8((int)u.w, true), w2, o2[7]);
}
__device__ __forceinline__ float reduce4_row(float d0, float d1, float d2, float d3, int lane) {
  const bool b0 = lane & 1, b1 = lane & 2;
  const float k0 = b0 ? d1 : d0, s0 = b0 ? d0 : d1;
  const float k1 = b0 ? d3 : d2, s1 = b0 ? d2 : d3;
  const float r0 = k0 + dpp_f<0xB1>(s0);
  const float r1 = k1 + dpp_f<0xB1>(s1);
  const float kk = b1 ? r1 : r0, ss = b1 ? r0 : r1;
  float q = kk + dpp_f<0x4E>(ss);
  q += dpp_f<0x128>(q);
  q += dpp_f<0x124>(q);
  return q;
}
#define EXP_LOAD(dst, dsc, TAB, SC, kbase, esrc)                                     \
  _Pragma("unroll") for (int j = 0; j < 8; ++j) {                                   \
    const int e = __builtin_amdgcn_readlane(esrc, ((kbase) + j) & 63);              \
    dst[j] = ((const uint4*)(TAB + (size_t)e * 1024))[lane];                        \
    dsc[j] = SC[e];                                                                  \
  }
#define EXP_LOADV(dst, TAB, kbase, esrc)                                             \
  _Pragma("unroll") for (int j = 0; j < 8; ++j) {                                   \
    const int e = __builtin_amdgcn_readlane(esrc, ((kbase) + j) & 63);              \
    dst[j] = ((const uint4*)(TAB + (size_t)e * 1024))[lane];                        \
  }
#define EXP_UDOT(src, ssc, kbase)                                                    \
  {                                                                                  \
    float d[8];                                                                      \
    _Pragma("unroll") for (int j = 0; j < 8; ++j) d[j] = dot16_fp8(src[j], x2) * ssc[j]; \
    const float qa = reduce4_row(d[0], d[1], d[2], d[3], lane);                      \
    const float qb = reduce4_row(d[4], d[5], d[6], d[7], lane);                      \
    float q = (lane & 4) ? qb : qa;                                                  \
    q += __shfl_xor(q, 16);                                                          \
    q += __shfl_xor(q, 32);                                                          \
    if ((lane >> 3) == ((((kbase)) & 63) >> 3)) { if ((kbase) < 64) h_lo = q; else h_hi = q; } \
  }
#define EXP_VACC(src, kbase, wsrc)                                                   \
  _Pragma("unroll") for (int j = 0; j < 8; ++j) {                                   \
    const float w = __int_as_float(__builtin_amdgcn_readlane(__float_as_int(wsrc), ((kbase) + j) & 63)); \
    axpy16_fp8(w, src[j], o2);                                                       \
  }

__device__ __forceinline__ void ph_expert(const Params& p, int layer) {
  const int lane = threadIdx.x & 63, wid = threadIdx.x >> 6;
  u16* xn16 = (u16*)(p.ws + OFF_XN);
  float* xres = (float*)(p.ws + OFF_X);
  const int* idxs = (const int*)(p.ws + OFF_IDX);
  const float* gates = (const float*)(p.ws + OFF_PGATE);
  const unsigned char* U = (const unsigned char*)(p.ws + OFF_U8);
  const unsigned char* V = (const unsigned char*)(p.ws + OFF_V8);
  const float* USC = (const float*)(p.ws + OFF_USC);
  const float* VSC = (const float*)(p.ws + OFF_VSC);
  for (int tb = blockIdx.x; tb < 4352; tb += gridDim.x) {
    const int t = tb * 4 + wid;
    v2f x2[8];
    {
      const uint4* xr = (const uint4*)(xn16 + (size_t)t * 1024 + lane * 16);
      uint4 xa = xr[0], xb = xr[1];
      x2[0] = v2f{bflo(xa.x), bfhi(xa.x)}; x2[1] = v2f{bflo(xa.y), bfhi(xa.y)};
      x2[2] = v2f{bflo(xa.z), bfhi(xa.z)}; x2[3] = v2f{bflo(xa.w), bfhi(xa.w)};
      x2[4] = v2f{bflo(xb.x), bfhi(xb.x)}; x2[5] = v2f{bflo(xb.y), bfhi(xb.y)};
      x2[6] = v2f{bflo(xb.z), bfhi(xb.z)}; x2[7] = v2f{bflo(xb.w), bfhi(xb.w)};
    }
    const int e_lo = idxs[(size_t)t * 128 + lane], e_hi = idxs[(size_t)t * 128 + 64 + lane];
    const float g_lo = gates[(size_t)t * 128 + lane], g_hi = gates[(size_t)t * 128 + 64 + lane];
    const float vs_lo = VSC[e_lo], vs_hi = VSC[e_hi];
    float h_lo = 0.f, h_hi = 0.f;
    {
      uint4 ba[8], bb[8]; float sa[8], sb[8];
      EXP_LOAD(ba, sa, U, USC, 0, e_lo)
#pragma unroll 1
      for (int kb = 0; kb < 64; kb += 16) {
        EXP_LOAD(bb, sb, U, USC, kb + 8, e_lo)
        EXP_UDOT(ba, sa, kb)
        if (kb + 16 < 64) { EXP_LOAD(ba, sa, U, USC, kb + 16, e_lo) } else { EXP_LOAD(ba, sa, U, USC, 0, e_hi) }
        EXP_UDOT(bb, sb, kb + 8)
      }
#pragma unroll 1
      for (int kb = 64; kb < 128; kb += 16) {
        EXP_LOAD(bb, sb, U, USC, kb + 8, e_hi)
        EXP_UDOT(ba, sa, kb)
        if (kb + 16 < 128) { EXP_LOAD(ba, sa, U, USC, kb + 16, e_hi) }
        EXP_UDOT(bb, sb, kb + 8)
      }
    }
    const float w_lo = 0.5f * h_lo * (1.f + erff(h_lo * 0.70710678118654752f)) * g_lo * vs_lo;
    const float w_hi = 0.5f * h_hi * (1.f + erff(h_hi * 0.70710678118654752f)) * g_hi * vs_hi;
    v2f o2[8];
#pragma unroll
    for (int i = 0; i < 8; ++i) o2[i] = v2f{0.f, 0.f};
    {
      uint4 ba[8], bb[8];
      EXP_LOADV(ba, V, 0, e_lo)
#pragma unroll 1
      for (int kb = 0; kb < 64; kb += 16) {
        EXP_LOADV(bb, V, kb + 8, e_lo)
        EXP_VACC(ba, kb, w_lo)
        if (kb + 16 < 64) { EXP_LOADV(ba, V, kb + 16, e_lo) } else { EXP_LOADV(ba, V, 0, e_hi) }
        EXP_VACC(bb, kb + 8, w_lo)
      }
#pragma unroll 1
      for (int kb = 64; kb < 128; kb += 16) {
        EXP_LOADV(bb, V, kb + 8, e_hi)
        EXP_VACC(ba, kb, w_hi)
        if (kb + 16 < 128) { EXP_LOADV(ba, V, kb + 16, e_hi) }
        EXP_VACC(bb, kb + 8, w_hi)
      }
    }
    float o[16];
#pragma unroll
    for (int i = 0; i < 8; ++i) { o[2 * i] = o2[i].x; o[2 * i + 1] = o2[i].y; }
    float* xr = xres + (size_t)t * 1024 + lane * 16;
    float ss = 0.f;
#pragma unroll
    for (int i = 0; i < 4; ++i) {
      float4 r = *(const float4*)(xr + i * 4);
      o[4 * i] += r.x; o[4 * i + 1] += r.y; o[4 * i + 2] += r.z; o[4 * i + 3] += r.w;
      ss += o[4 * i] * o[4 * i] + o[4 * i + 1] * o[4 * i + 1] + o[4 * i + 2] * o[4 * i + 2] + o[4 * i + 3] * o[4 * i + 3];
    }
    ss = wave_sum(ss);
    const float rs = rsqrtf(ss * (1.f / 1024.f) + 1e-6f);
    if (layer == 0) {
#pragma unroll
      for (int i = 0; i < 4; ++i) *(float4*)(xr + i * 4) = make_float4(o[4 * i], o[4 * i + 1], o[4 * i + 2], o[4 * i + 3]);
      uint4 wa, wb;
      wa.x = pack2(o[0] * rs, o[1] * rs); wa.y = pack2(o[2] * rs, o[3] * rs); wa.z = pack2(o[4] * rs, o[5] * rs); wa.w = pack2(o[6] * rs, o[7] * rs);
      wb.x = pack2(o[8] * rs, o[9] * rs); wb.y = pack2(o[10] * rs, o[11] * rs); wb.z = pack2(o[12] * rs, o[13] * rs); wb.w = pack2(o[14] * rs, o[15] * rs);
      uint4* xw = (uint4*)(xn16 + (size_t)t * 1024 + lane * 16);
      xw[0] = wa; xw[1] = wb;
    } else {
      const float* fg = p.final_norm + lane * 16;
      float* y = p.out + OUT_Y + (size_t)t * 1024 + lane * 16;
#pragma unroll
      for (int i = 0; i < 4; ++i) {
        float4 g = *(const float4*)(fg + i * 4);
        *(float4*)(y + i * 4) = make_float4(o[4 * i] * rs * g.x, o[4 * i + 1] * rs * g.y, o[4 * i + 2] * rs * g.z, o[4 * i + 3] * rs * g.w);
      }
    }
  }
}

struct XInfo { int nloc, nx, rank, xr; };
__device__ __forceinline__ float reduce8(float v) {
  v += dpp_f<0xB1>(v); v += dpp_f<0x4E>(v); v += dpp_f<0x141>(v);
  return v;
}
__device__ __forceinline__ void ph_expert_u(const Params& p, const XInfo xi) {
  const int lane = threadIdx.x & 63, wid = threadIdx.x >> 6, g = lane >> 3, i8 = lane & 7;
  const u16* xn16 = (const u16*)(p.ws + OFF_XN);
  const int* idxs = (const int*)(p.ws + OFF_IDX);
  float* ph = (float*)(p.ws + OFF_PH);
  for (int c = xi.xr; c < 8; c += xi.nx) {
    const unsigned char* Us = (const unsigned char*)(p.ws + OFF_U8) + (size_t)c * 2097152;
    const unsigned lo = (unsigned)i8 * 16u;
    int t = xi.rank * 4 + wid;
    int e[16];
    {
      const int t0 = min(t, NTOK - 1);
      const int4* ip = (const int4*)(idxs + (size_t)t0 * 128 + g * 16);
#pragma unroll
      for (int j = 0; j < 4; ++j) { int4 q = ip[j]; e[4 * j] = q.x; e[4 * j + 1] = q.y; e[4 * j + 2] = q.z; e[4 * j + 3] = q.w; }
    }
    for (; t < NTOK; t += xi.nloc * 4) {
      uint4 seg[16];
#pragma unroll
      for (int j = 0; j < 16; ++j) seg[j] = *(const uint4*)(Us + ((unsigned)e[j] * 128u + lo));
      v2f x2[8];
      {
        const uint4* xr = (const uint4*)(xn16 + (size_t)t * 1024 + c * 128 + i8 * 16);
        uint4 xa = xr[0], xb = xr[1];
        x2[0] = v2f{bflo(xa.x), bfhi(xa.x)}; x2[1] = v2f{bflo(xa.y), bfhi(xa.y)};
        x2[2] = v2f{bflo(xa.z), bfhi(xa.z)}; x2[3] = v2f{bflo(xa.w), bfhi(xa.w)};
        x2[4] = v2f{bflo(xb.x), bfhi(xb.x)}; x2[5] = v2f{bflo(xb.y), bfhi(xb.y)};
        x2[6] = v2f{bflo(xb.z), bfhi(xb.z)}; x2[7] = v2f{bflo(xb.w), bfhi(xb.w)};
      }
      {
        const int tn = min(t + xi.nloc * 4, NTOK - 1);
        const int4* ip = (const int4*)(idxs + (size_t)tn * 128 + g * 16);
#pragma unroll
        for (int j = 0; j < 4; ++j) { int4 q = ip[j]; e[4 * j] = q.x; e[4 * j + 1] = q.y; e[4 * j + 2] = q.z; e[4 * j + 3] = q.w; }
      }
      float d[16];
#pragma unroll
      for (int j = 0; j < 16; ++j) d[j] = reduce8(dot16_fp8(seg[j], x2));
      if (i8 == 0) {
        float* o = ph + ((size_t)c * NTOK + t) * 128 + g * 16;
#pragma unroll
        for (int j = 0; j < 4; ++j) *(float4*)(o + 4 * j) = make_float4(d[4 * j], d[4 * j + 1], d[4 * j + 2], d[4 * j + 3]);
      }
    }
  }
}
__device__ __forceinline__ void ph_expert_combine(const Params& p) {
  const int* idxs = (const int*)(p.ws + OFF_IDX);
  float* gates = (float*)(p.ws + OFF_PGATE);
  const float* ph = (const float*)(p.ws + OFF_PH);
  const float* USC = (const float*)(p.ws + OFF_USC);
  const float* VSC = (const float*)(p.ws + OFF_VSC);
  for (int i = blockIdx.x * 256 + threadIdx.x; i < NTOK * 128; i += gridDim.x * 256) {
    float s = 0.f;
#pragma unroll
    for (int c = 0; c < 8; ++c) s += ph[(size_t)c * NTOK * 128 + i];
    const int e = idxs[i];
    const float h = s * USC[e];
    gates[i] = 0.5f * h * (1.f + erff(h * 0.70710678118654752f)) * gates[i] * VSC[e];
  }
}
__device__ __forceinline__ void ph_expert_v(const Params& p, const XInfo xi) {
  const int lane = threadIdx.x & 63, wid = threadIdx.x >> 6, g = lane >> 3, i8 = lane & 7;
  const int* idxs = (const int*)(p.ws + OFF_IDX);
  const float* wts = (const float*)(p.ws + OFF_PGATE);
  float* xres = (float*)(p.ws + OFF_X);
  for (int c = xi.xr; c < 8; c += xi.nx) {
    const unsigned char* Vs = (const unsigned char*)(p.ws + OFF_V8) + (size_t)c * 2097152;
    const unsigned lo = (unsigned)i8 * 16u;
    int t = xi.rank * 4 + wid;
    int e[16]; float w[16];
    {
      const int t0 = min(t, NTOK - 1);
      const int4* ip = (const int4*)(idxs + (size_t)t0 * 128 + g * 16);
      const float4* wp = (const float4*)(wts + (size_t)t0 * 128 + g * 16);
#pragma unroll
      for (int j = 0; j < 4; ++j) { int4 q = ip[j]; float4 r = wp[j]; e[4 * j] = q.x; e[4 * j + 1] = q.y; e[4 * j + 2] = q.z; e[4 * j + 3] = q.w; w[4 * j] = r.x; w[4 * j + 1] = r.y; w[4 * j + 2] = r.z; w[4 * j + 3] = r.w; }
    }
    for (; t < NTOK; t += xi.nloc * 4) {
      v2f o2[8];
#pragma unroll
      for (int i = 0; i < 8; ++i) o2[i] = v2f{0.f, 0.f};
      {
        uint4 seg[16];
#pragma unroll
        for (int j = 0; j < 16; ++j) seg[j] = *(const uint4*)(Vs + ((unsigned)e[j] * 128u + lo));
#pragma unroll
        for (int j = 0; j < 16; ++j) axpy16_fp8(w[j], seg[j], o2);
      }
      __builtin_amdgcn_sched_barrier(0);
      {
        const int tn = min(t + xi.nloc * 4, NTOK - 1);
        const int4* ip = (const int4*)(idxs + (size_t)tn * 128 + g * 16);
        const float4* wp = (const float4*)(wts + (size_t)tn * 128 + g * 16);
#pragma unroll
        for (int j = 0; j < 4; ++j) { int4 q = ip[j]; float4 r = wp[j]; e[4 * j] = q.x; e[4 * j + 1] = q.y; e[4 * j + 2] = q.z; e[4 * j + 3] = q.w; w[4 * j] = r.x; w[4 * j + 1] = r.y; w[4 * j + 2] = r.z; w[4 * j + 3] = r.w; }
      }
      float o[16];
#pragma unroll
      for (int i = 0; i < 8; ++i) { o[2 * i] = o2[i].x; o[2 * i + 1] = o2[i].y; }
#pragma unroll
      for (int i = 0; i < 16; ++i) {
        float v = o[i];
        v += dpp_f<0x128>(v);
        v += __shfl_xor(v, 16);
        v += __shfl_xor(v, 32);
        o[i] = v;
        if ((i & 3) == 3) __builtin_amdgcn_sched_barrier(0);
      }
      if (g == 0) {
        float* xr = xres + (size_t)t * 1024 + c * 128 + i8 * 16;
#pragma unroll
        for (int i = 0; i < 4; ++i) {
          float4 r = *(const float4*)(xr + i * 4);
          *(float4*)(xr + i * 4) = make_float4(r.x + o[4 * i], r.y + o[4 * i + 1], r.z + o[4 * i + 2], r.w + o[4 * i + 3]);
        }
      }
    }
  }
}
__device__ __forceinline__ void ph_post_norm(const Params& p, int layer) {
  const int lane = threadIdx.x & 63, wid = threadIdx.x >> 6;
  const float* xres = (const float*)(p.ws + OFF_X);
  u16* xn16 = (u16*)(p.ws + OFF_XN);
  for (int u = blockIdx.x; u < 4352; u += gridDim.x) {
    const int t = u * 4 + wid;
    const float* x = xres + (size_t)t * 1024;
    float4 v[4]; float ss = 0.f;
#pragma unroll
    for (int i = 0; i < 4; ++i) {
      v[i] = *(const float4*)(x + i * 256 + lane * 4);
      ss += v[i].x * v[i].x + v[i].y * v[i].y + v[i].z * v[i].z + v[i].w * v[i].w;
    }
    ss = wave_sum(ss);
    const float r = rsqrtf(ss * (1.f / 1024.f) + 1e-6f);
    if (layer == 0) {
#pragma unroll
      for (int i = 0; i < 4; ++i) {
        uint2 w; w.x = pack2(v[i].x * r, v[i].y * r); w.y = pack2(v[i].z * r, v[i].w * r);
        *(uint2*)(xn16 + (size_t)t * 1024 + i * 256 + lane * 4) = w;
      }
    } else {
      float* y = p.out + OUT_Y + (size_t)t * 1024;
#pragma unroll
      for (int i = 0; i < 4; ++i) {
        float4 gg = *(const float4*)(p.final_norm + i * 256 + lane * 4);
        *(float4*)(y + i * 256 + lane * 4) = make_float4(v[i].x * r * gg.x, v[i].y * r * gg.y, v[i].z * r * gg.z, v[i].w * r * gg.w);
      }
    }
  }
}

__device__ __forceinline__ void ph_attn(const Params& p, char* smem) {
  const int tid = threadIdx.x, lane = tid & 63, wid = tid >> 6, fr = lane & 15, fq = lane >> 4;
  const u16* k16 = (const u16*)(p.ws + OFF_K16);
  const u16* v16 = (const u16*)(p.ws + OFF_V16A);
  const u16* q16 = (const u16*)(p.ws + OFF_Q16);
  u16* o16 = (u16*)(p.ws + OFF_O16);
  u16* Ks = (u16*)smem;
  u16* Vt = (u16*)(smem + 27648);
  for (int item = blockIdx.x; item < 1536; item += gridDim.x) {
    const bool is_p = item < 1024;
    int b, kvh, q0 = 0, nsub, nvalid, kpos0, minpos, tokbase;
    if (is_p) { b = item >> 7; kvh = (item >> 5) & 3; q0 = (item & 31) * 64; nsub = 4; nvalid = 192; kpos0 = q0 - 128; minpos = 0; tokbase = b * 2048; }
    else { int it2 = item - 1024; b = it2 >> 2; kvh = it2 & 3; nsub = 1; nvalid = 136; kpos0 = -128; minpos = -100000; tokbase = NTP + b * 8; }
    __syncthreads();
    for (int c = tid; c < 1536; c += 256) {
      const int j = c >> 3, ch = c & 7;
      uint4 kk = make_uint4(0, 0, 0, 0), vv = make_uint4(0, 0, 0, 0);
      if (is_p) {
        const int kp = kpos0 + j;
        if (kp >= 0) {
          const size_t off = (size_t)(tokbase + kp) * 256 + kvh * 64 + ch * 8;
          kk = *(const uint4*)(k16 + off); vv = *(const uint4*)(v16 + off);
        }
      } else {
        if (j < 128) {
          const size_t off = ((size_t)(b * 128 + j) * 4 + kvh) * 64 + ch * 8;
          float4 a0 = *(const float4*)(p.cache_k + off), a1 = *(const float4*)(p.cache_k + off + 4);
          float4 c0 = *(const float4*)(p.cache_v + off), c1 = *(const float4*)(p.cache_v + off + 4);
          kk.x = pack2(a0.x, a0.y); kk.y = pack2(a0.z, a0.w); kk.z = pack2(a1.x, a1.y); kk.w = pack2(a1.z, a1.w);
          vv.x = pack2(c0.x, c0.y); vv.y = pack2(c0.z, c0.w); vv.z = pack2(c1.x, c1.y); vv.w = pack2(c1.z, c1.w);
        } else if (j < 136) {
          const size_t off = (size_t)(tokbase + j - 128) * 256 + kvh * 64 + ch * 8;
          kk = *(const uint4*)(k16 + off); vv = *(const uint4*)(v16 + off);
        }
      }
      *(uint4*)(Ks + j * 72 + ch * 8) = kk;
      u16* vd = Vt + (ch * 8) * 200 + j;
      vd[0] = (u16)(vv.x & 0xffff); vd[200] = (u16)(vv.x >> 16);
      vd[400] = (u16)(vv.y & 0xffff); vd[600] = (u16)(vv.y >> 16);
      vd[800] = (u16)(vv.z & 0xffff); vd[1000] = (u16)(vv.z >> 16);
      vd[1200] = (u16)(vv.w & 0xffff); vd[1400] = (u16)(vv.w >> 16);
    }
    __syncthreads();
    const int head = kvh * 4 + wid;
    const float sink = p.sinks[head];
#pragma unroll 1
    for (int sub = 0; sub < nsub; ++sub) {
      int qtok, qp;
      if (is_p) { qp = q0 + sub * 16 + fr; qtok = tokbase + qp; }
      else { qp = fr & 7; qtok = tokbase + (fr & 7); }
      const u16* qrow = q16 + (size_t)qtok * 1024 + head * 64;
      const bf16x8 qf0 = *(const bf16x8*)(qrow + fq * 8);
      const bf16x8 qf1 = *(const bf16x8*)(qrow + 32 + fq * 8);
      f32x4 s[12];
#pragma unroll
      for (int ks = 0; ks < 12; ++ks) {
        const bf16x8 kf0 = *(const bf16x8*)(Ks + (ks * 16 + fr) * 72 + fq * 8);
        const bf16x8 kf1 = *(const bf16x8*)(Ks + (ks * 16 + fr) * 72 + 32 + fq * 8);
        f32x4 z = {0.f, 0.f, 0.f, 0.f};
        z = __builtin_amdgcn_mfma_f32_16x16x32_bf16(kf0, qf0, z, 0, 0, 0);
        s[ks] = __builtin_amdgcn_mfma_f32_16x16x32_bf16(kf1, qf1, z, 0, 0, 0);
        if ((ks & 3) == 3) __builtin_amdgcn_sched_barrier(0);
      }
      float mx = sink;
      const int lo_ = max(minpos, qp - 127), hi_ = min(qp, kpos0 + nvalid - 1);
      const unsigned span_ = (unsigned)(hi_ - lo_);
      const int kp0_ = kpos0 + fq * 4 - lo_;
#pragma unroll
      for (int ks = 0; ks < 12; ++ks)
#pragma unroll
        for (int j = 0; j < 4; ++j) {
          const bool valid = (unsigned)(kp0_ + ks * 16 + j) <= span_;
          const float v = valid ? s[ks][j] : -1.0e30f;
          s[ks][j] = v;
          mx = fmaxf(mx, v);
          if (j == 3) __builtin_amdgcn_sched_barrier(0);
        }
      mx = fmaxf(mx, __shfl_xor(mx, 16));
      mx = fmaxf(mx, __shfl_xor(mx, 32));
      float sum = 0.f;
#pragma unroll
      for (int ks = 0; ks < 12; ++ks)
#pragma unroll
        for (int j = 0; j < 4; ++j) {
          const float pv = (s[ks][j] > -1.0e29f) ? __expf(s[ks][j] - mx) : 0.f;
          s[ks][j] = pv;
          sum += pv;
          if (j == 3) __builtin_amdgcn_sched_barrier(0);
        }
      sum += __shfl_xor(sum, 16);
      sum += __shfl_xor(sum, 32);
      sum += __expf(sink - mx);
      const float inv = 1.f / sum;
      f32x4 o[4];
#pragma unroll
      for (int d = 0; d < 4; ++d) o[d] = f32x4{0.f, 0.f, 0.f, 0.f};
#pragma unroll
      for (int kk = 0; kk < 6; ++kk) {
        union { bf16x8 v; unsigned u[4]; } pb;
        pb.u[0] = pack2(s[2 * kk][0], s[2 * kk][1]); pb.u[1] = pack2(s[2 * kk][2], s[2 * kk][3]);
        pb.u[2] = pack2(s[2 * kk + 1][0], s[2 * kk + 1][1]); pb.u[3] = pack2(s[2 * kk + 1][2], s[2 * kk + 1][3]);
#pragma unroll
        for (int d = 0; d < 4; ++d) {
          union { bf16x8 v; uint2 h[2]; } vf;
          const u16* vr = Vt + (d * 16 + fr) * 200 + fq * 4;
          vf.h[0] = *(const uint2*)(vr + (2 * kk) * 16);
          vf.h[1] = *(const uint2*)(vr + (2 * kk + 1) * 16);
          o[d] = __builtin_amdgcn_mfma_f32_16x16x32_bf16(vf.v, pb.v, o[d], 0, 0, 0);
        }
        __builtin_amdgcn_sched_barrier(0);
      }
      if (is_p || fr < 8) {
#pragma unroll
        for (int d = 0; d < 4; ++d) {
          uint2 w; w.x = pack2(o[d][0] * inv, o[d][1] * inv); w.y = pack2(o[d][2] * inv, o[d][3] * inv);
          *(uint2*)(o16 + (size_t)qtok * 1024 + head * 64 + d * 16 + fq * 4) = w;
        }
      }
    }
  }
}


#define XB_TMO      128
#define XB_XCNT(j)  (256  + 64 * (j))
#define XB_XSUB(j)  (1280 + 64 * (j))
#define XB_XGEN(j)  (2304 + 64 * (j))
#define XB_TOP      3328
#define XB_TOPGEN   3392
#define XCD_BAR_WORDS 3456
#define XB_SPIN_CAP (1u << 20)
#define LAS __attribute__((address_space(3)))
__device__ __forceinline__ unsigned xb_ld(unsigned* p) { return __hip_atomic_load(p, __ATOMIC_RELAXED, __HIP_MEMORY_SCOPE_AGENT); }
__device__ __forceinline__ unsigned xb_add(unsigned* p, unsigned v) { return __hip_atomic_fetch_add(p, v, __ATOMIC_RELAXED, __HIP_MEMORY_SCOPE_AGENT); }
__device__ __forceinline__ unsigned xb_xcc_id() { return (unsigned)__builtin_amdgcn_s_getreg((3 << 11) | 20) & 0xFu; }
#define XB_SPIN(cond, bar) do { unsigned _sp = 0; while (cond) { __builtin_amdgcn_s_sleep(1); \
    if ((++_sp & 255u) == 0u) { if (xb_ld(&(bar)[XB_TMO])) break; if (_sp > XB_SPIN_CAP) { atomicAdd(&(bar)[XB_TMO], 1u); break; } } } } while (0)
struct XcdBarrier { unsigned* bar; unsigned x; volatile LAS unsigned* st; };
__device__ __forceinline__ XcdBarrier xcd_barrier_post(unsigned* bar, volatile LAS unsigned* st) {
  XcdBarrier b; b.bar = bar; b.x = xb_xcc_id(); b.st = st;
  if (threadIdx.x == 0) st[2] = xb_add(&bar[XB_XCNT(b.x)], 1u);
  return b;
}
__device__ __forceinline__ void xcd_barrier_complete(unsigned* bar, unsigned x, unsigned& nloc, unsigned& nx, unsigned& xr) {
  const unsigned G = gridDim.x * gridDim.y * gridDim.z;
  unsigned sum, cnt, mine, below, sp = 0u;
  for (;;) {
    sum = 0u; cnt = 0u; mine = 0u; below = 0u;
#pragma unroll
    for (unsigned j = 0; j < 16; ++j) { const unsigned c = xb_ld(&bar[XB_XCNT(j)]); sum += c; cnt += (c > 0u) ? 1u : 0u; mine = (j == x) ? c : mine; below += (j < x && c > 0u) ? 1u : 0u; }
    if (sum == G) break;
    __builtin_amdgcn_s_sleep(1);
    if ((++sp & 255u) == 0u) { if (xb_ld(&bar[XB_TMO])) break; if (sp > XB_SPIN_CAP) { atomicAdd(&bar[XB_TMO], 1u); break; } }
  }
  nloc = mine > 0u ? mine : 1u; nx = cnt > 0u ? cnt : 1u; xr = below;
}
__device__ __forceinline__ void xcd_barrier(const XcdBarrier& b) {
  asm volatile("s_waitcnt vmcnt(0)" ::: "memory");
  __syncthreads();
  if (threadIdx.x == 0) {
    unsigned* bar = b.bar;
    __builtin_amdgcn_s_waitcnt(0);
    unsigned nloc = b.st[0], nx = b.st[1];
    if (nloc == 0u) { unsigned xr; xcd_barrier_complete(bar, b.x, nloc, nx, xr); b.st[0] = nloc; b.st[1] = nx; b.st[3] = xr; }
    const unsigned old = xb_add(&bar[XB_XSUB(b.x)], 1u);
    const unsigned gen = old / nloc;
    if (old + 1u == (gen + 1u) * nloc) {
      __builtin_amdgcn_fence(__ATOMIC_RELEASE, "agent");
      asm volatile("s_waitcnt vmcnt(0)" ::: "memory");
      const unsigned og = xb_add(&bar[XB_TOP], 1u);
      const unsigned tg = og / nx;
      if (og + 1u == (tg + 1u) * nx) xb_add(&bar[XB_TOPGEN], 1u);
      else XB_SPIN(xb_ld(&bar[XB_TOPGEN]) == tg, bar);
      __builtin_amdgcn_fence(__ATOMIC_ACQUIRE, "agent");
      xb_add(&bar[XB_XGEN(b.x)], 1u);
      asm volatile("s_waitcnt vmcnt(0)" ::: "memory");
    } else {
      XB_SPIN(xb_ld(&bar[XB_XGEN(b.x)]) == gen, bar);
      __builtin_amdgcn_fence(__ATOMIC_ACQUIRE, "agent");
      asm volatile("s_waitcnt vmcnt(0)" ::: "memory");
    }
  }
  __syncthreads();
}

typedef const Params __attribute__((address_space(4))) CParams;
__device__ __forceinline__ Params load_params(CParams* q) {
  Params r;
  r.x_prompt = q->x_prompt;
  r.x_sample = q->x_sample;
  r.state_conv = q->state_conv;
  r.state_h = q->state_h;
  r.cache_k = q->cache_k;
  r.cache_v = q->cache_v;
  r.rg_norm = q->rg_norm;
  r.rg_w_in = q->rg_w_in;
  r.rg_conv_w = q->rg_conv_w;
  r.rg_conv_b = q->rg_conv_b;
  r.rg_wa = q->rg_wa;
  r.rg_ba = q->rg_ba;
  r.rg_wx = q->rg_wx;
  r.rg_bx = q->rg_bx;
  r.rg_lambda = q->rg_lambda;
  r.rg_w_out = q->rg_w_out;
  r.kv_norm = q->kv_norm;
  r.w_kv = q->w_kv;
  r.attn_norm = q->attn_norm;
  r.w_q = q->w_q;
  r.sinks = q->sinks;
  r.w_o = q->w_o;
  r.ffn_norm = q->ffn_norm;
  r.peer_wq = q->peer_wq;
  r.peer_subkeys = q->peer_subkeys;
  r.peer_u = q->peer_u;
  r.peer_v = q->peer_v;
  r.final_norm = q->final_norm;
  r.out = q->out;
  r.ws = q->ws;
  r.ph_begin = q->ph_begin;
  r.ph_end = q->ph_end;
  return r;
}

template <int ph>
__device__ __forceinline__ void run_phase(const Params& p, char* smem, const XInfo xi) {
  char* ws = p.ws;
  switch (ph) {
    case 0: ph_convert0(p, smem); break;
    case 1: {
      EpiWin e{(u16*)(ws + OFF_GATE16), (float*)(ws + OFF_REC32)};
      gemm_tiles((const u16*)(ws + OFF_XN), 1024, (const u16*)(ws + OFF_WT_IN), 1024, 1024, 0, 16, e, smem);
    } break;
    case 2: ph_conv(p); break;
    case 3: {
      EpiBd e{(float*)(ws + OFF_LOGA), (u16*)(ws + OFF_IG16), p.rg_ba, p.rg_bx, p.rg_lambda};
      gemm_tiles((const u16*)(ws + OFF_XC16), 1024, (const u16*)(ws + OFF_WT_BD), 128, 128, 8, 16, e, smem);
    } break;
    case 4: ph_scanA(p); break;
    case 20: ph_scanA2(p); break;
    case 5: ph_scanB(p); break;
    case 6: {
      EpiResid e{p.x_prompt, p.x_sample, (float*)(ws + OFF_X), 1};
      gemm_tiles((const u16*)(ws + OFF_HG16), 1024, (const u16*)(ws + OFF_WT_OUT), 1024, 1024, 0, 8, e, smem);
      ph_cvt_tables(p, 0);
    } break;
    case 7: ph_rmsnorm(p, p.ffn_norm); break;
    case 8: case 16: {
      EpiScoresTopk e{(const u16*)(ws + (ph == 8 ? OFF_WT_SK0 : OFF_WT_SK1)), (int*)(ws + OFF_TKEY), smem};
      gemm_tiles((const u16*)(ws + OFF_XN), 1024, (const u16*)(ws + (ph == 8 ? OFF_WT_PQ0 : OFF_WT_PQ1)), 1024, 1024, 0, 16, e, smem);
    } break;
    case 9: case 17: {
      EpiTopk e{(int*)(ws + OFF_TKEY), smem};
      gemm_tiles((const u16*)(ws + OFF_QP16), 2048, (const u16*)(ws + (ph == 9 ? OFF_WT_SK0 : OFF_WT_SK1)), 128, 128, 16, 16, e, smem);
    } break;
    case 10: case 18: ph_topk(p, smem); break;
    case 11: case 19: ph_expert_u(p, xi); break;
    case 21: case 24: ph_expert_combine(p); break;
    case 22: case 25: ph_expert_v(p, xi); break;
    case 23: ph_post_norm(p, 0); break;
    case 26: ph_post_norm(p, 1); break;
    case 12: {
      EpiKvq e{(u16*)(ws + OFF_K16), (u16*)(ws + OFF_V16A), (u16*)(ws + OFF_Q16), (const float2*)(ws + OFF_ROPE), p.out};
      gemm_tiles((const u16*)(ws + OFF_XN), 1024, (const u16*)(ws + OFF_WT_KVQ), 1024, 1024, 0, 12, e, smem);
      ph_cvt_tables(p, 1);
    } break;
    case 13: ph_attn(p, smem); break;
    case 14: {
      EpiResid e{p.x_prompt, p.x_sample, (float*)(ws + OFF_X), 0};
      gemm_tiles((const u16*)(ws + OFF_O16), 1024, (const u16*)(ws + OFF_WT_O), 1024, 1024, 0, 8, e, smem);
    } break;
    case 15: ph_rmsnorm(p, p.ffn_norm + 1024); break;
    default: break;
  }
}

__global__ void __launch_bounds__(256, 2) yoco_megakernel(Params p) {
  __shared__ __attribute__((aligned(16))) char smem[73728];
  __shared__ uint4 xb_words;
  cg::grid_group grid = cg::this_grid();
  if (threadIdx.x == 0) xb_words = make_uint4(0u, 0u, 0u, 0u);
  __syncthreads();
  XcdBarrier xb = xcd_barrier_post((unsigned*)(p.ws + OFF_BAR), (volatile LAS unsigned*)&xb_words);
  if (p.ph_end > 1000) grid.sync();
#define LAUNDER(q) CParams* q = (CParams*)__builtin_amdgcn_kernarg_segment_ptr(); asm volatile("" : "+s"(q));
#define PH(k) run_phase<k>(p, smem, xi); xcd_barrier(xb);
  XInfo xi; xi.nloc = 1; xi.nx = 1; xi.rank = 0; xi.xr = 0;
  PH(0)
  { volatile LAS unsigned* st = (volatile LAS unsigned*)&xb_words; xi.nloc = __builtin_amdgcn_readfirstlane((int)st[0]); xi.nx = __builtin_amdgcn_readfirstlane((int)st[1]); xi.rank = __builtin_amdgcn_readfirstlane((int)st[2]); xi.xr = __builtin_amdgcn_readfirstlane((int)st[3]); }
  PH(1) PH(2) PH(3) PH(4) PH(20) PH(5) PH(6) PH(7) PH(8)
  PH(10) PH(11) PH(21) PH(22) PH(23) PH(12) PH(13) PH(14) PH(15) PH(16) PH(18) PH(19) PH(24) PH(25)
  run_phase<26>(p, smem, xi);
}

extern "C" void kernel_launch(void* const* d_in, const int* in_sizes, int n_in, void* d_out, int out_size,
                              void* d_ws, size_t ws_size, hipStream_t stream) {
  static int grid_blocks = 0;
  if (!grid_blocks) {
    int dev = 0, cus = 0, per_cu = 0;
    hipGetDevice(&dev);
    hipDeviceGetAttribute(&cus, hipDeviceAttributeMultiprocessorCount, dev);
    hipOccupancyMaxActiveBlocksPerMultiprocessor(&per_cu, yoco_megakernel, 256, 0);
    if (per_cu > 2) per_cu = 2;
    if (per_cu < 1) per_cu = 1;
    grid_blocks = cus * per_cu;
    if (ws_size < WS_NEEDED) fprintf(stderr, "workspace too small: %zu < %llu\n", ws_size, (unsigned long long)WS_NEEDED);
  }
  Params p{};
  const float** f = (const float**)&p;
  for (int i = 0; i < 28; ++i) f[i] = (const float*)d_in[i];
  p.out = (float*)d_out;
  p.ws = (char*)d_ws;
  hipMemsetAsync((char*)d_ws + OFF_BAR, 0, XCD_BAR_WORDS * sizeof(unsigned), stream);
#if MULTI_LAUNCH
  for (int ph = 0; ph < NPHASE; ++ph) {
    p.ph_begin = ph; p.ph_end = ph + 1;
    hipLaunchKernelGGL(yoco_megakernel, dim3(grid_blocks), dim3(256), 0, stream, p);
  }
#else
  p.ph_begin = 0; p.ph_end = NPHASE;
  void* args[] = {&p};
  hipError_t e = hipLaunchCooperativeKernel((void*)yoco_megakernel, dim3(grid_blocks), dim3(256), args, 0, stream);
  if (e != hipSuccess) fprintf(stderr, "cooperative launch failed: %s (grid %d)\n", hipGetErrorString(e), grid_blocks);
#endif
}
```

```cpp
#include <hip/hip_runtime.h>
#include <hip/hip_cooperative_groups.h>
#include <cstdio>
#include <cstdint>
namespace cg = cooperative_groups;

typedef unsigned short u16;
typedef __attribute__((ext_vector_type(8))) short bf16x8;
typedef __attribute__((ext_vector_type(4))) float f32x4;

#define NTOK 17408
#define NTP 16384
#define MIB 1048576ull
#define NPHASE 20
#ifndef MULTI_LAUNCH
#define MULTI_LAUNCH 0
#endif

#define OFF_WT_IN   (0 * MIB)
#define OFF_WT_OUT  (4 * MIB)
#define OFF_WT_BD   (6 * MIB)
#define OFF_WT_PQ0  (7 * MIB)
#define OFF_WT_PQ1  (11 * MIB)
#define OFF_WT_KVQ  (15 * MIB)
#define OFF_WT_O    (18 * MIB)
#define OFF_WT_SK0  (20 * MIB)
#define OFF_WT_SK1  (20 * MIB + 524288ull)
#define OFF_ROPE    (21 * MIB)
#define OFF_USC     (21 * MIB + 655360ull)
#define OFF_VSC     (21 * MIB + 655360ull + 65536ull)
#define OFF_U8      (22 * MIB)
#define OFF_V8      (38 * MIB)
#define OFF_XN      (86 * MIB)
#define OFF_X       (120 * MIB)
#define OFF_GATE16  (188 * MIB)
#define OFF_REC32   (222 * MIB)
#define OFF_XC32    (290 * MIB)
#define OFF_XC16    (358 * MIB)
#define OFF_LOGA    (222 * MIB)
#define OFF_IG16    (22 * MIB)
#define OFF_AGGA    (56 * MIB)
#define OFF_AGGB    (60 * MIB)
#define OFF_HG16    (358 * MIB)
#define OFF_QP16    (188 * MIB)
#define OFF_S32     (256 * MIB)
#define OFF_PH      (256 * MIB)
#define OFF_TKEY    (256 * MIB)
#define OFF_IDX     (188 * MIB)
#define OFF_PGATE   (197 * MIB)
#define OFF_K16     (188 * MIB)
#define OFF_V16A    (197 * MIB)
#define OFF_Q16     (206 * MIB)
#define OFF_O16     (240 * MIB)
#define OFF_BAR     (392 * MIB)
#define WS_NEEDED   (392 * MIB + 16384ull)

#define OUT_Y      0
#define OUT_CONVP  17825792
#define OUT_HP     17850368
#define OUT_KP     17858560
#define OUT_VP     18120704
#define OUT_CONVS  18382848
#define OUT_HS     18776064
#define OUT_KS     18907136
#define OUT_VS     23101440

struct Params {
  const float *x_prompt, *x_sample, *state_conv, *state_h, *cache_k, *cache_v;
  const float *rg_norm, *rg_w_in, *rg_conv_w, *rg_conv_b, *rg_wa, *rg_ba, *rg_wx, *rg_bx, *rg_lambda, *rg_w_out;
  const float *kv_norm, *w_kv, *attn_norm, *w_q, *sinks, *w_o, *ffn_norm, *peer_wq, *peer_subkeys, *peer_u, *peer_v, *final_norm;
  float* out;
  char* ws;
  int ph_begin, ph_end;
};

__device__ __forceinline__ u16 f2bf(float f) {
  unsigned u = __float_as_uint(f);
  u += 0x7fffu + ((u >> 16) & 1u);
  return (u16)(u >> 16);
}
__device__ __forceinline__ float bf2f(u16 h) { return __uint_as_float(((unsigned)h) << 16); }
__device__ __forceinline__ unsigned pack2(float a, float b) { return (unsigned)f2bf(a) | ((unsigned)f2bf(b) << 16); }
__device__ __forceinline__ float bflo(unsigned u) { return __uint_as_float(u << 16); }
__device__ __forceinline__ float bfhi(unsigned u) { return __uint_as_float(u & 0xffff0000u); }
__device__ __forceinline__ float wave_sum(float v) {
#pragma unroll
  for (int o = 32; o > 0; o >>= 1) v += __shfl_xor(v, o);
  return v;
}
__device__ __forceinline__ const float* xin_row(const Params& p, int token) {
  return token < NTP ? p.x_prompt + (size_t)token * 1024 : p.x_sample + (size_t)(token - NTP) * 1024;
}
__device__ __forceinline__ float gelu_tanh(float x) {
  float u = 0.7978845608028654f * (x + 0.044715f * x * x * x);
  float e = __expf(2.f * u);
  float th = 1.f - 2.f / (e + 1.f);
  return 0.5f * x * (1.f + th);
}
__device__ __forceinline__ float sigmoidf_(float x) { return 1.f / (1.f + __expf(-x)); }

template <int CTRL>
__device__ __forceinline__ int dpp_i(int v) { return __builtin_amdgcn_update_dpp(v, v, CTRL, 0xf, 0xf, false); }
__device__ __forceinline__ int grp_max_i(int v) {
  v = max(v, dpp_i<0xB1>(v));
  v = max(v, dpp_i<0x4E>(v));
  v = max(v, dpp_i<0x141>(v));
  v = max(v, dpp_i<0x140>(v));
  return v;
}
__device__ __forceinline__ float grp_max_f(float v) {
  v = fmaxf(v, __int_as_float(dpp_i<0xB1>(__float_as_int(v))));
  v = fmaxf(v, __int_as_float(dpp_i<0x4E>(__float_as_int(v))));
  v = fmaxf(v, __int_as_float(dpp_i<0x141>(__float_as_int(v))));
  v = fmaxf(v, __int_as_float(dpp_i<0x140>(__float_as_int(v))));
  return v;
}
__device__ __forceinline__ float grp_sum_f(float v) {
  v += __int_as_float(dpp_i<0xB1>(__float_as_int(v)));
  v += __int_as_float(dpp_i<0x4E>(__float_as_int(v)));
  v += __int_as_float(dpp_i<0x141>(__float_as_int(v)));
  v += __int_as_float(dpp_i<0x140>(__float_as_int(v)));
  return v;
}

__device__ __forceinline__ void transpose_unit(const float* __restrict__ src, int ld_src, u16* __restrict__ dst, int ld_dst,
                               int kt, int nt, const float* __restrict__ gain, float* lds) {
  const int tid = threadIdx.x;
#pragma unroll
  for (int j = 0; j < 4; ++j) {
    int idx = tid + j * 256;
    int k = idx >> 4, c4 = idx & 15;
    float4 v = *(const float4*)(src + (size_t)(kt * 64 + k) * ld_src + nt * 64 + c4 * 4);
    float g = gain ? gain[kt * 64 + k] : 1.f;
    float* d = lds + k * 65 + c4 * 4;
    d[0] = v.x * g; d[1] = v.y * g; d[2] = v.z * g; d[3] = v.w * g;
  }
  __syncthreads();
#pragma unroll
  for (int j = 0; j < 2; ++j) {
    int c = tid + j * 256;
    int n = c >> 3, kc = c & 7;
    uint4 o;
    o.x = pack2(lds[(kc * 8 + 0) * 65 + n], lds[(kc * 8 + 1) * 65 + n]);
    o.y = pack2(lds[(kc * 8 + 2) * 65 + n], lds[(kc * 8 + 3) * 65 + n]);
    o.z = pack2(lds[(kc * 8 + 4) * 65 + n], lds[(kc * 8 + 5) * 65 + n]);
    o.w = pack2(lds[(kc * 8 + 6) * 65 + n], lds[(kc * 8 + 7) * 65 + n]);
    *(uint4*)(dst + (size_t)(nt * 64 + n) * ld_dst + kt * 64 + kc * 8) = o;
  }
  __syncthreads();
}

__device__ __forceinline__ void transpose_job(const Params& p, int u, float* lds) {
  char* ws = p.ws;
  if (u < 512) { transpose_unit(p.rg_w_in, 2048, (u16*)(ws + OFF_WT_IN), 1024, u >> 5, u & 31, nullptr, lds); return; }
  u -= 512;
  if (u < 256) { transpose_unit(p.rg_w_out, 1024, (u16*)(ws + OFF_WT_OUT), 1024, u >> 4, u & 15, nullptr, lds); return; }
  u -= 256;
  if (u < 64) {
    int which = u >> 5; int r = u & 31; int bi = r >> 2; int t = r & 3;
    const float* src = (which ? p.rg_wx : p.rg_wa) + (size_t)bi * 16384;
    u16* dst = (u16*)(ws + OFF_WT_BD) + (size_t)(which * 1024 + bi * 128) * 128;
    transpose_unit(src, 128, dst, 128, t >> 1, t & 1, nullptr, lds); return;
  }
  u -= 64;
  if (u < 1024) {
    int l = u >> 9; int r = u & 511;
    transpose_unit(p.peer_wq + (size_t)l * 2097152, 2048, (u16*)(ws + (l ? OFF_WT_PQ1 : OFF_WT_PQ0)), 1024, r >> 5, r & 31, nullptr, lds); return;
  }
  u -= 1024;
  if (u < 128) { transpose_unit(p.w_kv, 512, (u16*)(ws + OFF_WT_KVQ), 1024, u >> 3, u & 7, p.kv_norm, lds); return; }
  u -= 128;
  if (u < 256) { transpose_unit(p.w_q, 1024, (u16*)(ws + OFF_WT_KVQ) + (size_t)512 * 1024, 1024, u >> 4, u & 15, p.attn_norm, lds); return; }
  u -= 256;
  transpose_unit(p.w_o, 1024, (u16*)(ws + OFF_WT_O), 1024, u >> 4, u & 15, nullptr, lds);
}

__device__ __forceinline__ void cvt_unit(const float* __restrict__ src, u16* __restrict__ dst, size_t base) {
  const int tid = threadIdx.x;
#pragma unroll
  for (int j = 0; j < 2; ++j) {
    size_t o = base + j * 1024 + tid * 4;
    float4 v = *(const float4*)(src + o);
    uint2 w; w.x = pack2(v.x, v.y); w.y = pack2(v.z, v.w);
    *(uint2*)(dst + o) = w;
  }
}

__device__ __forceinline__ void rmsnorm_row(const float* __restrict__ x, const float* __restrict__ g, u16* __restrict__ o, int lane) {
  float4 v[4];
  float ss = 0.f;
#pragma unroll
  for (int i = 0; i < 4; ++i) {
    v[i] = *(const float4*)(x + i * 256 + lane * 4);
    ss += v[i].x * v[i].x + v[i].y * v[i].y + v[i].z * v[i].z + v[i].w * v[i].w;
  }
  ss = wave_sum(ss);
  float r = rsqrtf(ss * (1.f / 1024.f) + 1e-6f);
#pragma unroll
  for (int i = 0; i < 4; ++i) {
    float4 gg = *(const float4*)(g + i * 256 + lane * 4);
    uint2 w; w.x = pack2(v[i].x * r * gg.x, v[i].y * r * gg.y); w.y = pack2(v[i].z * r * gg.z, v[i].w * r * gg.w);
    *(uint2*)(o + i * 256 + lane * 4) = w;
  }
}

__device__ __forceinline__ void ph_convert0(const Params& p, char* smem) {
  const int tid = threadIdx.x, lane = tid & 63, wid = tid >> 6;
  const int NT = 2496, NSK = 256, NROPE = 257, NRMS = 4352, NCACHE = 3840;
  const int total = NT + NSK + NROPE + NRMS + NCACHE;
  for (int u0 = blockIdx.x; u0 < total; u0 += gridDim.x) {
    int u = u0;
    if (u < NT) { transpose_job(p, u, (float*)smem); continue; }
    u -= NT;
    if (u < NSK) {
      int l = u >> 7; int r = u & 127;
      const float* src = p.peer_subkeys + (size_t)l * 32768;
      u16* dst = (u16*)(p.ws + (l ? OFF_WT_SK1 : OFF_WT_SK0));
#pragma unroll
      for (int j = 0; j < 2; ++j) {
        int i = r * 2048 + j * 1024 + tid * 4;
        int s = ((i >> 14) & 1) * 16384 + (i & 16383);
        float4 v = *(const float4*)(src + s);
        uint2 w; w.x = pack2(v.x, v.y); w.y = pack2(v.z, v.w);
        *(uint2*)(dst + i) = w;
      }
      continue;
    }
    u -= NSK;
    if (u < NROPE) {
      int i = u * 256 + tid;
      if (i < 2056 * 32) {
        int pi = i >> 5, d = i & 31;
        int pos = pi < 2048 ? pi : (16384 + pi - 2048);
        float inv = (float)pow(10000.0, -(double)d / 32.0);
        float ang = (float)pos * inv;
        double sn, cs;
        sincos((double)ang, &sn, &cs);
        float2* rt = (float2*)(p.ws + OFF_ROPE);
        rt[i] = make_float2((float)cs, (float)sn);
      }
      continue;
    }
    u -= NROPE;
    if (u < NRMS) {
      int t = u * 4 + wid;
      rmsnorm_row(xin_row(p, t), p.rg_norm, (u16*)(p.ws + OFF_XN) + (size_t)t * 1024, lane);
      continue;
    }
    u -= NRMS;
    {
      int which = u / 1920; int r = u - which * 1920;
      int b = r / 15, c = r - b * 15;
      const float* src = (which ? p.cache_v : p.cache_k) + (size_t)b * 32768 + 2048 + c * 2048;
      float* dst = p.out + (which ? OUT_VS : OUT_KS) + (size_t)b * 32768 + c * 2048;
#pragma unroll
      for (int j = 0; j < 2; ++j) {
        int o = j * 1024 + tid * 4;
        *(float4*)(dst + o) = *(const float4*)(src + o);
      }
    }
  }
}

__device__ __forceinline__ void ph_cvt_tables(const Params& p, int layer) {
  const int lane = threadIdx.x & 63, wid = threadIdx.x >> 6;
  for (int u = blockIdx.x; u < 8192; u += gridDim.x) {
    const int which = u >> 12; const int row = (u & 4095) * 4 + wid;
    const float* src = (which ? p.peer_v : p.peer_u) + (size_t)layer * 16777216 + (size_t)row * 1024 + lane * 16;
    unsigned char* dst = (unsigned char*)(p.ws + (which ? OFF_V8 : OFF_U8)) + (size_t)(lane >> 3) * 2097152 + (size_t)row * 128 + (lane & 7) * 16;
    float* sc = (float*)(p.ws + (which ? OFF_VSC : OFF_USC));
    float4 a = *(const float4*)(src), b = *(const float4*)(src + 4), c = *(const float4*)(src + 8), d = *(const float4*)(src + 12);
    float m = fmaxf(fmaxf(fmaxf(fabsf(a.x), fabsf(a.y)), fmaxf(fabsf(a.z), fabsf(a.w))), fmaxf(fmaxf(fabsf(b.x), fabsf(b.y)), fmaxf(fabsf(b.z), fabsf(b.w))));
    m = fmaxf(m, fmaxf(fmaxf(fmaxf(fabsf(c.x), fabsf(c.y)), fmaxf(fabsf(c.z), fabsf(c.w))), fmaxf(fmaxf(fabsf(d.x), fabsf(d.y)), fmaxf(fabsf(d.z), fabsf(d.w)))));
#pragma unroll
    for (int o = 32; o > 0; o >>= 1) m = fmaxf(m, __shfl_xor(m, o));
    const float scl = m > 0.f ? 440.f / m : 1.f;
    uint4 w; int t;
    t = 0; t = __builtin_amdgcn_cvt_pk_fp8_f32(a.x * scl, a.y * scl, t, false); t = __builtin_amdgcn_cvt_pk_fp8_f32(a.z * scl, a.w * scl, t, true); w.x = (unsigned)t;
    t = 0; t = __builtin_amdgcn_cvt_pk_fp8_f32(b.x * scl, b.y * scl, t, false); t = __builtin_amdgcn_cvt_pk_fp8_f32(b.z * scl, b.w * scl, t, true); w.y = (unsigned)t;
    t = 0; t = __builtin_amdgcn_cvt_pk_fp8_f32(c.x * scl, c.y * scl, t, false); t = __builtin_amdgcn_cvt_pk_fp8_f32(c.z * scl, c.w * scl, t, true); w.z = (unsigned)t;
    t = 0; t = __builtin_amdgcn_cvt_pk_fp8_f32(d.x * scl, d.y * scl, t, false); t = __builtin_amdgcn_cvt_pk_fp8_f32(d.z * scl, d.w * scl, t, true); w.w = (unsigned)t;
    *(uint4*)dst = w;
    if (lane == 0) sc[row] = m > 0.f ? m / 440.f : 1.f;
  }
}

__device__ __forceinline__ void ph_rmsnorm(const Params& p, const float* g) {
  const int lane = threadIdx.x & 63, wid = threadIdx.x >> 6;
  const float* x = (const float*)(p.ws + OFF_X);
  u16* xn = (u16*)(p.ws + OFF_XN);
  for (int u = blockIdx.x; u < 4352; u += gridDim.x) {
    int t = u * 4 + wid;
    rmsnorm_row(x + (size_t)t * 1024, g, xn + (size_t)t * 1024, lane);
  }
}

#define LASP __attribute__((address_space(3)))
template <class Epi>
__device__ __forceinline__ void gemm_tiles(const u16* __restrict__ A, int lda, const u16* __restrict__ W, int ldw,
                                           int K, int kmod, int ntn, const Epi& epi, char* smem_g) {
  LASP unsigned char* smem = (LASP unsigned char*)smem_g;
  const int tid = threadIdx.x, lane = tid & 63, wid = tid >> 6;
  const int wr = wid >> 1, wc = wid & 1, fr = lane & 15, fq = lane >> 4;
  const int total = 136 * ntn;
  const int nk = K >> 6;
  int offA[4], offW[4];
#pragma unroll
  for (int i = 0; i < 4; ++i) {
    const int R = (i * 4 + wid) * 8 + (lane >> 3), C = ((lane & 7) ^ (lane >> 3)) * 8;
    offA[i] = R * lda + C; offW[i] = R * ldw + C;
  }
  const int lo0 = (fr >> 3) * 1024 + (fr & 7) * 128 + ((fq ^ (fr & 7)) * 16);
  const int lo1 = (fr >> 3) * 1024 + (fr & 7) * 128 + (((4 + fq) ^ (fr & 7)) * 16);
#define GEMM_STAGE(buf, Ag_, Wg_, k0_)                                                                          \
  _Pragma("unroll") for (int i = 0; i < 4; ++i) {                                                               \
    __builtin_amdgcn_global_load_lds((const unsigned*)((Wg_) + offW[i] + (k0_)), (LASP unsigned*)(smem + (buf) * 32768 + i * 4096 + wid * 1024), 16, 0, 0);         \
    __builtin_amdgcn_global_load_lds((const unsigned*)((Ag_) + offA[i] + (k0_)), (LASP unsigned*)(smem + (buf) * 32768 + 16384 + i * 4096 + wid * 1024), 16, 0, 0); \
  }
  for (int tile = blockIdx.x; tile < total; tile += gridDim.x) {
    const int tm = tile / ntn, tn = tile - tm * ntn;
    const u16* Ag = A + (size_t)(tm * 128) * lda + (kmod ? (tn % kmod) * 128 : 0);
    const u16* Wg = W + (size_t)(tn * 128) * ldw;
    f32x4 acc[4][4];
#pragma unroll
    for (int m = 0; m < 4; ++m)
#pragma unroll
      for (int n = 0; n < 4; ++n) acc[m][n] = f32x4{0.f, 0.f, 0.f, 0.f};
    __syncthreads();
    GEMM_STAGE(0, Ag, Wg, 0)
    for (int kt = 0; kt < nk; ++kt) {
      const int cur = kt & 1;
      asm volatile("s_waitcnt vmcnt(0)" ::: "memory");
      __syncthreads();
      const LASP unsigned char* sW = smem + cur * 32768 + wr * 8192;
      const LASP unsigned char* sA = smem + cur * 32768 + 16384 + wc * 8192;
      bf16x8 a[2][4], b[2][4];
#pragma unroll
      for (int m = 0; m < 4; ++m) { a[0][m] = *(const LASP bf16x8*)(sW + m * 2048 + lo0); a[1][m] = *(const LASP bf16x8*)(sW + m * 2048 + lo1); }
#pragma unroll
      for (int n = 0; n < 4; ++n) { b[0][n] = *(const LASP bf16x8*)(sA + n * 2048 + lo0); b[1][n] = *(const LASP bf16x8*)(sA + n * 2048 + lo1); }
      __builtin_amdgcn_sched_barrier(0);
      if (kt + 1 < nk) { GEMM_STAGE(cur ^ 1, Ag, Wg, (kt + 1) * 64) }
      __builtin_amdgcn_sched_barrier(0);
#pragma unroll
      for (int ks = 0; ks < 2; ++ks)
#pragma unroll
        for (int m = 0; m < 4; ++m)
#pragma unroll
          for (int n = 0; n < 4; ++n) acc[m][n] = __builtin_amdgcn_mfma_f32_16x16x32_bf16(a[ks][m], b[ks][n], acc[m][n], 0, 0, 0);
    }
    epi(acc, tm * 128 + wc * 64, tn * 128 + wr * 64, fr, fq);
  }
#undef GEMM_STAGE
}

struct EpiWin {
  u16* gate16; float* rec32;
  __device__ __forceinline__ void operator()(const f32x4 (&acc)[4][4], int tok0, int feat0, int fr, int fq) const {
#pragma unroll
    for (int n = 0; n < 4; ++n) {
      const int tok = tok0 + n * 16 + fr;
#pragma unroll
      for (int m = 0; m < 4; ++m) {
        const int f = feat0 + m * 16 + fq * 4;
        f32x4 v = acc[m][n];
        if (feat0 < 1024) {
          uint2 w; w.x = pack2(gelu_tanh(v[0]), gelu_tanh(v[1])); w.y = pack2(gelu_tanh(v[2]), gelu_tanh(v[3]));
          *(uint2*)(gate16 + (size_t)tok * 1024 + f) = w;
        } else {
          *(float4*)(rec32 + (size_t)tok * 1024 + (f - 1024)) = make_float4(v[0], v[1], v[2], v[3]);
        }
      }
    }
  }
};
struct EpiBd {
  float* loga; u16* ig16; const float *ba, *bx, *lam;
  __device__ __forceinline__ void operator()(const f32x4 (&acc)[4][4], int tok0, int feat0, int fr, int fq) const {
#pragma unroll
    for (int m = 0; m < 4; ++m) {
      const int f = feat0 + m * 16 + fq * 4;
      if (feat0 < 1024) {
        float4 b4 = *(const float4*)(ba + f);
        float4 l4 = *(const float4*)(lam + f);
        float sp0 = log1pf(__expf(-l4.x)), sp1 = log1pf(__expf(-l4.y)), sp2 = log1pf(__expf(-l4.z)), sp3 = log1pf(__expf(-l4.w));
#pragma unroll
        for (int n = 0; n < 4; ++n) {
          const int tok = tok0 + n * 16 + fr;
          f32x4 v = acc[m][n];
          float4 o;
          o.x = -8.f * sigmoidf_(v[0] + b4.x) * sp0;
          o.y = -8.f * sigmoidf_(v[1] + b4.y) * sp1;
          o.z = -8.f * sigmoidf_(v[2] + b4.z) * sp2;
          o.w = -8.f * sigmoidf_(v[3] + b4.w) * sp3;
          *(float4*)(loga + (size_t)tok * 1024 + f) = o;
        }
      } else {
        float4 b4 = *(const float4*)(bx + (f - 1024));
#pragma unroll
        for (int n = 0; n < 4; ++n) {
          const int tok = tok0 + n * 16 + fr;
          f32x4 v = acc[m][n];
          uint2 w;
          w.x = pack2(sigmoidf_(v[0] + b4.x), sigmoidf_(v[1] + b4.y));
          w.y = pack2(sigmoidf_(v[2] + b4.z), sigmoidf_(v[3] + b4.w));
          *(uint2*)(ig16 + (size_t)tok * 1024 + (f - 1024)) = w;
        }
      }
    }
  }
};
struct EpiResid {
  const float* xp; const float* xs; float* xres; int first;
  __device__ __forceinline__ void operator()(const f32x4 (&acc)[4][4], int tok0, int feat0, int fr, int fq) const {
#pragma unroll
    for (int n = 0; n < 4; ++n) {
      const int tok = tok0 + n * 16 + fr;
      const float* base = first ? (tok < NTP ? xp + (size_t)tok * 1024 : xs + (size_t)(tok - NTP) * 1024) : (xres + (size_t)tok * 1024);
#pragma unroll
      for (int m = 0; m < 4; ++m) {
        const int f = feat0 + m * 16 + fq * 4;
        float4 b = *(const float4*)(base + f);
        f32x4 v = acc[m][n];
        *(float4*)(xres + (size_t)tok * 1024 + f) = make_float4(b.x + v[0], b.y + v[1], b.z + v[2], b.w + v[3]);
      }
    }
  }
};
struct EpiBf16 {
  u16* o; int ld;
  __device__ __forceinline__ void operator()(const f32x4 (&acc)[4][4], int tok0, int feat0, int fr, int fq) const {
#pragma unroll
    for (int n = 0; n < 4; ++n) {
      const int tok = tok0 + n * 16 + fr;
#pragma unroll
      for (int m = 0; m < 4; ++m) {
        const int f = feat0 + m * 16 + fq * 4;
        f32x4 v = acc[m][n];
        uint2 w; w.x = pack2(v[0], v[1]); w.y = pack2(v[2], v[3]);
        *(uint2*)(o + (size_t)tok * ld + f) = w;
      }
    }
  }
};
struct EpiF32 {
  float* o; int ld;
  __device__ __forceinline__ void operator()(const f32x4 (&acc)[4][4], int tok0, int feat0, int fr, int fq) const {
#pragma unroll
    for (int n = 0; n < 4; ++n) {
      const int tok = tok0 + n * 16 + fr;
#pragma unroll
      for (int m = 0; m < 4; ++m) {
        const int f = feat0 + m * 16 + fq * 4;
        f32x4 v = acc[m][n];
        *(float4*)(o + (size_t)tok * ld + f) = make_float4(v[0], v[1], v[2], v[3]);
      }
    }
  }
};
__device__ __forceinline__ int mkkey(float v, int n) {
  int i = __float_as_int(v);
  i ^= (i >> 31) & 0x7fffffff;
  return (i & ~127) | (127 - n);
}
__device__ __forceinline__ float keyval(int k) {
  int i = (k & ~127) | 64;
  i ^= (i >> 31) & 0x7fffffff;
  return __int_as_float(i);
}
__device__ __forceinline__ int keyidx(int k) { return 127 - (k & 127); }
#define CE(i, j) { int hi_ = max(k[i], k[j]); int lo_ = min(k[i], k[j]); k[i] = hi_; k[j] = lo_; }

struct EpiTopk {
  int* tkey; char* smem;
  __device__ __forceinline__ void operator()(const f32x4 (&acc)[4][4], int tok0, int feat0, int fr, int fq) const {
    float* S = (float*)smem;
    const int tid = threadIdx.x, lane = tid & 63, wid = tid >> 6, g = lane >> 4, li = lane & 15;
    const int wc64 = tok0 & 127, wr64 = feat0 & 127;
    __syncthreads();
#pragma unroll
    for (int n = 0; n < 4; ++n)
#pragma unroll
      for (int m = 0; m < 4; ++m) {
        f32x4 v = acc[m][n];
        *(float4*)(S + (wc64 + n * 16 + fr) * 132 + wr64 + m * 16 + fq * 4) = make_float4(v[0], v[1], v[2], v[3]);
      }
    __syncthreads();
    const int tokbase = tok0 - wc64, hp = feat0 >> 7;
#pragma unroll 1
    for (int pass = 0; pass < 8; ++pass) {
      const int row = pass * 16 + wid * 4 + g;
      const float* r = S + row * 132;
      float4 v0 = *(const float4*)(r + li * 4), v1 = *(const float4*)(r + 64 + li * 4);
      int k[8];
      k[0] = mkkey(v0.x, li * 4 + 0); k[1] = mkkey(v0.y, li * 4 + 1); k[2] = mkkey(v0.z, li * 4 + 2); k[3] = mkkey(v0.w, li * 4 + 3);
      k[4] = mkkey(v1.x, 64 + li * 4 + 0); k[5] = mkkey(v1.y, 64 + li * 4 + 1); k[6] = mkkey(v1.z, 64 + li * 4 + 2); k[7] = mkkey(v1.w, 64 + li * 4 + 3);
      CE(0, 1) CE(2, 3) CE(4, 5) CE(6, 7)
      CE(0, 2) CE(1, 3) CE(4, 6) CE(5, 7)
      CE(1, 2) CE(5, 6)
      CE(0, 4) CE(1, 5) CE(2, 6) CE(3, 7)
      CE(2, 4) CE(3, 5)
      CE(1, 2) CE(3, 4) CE(5, 6)
      int res = (int)0x80000000;
#pragma unroll
      for (int it = 0; it < 16; ++it) {
        const int M = grp_max_i(k[0]);
        const bool win = (k[0] == M);
        if (li == it) res = M;
#pragma unroll
        for (int i = 0; i < 7; ++i) k[i] = win ? k[i + 1] : k[i];
        k[7] = win ? (int)0x80000000 : k[7];
      }
      tkey[((size_t)(tokbase + row) * 16 + hp) * 16 + li] = res;
    }
  }
};
struct EpiScoresTopk {
  const u16* sk; int* tkey; char* smem_g;
  __device__ __forceinline__ void operator()(const f32x4 (&acc)[4][4], int tok0, int feat0, int fr, int fq) const {
    LASP unsigned char* smem = (LASP unsigned char*)smem_g;
    const int tid = threadIdx.x, lane = tid & 63, wid = tid >> 6, wr = wid >> 1, wc = wid & 1;
    const int tn = feat0 >> 7;
    __syncthreads();
    {
      const int swz = (lane * 16) ^ ((lane >> 5) << 5);
#pragma unroll
      for (int i = 0; i < 4; ++i) {
        const int st = i * 4 + wid;
        const int R = (st >> 1) * 16 + (swz >> 6), C = (st & 1) * 32 + ((swz & 63) >> 1);
        const u16* src = sk + (size_t)(tn * 128 + R) * 128 + C;
        __builtin_amdgcn_global_load_lds((const unsigned*)src, (LASP unsigned*)(smem + i * 4096 + wid * 1024), 16, 0, 0);
        __builtin_amdgcn_global_load_lds((const unsigned*)(src + 64), (LASP unsigned*)(smem + 32768 + i * 4096 + wid * 1024), 16, 0, 0);
      }
    }
#pragma unroll
    for (int n = 0; n < 4; ++n)
#pragma unroll
      for (int m = 0; m < 4; ++m) {
        const int r = wc * 64 + n * 16 + fr, c = m * 16 + fq * 4;
        int ob = (r & 15) * 64 + (c & 31) * 2;
        ob ^= ((ob >> 9) & 1) << 5;
        const int off = wr * 32768 + 16384 + ((r >> 4) * 2 + (c >> 5)) * 1024 + ob;
        f32x4 v = acc[m][n];
        typedef unsigned u32x2_t __attribute__((ext_vector_type(2)));
        u32x2_t w; w.x = pack2(v[0], v[1]); w.y = pack2(v[2], v[3]);
        *(LASP u32x2_t*)(smem + off) = w;
      }
    asm volatile("s_waitcnt vmcnt(0)" ::: "memory");
    __syncthreads();
    f32x4 acc2[4][4];
#pragma unroll
    for (int m = 0; m < 4; ++m)
#pragma unroll
      for (int n = 0; n < 4; ++n) acc2[m][n] = f32x4{0.f, 0.f, 0.f, 0.f};
    const int lane_off = (fr * 64 + fq * 16) ^ ((fr >> 3) << 5);
#pragma unroll
    for (int kt2 = 0; kt2 < 2; ++kt2) {
      const LASP unsigned char* sW = smem + kt2 * 32768;
      const LASP unsigned char* sA = sW + 16384;
#pragma unroll
      for (int ks = 0; ks < 2; ++ks) {
        bf16x8 a[4], b[4];
#pragma unroll
        for (int m = 0; m < 4; ++m) a[m] = *(const LASP bf16x8*)(sW + (wr * 8 + m * 2 + ks) * 1024 + lane_off);
#pragma unroll
        for (int n = 0; n < 4; ++n) b[n] = *(const LASP bf16x8*)(sA + (wc * 8 + n * 2 + ks) * 1024 + lane_off);
#pragma unroll
        for (int m = 0; m < 4; ++m)
#pragma unroll
          for (int n = 0; n < 4; ++n) acc2[m][n] = __builtin_amdgcn_mfma_f32_16x16x32_bf16(a[m], b[n], acc2[m][n], 0, 0, 0);
      }
    }
    EpiTopk e{tkey, smem_g};
    e(acc2, tok0, feat0, fr, fq);
  }
};
struct EpiKvq {
  u16 *k16, *v16, *q16; const float2* rope; float* out;
  __device__ __forceinline__ void operator()(const f32x4 (&acc)[4][4], int tok0, int feat0, int fr, int fq) const {
#pragma unroll
    for (int n = 0; n < 4; ++n) {
      const int tok = tok0 + n * 16 + fr;
      int b, t, pi, orow; bool is_p = tok < NTP;
      if (is_p) { b = tok >> 11; t = tok & 2047; pi = t; orow = t - 1920; }
      else { int ts = tok - NTP; b = ts >> 3; t = ts & 7; pi = 2048 + t; orow = 120 + t; }
      if (feat0 >= 256 && feat0 < 512) {
        const int kvh = (feat0 - 256) >> 6;
#pragma unroll
        for (int m = 0; m < 4; ++m) {
          const int d = m * 16 + fq * 4;
          f32x4 v = acc[m][n];
          uint2 w; w.x = pack2(v[0], v[1]); w.y = pack2(v[2], v[3]);
          *(uint2*)(v16 + (size_t)tok * 256 + kvh * 64 + d) = w;
          if (orow >= 0) {
            float* dst = out + (is_p ? OUT_VP : OUT_VS) + ((size_t)(b * 128 + orow) * 4 + kvh) * 64 + d;
            *(float4*)dst = make_float4(v[0], v[1], v[2], v[3]);
          }
        }
      } else {
        const bool isk = feat0 < 256;
        const float sc = isk ? 1.f : 0.125f;
#pragma unroll
        for (int m = 0; m < 2; ++m) {
          const int d = m * 16 + fq * 4;
          f32x4 x1 = acc[m][n], x2 = acc[m + 2][n];
          const float2* rp = rope + pi * 32 + d;
          float o1[4], o2[4];
#pragma unroll
          for (int j = 0; j < 4; ++j) {
            float2 csn = rp[j];
            o1[j] = (x1[j] * csn.x - x2[j] * csn.y) * sc;
            o2[j] = (x2[j] * csn.x + x1[j] * csn.y) * sc;
          }
          uint2 w1, w2;
          w1.x = pack2(o1[0], o1[1]); w1.y = pack2(o1[2], o1[3]);
          w2.x = pack2(o2[0], o2[1]); w2.y = pack2(o2[2], o2[3]);
          if (isk) {
            const int kvh = feat0 >> 6;
            *(uint2*)(k16 + (size_t)tok * 256 + kvh * 64 + d) = w1;
            *(uint2*)(k16 + (size_t)tok * 256 + kvh * 64 + d + 32) = w2;
            if (orow >= 0) {
              float* dst = out + (is_p ? OUT_KP : OUT_KS) + ((size_t)(b * 128 + orow) * 4 + kvh) * 64 + d;
              *(float4*)dst = make_float4(o1[0], o1[1], o1[2], o1[3]);
              *(float4*)(dst + 32) = make_float4(o2[0], o2[1], o2[2], o2[3]);
            }
          } else {
            const int f = feat0 - 512;
            *(uint2*)(q16 + (size_t)tok * 1024 + f + d) = w1;
            *(uint2*)(q16 + (size_t)tok * 1024 + f + d + 32) = w2;
          }
        }
      }
    }
  }
};

__device__ __forceinline__ void ph_conv(const Params& p) {
  const float* rec = (const float*)(p.ws + OFF_REC32);
  float* xc32 = (float*)(p.ws + OFF_XC32);
  u16* xc16 = (u16*)(p.ws + OFF_XC16);
  const int c = threadIdx.x * 4;
  const float4 w0 = *(const float4*)(p.rg_conv_w + c), w1 = *(const float4*)(p.rg_conv_w + 1024 + c);
  const float4 w2 = *(const float4*)(p.rg_conv_w + 2048 + c), w3 = *(const float4*)(p.rg_conv_w + 3072 + c);
  const float4 cb = *(const float4*)(p.rg_conv_b + c);
  for (int u = blockIdx.x; u < NTOK / 8; u += gridDim.x) {
    const int tok0 = u * 8;
    int b, t0; const float* buf = nullptr;
    if (tok0 < NTP) { b = tok0 >> 11; t0 = tok0 & 2047; }
    else { b = (tok0 - NTP) >> 3; t0 = 0; buf = p.state_conv + (size_t)b * 3072; }
    float4 r1, r2, r3;
    const float4 z = make_float4(0.f, 0.f, 0.f, 0.f);
    if (t0 >= 3) {
      r1 = *(const float4*)(rec + (size_t)(tok0 - 1) * 1024 + c);
      r2 = *(const float4*)(rec + (size_t)(tok0 - 2) * 1024 + c);
      r3 = *(const float4*)(rec + (size_t)(tok0 - 3) * 1024 + c);
    } else if (buf) {
      r1 = *(const float4*)(buf + 2048 + c); r2 = *(const float4*)(buf + 1024 + c); r3 = *(const float4*)(buf + c);
    } else { r1 = z; r2 = z; r3 = z; }
    float4 r0[8];
#pragma unroll
    for (int s = 0; s < 8; ++s) r0[s] = *(const float4*)(rec + (size_t)(tok0 + s) * 1024 + c);
#pragma unroll
    for (int s = 0; s < 8; ++s) {
      const float4 x = r0[s];
      float4 o;
      o.x = cb.x + w3.x * x.x + w2.x * r1.x + w1.x * r2.x + w0.x * r3.x;
      o.y = cb.y + w3.y * x.y + w2.y * r1.y + w1.y * r2.y + w0.y * r3.y;
      o.z = cb.z + w3.z * x.z + w2.z * r1.z + w1.z * r2.z + w0.z * r3.z;
      o.w = cb.w + w3.w * x.w + w2.w * r1.w + w1.w * r2.w + w0.w * r3.w;
      const size_t off = (size_t)(tok0 + s) * 1024 + c;
      *(float4*)(xc32 + off) = o;
      uint2 w; w.x = pack2(o.x, o.y); w.y = pack2(o.z, o.w);
      *(uint2*)(xc16 + off) = w;
      const int t = t0 + s;
      if (tok0 < NTP) {
        if (t >= 2045) *(float4*)(p.out + OUT_CONVP + ((size_t)b * 3 + (t - 2045)) * 1024 + c) = x;
      } else {
        if (t >= 5) *(float4*)(p.out + OUT_CONVS + ((size_t)b * 3 + (t - 5)) * 1024 + c) = x;
      }
      r3 = r2; r2 = r1; r1 = x;
    }
  }
}

__device__ __forceinline__ float rg_mult(float la) {
  const float t = 2.f * la;
  const float ser = -t * (1.f + t * (0.5f + t * (0.16666667f + t * (0.041666668f + t * 0.0083333333f))));
  const float dir = 1.f - __expf(t);
  return __builtin_amdgcn_sqrtf(t > -0.25f ? ser : dir);
}
__device__ __forceinline__ void scan_step(const float* loga, const u16* ig16, const float* xc32, size_t off, float4& a, float4& bt) {
  float4 la = *(const float4*)(loga + off);
  uint2 gi = *(const uint2*)(ig16 + off);
  float4 xc = *(const float4*)(xc32 + off);
  a.x = __expf(la.x); a.y = __expf(la.y); a.z = __expf(la.z); a.w = __expf(la.w);
  bt.x = rg_mult(la.x) * bflo(gi.x) * xc.x;
  bt.y = rg_mult(la.y) * bfhi(gi.x) * xc.y;
  bt.z = rg_mult(la.z) * bflo(gi.y) * xc.z;
  bt.w = rg_mult(la.w) * bfhi(gi.y) * xc.w;
}
__device__ __forceinline__ void ph_scanA(const Params& p) {
  const float* loga = (const float*)(p.ws + OFF_LOGA);
  const u16* ig16 = (const u16*)(p.ws + OFF_IG16);
  const float* xc32 = (const float*)(p.ws + OFF_XC32);
  float* aggA = (float*)(p.ws + OFF_AGGA);
  float* aggB = (float*)(p.ws + OFF_AGGB);
  const int c = threadIdx.x * 4;
  for (int item = blockIdx.x; item < 1024; item += gridDim.x) {
    const int b = item >> 7, ch = item & 127;
    float4 A = make_float4(1.f, 1.f, 1.f, 1.f), B = make_float4(0.f, 0.f, 0.f, 0.f);
    const size_t tok0 = (size_t)b * 2048 + ch * 16;
#pragma unroll 8
    for (int s = 0; s < 16; ++s) {
      float4 a, bt;
      scan_step(loga, ig16, xc32, (tok0 + s) * 1024 + c, a, bt);
      A.x *= a.x; A.y *= a.y; A.z *= a.z; A.w *= a.w;
      B.x = a.x * B.x + bt.x; B.y = a.y * B.y + bt.y; B.z = a.z * B.z + bt.z; B.w = a.w * B.w + bt.w;
    }
    *(float4*)(aggA + (size_t)item * 1024 + c) = A;
    *(float4*)(aggB + (size_t)item * 1024 + c) = B;
  }
}
__device__ __forceinline__ void ph_scanA2(const Params& p) {
  const float* aggA = (const float*)(p.ws + OFF_AGGA);
  float* aggB = (float*)(p.ws + OFF_AGGB);
  for (int u = blockIdx.x; u < 32; u += gridDim.x) {
    const int b = u >> 2, c = (u & 3) * 256 + threadIdx.x;
    float h = 0.f;
#pragma unroll 16
    for (int ch = 0; ch < 128; ++ch) {
      const size_t o = (size_t)(b * 128 + ch) * 1024 + c;
      const float A = aggA[o], B = aggB[o];
      aggB[o] = h;
      h = A * h + B;
    }
  }
}
__device__ __forceinline__ void ph_scanB(const Params& p) {
  const float* loga = (const float*)(p.ws + OFF_LOGA);
  const u16* ig16 = (const u16*)(p.ws + OFF_IG16);
  const float* xc32 = (const float*)(p.ws + OFF_XC32);
  const u16* gate16 = (const u16*)(p.ws + OFF_GATE16);
  u16* hg16 = (u16*)(p.ws + OFF_HG16);
  const float* aggB = (const float*)(p.ws + OFF_AGGB);
  const int c = threadIdx.x * 4;
  for (int item = blockIdx.x; item < 1088; item += gridDim.x) {
    float4 h; size_t tok0; float* hout = nullptr;
    if (item < 1024) {
      const int b = item >> 7, ch = item & 127;
      h = *(const float4*)(aggB + (size_t)item * 1024 + c);
      tok0 = (size_t)b * 2048 + ch * 16;
      if (ch == 127) hout = p.out + OUT_HP + (size_t)b * 1024 + c;
    } else {
      tok0 = (size_t)NTP + (size_t)(item - 1024) * 16;
      h = make_float4(0.f, 0.f, 0.f, 0.f);
    }
#pragma unroll 8
    for (int s = 0; s < 16; ++s) {
      float4 a, bt;
      const size_t off = (tok0 + s) * 1024 + c;
      if (item >= 1024 && (s & 7) == 0) h = *(const float4*)(p.state_h + (size_t)((item - 1024) * 2 + (s >> 3)) * 1024 + c);
      scan_step(loga, ig16, xc32, off, a, bt);
      h.x = a.x * h.x + bt.x; h.y = a.y * h.y + bt.y; h.z = a.z * h.z + bt.z; h.w = a.w * h.w + bt.w;
      uint2 g = *(const uint2*)(gate16 + off);
      uint2 w; w.x = pack2(h.x * bflo(g.x), h.y * bfhi(g.x)); w.y = pack2(h.z * bflo(g.y), h.w * bfhi(g.y));
      *(uint2*)(hg16 + off) = w;
      if (item >= 1024 && (s & 7) == 7) *(float4*)(p.out + OUT_HS + (size_t)((item - 1024) * 2 + (s >> 3)) * 1024 + c) = h;
    }
    if (hout) *(float4*)hout = h;
  }
}

__device__ __forceinline__ int mkkey8(float v, int code) {
  int i = __float_as_int(v);
  i ^= (i >> 31) & 0x7fffffff;
  return (i & ~255) | code;
}
__device__ __forceinline__ float keyval8(int k) {
  int i = (k & ~255) | 128;
  i ^= (i >> 31) & 0x7fffffff;
  return __int_as_float(i);
}
__device__ __forceinline__ void ph_topk(const Params& p, char* smem) {
  const int tid = threadIdx.x, lane = tid & 63, wid = tid >> 6, g = lane >> 4, li = lane & 15;
  const int* tkg = (const int*)(p.ws + OFF_TKEY);
  int* idx_out = (int*)(p.ws + OFF_IDX);
  float* gate_out = (float*)(p.ws + OFF_PGATE);
  int* tkey = (int*)smem + wid * 1024;
  float* tval = (float*)(tkey + 512);
  for (int tb = blockIdx.x; tb < 2176; tb += gridDim.x) {
    const int tbase = tb * 8 + wid * 2;
#pragma unroll
    for (int j = 0; j < 2; ++j) {
      const int4 kk = ((const int4*)(tkg + (size_t)tbase * 256))[j * 64 + lane];
      ((int4*)tkey)[j * 64 + lane] = kk;
      ((float4*)tval)[j * 64 + lane] = make_float4(keyval(kk.x), keyval(kk.y), keyval(kk.z), keyval(kk.w));
    }
    __syncthreads();
    const float* v1[4];
    float sv0[4]; int key[4], rk[4], ptr[4];
#pragma unroll
    for (int q = 0; q < 4; ++q) {
      const int h = (q & 1) * 4 + g;
      const float* v0 = tval + (q >> 1) * 256 + (h * 2) * 16;
      v1[q] = v0 + 16;
      sv0[q] = v0[li];
      ptr[q] = 0; rk[q] = 0;
      key[q] = mkkey8(sv0[q] + v1[q][0], 255 - li * 16);
    }
#pragma unroll 1
    for (int it = 0; it < 16; ++it) {
#pragma unroll
      for (int q = 0; q < 4; ++q) {
        const int M = grp_max_i(key[q]);
        const bool win = (key[q] == M);
        if (li == it) rk[q] = M;
        const int np = ptr[q] + (win ? 1 : 0);
        const int nk = (np < 16) ? mkkey8(sv0[q] + v1[q][np & 15], 255 - (li * 16 + np)) : (int)0x80000000;
        key[q] = win ? nk : key[q];
        ptr[q] = np;
      }
    }
#pragma unroll
    for (int q = 0; q < 4; ++q) {
      const int h = (q & 1) * 4 + g;
      const int t = tbase + (q >> 1);
      const int* t0 = tkey + (q >> 1) * 256 + (h * 2) * 16;
      const int rc = 255 - (rk[q] & 255);
      const float rv = keyval8(rk[q]);
      const int ia = keyidx(t0[rc >> 4]);
      const int ib = keyidx(t0[16 + (rc & 15)]);
      const float mx = grp_max_f(rv);
      const float ex = __expf(rv - mx);
      const float sm = grp_sum_f(ex);
      idx_out[(size_t)t * 128 + h * 16 + li] = ia * 128 + ib;
      gate_out[(size_t)t * 128 + h * 16 + li] = ex / sm;
    }
    __syncthreads();
  }
}

typedef float v2f __attribute__((ext_vector_type(2)));
template <int CTRL>
__device__ __forceinline__ float dpp_f(float v) { return __int_as_float(__builtin_amdgcn_update_dpp(0, __float_as_int(v), CTRL, 0xf, 0xf, false)); }
__device__ __forceinline__ float dot16_fp8(uint4 u, const v2f* x2) {
  v2f acc = {0.f, 0.f};
  acc = __builtin_elementwise_fma(__builtin_amdgcn_cvt_pk_f32_fp8((int)u.x, false), x2[0], acc);
  acc = __builtin_elementwise_fma(__builtin_amdgcn_cvt_pk_f32_fp8((int)u.x, true), x2[1], acc);
  acc = __builtin_elementwise_fma(__builtin_amdgcn_cvt_pk_f32_fp8((int)u.y, false), x2[2], acc);
  acc = __builtin_elementwise_fma(__builtin_amdgcn_cvt_pk_f32_fp8((int)u.y, true), x2[3], acc);
  acc = __builtin_elementwise_fma(__builtin_amdgcn_cvt_pk_f32_fp8((int)u.z, false), x2[4], acc);
  acc = __builtin_elementwise_fma(__builtin_amdgcn_cvt_pk_f32_fp8((int)u.z, true), x2[5], acc);
  acc = __builtin_elementwise_fma(__builtin_amdgcn_cvt_pk_f32_fp8((int)u.w, false), x2[6], acc);
  acc = __builtin_elementwise_fma(__builtin_amdgcn_cvt_pk_f32_fp8((int)u.w, true), x2[7], acc);
  return acc.x + acc.y;
}
__device__ __forceinline__ void axpy16_fp8(float w, uint4 u, v2f* o2) {
  const v2f w2 = {w, w};
  o2[0] = __builtin_elementwise_fma(__builtin_amdgcn_cvt_pk_f32_fp8((int)u.x, false), w2, o2[0]);
  o2[1] = __builtin_elementwise_fma(__builtin_amdgcn_cvt_pk_f32_fp8((int)u.x, true), w2, o2[1]);
  o2[2] = __builtin_elementwise_fma(__builtin_amdgcn_cvt_pk_f32_fp8((int)u.y, false), w2, o2[2]);
  o2[3] = __builtin_elementwise_fma(__builtin_amdgcn_cvt_pk_f32_fp8((int)u.y, true), w2, o2[3]);
  o2[4] = __builtin_elementwise_fma(__builtin_amdgcn_cvt_pk_f32_fp8((int)u.z, false), w2, o2[4]);
  o2[5] = __builtin_elementwise_fma(__builtin_amdgcn_cvt_pk_f32_fp8((int)u.z, true), w2, o2[5]);
  o2[6] = __builtin_elementwise_fma(__builtin_amdgcn_cvt_pk_f32_fp8((int)u.w, false), w2, o2[6]);
  o2[7] = __builtin_elementwise_fma(__builtin_amdgcn_cvt_pk_f32_fp8((int)u.w, true), w2, o2[7]);
}
__device__ __forceinline__ float reduce4_row(float d0, float d1, float d2, float d3, int lane) {
  const bool b0 = lane & 1, b1 = lane & 2;
  const float k0 = b0 ? d1 : d0, s0 = b0 ? d0 : d1;
  const float k1 = b0 ? d3 : d2, s1 = b0 ? d2 : d3;
  const float r0 = k0 + dpp_f<0xB1>(s0);
  const float r1 = k1 + dpp_f<0xB1>(s1);
  const float kk = b1 ? r1 : r0, ss = b1 ? r0 : r1;
  float q = kk + dpp_f<0x4E>(ss);
  q += dpp_f<0x128>(q);
  q += dpp_f<0x124>(q);
  return q;
}
#define EXP_LOAD(dst, dsc, TAB, SC, kbase, esrc)                                     \
  _Pragma("unroll") for (int j = 0; j < 8; ++j) {                                   \
    const int e = __builtin_amdgcn_readlane(esrc, ((kbase) + j) & 63);              \
    dst[j] = ((const uint4*)(TAB + (size_t)e * 1024))[lane];                        \
    dsc[j] = SC[e];                                                                  \
  }
#define EXP_LOADV(dst, TAB, kbase, esrc)                                             \
  _Pragma("unroll") for (int j = 0; j < 8; ++j) {                                   \
    const int e = __builtin_amdgcn_readlane(esrc, ((kbase) + j) & 63);              \
    dst[j] = ((const uint4*)(TAB + (size_t)e * 1024))[lane];                        \
  }
#define EXP_UDOT(src, ssc, kbase)                                                    \
  {                                                                                  \
    float d[8];                                                                      \
    _Pragma("unroll") for (int j = 0; j < 8; ++j) d[j] = dot16_fp8(src[j], x2) * ssc[j]; \
    const float qa = reduce4_row(d[0], d[1], d[2], d[3], lane);                      \
    const float qb = reduce4_row(d[4], d[5], d[6], d[7], lane);                      \
    float q = (lane & 4) ? qb : qa;                                                  \
    q += __shfl_xor(q, 16);                                                          \
    q += __shfl_xor(q, 32);                                                          \
    if ((lane >> 3) == ((((kbase)) & 63) >> 3)) { if ((kbase) < 64) h_lo = q; else h_hi = q; } \
  }
#define EXP_VACC(src, kbase, wsrc)                                                   \
  _Pragma("unroll") for (int j = 0; j < 8; ++j) {                                   \
    const float w = __int_as_float(__builtin_amdgcn_readlane(__float_as_int(wsrc), ((kbase) + j) & 63)); \
    axpy16_fp8(w, src[j], o2);                                                       \
  }

__device__ __forceinline__ void ph_expert(const Params& p, int layer) {
  const int lane = threadIdx.x & 63, wid = threadIdx.x >> 6;
  u16* xn16 = (u16*)(p.ws + OFF_XN);
  float* xres = (float*)(p.ws + OFF_X);
  const int* idxs = (const int*)(p.ws + OFF_IDX);
  const float* gates = (const float*)(p.ws + OFF_PGATE);
  const unsigned char* U = (const unsigned char*)(p.ws + OFF_U8);
  const unsigned char* V = (const unsigned char*)(p.ws + OFF_V8);
  const float* USC = (const float*)(p.ws + OFF_USC);
  const float* VSC = (const float*)(p.ws + OFF_VSC);
  for (int tb = blockIdx.x; tb < 4352; tb += gridDim.x) {
    const int t = tb * 4 + wid;
    v2f x2[8];
    {
      const uint4* xr = (const uint4*)(xn16 + (size_t)t * 1024 + lane * 16);
      uint4 xa = xr[0], xb = xr[1];
      x2[0] = v2f{bflo(xa.x), bfhi(xa.x)}; x2[1] = v2f{bflo(xa.y), bfhi(xa.y)};
      x2[2] = v2f{bflo(xa.z), bfhi(xa.z)}; x2[3] = v2f{bflo(xa.w), bfhi(xa.w)};
      x2[4] = v2f{bflo(xb.x), bfhi(xb.x)}; x2[5] = v2f{bflo(xb.y), bfhi(xb.y)};
      x2[6] = v2f{bflo(xb.z), bfhi(xb.z)}; x2[7] = v2f{bflo(xb.w), bfhi(xb.w)};
    }
    const int e_lo = idxs[(size_t)t * 128 + lane], e_hi = idxs[(size_t)t * 128 + 64 + lane];
    const float g_lo = gates[(size_t)t * 128 + lane], g_hi = gates[(size_t)t * 128 + 64 + lane];
    const float vs_lo = VSC[e_lo], vs_hi = VSC[e_hi];
    float h_lo = 0.f, h_hi = 0.f;
    {
      uint4 ba[8], bb[8]; float sa[8], sb[8];
      EXP_LOAD(ba, sa, U, USC, 0, e_lo)
#pragma unroll 1
      for (int kb = 0; kb < 64; kb += 16) {
        EXP_LOAD(bb, sb, U, USC, kb + 8, e_lo)
        EXP_UDOT(ba, sa, kb)
        if (kb + 16 < 64) { EXP_LOAD(ba, sa, U, USC, kb + 16, e_lo) } else { EXP_LOAD(ba, sa, U, USC, 0, e_hi) }
        EXP_UDOT(bb, sb, kb + 8)
      }
#pragma unroll 1
      for (int kb = 64; kb < 128; kb += 16) {
        EXP_LOAD(bb, sb, U, USC, kb + 8, e_hi)
        EXP_UDOT(ba, sa, kb)
        if (kb + 16 < 128) { EXP_LOAD(ba, sa, U, USC, kb + 16, e_hi) }
        EXP_UDOT(bb, sb, kb + 8)
      }
    }
    const float w_lo = 0.5f * h_lo * (1.f + erff(h_lo * 0.70710678118654752f)) * g_lo * vs_lo;
    const float w_hi = 0.5f * h_hi * (1.f + erff(h_hi * 0.70710678118654752f)) * g_hi * vs_hi;
    v2f o2[8];
#pragma unroll
    for (int i = 0; i < 8; ++i) o2[i] = v2f{0.f, 0.f};
    {
      uint4 ba[8], bb[8];
      EXP_LOADV(ba, V, 0, e_lo)
#pragma unroll 1
      for (int kb = 0; kb < 64; kb += 16) {
        EXP_LOADV(bb, V, kb + 8, e_lo)
        EXP_VACC(ba, kb, w_lo)
        if (kb + 16 < 64) { EXP_LOADV(ba, V, kb + 16, e_lo) } else { EXP_LOADV(ba, V, 0, e_hi) }
        EXP_VACC(bb, kb + 8, w_lo)
      }
#pragma unroll 1
      for (int kb = 64; kb < 128; kb += 16) {
        EXP_LOADV(bb, V, kb + 8, e_hi)
        EXP_VACC(ba, kb, w_hi)
        if (kb + 16 < 128) { EXP_LOADV(ba, V, kb + 16, e_hi) }
        EXP_VACC(bb, kb + 8, w_hi)
      }
    }
    float o[16];
#pragma unroll
    for (int i = 0; i < 8; ++i) { o[2 * i] = o2[i].x; o[2 * i + 1] = o2[i].y; }
    float* xr = xres + (size_t)t * 1024 + lane * 16;
    float ss = 0.f;
#pragma unroll
    for (int i = 0; i < 4; ++i) {
      float4 r = *(const float4*)(xr + i * 4);
      o[4 * i] += r.x; o[4 * i + 1] += r.y; o[4 * i + 2] += r.z; o[4 * i + 3] += r.w;
      ss += o[4 * i] * o[4 * i] + o[4 * i + 1] * o[4 * i + 1] + o[4 * i + 2] * o[4 * i + 2] + o[4 * i + 3] * o[4 * i + 3];
    }
    ss = wave_sum(ss);
    const float rs = rsqrtf(ss * (1.f / 1024.f) + 1e-6f);
    if (layer == 0) {
#pragma unroll
      for (int i = 0; i < 4; ++i) *(float4*)(xr + i * 4) = make_float4(o[4 * i], o[4 * i + 1], o[4 * i + 2], o[4 * i + 3]);
      uint4 wa, wb;
      wa.x = pack2(o[0] * rs, o[1] * rs); wa.y = pack2(o[2] * rs, o[3] * rs); wa.z = pack2(o[4] * rs, o[5] * rs); wa.w = pack2(o[6] * rs, o[7] * rs);
      wb.x = pack2(o[8] * rs, o[9] * rs); wb.y = pack2(o[10] * rs, o[11] * rs); wb.z = pack2(o[12] * rs, o[13] * rs); wb.w = pack2(o[14] * rs, o[15] * rs);
      uint4* xw = (uint4*)(xn16 + (size_t)t * 1024 + lane * 16);
      xw[0] = wa; xw[1] = wb;
    } else {
      const float* fg = p.final_norm + lane * 16;
      float* y = p.out + OUT_Y + (size_t)t * 1024 + lane * 16;
#pragma unroll
      for (int i = 0; i < 4; ++i) {
        float4 g = *(const float4*)(fg + i * 4);
        *(float4*)(y + i * 4) = make_float4(o[4 * i] * rs * g.x, o[4 * i + 1] * rs * g.y, o[4 * i + 2] * rs * g.z, o[4 * i + 3] * rs * g.w);
      }
    }
  }
}

struct XInfo { int nloc, nx, rank, xr; };
__device__ __forceinline__ float reduce8(float v) {
  v += dpp_f<0xB1>(v); v += dpp_f<0x4E>(v); v += dpp_f<0x141>(v);
  return v;
}
__device__ __forceinline__ void ph_expert_u(const Params& p, const XInfo xi) {
  const int lane = threadIdx.x & 63, wid = threadIdx.x >> 6, g = lane >> 3, i8 = lane & 7;
  const u16* xn16 = (const u16*)(p.ws + OFF_XN);
  const int* idxs = (const int*)(p.ws + OFF_IDX);
  float* ph = (float*)(p.ws + OFF_PH);
  for (int c = xi.xr; c < 8; c += xi.nx) {
    const unsigned char* Us = (const unsigned char*)(p.ws + OFF_U8) + (size_t)c * 2097152;
    const unsigned lo = (unsigned)i8 * 16u;
    int t = xi.rank * 4 + wid;
    int e[16];
    {
      const int t0 = min(t, NTOK - 1);
      const int4* ip = (const int4*)(idxs + (size_t)t0 * 128 + g * 16);
#pragma unroll
      for (int j = 0; j < 4; ++j) { int4 q = ip[j]; e[4 * j] = q.x; e[4 * j + 1] = q.y; e[4 * j + 2] = q.z; e[4 * j + 3] = q.w; }
    }
    for (; t < NTOK; t += xi.nloc * 4) {
      uint4 seg[16];
#pragma unroll
      for (int j = 0; j < 16; ++j) seg[j] = *(const uint4*)(Us + ((unsigned)e[j] * 128u + lo));
      v2f x2[8];
      {
        const uint4* xr = (const uint4*)(xn16 + (size_t)t * 1024 + c * 128 + i8 * 16);
        uint4 xa = xr[0], xb = xr[1];
        x2[0] = v2f{bflo(xa.x), bfhi(xa.x)}; x2[1] = v2f{bflo(xa.y), bfhi(xa.y)};
        x2[2] = v2f{bflo(xa.z), bfhi(xa.z)}; x2[3] = v2f{bflo(xa.w), bfhi(xa.w)};
        x2[4] = v2f{bflo(xb.x), bfhi(xb.x)}; x2[5] = v2f{bflo(xb.y), bfhi(xb.y)};
        x2[6] = v2f{bflo(xb.z), bfhi(xb.z)}; x2[7] = v2f{bflo(xb.w), bfhi(xb.w)};
      }
      {
        const int tn = min(t + xi.nloc * 4, NTOK - 1);
        const int4* ip = (const int4*)(idxs + (size_t)tn * 128 + g * 16);
#pragma unroll
        for (int j = 0; j < 4; ++j) { int4 q = ip[j]; e[4 * j] = q.x; e[4 * j + 1] = q.y; e[4 * j + 2] = q.z; e[4 * j + 3] = q.w; }
      }
      float d[16];
#pragma unroll
      for (int j = 0; j < 16; ++j) d[j] = reduce8(dot16_fp8(seg[j], x2));
      if (i8 == 0) {
        float* o = ph + ((size_t)c * NTOK + t) * 128 + g * 16;
#pragma unroll
        for (int j = 0; j < 4; ++j) *(float4*)(o + 4 * j) = make_float4(d[4 * j], d[4 * j + 1], d[4 * j + 2], d[4 * j + 3]);
      }
    }
  }
}
__device__ __forceinline__ void ph_expert_combine(const Params& p) {
  const int* idxs = (const int*)(p.ws + OFF_IDX);
  float* gates = (float*)(p.ws + OFF_PGATE);
  const float* ph = (const float*)(p.ws + OFF_PH);
  const float* USC = (const float*)(p.ws + OFF_USC);
  const float* VSC = (const float*)(p.ws + OFF_VSC);
  for (int i = blockIdx.x * 256 + threadIdx.x; i < NTOK * 128; i += gridDim.x * 256) {
    float s = 0.f;
#pragma unroll
    for (int c = 0; c < 8; ++c) s += ph[(size_t)c * NTOK * 128 + i];
    const int e = idxs[i];
    const float h = s * USC[e];
    gates[i] = 0.5f * h * (1.f + erff(h * 0.70710678118654752f)) * gates[i] * VSC[e];
  }
}
__device__ __forceinline__ void ph_expert_v(const Params& p, const XInfo xi) {
  const int lane = threadIdx.x & 63, wid = threadIdx.x >> 6, g = lane >> 3, i8 = lane & 7;
  const int* idxs = (const int*)(p.ws + OFF_IDX);
  const float* wts = (const float*)(p.ws + OFF_PGATE);
  float* xres = (float*)(p.ws + OFF_X);
  for (int c = xi.xr; c < 8; c += xi.nx) {
    const unsigned char* Vs = (const unsigned char*)(p.ws + OFF_V8) + (size_t)c * 2097152;
    const unsigned lo = (unsigned)i8 * 16u;
    int t = xi.rank * 4 + wid;
    int e[16]; float w[16];
    {
      const int t0 = min(t, NTOK - 1);
      const int4* ip = (const int4*)(idxs + (size_t)t0 * 128 + g * 16);
      const float4* wp = (const float4*)(wts + (size_t)t0 * 128 + g * 16);
#pragma unroll
      for (int j = 0; j < 4; ++j) { int4 q = ip[j]; float4 r = wp[j]; e[4 * j] = q.x; e[4 * j + 1] = q.y; e[4 * j + 2] = q.z; e[4 * j + 3] = q.w; w[4 * j] = r.x; w[4 * j + 1] = r.y; w[4 * j + 2] = r.z; w[4 * j + 3] = r.w; }
    }
    for (; t < NTOK; t += xi.nloc * 4) {
      v2f o2[8];
#pragma unroll
      for (int i = 0; i < 8; ++i) o2[i] = v2f{0.f, 0.f};
      {
        uint4 seg[16];
#pragma unroll
        for (int j = 0; j < 16; ++j) seg[j] = *(const uint4*)(Vs + ((unsigned)e[j] * 128u + lo));
#pragma unroll
        for (int j = 0; j < 16; ++j) axpy16_fp8(w[j], seg[j], o2);
      }
      __builtin_amdgcn_sched_barrier(0);
      {
        const int tn = min(t + xi.nloc * 4, NTOK - 1);
        const int4* ip = (const int4*)(idxs + (size_t)tn * 128 + g * 16);
        const float4* wp = (const float4*)(wts + (size_t)tn * 128 + g * 16);
#pragma unroll
        for (int j = 0; j < 4; ++j) { int4 q = ip[j]; float4 r = wp[j]; e[4 * j] = q.x; e[4 * j + 1] = q.y; e[4 * j + 2] = q.z; e[4 * j + 3] = q.w; w[4 * j] = r.x; w[4 * j + 1] = r.y; w[4 * j + 2] = r.z; w[4 * j + 3] = r.w; }
      }
      float o[16];
#pragma unroll
      for (int i = 0; i < 8; ++i) { o[2 * i] = o2[i].x; o[2 * i + 1] = o2[i].y; }
#pragma unroll
      for (int i = 0; i < 16; ++i) {
        float v = o[i];
        v += dpp_f<0x128>(v);
        v += __shfl_xor(v, 16);
        v += __shfl_xor(v, 32);
        o[i] = v;
        if ((i & 3) == 3) __builtin_amdgcn_sched_barrier(0);
      }
      if (g == 0) {
        float* xr = xres + (size_t)t * 1024 + c * 128 + i8 * 16;
#pragma unroll
        for (int i = 0; i < 4; ++i) {
          float4 r = *(const float4*)(xr + i * 4);
          *(float4*)(xr + i * 4) = make_float4(r.x + o[4 * i], r.y + o[4 * i + 1], r.z + o[4 * i + 2], r.w + o[4 * i + 3]);
        }
      }
    }
  }
}
__device__ __forceinline__ void ph_post_norm(const Params& p, int layer) {
  const int lane = threadIdx.x & 63, wid = threadIdx.x >> 6;
  const float* xres = (const float*)(p.ws + OFF_X);
  u16* xn16 = (u16*)(p.ws + OFF_XN);
  for (int u = blockIdx.x; u < 4352; u += gridDim.x) {
    const int t = u * 4 + wid;
    const float* x = xres + (size_t)t * 1024;
    float4 v[4]; float ss = 0.f;
#pragma unroll
    for (int i = 0; i < 4; ++i) {
      v[i] = *(const float4*)(x + i * 256 + lane * 4);
      ss += v[i].x * v[i].x + v[i].y * v[i].y + v[i].z * v[i].z + v[i].w * v[i].w;
    }
    ss = wave_sum(ss);
    const float r = rsqrtf(ss * (1.f / 1024.f) + 1e-6f);
    if (layer == 0) {
#pragma unroll
      for (int i = 0; i < 4; ++i) {
        uint2 w; w.x = pack2(v[i].x * r, v[i].y * r); w.y = pack2(v[i].z * r, v[i].w * r);
        *(uint2*)(xn16 + (size_t)t * 1024 + i * 256 + lane * 4) = w;
      }
    } else {
      float* y = p.out + OUT_Y + (size_t)t * 1024;
#pragma unroll
      for (int i = 0; i < 4; ++i) {
        float4 gg = *(const float4*)(p.final_norm + i * 256 + lane * 4);
        *(float4*)(y + i * 256 + lane * 4) = make_float4(v[i].x * r * gg.x, v[i].y * r * gg.y, v[i].z * r * gg.z, v[i].w * r * gg.w);
      }
    }
  }
}

__device__ __forceinline__ void ph_attn(const Params& p, char* smem) {
  const int tid = threadIdx.x, lane = tid & 63, wid = tid >> 6, fr = lane & 15, fq = lane >> 4;
  const u16* k16 = (const u16*)(p.ws + OFF_K16);
  const u16* v16 = (const u16*)(p.ws + OFF_V16A);
  const u16* q16 = (const u16*)(p.ws + OFF_Q16);
  u16* o16 = (u16*)(p.ws + OFF_O16);
  u16* Ks = (u16*)smem;
  u16* Vt = (u16*)(smem + 27648);
  for (int item = blockIdx.x; item < 1536; item += gridDim.x) {
    const bool is_p = item < 1024;
    int b, kvh, q0 = 0, nsub, nvalid, kpos0, minpos, tokbase;
    if (is_p) { b = item >> 7; kvh = (item >> 5) & 3; q0 = (item & 31) * 64; nsub = 4; nvalid = 192; kpos0 = q0 - 128; minpos = 0; tokbase = b * 2048; }
    else { int it2 = item - 1024; b = it2 >> 2; kvh = it2 & 3; nsub = 1; nvalid = 136; kpos0 = -128; minpos = -100000; tokbase = NTP + b * 8; }
    __syncthreads();
    for (int c = tid; c < 1536; c += 256) {
      const int j = c >> 3, ch = c & 7;
      uint4 kk = make_uint4(0, 0, 0, 0), vv = make_uint4(0, 0, 0, 0);
      if (is_p) {
        const int kp = kpos0 + j;
        if (kp >= 0) {
          const size_t off = (size_t)(tokbase + kp) * 256 + kvh * 64 + ch * 8;
          kk = *(const uint4*)(k16 + off); vv = *(const uint4*)(v16 + off);
        }
      } else {
        if (j < 128) {
          const size_t off = ((size_t)(b * 128 + j) * 4 + kvh) * 64 + ch * 8;
          float4 a0 = *(const float4*)(p.cache_k + off), a1 = *(const float4*)(p.cache_k + off + 4);
          float4 c0 = *(const float4*)(p.cache_v + off), c1 = *(const float4*)(p.cache_v + off + 4);
          kk.x = pack2(a0.x, a0.y); kk.y = pack2(a0.z, a0.w); kk.z = pack2(a1.x, a1.y); kk.w = pack2(a1.z, a1.w);
          vv.x = pack2(c0.x, c0.y); vv.y = pack2(c0.z, c0.w); vv.z = pack2(c1.x, c1.y); vv.w = pack2(c1.z, c1.w);
        } else if (j < 136) {
          const size_t off = (size_t)(tokbase + j - 128) * 256 + kvh * 64 + ch * 8;
          kk = *(const uint4*)(k16 + off); vv = *(const uint4*)(v16 + off);
        }
      }
      *(uint4*)(Ks + j * 72 + ch * 8) = kk;
      u16* vd = Vt + (ch * 8) * 200 + j;
      vd[0] = (u16)(vv.x & 0xffff); vd[200] = (u16)(vv.x >> 16);
      vd[400] = (u16)(vv.y & 0xffff); vd[600] = (u16)(vv.y >> 16);
      vd[800] = (u16)(vv.z & 0xffff); vd[1000] = (u16)(vv.z >> 16);
      vd[1200] = (u16)(vv.w & 0xffff); vd[1400] = (u16)(vv.w >> 16);
    }
    __syncthreads();
    const int head = kvh * 4 + wid;
    const float sink = p.sinks[head];
#pragma unroll 1
    for (int sub = 0; sub < nsub; ++sub) {
      int qtok, qp;
      if (is_p) { qp = q0 + sub * 16 + fr; qtok = tokbase + qp; }
      else { qp = fr & 7; qtok = tokbase + (fr & 7); }
      const u16* qrow = q16 + (size_t)qtok * 1024 + head * 64;
      const bf16x8 qf0 = *(const bf16x8*)(qrow + fq * 8);
      const bf16x8 qf1 = *(const bf16x8*)(qrow + 32 + fq * 8);
      f32x4 s[12];
#pragma unroll
      for (int ks = 0; ks < 12; ++ks) {
        const bf16x8 kf0 = *(const bf16x8*)(Ks + (ks * 16 + fr) * 72 + fq * 8);
        const bf16x8 kf1 = *(const bf16x8*)(Ks + (ks * 16 + fr) * 72 + 32 + fq * 8);
        f32x4 z = {0.f, 0.f, 0.f, 0.f};
        z = __builtin_amdgcn_mfma_f32_16x16x32_bf16(kf0, qf0, z, 0, 0, 0);
        s[ks] = __builtin_amdgcn_mfma_f32_16x16x32_bf16(kf1, qf1, z, 0, 0, 0);
        if ((ks & 3) == 3) __builtin_amdgcn_sched_barrier(0);
      }
      float mx = sink;
      const int lo_ = max(minpos, qp - 127), hi_ = min(qp, kpos0 + nvalid - 1);
      const unsigned span_ = (unsigned)(hi_ - lo_);
      const int kp0_ = kpos0 + fq * 4 - lo_;
#pragma unroll
      for (int ks = 0; ks < 12; ++ks)
#pragma unroll
        for (int j = 0; j < 4; ++j) {
          const bool valid = (unsigned)(kp0_ + ks * 16 + j) <= span_;
          const float v = valid ? s[ks][j] : -1.0e30f;
          s[ks][j] = v;
          mx = fmaxf(mx, v);
          if (j == 3) __builtin_amdgcn_sched_barrier(0);
        }
      mx = fmaxf(mx, __shfl_xor(mx, 16));
      mx = fmaxf(mx, __shfl_xor(mx, 32));
      float sum = 0.f;
#pragma unroll
      for (int ks = 0; ks < 12; ++ks)
#pragma unroll
        for (int j = 0; j < 4; ++j) {
          const float pv = (s[ks][j] > -1.0e29f) ? __expf(s[ks][j] - mx) : 0.f;
          s[ks][j] = pv;
          sum += pv;
          if (j == 3) __builtin_amdgcn_sched_barrier(0);
        }
      sum += __shfl_xor(sum, 16);
      sum += __shfl_xor(sum, 32);
      sum += __expf(sink - mx);
      const float inv = 1.f / sum;
      f32x4 o[4];
#pragma unroll
      for (int d = 0; d < 4; ++d) o[d] = f32x4{0.f, 0.f, 0.f, 0.f};
#pragma unroll
      for (int kk = 0; kk < 6; ++kk) {
        union { bf16x8 v; unsigned u[4]; } pb;
        pb.u[0] = pack2(s[2 * kk][0], s[2 * kk][1]); pb.u[1] = pack2(s[2 * kk][2], s[2 * kk][3]);
        pb.u[2] = pack2(s[2 * kk + 1][0], s[2 * kk + 1][1]); pb.u[3] = pack2(s[2 * kk + 1][2], s[2 * kk + 1][3]);
#pragma unroll
        for (int d = 0; d < 4; ++d) {
          union { bf16x8 v; uint2 h[2]; } vf;
          const u16* vr = Vt + (d * 16 + fr) * 200 + fq * 4;
          vf.h[0] = *(const uint2*)(vr + (2 * kk) * 16);
          vf.h[1] = *(const uint2*)(vr + (2 * kk + 1) * 16);
          o[d] = __builtin_amdgcn_mfma_f32_16x16x32_bf16(vf.v, pb.v, o[d], 0, 0, 0);
        }
        __builtin_amdgcn_sched_barrier(0);
      }
      if (is_p || fr < 8) {
#pragma unroll
        for (int d = 0; d < 4; ++d) {
          uint2 w; w.x = pack2(o[d][0] * inv, o[d][1] * inv); w.y = pack2(o[d][2] * inv, o[d][3] * inv);
          *(uint2*)(o16 + (size_t)qtok * 1024 + head * 64 + d * 16 + fq * 4) = w;
        }
      }
    }
  }
}


#define XB_TMO      128
#define XB_XCNT(j)  (256  + 64 * (j))
#define XB_XSUB(j)  (1280 + 64 * (j))
#define XB_XGEN(j)  (2304 + 64 * (j))
#define XB_TOP      3328
#define XB_TOPGEN   3392
#define XCD_BAR_WORDS 3456
#define XB_SPIN_CAP (1u << 20)
#define LAS __attribute__((address_space(3)))
__device__ __forceinline__ unsigned xb_ld(unsigned* p) { return __hip_atomic_load(p, __ATOMIC_RELAXED, __HIP_MEMORY_SCOPE_AGENT); }
__device__ __forceinline__ unsigned xb_add(unsigned* p, unsigned v) { return __hip_atomic_fetch_add(p, v, __ATOMIC_RELAXED, __HIP_MEMORY_SCOPE_AGENT); }
__device__ __forceinline__ unsigned xb_xcc_id() { return (unsigned)__builtin_amdgcn_s_getreg((3 << 11) | 20) & 0xFu; }
#define XB_SPIN(cond, bar) do { unsigned _sp = 0; while (cond) { __builtin_amdgcn_s_sleep(1); \
    if ((++_sp & 255u) == 0u) { if (xb_ld(&(bar)[XB_TMO])) break; if (_sp > XB_SPIN_CAP) { atomicAdd(&(bar)[XB_TMO], 1u); break; } } } } while (0)
struct XcdBarrier { unsigned* bar; unsigned x; volatile LAS unsigned* st; };
__device__ __forceinline__ XcdBarrier xcd_barrier_post(unsigned* bar, volatile LAS unsigned* st) {
  XcdBarrier b; b.bar = bar; b.x = xb_xcc_id(); b.st = st;
  if (threadIdx.x == 0) st[2] = xb_add(&bar[XB_XCNT(b.x)], 1u);
  return b;
}
__device__ __forceinline__ void xcd_barrier_complete(unsigned* bar, unsigned x, unsigned& nloc, unsigned& nx, unsigned& xr) {
  const unsigned G = gridDim.x * gridDim.y * gridDim.z;
  unsigned sum, cnt, mine, below, sp = 0u;
  for (;;) {
    sum = 0u; cnt = 0u; mine = 0u; below = 0u;
#pragma unroll
    for (unsigned j = 0; j < 16; ++j) { const unsigned c = xb_ld(&bar[XB_XCNT(j)]); sum += c; cnt += (c > 0u) ? 1u : 0u; mine = (j == x) ? c : mine; below += (j < x && c > 0u) ? 1u : 0u; }
    if (sum == G) break;
    __builtin_amdgcn_s_sleep(1);
    if ((++sp & 255u) == 0u) { if (xb_ld(&bar[XB_TMO])) break; if (sp > XB_SPIN_CAP) { atomicAdd(&bar[XB_TMO], 1u); break; } }
  }
  nloc = mine > 0u ? mine : 1u; nx = cnt > 0u ? cnt : 1u; xr = below;
}
__device__ __forceinline__ void xcd_barrier(const XcdBarrier& b) {
  asm volatile("s_waitcnt vmcnt(0)" ::: "memory");
  __syncthreads();
  if (threadIdx.x == 0) {
    unsigned* bar = b.bar;
    __builtin_amdgcn_s_waitcnt(0);
    unsigned nloc = b.st[0], nx = b.st[1];
    if (nloc == 0u) { unsigned xr; xcd_barrier_complete(bar, b.x, nloc, nx, xr); b.st[0] = nloc; b.st[1] = nx; b.st[3] = xr; }
    const unsigned old = xb_add(&bar[XB_XSUB(b.x)], 1u);
    const unsigned gen = old / nloc;
    if (old + 1u == (gen + 1u) * nloc) {
      __builtin_amdgcn_fence(__ATOMIC_RELEASE, "agent");
      asm volatile("s_waitcnt vmcnt(0)" ::: "memory");
      const unsigned og = xb_add(&bar[XB_TOP], 1u);
      const unsigned tg = og / nx;
      if (og + 1u == (tg + 1u) * nx) xb_add(&bar[XB_TOPGEN], 1u);
      else XB_SPIN(xb_ld(&bar[XB_TOPGEN]) == tg, bar);
      __builtin_amdgcn_fence(__ATOMIC_ACQUIRE, "agent");
      xb_add(&bar[XB_XGEN(b.x)], 1u);
      asm volatile("s_waitcnt vmcnt(0)" ::: "memory");
    } else {
      XB_SPIN(xb_ld(&bar[XB_XGEN(b.x)]) == gen, bar);
      __builtin_amdgcn_fence(__ATOMIC_ACQUIRE, "agent");
      asm volatile("s_waitcnt vmcnt(0)" ::: "memory");
    }
  }
  __syncthreads();
}

typedef const Params __attribute__((address_space(4))) CParams;
__device__ __forceinline__ Params load_params(CParams* q) {
  Params r;
  r.x_prompt = q->x_prompt;
  r.x_sample = q->x_sample;
  r.state_conv = q->state_conv;
  r.state_h = q->state_h;
  r.cache_k = q->cache_k;
  r.cache_v = q->cache_v;
  r.rg_norm = q->rg_norm;
  r.rg_w_in = q->rg_w_in;
  r.rg_conv_w = q->rg_conv_w;
  r.rg_conv_b = q->rg_conv_b;
  r.rg_wa = q->rg_wa;
  r.rg_ba = q->rg_ba;
  r.rg_wx = q->rg_wx;
  r.rg_bx = q->rg_bx;
  r.rg_lambda = q->rg_lambda;
  r.rg_w_out = q->rg_w_out;
  r.kv_norm = q->kv_norm;
  r.w_kv = q->w_kv;
  r.attn_norm = q->attn_norm;
  r.w_q = q->w_q;
  r.sinks = q->sinks;
  r.w_o = q->w_o;
  r.ffn_norm = q->ffn_norm;
  r.peer_wq = q->peer_wq;
  r.peer_subkeys = q->peer_subkeys;
  r.peer_u = q->peer_u;
  r.peer_v = q->peer_v;
  r.final_norm = q->final_norm;
  r.out = q->out;
  r.ws = q->ws;
  r.ph_begin = q->ph_begin;
  r.ph_end = q->ph_end;
  return r;
}

template <int ph>
__device__ __forceinline__ void run_phase(const Params& p, char* smem, const XInfo xi) {
  char* ws = p.ws;
  switch (ph) {
    case 0: ph_convert0(p, smem); break;
    case 1: {
      EpiWin e{(u16*)(ws + OFF_GATE16), (float*)(ws + OFF_REC32)};
      gemm_tiles((const u16*)(ws + OFF_XN), 1024, (const u16*)(ws + OFF_WT_IN), 1024, 1024, 0, 16, e, smem);
    } break;
    case 2: ph_conv(p); break;
    case 3: {
      EpiBd e{(float*)(ws + OFF_LOGA), (u16*)(ws + OFF_IG16), p.rg_ba, p.rg_bx, p.rg_lambda};
      gemm_tiles((const u16*)(ws + OFF_XC16), 1024, (const u16*)(ws + OFF_WT_BD), 128, 128, 8, 16, e, smem);
    } break;
    case 4: ph_scanA(p); break;
    case 20: ph_scanA2(p); break;
    case 5: ph_scanB(p); break;
    case 6: {
      EpiResid e{p.x_prompt, p.x_sample, (float*)(ws + OFF_X), 1};
      gemm_tiles((const u16*)(ws + OFF_HG16), 1024, (const u16*)(ws + OFF_WT_OUT), 1024, 1024, 0, 8, e, smem);
      ph_cvt_tables(p, 0);
    } break;
    case 7: ph_rmsnorm(p, p.ffn_norm); break;
    case 8: case 16: {
      EpiScoresTopk e{(const u16*)(ws + (ph == 8 ? OFF_WT_SK0 : OFF_WT_SK1)), (int*)(ws + OFF_TKEY), smem};
      gemm_tiles((const u16*)(ws + OFF_XN), 1024, (const u16*)(ws + (ph == 8 ? OFF_WT_PQ0 : OFF_WT_PQ1)), 1024, 1024, 0, 16, e, smem);
    } break;
    case 9: case 17: {
      EpiTopk e{(int*)(ws + OFF_TKEY), smem};
      gemm_tiles((const u16*)(ws + OFF_QP16), 2048, (const u16*)(ws + (ph == 9 ? OFF_WT_SK0 : OFF_WT_SK1)), 128, 128, 16, 16, e, smem);
    } break;
    case 10: case 18: ph_topk(p, smem); break;
    case 11: case 19: ph_expert_u(p, xi); break;
    case 21: case 24: ph_expert_combine(p); break;
    case 22: case 25: ph_expert_v(p, xi); break;
    case 23: ph_post_norm(p, 0); break;
    case 26: ph_post_norm(p, 1); break;
    case 12: {
      EpiKvq e{(u16*)(ws + OFF_K16), (u16*)(ws + OFF_V16A), (u16*)(ws + OFF_Q16), (const float2*)(ws + OFF_ROPE), p.out};
      gemm_tiles((const u16*)(ws + OFF_XN), 1024, (const u16*)(ws + OFF_WT_KVQ), 1024, 1024, 0, 12, e, smem);
      ph_cvt_tables(p, 1);
    } break;
    case 13: ph_attn(p, smem); break;
    case 14: {
      EpiResid e{p.x_prompt, p.x_sample, (float*)(ws + OFF_X), 0};
      gemm_tiles((const u16*)(ws + OFF_O16), 1024, (const u16*)(ws + OFF_WT_O), 1024, 1024, 0, 8, e, smem);
    } break;
    case 15: ph_rmsnorm(p, p.ffn_norm + 1024); break;
    default: break;
  }
}

__global__ void __launch_bounds__(256, 2) yoco_megakernel(Params p) {
  __shared__ __attribute__((aligned(16))) char smem[73728];
  __shared__ uint4 xb_words;
  cg::grid_group grid = cg::this_grid();
  if (threadIdx.x == 0) xb_words = make_uint4(0u, 0u, 0u, 0u);
  __syncthreads();
  XcdBarrier xb = xcd_barrier_post((unsigned*)(p.ws + OFF_BAR), (volatile LAS unsigned*)&xb_words);
  if (p.ph_end > 1000) grid.sync();
#define LAUNDER(q) CParams* q = (CParams*)__builtin_amdgcn_kernarg_segment_ptr(); asm volatile("" : "+s"(q));
#define PH(k) run_phase<k>(p, smem, xi); xcd_barrier(xb);
  XInfo xi; xi.nloc = 1; xi.nx = 1; xi.rank = 0; xi.xr = 0;
  PH(0)
  { volatile LAS unsigned* st = (volatile LAS unsigned*)&xb_words; xi.nloc = __builtin_amdgcn_readfirstlane((int)st[0]); xi.nx = __builtin_amdgcn_readfirstlane((int)st[1]); xi.rank = __builtin_amdgcn_readfirstlane((int)st[2]); xi.xr = __builtin_amdgcn_readfirstlane((int)st[3]); }
  PH(1) PH(2) PH(3) PH(4) PH(20) PH(5) PH(6) PH(7) PH(8)
  PH(10) PH(11) PH(21) PH(22) PH(23) PH(12) PH(13) PH(14) PH(15) PH(16) PH(18) PH(19) PH(24) PH(25)
  run_phase<26>(p, smem, xi);
}

extern "C" void kernel_launch(void* const* d_in, const int* in_sizes, int n_in, void* d_out, int out_size,
                              void* d_ws, size_t ws_size, hipStream_t stream) {
  static int grid_blocks = 0;
  if (!grid_blocks) {
    int dev = 0, cus = 0, per_cu = 0;
    hipGetDevice(&dev);
    hipDeviceGetAttribute(&cus, hipDeviceAttributeMultiprocessorCount, dev);
    hipOccupancyMaxActiveBlocksPerMultiprocessor(&per_cu, yoco_megakernel, 256, 0);
    if (per_cu > 2) per_cu = 2;
    if (per_cu < 1) per_cu = 1;
    grid_blocks = cus * per_cu;
    if (ws_size < WS_NEEDED) fprintf(stderr, "workspace too small: %zu < %llu\n", ws_size, (unsigned long long)WS_NEEDED);
  }
  Params p{};
  const float** f = (const float**)&p;
  for (int i = 0; i < 28; ++i) f[i] = (const float*)d_in[i];
  p.out = (float*)d_out;
  p.ws = (char*)d_ws;
  hipMemsetAsync((char*)d_ws + OFF_BAR, 0, XCD_BAR_WORDS * sizeof(unsigned), stream);
#if MULTI_LAUNCH
  for (int ph = 0; ph < NPHASE; ++ph) {
    p.ph_begin = ph; p.ph_end = ph + 1;
    hipLaunchKernelGGL(yoco_megakernel, dim3(grid_blocks), dim3(256), 0, stream, p);
  }
#else
  p.ph_begin = 0; p.ph_end = NPHASE;
  void* args[] = {&p};
  hipError_t e = hipLaunchCooperativeKernel((void*)yoco_megakernel, dim3(grid_blocks), dim3(256), args, 0, stream);
  if (e != hipSuccess) fprintf(stderr, "cooperative launch failed: %s (grid %d)\n", hipGetErrorString(e), grid_blocks);
#endif
}
```

```cpp
#include <hip/hip_runtime.h>
#include <hip/hip_cooperative_groups.h>
#include <cstdio>
#include <cstdint>
namespace cg = cooperative_groups;

typedef unsigned short u16;
typedef __attribute__((ext_vector_type(8))) short bf16x8;
typedef __attribute__((ext_vector_type(4))) float f32x4;

#define NTOK 17408
#define NTP 16384
#define MIB 1048576ull
#define NPHASE 20
#ifndef MULTI_LAUNCH
#define MULTI_LAUNCH 0
#endif

#define OFF_WT_IN   (0 * MIB)
#define OFF_WT_OUT  (4 * MIB)
#define OFF_WT_BD   (6 * MIB)
#define OFF_WT_PQ0  (7 * MIB)
#define OFF_WT_PQ1  (11 * MIB)
#define OFF_WT_KVQ  (15 * MIB)
#define OFF_WT_O    (18 * MIB)
#define OFF_WT_SK0  (20 * MIB)
#define OFF_WT_SK1  (20 * MIB + 524288ull)
#define OFF_ROPE    (21 * MIB)
#define OFF_USC     (21 * MIB + 655360ull)
#define OFF_VSC     (21 * MIB + 655360ull + 65536ull)
#define OFF_U8      (22 * MIB)
#define OFF_V8      (38 * MIB)
#define OFF_XN      (86 * MIB)
#define OFF_X       (120 * MIB)
#define OFF_GATE16  (188 * MIB)
#define OFF_REC32   (222 * MIB)
#define OFF_XC32    (290 * MIB)
#define OFF_XC16    (358 * MIB)
#define OFF_LOGA    (222 * MIB)
#define OFF_IG16    (22 * MIB)
#define OFF_AGGA    (56 * MIB)
#define OFF_AGGB    (60 * MIB)
#define OFF_HG16    (358 * MIB)
#define OFF_QP16    (188 * MIB)
#define OFF_S32     (256 * MIB)
#define OFF_PH      (256 * MIB)
#define OFF_TKEY    (256 * MIB)
#define OFF_IDX     (188 * MIB)
#define OFF_PGATE   (197 * MIB)
#define OFF_K16     (188 * MIB)
#define OFF_V16A    (197 * MIB)
#define OFF_Q16     (206 * MIB)
#define OFF_O16     (240 * MIB)
#define OFF_BAR     (392 * MIB)
#define WS_NEEDED   (392 * MIB + 16384ull)

#define OUT_Y      0
#define OUT_CONVP  17825792
#define OUT_HP     17850368
#define OUT_KP     17858560
#define OUT_VP     18120704
#define OUT_CONVS  18382848
#define OUT_HS     18776064
#define OUT_KS     18907136
#define OUT_VS     23101440

struct Params {
  const float *x_prompt, *x_sample, *state_conv, *state_h, *cache_k, *cache_v;
  const float *rg_norm, *rg_w_in, *rg_conv_w, *rg_conv_b, *rg_wa, *rg_ba, *rg_wx, *rg_bx, *rg_lambda, *rg_w_out;
  const float *kv_norm, *w_kv, *attn_norm, *w_q, *sinks, *w_o, *ffn_norm, *peer_wq, *peer_subkeys, *peer_u, *peer_v, *final_norm;
  float* out;
  char* ws;
  int ph_begin, ph_end;
};


__device__ __forceinline__ int ltid() { int t = threadIdx.x; asm volatile("" : "+v"(t)); return t; }
__device__ __forceinline__ u16 f2bf(float f) {
  unsigned u = __float_as_uint(f);
  u += 0x7fffu + ((u >> 16) & 1u);
  return (u16)(u >> 16);
}
__device__ __forceinline__ float bf2f(u16 h) { return __uint_as_float(((unsigned)h) << 16); }
__device__ __forceinline__ unsigned pack2(float a, float b) { return (unsigned)f2bf(a) | ((unsigned)f2bf(b) << 16); }
__device__ __forceinline__ float bflo(unsigned u) { return __uint_as_float(u << 16); }
__device__ __forceinline__ float bfhi(unsigned u) { return __uint_as_float(u & 0xffff0000u); }
__device__ __forceinline__ float wave_sum(float v) {
#pragma unroll
  for (int o = 32; o > 0; o >>= 1) v += __shfl_xor(v, o);
  return v;
}
__device__ __forceinline__ const float* xin_row(const Params& p, int token) {
  return token < NTP ? p.x_prompt + (size_t)token * 1024 : p.x_sample + (size_t)(token - NTP) * 1024;
}
__device__ __forceinline__ float gelu_tanh(float x) {
  float u = 0.7978845608028654f * (x + 0.044715f * x * x * x);
  float e = __expf(2.f * u);
  float th = 1.f - 2.f / (e + 1.f);
  return 0.5f * x * (1.f + th);
}
__device__ __forceinline__ float sigmoidf_(float x) { return 1.f / (1.f + __expf(-x)); }

template <int CTRL>
__device__ __forceinline__ int dpp_i(int v) { return __builtin_amdgcn_update_dpp(v, v, CTRL, 0xf, 0xf, false); }
__device__ __forceinline__ int grp_max_i(int v) {
  v = max(v, dpp_i<0xB1>(v));
  v = max(v, dpp_i<0x4E>(v));
  v = max(v, dpp_i<0x141>(v));
  v = max(v, dpp_i<0x140>(v));
  return v;
}
__device__ __forceinline__ float grp_max_f(float v) {
  v = fmaxf(v, __int_as_float(dpp_i<0xB1>(__float_as_int(v))));
  v = fmaxf(v, __int_as_float(dpp_i<0x4E>(__float_as_int(v))));
  v = fmaxf(v, __int_as_float(dpp_i<0x141>(__float_as_int(v))));
  v = fmaxf(v, __int_as_float(dpp_i<0x140>(__float_as_int(v))));
  return v;
}
__device__ __forceinline__ float grp_sum_f(float v) {
  v += __int_as_float(dpp_i<0xB1>(__float_as_int(v)));
  v += __int_as_float(dpp_i<0x4E>(__float_as_int(v)));
  v += __int_as_float(dpp_i<0x141>(__float_as_int(v)));
  v += __int_as_float(dpp_i<0x140>(__float_as_int(v)));
  return v;
}

__device__ __forceinline__ void transpose_unit(const float* __restrict__ src, int ld_src, u16* __restrict__ dst, int ld_dst,
                               int kt, int nt, const float* __restrict__ gain, float* lds) {
  const int tid = ltid();
#pragma unroll
  for (int j = 0; j < 4; ++j) {
    int idx = tid + j * 256;
    int k = idx >> 4, c4 = idx & 15;
    float4 v = *(const float4*)(src + (size_t)(kt * 64 + k) * ld_src + nt * 64 + c4 * 4);
    float g = gain ? gain[kt * 64 + k] : 1.f;
    float* d = lds + k * 65 + c4 * 4;
    d[0] = v.x * g; d[1] = v.y * g; d[2] = v.z * g; d[3] = v.w * g;
  }
  __syncthreads();
#pragma unroll
  for (int j = 0; j < 2; ++j) {
    int c = tid + j * 256;
    int n = c >> 3, kc = c & 7;
    uint4 o;
    o.x = pack2(lds[(kc * 8 + 0) * 65 + n], lds[(kc * 8 + 1) * 65 + n]);
    o.y = pack2(lds[(kc * 8 + 2) * 65 + n], lds[(kc * 8 + 3) * 65 + n]);
    o.z = pack2(lds[(kc * 8 + 4) * 65 + n], lds[(kc * 8 + 5) * 65 + n]);
    o.w = pack2(lds[(kc * 8 + 6) * 65 + n], lds[(kc * 8 + 7) * 65 + n]);
    *(uint4*)(dst + (size_t)(nt * 64 + n) * ld_dst + kt * 64 + kc * 8) = o;
  }
  __syncthreads();
}

__device__ __forceinline__ void transpose_job(const Params& p, int u, float* lds) {
  char* ws = p.ws;
  if (u < 512) { transpose_unit(p.rg_w_in, 2048, (u16*)(ws + OFF_WT_IN), 1024, u >> 5, u & 31, nullptr, lds); return; }
  u -= 512;
  if (u < 256) { transpose_unit(p.rg_w_out, 1024, (u16*)(ws + OFF_WT_OUT), 1024, u >> 4, u & 15, nullptr, lds); return; }
  u -= 256;
  if (u < 64) {
    int which = u >> 5; int r = u & 31; int bi = r >> 2; int t = r & 3;
    const float* src = (which ? p.rg_wx : p.rg_wa) + (size_t)bi * 16384;
    u16* dst = (u16*)(ws + OFF_WT_BD) + (size_t)(which * 1024 + bi * 128) * 128;
    transpose_unit(src, 128, dst, 128, t >> 1, t & 1, nullptr, lds); return;
  }
  u -= 64;
  if (u < 1024) {
    int l = u >> 9; int r = u & 511;
    transpose_unit(p.peer_wq + (size_t)l * 2097152, 2048, (u16*)(ws + (l ? OFF_WT_PQ1 : OFF_WT_PQ0)), 1024, r >> 5, r & 31, nullptr, lds); return;
  }
  u -= 1024;
  if (u < 128) { transpose_unit(p.w_kv, 512, (u16*)(ws + OFF_WT_KVQ), 1024, u >> 3, u & 7, p.kv_norm, lds); return; }
  u -= 128;
  if (u < 256) { transpose_unit(p.w_q, 1024, (u16*)(ws + OFF_WT_KVQ) + (size_t)512 * 1024, 1024, u >> 4, u & 15, p.attn_norm, lds); return; }
  u -= 256;
  transpose_unit(p.w_o, 1024, (u16*)(ws + OFF_WT_O), 1024, u >> 4, u & 15, nullptr, lds);
}

__device__ __forceinline__ void cvt_unit(const float* __restrict__ src, u16* __restrict__ dst, size_t base) {
  const int tid = ltid();
#pragma unroll
  for (int j = 0; j < 2; ++j) {
    size_t o = base + j * 1024 + tid * 4;
    float4 v = *(const float4*)(src + o);
    uint2 w; w.x = pack2(v.x, v.y); w.y = pack2(v.z, v.w);
    *(uint2*)(dst + o) = w;
  }
}

__device__ __forceinline__ void rmsnorm_row(const float* __restrict__ x, const float* __restrict__ g, u16* __restrict__ o, int lane) {
  float4 v[4];
  float ss = 0.f;
#pragma unroll
  for (int i = 0; i < 4; ++i) {
    v[i] = *(const float4*)(x + i * 256 + lane * 4);
    ss += v[i].x * v[i].x + v[i].y * v[i].y + v[i].z * v[i].z + v[i].w * v[i].w;
  }
  ss = wave_sum(ss);
  float r = rsqrtf(ss * (1.f / 1024.f) + 1e-6f);
#pragma unroll
  for (int i = 0; i < 4; ++i) {
    float4 gg = *(const float4*)(g + i * 256 + lane * 4);
    uint2 w; w.x = pack2(v[i].x * r * gg.x, v[i].y * r * gg.y); w.y = pack2(v[i].z * r * gg.z, v[i].w * r * gg.w);
    *(uint2*)(o + i * 256 + lane * 4) = w;
  }
}

__device__ __forceinline__ void ph_convert0(const Params& p, char* smem) {
  const int tid = ltid(), lane = tid & 63, wid = tid >> 6;
  const int NT = 2496, NSK = 256, NROPE = 257, NRMS = 4352, NCACHE = 3840;
  const int total = NT + NSK + NROPE + NRMS + NCACHE;
  for (int u0 = blockIdx.x; u0 < total; u0 += gridDim.x) {
    int u = u0;
    if (u < NT) { transpose_job(p, u, (float*)smem); continue; }
    u -= NT;
    if (u < NSK) {
      int l = u >> 7; int r = u & 127;
      const float* src = p.peer_subkeys + (size_t)l * 32768;
      u16* dst = (u16*)(p.ws + (l ? OFF_WT_SK1 : OFF_WT_SK0));
#pragma unroll
      for (int j = 0; j < 2; ++j) {
        int i = r * 2048 + j * 1024 + tid * 4;
        int s = ((i >> 14) & 1) * 16384 + (i & 16383);
        float4 v = *(const float4*)(src + s);
        uint2 w; w.x = pack2(v.x, v.y); w.y = pack2(v.z, v.w);
        *(uint2*)(dst + i) = w;
      }
      continue;
    }
    u -= NSK;
    if (u < NROPE) {
      int i = u * 256 + tid;
      if (i < 2056 * 32) {
        int pi = i >> 5, d = i & 31;
        int pos = pi < 2048 ? pi : (16384 + pi - 2048);
        float inv = (float)pow(10000.0, -(double)d / 32.0);
        float ang = (float)pos * inv;
        double sn, cs;
        sincos((double)ang, &sn, &cs);
        float2* rt = (float2*)(p.ws + OFF_ROPE);
        rt[i] = make_float2((float)cs, (float)sn);
      }
      continue;
    }
    u -= NROPE;
    if (u < NRMS) {
      int t = u * 4 + wid;
      rmsnorm_row(xin_row(p, t), p.rg_norm, (u16*)(p.ws + OFF_XN) + (size_t)t * 1024, lane);
      continue;
    }
    u -= NRMS;
    {
      int which = u / 1920; int r = u - which * 1920;
      int b = r / 15, c = r - b * 15;
      const float* src = (which ? p.cache_v : p.cache_k) + (size_t)b * 32768 + 2048 + c * 2048;
      float* dst = p.out + (which ? OUT_VS : OUT_KS) + (size_t)b * 32768 + c * 2048;
#pragma unroll
      for (int j = 0; j < 2; ++j) {
        int o = j * 1024 + tid * 4;
        *(float4*)(dst + o) = *(const float4*)(src + o);
      }
    }
  }
}

__device__ __forceinline__ void ph_cvt_tables(const Params& p, int layer) {
  const int lane = ltid() & 63, wid = ltid() >> 6;
  for (int u = blockIdx.x; u < 8192; u += gridDim.x) {
    const int which = u >> 12; const int row = (u & 4095) * 4 + wid;
    const float* src = (which ? p.peer_v : p.peer_u) + (size_t)layer * 16777216 + (size_t)row * 1024 + lane * 16;
    unsigned char* dst = (unsigned char*)(p.ws + (which ? OFF_V8 : OFF_U8)) + (size_t)(lane >> 3) * 2097152 + (size_t)row * 128 + (lane & 7) * 16;
    float* sc = (float*)(p.ws + (which ? OFF_VSC : OFF_USC));
    float4 a = *(const float4*)(src), b = *(const float4*)(src + 4), c = *(const float4*)(src + 8), d = *(const float4*)(src + 12);
    float m = fmaxf(fmaxf(fmaxf(fabsf(a.x), fabsf(a.y)), fmaxf(fabsf(a.z), fabsf(a.w))), fmaxf(fmaxf(fabsf(b.x), fabsf(b.y)), fmaxf(fabsf(b.z), fabsf(b.w))));
    m = fmaxf(m, fmaxf(fmaxf(fmaxf(fabsf(c.x), fabsf(c.y)), fmaxf(fabsf(c.z), fabsf(c.w))), fmaxf(fmaxf(fabsf(d.x), fabsf(d.y)), fmaxf(fabsf(d.z), fabsf(d.w)))));
#pragma unroll
    for (int o = 32; o > 0; o >>= 1) m = fmaxf(m, __shfl_xor(m, o));
    const float scl = m > 0.f ? 440.f / m : 1.f;
    uint4 w; int t;
    t = 0; t = __builtin_amdgcn_cvt_pk_fp8_f32(a.x * scl, a.y * scl, t, false); t = __builtin_amdgcn_cvt_pk_fp8_f32(a.z * scl, a.w * scl, t, true); w.x = (unsigned)t;
    t = 0; t = __builtin_amdgcn_cvt_pk_fp8_f32(b.x * scl, b.y * scl, t, false); t = __builtin_amdgcn_cvt_pk_fp8_f32(b.z * scl, b.w * scl, t, true); w.y = (unsigned)t;
    t = 0; t = __builtin_amdgcn_cvt_pk_fp8_f32(c.x * scl, c.y * scl, t, false); t = __builtin_amdgcn_cvt_pk_fp8_f32(c.z * scl, c.w * scl, t, true); w.z = (unsigned)t;
    t = 0; t = __builtin_amdgcn_cvt_pk_fp8_f32(d.x * scl, d.y * scl, t, false); t = __builtin_amdgcn_cvt_pk_fp8_f32(d.z * scl, d.w * scl, t, true); w.w = (unsigned)t;
    *(uint4*)dst = w;
    if (lane == 0) sc[row] = m > 0.f ? m / 440.f : 1.f;
  }
}

__device__ __forceinline__ void ph_rmsnorm(const Params& p, const float* g) {
  const int lane = ltid() & 63, wid = ltid() >> 6;
  const float* x = (const float*)(p.ws + OFF_X);
  u16* xn = (u16*)(p.ws + OFF_XN);
  for (int u = blockIdx.x; u < 4352; u += gridDim.x) {
    int t = u * 4 + wid;
    rmsnorm_row(x + (size_t)t * 1024, g, xn + (size_t)t * 1024, lane);
  }
}

#define LASP __attribute__((address_space(3)))
template <class Epi>
__device__ __forceinline__ void gemm_tiles(const u16* __restrict__ A, int lda, const u16* __restrict__ W, int ldw,
                                           int K, int kmod, int ntn, const Epi& epi, char* smem_g) {
  LASP unsigned char* smem = (LASP unsigned char*)smem_g;
  const int tid = ltid(), lane = tid & 63, wid = tid >> 6;
  const int wr = wid >> 1, wc = wid & 1, fr = lane & 15, fq = lane >> 4;
  const int total = 136 * ntn;
  const int nk = K >> 6;
  int offA[4], offW[4];
#pragma unroll
  for (int i = 0; i < 4; ++i) {
    const int R = (i * 4 + wid) * 8 + (lane >> 3), C = ((lane & 7) ^ (lane >> 3)) * 8;
    offA[i] = R * lda + C; offW[i] = R * ldw + C;
  }
  const int lo0 = (fr >> 3) * 1024 + (fr & 7) * 128 + ((fq ^ (fr & 7)) * 16);
  const int lo1 = (fr >> 3) * 1024 + (fr & 7) * 128 + (((4 + fq) ^ (fr & 7)) * 16);
  for (int tile = blockIdx.x; tile < total; tile += gridDim.x) {
    const int tm = tile / ntn, tn = tile - tm * ntn;
    const u16* Ag = A + (size_t)(tm * 128) * lda + (kmod ? (tn % kmod) * 128 : 0);
    const u16* Wg = W + (size_t)(tn * 128) * ldw;
    f32x4 acc[4][4];
#pragma unroll
    for (int m = 0; m < 4; ++m)
#pragma unroll
      for (int n = 0; n < 4; ++n) acc[m][n] = f32x4{0.f, 0.f, 0.f, 0.f};
    for (int kt = 0; kt < nk; ++kt) {
      __syncthreads();
#pragma unroll
      for (int i = 0; i < 4; ++i) {
        __builtin_amdgcn_global_load_lds((const unsigned*)(Wg + offW[i] + kt * 64), (LASP unsigned*)(smem + i * 4096 + wid * 1024), 16, 0, 0);
        __builtin_amdgcn_global_load_lds((const unsigned*)(Ag + offA[i] + kt * 64), (LASP unsigned*)(smem + 16384 + i * 4096 + wid * 1024), 16, 0, 0);
      }
      asm volatile("s_waitcnt vmcnt(0)" ::: "memory");
      __syncthreads();
      const LASP unsigned char* sW = smem + wr * 8192;
      const LASP unsigned char* sA = smem + 16384 + wc * 8192;
#pragma unroll
      for (int ks = 0; ks < 2; ++ks) {
        const int lo = ks ? lo1 : lo0;
        bf16x8 a[4], b[4];
#pragma unroll
        for (int m = 0; m < 4; ++m) a[m] = *(const LASP bf16x8*)(sW + m * 2048 + lo);
#pragma unroll
        for (int n = 0; n < 4; ++n) b[n] = *(const LASP bf16x8*)(sA + n * 2048 + lo);
#pragma unroll
        for (int m = 0; m < 4; ++m)
#pragma unroll
          for (int n = 0; n < 4; ++n) acc[m][n] = __builtin_amdgcn_mfma_f32_16x16x32_bf16(a[m], b[n], acc[m][n], 0, 0, 0);
      }
    }
    epi(acc, tm * 128 + wc * 64, tn * 128 + wr * 64, fr, fq);
  }
}

struct EpiWin {
  u16* gate16; float* rec32;
  __device__ __forceinline__ void operator()(const f32x4 (&acc)[4][4], int tok0, int feat0, int fr, int fq) const {
#pragma unroll
    for (int n = 0; n < 4; ++n) {
      const int tok = tok0 + n * 16 + fr;
#pragma unroll
      for (int m = 0; m < 4; ++m) {
        const int f = feat0 + m * 16 + fq * 4;
        f32x4 v = acc[m][n];
        if (feat0 < 1024) {
          uint2 w; w.x = pack2(gelu_tanh(v[0]), gelu_tanh(v[1])); w.y = pack2(gelu_tanh(v[2]), gelu_tanh(v[3]));
          *(uint2*)(gate16 + (size_t)tok * 1024 + f) = w;
        } else {
          *(float4*)(rec32 + (size_t)tok * 1024 + (f - 1024)) = make_float4(v[0], v[1], v[2], v[3]);
        }
      }
    }
  }
};
struct EpiBd {
  float* loga; u16* ig16; const float *ba, *bx, *lam;
  __device__ __forceinline__ void operator()(const f32x4 (&acc)[4][4], int tok0, int feat0, int fr, int fq) const {
#pragma unroll
    for (int m = 0; m < 4; ++m) {
      const int f = feat0 + m * 16 + fq * 4;
      if (feat0 < 1024) {
        float4 b4 = *(const float4*)(ba + f);
        float4 l4 = *(const float4*)(lam + f);
        float sp0 = log1pf(__expf(-l4.x)), sp1 = log1pf(__expf(-l4.y)), sp2 = log1pf(__expf(-l4.z)), sp3 = log1pf(__expf(-l4.w));
#pragma unroll
        for (int n = 0; n < 4; ++n) {
          const int tok = tok0 + n * 16 + fr;
          f32x4 v = acc[m][n];
          float4 o;
          o.x = -8.f * sigmoidf_(v[0] + b4.x) * sp0;
          o.y = -8.f * sigmoidf_(v[1] + b4.y) * sp1;
          o.z = -8.f * sigmoidf_(v[2] + b4.z) * sp2;
          o.w = -8.f * sigmoidf_(v[3] + b4.w) * sp3;
          *(float4*)(loga + (size_t)tok * 1024 + f) = o;
        }
      } else {
        float4 b4 = *(const float4*)(bx + (f - 1024));
#pragma unroll
        for (int n = 0; n < 4; ++n) {
          const int tok = tok0 + n * 16 + fr;
          f32x4 v = acc[m][n];
          uint2 w;
          w.x = pack2(sigmoidf_(v[0] + b4.x), sigmoidf_(v[1] + b4.y));
          w.y = pack2(sigmoidf_(v[2] + b4.z), sigmoidf_(v[3] + b4.w));
          *(uint2*)(ig16 + (size_t)tok * 1024 + (f - 1024)) = w;
        }
      }
    }
  }
};
struct EpiResid {
  const float* xp; const float* xs; float* xres; int first;
  __device__ __forceinline__ void operator()(const f32x4 (&acc)[4][4], int tok0, int feat0, int fr, int fq) const {
#pragma unroll
    for (int n = 0; n < 4; ++n) {
      const int tok = tok0 + n * 16 + fr;
      const float* base = first ? (tok < NTP ? xp + (size_t)tok * 1024 : xs + (size_t)(tok - NTP) * 1024) : (xres + (size_t)tok * 1024);
#pragma unroll
      for (int m = 0; m < 4; ++m) {
        const int f = feat0 + m * 16 + fq * 4;
        float4 b = *(const float4*)(base + f);
        f32x4 v = acc[m][n];
        *(float4*)(xres + (size_t)tok * 1024 + f) = make_float4(b.x + v[0], b.y + v[1], b.z + v[2], b.w + v[3]);
      }
    }
  }
};
struct EpiBf16 {
  u16* o; int ld;
  __device__ __forceinline__ void operator()(const f32x4 (&acc)[4][4], int tok0, int feat0, int fr, int fq) const {
#pragma unroll
    for (int n = 0; n < 4; ++n) {
      const int tok = tok0 + n * 16 + fr;
#pragma unroll
      for (int m = 0; m < 4; ++m) {
        const int f = feat0 + m * 16 + fq * 4;
        f32x4 v = acc[m][n];
        uint2 w; w.x = pack2(v[0], v[1]); w.y = pack2(v[2], v[3]);
        *(uint2*)(o + (size_t)tok * ld + f) = w;
      }
    }
  }
};
struct EpiF32 {
  float* o; int ld;
  __device__ __forceinline__ void operator()(const f32x4 (&acc)[4][4], int tok0, int feat0, int fr, int fq) const {
#pragma unroll
    for (int n = 0; n < 4; ++n) {
      const int tok = tok0 + n * 16 + fr;
#pragma unroll
      for (int m = 0; m < 4; ++m) {
        const int f = feat0 + m * 16 + fq * 4;
        f32x4 v = acc[m][n];
        *(float4*)(o + (size_t)tok * ld + f) = make_float4(v[0], v[1], v[2], v[3]);
      }
    }
  }
};
__device__ __forceinline__ int mkkey(float v, int n) {
  int i = __float_as_int(v);
  i ^= (i >> 31) & 0x7fffffff;
  return (i & ~127) | (127 - n);
}
__device__ __forceinline__ float keyval(int k) {
  int i = (k & ~127) | 64;
  i ^= (i >> 31) & 0x7fffffff;
  return __int_as_float(i);
}
__device__ __forceinline__ int keyidx(int k) { return 127 - (k & 127); }
#define CE(i, j) { int hi_ = max(k[i], k[j]); int lo_ = min(k[i], k[j]); k[i] = hi_; k[j] = lo_; }

struct EpiTopk {
  int* tkey; char* smem;
  __device__ __forceinline__ void operator()(const f32x4 (&acc)[4][4], int tok0, int feat0, int fr, int fq) const {
    float* S = (float*)smem;
    const int tid = ltid(), lane = tid & 63, wid = tid >> 6, g = lane >> 4, li = lane & 15;
    const int wc = (tok0 >> 6) & 1, wr64 = feat0 & 127;
    const int tokbase = tok0 & ~127, hp = feat0 >> 7;
#pragma unroll 1
    for (int half = 0; half < 2; ++half) {
      __syncthreads();
      if (wc == half) {
#pragma unroll
        for (int n = 0; n < 4; ++n)
#pragma unroll
          for (int m = 0; m < 4; ++m) {
            f32x4 v = acc[m][n];
            *(float4*)(S + (n * 16 + fr) * 132 + wr64 + m * 16 + fq * 4) = make_float4(v[0], v[1], v[2], v[3]);
          }
      }
      __syncthreads();
#pragma unroll 1
      for (int pass = 0; pass < 4; ++pass) {
        const int row = pass * 16 + wid * 4 + g;
        const float* r = S + row * 132;
        float4 v0 = *(const float4*)(r + li * 4), v1 = *(const float4*)(r + 64 + li * 4);
        int k[8];
        k[0] = mkkey(v0.x, li * 4 + 0); k[1] = mkkey(v0.y, li * 4 + 1); k[2] = mkkey(v0.z, li * 4 + 2); k[3] = mkkey(v0.w, li * 4 + 3);
        k[4] = mkkey(v1.x, 64 + li * 4 + 0); k[5] = mkkey(v1.y, 64 + li * 4 + 1); k[6] = mkkey(v1.z, 64 + li * 4 + 2); k[7] = mkkey(v1.w, 64 + li * 4 + 3);
        CE(0, 1) CE(2, 3) CE(4, 5) CE(6, 7)
        CE(0, 2) CE(1, 3) CE(4, 6) CE(5, 7)
        CE(1, 2) CE(5, 6)
        CE(0, 4) CE(1, 5) CE(2, 6) CE(3, 7)
        CE(2, 4) CE(3, 5)
        CE(1, 2) CE(3, 4) CE(5, 6)
        int res = (int)0x80000000;
#pragma unroll
        for (int it = 0; it < 16; ++it) {
          const int M = grp_max_i(k[0]);
          const bool win = (k[0] == M);
          if (li == it) res = M;
#pragma unroll
          for (int i = 0; i < 7; ++i) k[i] = win ? k[i + 1] : k[i];
          k[7] = win ? (int)0x80000000 : k[7];
        }
        tkey[((size_t)(tokbase + half * 64 + row) * 16 + hp) * 16 + li] = res;
      }
    }
  }
};
struct EpiScoresTopk {
  const u16* sk; int* tkey; char* smem_g;
  __device__ __forceinline__ void operator()(const f32x4 (&acc)[4][4], int tok0, int feat0, int fr, int fq) const {
    LASP unsigned char* smem = (LASP unsigned char*)smem_g;
    const int tid = ltid(), lane = tid & 63, wid = tid >> 6, wr = wid >> 1, wc = wid & 1;
    const int tn = feat0 >> 7;
    const int swz = (lane * 16) ^ ((lane >> 5) << 5);
    __syncthreads();
#define SK_STAGE(kt2_)                                                                                           \
    _Pragma("unroll") for (int i = 0; i < 4; ++i) {                                                              \
      const int st = i * 4 + wid;                                                                                \
      const int R = (st >> 1) * 16 + (swz >> 6), C = (st & 1) * 32 + ((swz & 63) >> 1);                          \
      __builtin_amdgcn_global_load_lds((const unsigned*)(sk + (size_t)(tn * 128 + R) * 128 + (kt2_) * 64 + C),   \
                                       (LASP unsigned*)(smem + 32768 + i * 4096 + wid * 1024), 16, 0, 0);        \
    }
    SK_STAGE(0)
#pragma unroll
    for (int n = 0; n < 4; ++n)
#pragma unroll
      for (int m = 0; m < 4; ++m) {
        const int r = wc * 64 + n * 16 + fr, c = m * 16 + fq * 4;
        int ob = (r & 15) * 64 + (c & 31) * 2;
        ob ^= ((ob >> 9) & 1) << 5;
        const int off = wr * 16384 + ((r >> 4) * 2 + (c >> 5)) * 1024 + ob;
        f32x4 v = acc[m][n];
        typedef unsigned u32x2_t __attribute__((ext_vector_type(2)));
        u32x2_t w; w.x = pack2(v[0], v[1]); w.y = pack2(v[2], v[3]);
        *(LASP u32x2_t*)(smem + off) = w;
      }
    __builtin_amdgcn_sched_barrier(0);
    f32x4 acc2[4][4];
#pragma unroll
    for (int m = 0; m < 4; ++m)
#pragma unroll
      for (int n = 0; n < 4; ++n) acc2[m][n] = f32x4{0.f, 0.f, 0.f, 0.f};
    const int lane_off = (fr * 64 + fq * 16) ^ ((fr >> 3) << 5);
#pragma unroll 1
    for (int kt2 = 0; kt2 < 2; ++kt2) {
      asm volatile("s_waitcnt vmcnt(0)" ::: "memory");
      __syncthreads();
      const LASP unsigned char* sW = smem + 32768;
      const LASP unsigned char* sA = smem + kt2 * 16384;
      bf16x8 a[2][4];
#pragma unroll
      for (int ks = 0; ks < 2; ++ks)
#pragma unroll
        for (int m = 0; m < 4; ++m) a[ks][m] = *(const LASP bf16x8*)(sW + (wr * 8 + m * 2 + ks) * 1024 + lane_off);
      __syncthreads();
      if (kt2 == 0) { SK_STAGE(1) }
#pragma unroll
      for (int ks = 0; ks < 2; ++ks) {
        bf16x8 b[4];
#pragma unroll
        for (int n = 0; n < 4; ++n) b[n] = *(const LASP bf16x8*)(sA + (wc * 8 + n * 2 + ks) * 1024 + lane_off);
#pragma unroll
        for (int m = 0; m < 4; ++m)
#pragma unroll
          for (int n = 0; n < 4; ++n) acc2[m][n] = __builtin_amdgcn_mfma_f32_16x16x32_bf16(a[ks][m], b[n], acc2[m][n], 0, 0, 0);
        __builtin_amdgcn_sched_barrier(0);
      }
    }
#undef SK_STAGE
    EpiTopk e{tkey, smem_g};
    e(acc2, tok0, feat0, fr, fq);
  }
};
struct EpiKvq {
  u16 *k16, *v16, *q16; const float2* rope; float* out;
  __device__ __forceinline__ void operator()(const f32x4 (&acc)[4][4], int tok0, int feat0, int fr, int fq) const {
#pragma unroll
    for (int n = 0; n < 4; ++n) {
      const int tok = tok0 + n * 16 + fr;
      int b, t, pi, orow; bool is_p = tok < NTP;
      if (is_p) { b = tok >> 11; t = tok & 2047; pi = t; orow = t - 1920; }
      else { int ts = tok - NTP; b = ts >> 3; t = ts & 7; pi = 2048 + t; orow = 120 + t; }
      if (feat0 >= 256 && feat0 < 512) {
        const int kvh = (feat0 - 256) >> 6;
#pragma unroll
        for (int m = 0; m < 4; ++m) {
          const int d = m * 16 + fq * 4;
          f32x4 v = acc[m][n];
          uint2 w; w.x = pack2(v[0], v[1]); w.y = pack2(v[2], v[3]);
          *(uint2*)(v16 + (size_t)tok * 256 + kvh * 64 + d) = w;
          if (orow >= 0) {
            float* dst = out + (is_p ? OUT_VP : OUT_VS) + ((size_t)(b * 128 + orow) * 4 + kvh) * 64 + d;
            *(float4*)dst = make_float4(v[0], v[1], v[2], v[3]);
          }
        }
      } else {
        const bool isk = feat0 < 256;
        const float sc = isk ? 1.f : 0.125f;
#pragma unroll
        for (int m = 0; m < 2; ++m) {
          const int d = m * 16 + fq * 4;
          f32x4 x1 = acc[m][n], x2 = acc[m + 2][n];
          const float2* rp = rope + pi * 32 + d;
          float o1[4], o2[4];
#pragma unroll
          for (int j = 0; j < 4; ++j) {
            float2 csn = rp[j];
            o1[j] = (x1[j] * csn.x - x2[j] * csn.y) * sc;
            o2[j] = (x2[j] * csn.x + x1[j] * csn.y) * sc;
          }
          uint2 w1, w2;
          w1.x = pack2(o1[0], o1[1]); w1.y = pack2(o1[2], o1[3]);
          w2.x = pack2(o2[0], o2[1]); w2.y = pack2(o2[2], o2[3]);
          if (isk) {
            const int kvh = feat0 >> 6;
            *(uint2*)(k16 + (size_t)tok * 256 + kvh * 64 + d) = w1;
            *(uint2*)(k16 + (size_t)tok * 256 + kvh * 64 + d + 32) = w2;
            if (orow >= 0) {
              float* dst = out + (is_p ? OUT_KP : OUT_KS) + ((size_t)(b * 128 + orow) * 4 + kvh) * 64 + d;
              *(float4*)dst = make_float4(o1[0], o1[1], o1[2], o1[3]);
              *(float4*)(dst + 32) = make_float4(o2[0], o2[1], o2[2], o2[3]);
            }
          } else {
            const int f = feat0 - 512;
            *(uint2*)(q16 + (size_t)tok * 1024 + f + d) = w1;
            *(uint2*)(q16 + (size_t)tok * 1024 + f + d + 32) = w2;
          }
        }
      }
    }
  }
};

__device__ __forceinline__ void ph_conv(const Params& p) {
  const float* rec = (const float*)(p.ws + OFF_REC32);
  float* xc32 = (float*)(p.ws + OFF_XC32);
  u16* xc16 = (u16*)(p.ws + OFF_XC16);
  const int c = ltid() * 4;
  const float4 w0 = *(const float4*)(p.rg_conv_w + c), w1 = *(const float4*)(p.rg_conv_w + 1024 + c);
  const float4 w2 = *(const float4*)(p.rg_conv_w + 2048 + c), w3 = *(const float4*)(p.rg_conv_w + 3072 + c);
  const float4 cb = *(const float4*)(p.rg_conv_b + c);
  for (int u = blockIdx.x; u < NTOK / 8; u += gridDim.x) {
    const int tok0 = u * 8;
    int b, t0; const float* buf = nullptr;
    if (tok0 < NTP) { b = tok0 >> 11; t0 = tok0 & 2047; }
    else { b = (tok0 - NTP) >> 3; t0 = 0; buf = p.state_conv + (size_t)b * 3072; }
    float4 r1, r2, r3;
    const float4 z = make_float4(0.f, 0.f, 0.f, 0.f);
    if (t0 >= 3) {
      r1 = *(const float4*)(rec + (size_t)(tok0 - 1) * 1024 + c);
      r2 = *(const float4*)(rec + (size_t)(tok0 - 2) * 1024 + c);
      r3 = *(const float4*)(rec + (size_t)(tok0 - 3) * 1024 + c);
    } else if (buf) {
      r1 = *(const float4*)(buf + 2048 + c); r2 = *(const float4*)(buf + 1024 + c); r3 = *(const float4*)(buf + c);
    } else { r1 = z; r2 = z; r3 = z; }
    float4 r0[8];
#pragma unroll
    for (int s = 0; s < 8; ++s) r0[s] = *(const float4*)(rec + (size_t)(tok0 + s) * 1024 + c);
#pragma unroll
    for (int s = 0; s < 8; ++s) {
      const float4 x = r0[s];
      float4 o;
      o.x = cb.x + w3.x * x.x + w2.x * r1.x + w1.x * r2.x + w0.x * r3.x;
      o.y = cb.y + w3.y * x.y + w2.y * r1.y + w1.y * r2.y + w0.y * r3.y;
      o.z = cb.z + w3.z * x.z + w2.z * r1.z + w1.z * r2.z + w0.z * r3.z;
      o.w = cb.w + w3.w * x.w + w2.w * r1.w + w1.w * r2.w + w0.w * r3.w;
      const size_t off = (size_t)(tok0 + s) * 1024 + c;
      *(float4*)(xc32 + off) = o;
      uint2 w; w.x = pack2(o.x, o.y); w.y = pack2(o.z, o.w);
      *(uint2*)(xc16 + off) = w;
      const int t = t0 + s;
      if (tok0 < NTP) {
        if (t >= 2045) *(float4*)(p.out + OUT_CONVP + ((size_t)b * 3 + (t - 2045)) * 1024 + c) = x;
      } else {
        if (t >= 5) *(float4*)(p.out + OUT_CONVS + ((size_t)b * 3 + (t - 5)) * 1024 + c) = x;
      }
      r3 = r2; r2 = r1; r1 = x;
    }
  }
}

__device__ __forceinline__ float rg_mult(float la) {
  const float t = 2.f * la;
  const float ser = -t * (1.f + t * (0.5f + t * (0.16666667f + t * (0.041666668f + t * 0.0083333333f))));
  const float dir = 1.f - __expf(t);
  return __builtin_amdgcn_sqrtf(t > -0.25f ? ser : dir);
}
__device__ __forceinline__ void scan_step(const float* loga, const u16* ig16, const float* xc32, size_t off, float4& a, float4& bt) {
  float4 la = *(const float4*)(loga + off);
  uint2 gi = *(const uint2*)(ig16 + off);
  float4 xc = *(const float4*)(xc32 + off);
  a.x = __expf(la.x); a.y = __expf(la.y); a.z = __expf(la.z); a.w = __expf(la.w);
  bt.x = rg_mult(la.x) * bflo(gi.x) * xc.x;
  bt.y = rg_mult(la.y) * bfhi(gi.x) * xc.y;
  bt.z = rg_mult(la.z) * bflo(gi.y) * xc.z;
  bt.w = rg_mult(la.w) * bfhi(gi.y) * xc.w;
}
__device__ __forceinline__ void ph_scanA(const Params& p) {
  const float* loga = (const float*)(p.ws + OFF_LOGA);
  const u16* ig16 = (const u16*)(p.ws + OFF_IG16);
  const float* xc32 = (const float*)(p.ws + OFF_XC32);
  float* aggA = (float*)(p.ws + OFF_AGGA);
  float* aggB = (float*)(p.ws + OFF_AGGB);
  const int c = ltid() * 4;
  for (int item = blockIdx.x; item < 1024; item += gridDim.x) {
    const int b = item >> 7, ch = item & 127;
    float4 A = make_float4(1.f, 1.f, 1.f, 1.f), B = make_float4(0.f, 0.f, 0.f, 0.f);
    const size_t tok0 = (size_t)b * 2048 + ch * 16;
#pragma unroll 8
    for (int s = 0; s < 16; ++s) {
      float4 a, bt;
      scan_step(loga, ig16, xc32, (tok0 + s) * 1024 + c, a, bt);
      A.x *= a.x; A.y *= a.y; A.z *= a.z; A.w *= a.w;
      B.x = a.x * B.x + bt.x; B.y = a.y * B.y + bt.y; B.z = a.z * B.z + bt.z; B.w = a.w * B.w + bt.w;
    }
    *(float4*)(aggA + (size_t)item * 1024 + c) = A;
    *(float4*)(aggB + (size_t)item * 1024 + c) = B;
  }
}
__device__ __forceinline__ void ph_scanA2(const Params& p) {
  const float* aggA = (const float*)(p.ws + OFF_AGGA);
  float* aggB = (float*)(p.ws + OFF_AGGB);
  for (int u = blockIdx.x; u < 32; u += gridDim.x) {
    const int b = u >> 2, c = (u & 3) * 256 + ltid();
    float h = 0.f;
#pragma unroll 16
    for (int ch = 0; ch < 128; ++ch) {
      const size_t o = (size_t)(b * 128 + ch) * 1024 + c;
      const float A = aggA[o], B = aggB[o];
      aggB[o] = h;
      h = A * h + B;
    }
  }
}
__device__ __forceinline__ void ph_scanB(const Params& p) {
  const float* loga = (const float*)(p.ws + OFF_LOGA);
  const u16* ig16 = (const u16*)(p.ws + OFF_IG16);
  const float* xc32 = (const float*)(p.ws + OFF_XC32);
  const u16* gate16 = (const u16*)(p.ws + OFF_GATE16);
  u16* hg16 = (u16*)(p.ws + OFF_HG16);
  const float* aggB = (const float*)(p.ws + OFF_AGGB);
  const int c = ltid() * 4;
  for (int item = blockIdx.x; item < 1088; item += gridDim.x) {
    float4 h; size_t tok0; float* hout = nullptr;
    if (item < 1024) {
      const int b = item >> 7, ch = item & 127;
      h = *(const float4*)(aggB + (size_t)item * 1024 + c);
      tok0 = (size_t)b * 2048 + ch * 16;
      if (ch == 127) hout = p.out + OUT_HP + (size_t)b * 1024 + c;
    } else {
      tok0 = (size_t)NTP + (size_t)(item - 1024) * 16;
      h = make_float4(0.f, 0.f, 0.f, 0.f);
    }
#pragma unroll 8
    for (int s = 0; s < 16; ++s) {
      float4 a, bt;
      const size_t off = (tok0 + s) * 1024 + c;
      if (item >= 1024 && (s & 7) == 0) h = *(const float4*)(p.state_h + (size_t)((item - 1024) * 2 + (s >> 3)) * 1024 + c);
      scan_step(loga, ig16, xc32, off, a, bt);
      h.x = a.x * h.x + bt.x; h.y = a.y * h.y + bt.y; h.z = a.z * h.z + bt.z; h.w = a.w * h.w + bt.w;
      uint2 g = *(const uint2*)(gate16 + off);
      uint2 w; w.x = pack2(h.x * bflo(g.x), h.y * bfhi(g.x)); w.y = pack2(h.z * bflo(g.y), h.w * bfhi(g.y));
      *(uint2*)(hg16 + off) = w;
      if (item >= 1024 && (s & 7) == 7) *(float4*)(p.out + OUT_HS + (size_t)((item - 1024) * 2 + (s >> 3)) * 1024 + c) = h;
    }
    if (hout) *(float4*)hout = h;
  }
}

__device__ __forceinline__ int mkkey8(float v, int code) {
  int i = __float_as_int(v);
  i ^= (i >> 31) & 0x7fffffff;
  return (i & ~255) | code;
}
__device__ __forceinline__ float keyval8(int k) {
  int i = (k & ~255) | 128;
  i ^= (i >> 31) & 0x7fffffff;
  return __int_as_float(i);
}
__device__ __forceinline__ void ph_topk(const Params& p, char* smem) {
  const int tid = ltid(), lane = tid & 63, wid = tid >> 6, g = lane >> 4, li = lane & 15;
  const int* tkg = (const int*)(p.ws + OFF_TKEY);
  int* idx_out = (int*)(p.ws + OFF_IDX);
  float* gate_out = (float*)(p.ws + OFF_PGATE);
  int* tkey = (int*)smem + wid * 1024;
  float* tval = (float*)(tkey + 512);
  for (int tb = blockIdx.x; tb < 2176; tb += gridDim.x) {
    const int tbase = tb * 8 + wid * 2;
#pragma unroll
    for (int j = 0; j < 2; ++j) {
      const int4 kk = ((const int4*)(tkg + (size_t)tbase * 256))[j * 64 + lane];
      ((int4*)tkey)[j * 64 + lane] = kk;
      ((float4*)tval)[j * 64 + lane] = make_float4(keyval(kk.x), keyval(kk.y), keyval(kk.z), keyval(kk.w));
    }
    __syncthreads();
    const float* v1[4];
    float sv0[4]; int key[4], rk[4], ptr[4];
#pragma unroll
    for (int q = 0; q < 4; ++q) {
      const int h = (q & 1) * 4 + g;
      const float* v0 = tval + (q >> 1) * 256 + (h * 2) * 16;
      v1[q] = v0 + 16;
      sv0[q] = v0[li];
      ptr[q] = 0; rk[q] = 0;
      key[q] = mkkey8(sv0[q] + v1[q][0], 255 - li * 16);
    }
#pragma unroll 1
    for (int it = 0; it < 16; ++it) {
#pragma unroll
      for (int q = 0; q < 4; ++q) {
        const int M = grp_max_i(key[q]);
        const bool win = (key[q] == M);
        if (li == it) rk[q] = M;
        const int np = ptr[q] + (win ? 1 : 0);
        const int nk = (np < 16) ? mkkey8(sv0[q] + v1[q][np & 15], 255 - (li * 16 + np)) : (int)0x80000000;
        key[q] = win ? nk : key[q];
        ptr[q] = np;
      }
    }
#pragma unroll
    for (int q = 0; q < 4; ++q) {
      const int h = (q & 1) * 4 + g;
      const int t = tbase + (q >> 1);
      const int* t0 = tkey + (q >> 1) * 256 + (h * 2) * 16;
      const int rc = 255 - (rk[q] & 255);
      const float rv = keyval8(rk[q]);
      const int ia = keyidx(t0[rc >> 4]);
      const int ib = keyidx(t0[16 + (rc & 15)]);
      const float mx = grp_max_f(rv);
      const float ex = __expf(rv - mx);
      const float sm = grp_sum_f(ex);
      idx_out[(size_t)t * 128 + h * 16 + li] = ia * 128 + ib;
      gate_out[(size_t)t * 128 + h * 16 + li] = ex / sm;
    }
    __syncthreads();
  }
}

typedef float v2f __attribute__((ext_vector_type(2)));
template <int CTRL>
__device__ __forceinline__ float dpp_f(float v) { return __int_as_float(__builtin_amdgcn_update_dpp(0, __float_as_int(v), CTRL, 0xf, 0xf, false)); }
__device__ __forceinline__ float dot16_fp8(uint4 u, const v2f* x2) {
  v2f acc = {0.f, 0.f};
  acc = __builtin_elementwise_fma(__builtin_amdgcn_cvt_pk_f32_fp8((int)u.x, false), x2[0], acc);
  acc = __builtin_elementwise_fma(__builtin_amdgcn_cvt_pk_f32_fp8((int)u.x, true), x2[1], acc);
  acc = __builtin_elementwise_fma(__builtin_amdgcn_cvt_pk_f32_fp8((int)u.y, false), x2[2], acc);
  acc = __builtin_elementwise_fma(__builtin_amdgcn_cvt_pk_f32_fp8((int)u.y, true), x2[3], acc);
  acc = __builtin_elementwise_fma(__builtin_amdgcn_cvt_pk_f32_fp8((int)u.z, false), x2[4], acc);
  acc = __builtin_elementwise_fma(__builtin_amdgcn_cvt_pk_f32_fp8((int)u.z, true), x2[5], acc);
  acc = __builtin_elementwise_fma(__builtin_amdgcn_cvt_pk_f32_fp8((int)u.w, false), x2[6], acc);
  acc = __builtin_elementwise_fma(__builtin_amdgcn_cvt_pk_f32_fp8((int)u.w, true), x2[7], acc);
  return acc.x + acc.y;
}
__device__ __forceinline__ void axpy16_fp8(float w, uint4 u, v2f* o2) {
  const v2f w2 = {w, w};
  o2[0] = __builtin_elementwise_fma(__builtin_amdgcn_cvt_pk_f32_fp8((int)u.x, false), w2, o2[0]);
  o2[1] = __builtin_elementwise_fma(__builtin_amdgcn_cvt_pk_f32_fp8((int)u.x, true), w2, o2[1]);
  o2[2] = __builtin_elementwise_fma(__builtin_amdgcn_cvt_pk_f32_fp8((int)u.y, false), w2, o2[2]);
  o2[3] = __builtin_elementwise_fma(__builtin_amdgcn_cvt_pk_f32_fp8((int)u.y, true), w2, o2[3]);
  o2[4] = __builtin_elementwise_fma(__builtin_amdgcn_cvt_pk_f32_fp8((int)u.z, false), w2, o2[4]);
  o2[5] = __builtin_elementwise_fma(__builtin_amdgcn_cvt_pk_f32_fp8((int)u.z, true), w2, o2[5]);
  o2[6] = __builtin_elementwise_fma(__builtin_amdgcn_cvt_pk_f32_fp8((int)u.w, false), w2, o2[6]);
  o2[7] = __builtin_elementwise_fma(__builtin_amdgcn_cvt_pk_f32_fp8((int)u.w, true), w2, o2[7]);
}
__device__ __forceinline__ float reduce4_row(float d0, float d1, float d2, float d3, int lane) {
  const bool b0 = lane & 1, b1 = lane & 2;
  const float k0 = b0 ? d1 : d0, s0 = b0 ? d0 : d1;
  const float k1 = b0 ? d3 : d2, s1 = b0 ? d2 : d3;
  const float r0 = k0 + dpp_f<0xB1>(s0);
  const float r1 = k1 + dpp_f<0xB1>(s1);
  const float kk = b1 ? r1 : r0, ss = b1 ? r0 : r1;
  float q = kk + dpp_f<0x4E>(ss);
  q += dpp_f<0x128>(q);
  q += dpp_f<0x124>(q);
  return q;
}
#define EXP_LOAD(dst, dsc, TAB, SC, kbase, esrc)                                     \
  _Pragma("unroll") for (int j = 0; j < 8; ++j) {                                   \
    const int e = __builtin_amdgcn_readlane(esrc, ((kbase) + j) & 63);              \
    dst[j] = ((const uint4*)(TAB + (size_t)e * 1024))[lane];                        \
    dsc[j] = SC[e];                                                                  \
  }
#define EXP_LOADV(dst, TAB, kbase, esrc)                                             \
  _Pragma("unroll") for (int j = 0; j < 8; ++j) {                                   \
    const int e = __builtin_amdgcn_readlane(esrc, ((kbase) + j) & 63);              \
    dst[j] = ((const uint4*)(TAB + (size_t)e * 1024))[lane];                        \
  }
#define EXP_UDOT(src, ssc, kbase)                                                    \
  {                                                                                  \
    float d[8];                                                                      \
    _Pragma("unroll") for (int j = 0; j < 8; ++j) d[j] = dot16_fp8(src[j], x2) * ssc[j]; \
    const float qa = reduce4_row(d[0], d[1], d[2], d[3], lane);                      \
    const float qb = reduce4_row(d[4], d[5], d[6], d[7], lane);                      \
    float q = (lane & 4) ? qb : qa;                                                  \
    q += __shfl_xor(q, 16);                                                          \
    q += __shfl_xor(q, 32);                                                          \
    if ((lane >> 3) == ((((kbase)) & 63) >> 3)) { if ((kbase) < 64) h_lo = q; else h_hi = q; } \
  }
#define EXP_VACC(src, kbase, wsrc)                                                   \
  _Pragma("unroll") for (int j = 0; j < 8; ++j) {                                   \
    const float w = __int_as_float(__builtin_amdgcn_readlane(__float_as_int(wsrc), ((kbase) + j) & 63)); \
    axpy16_fp8(w, src[j], o2);                                                       \
  }

__device__ __forceinline__ void ph_expert(const Params& p, int layer) {
  const int lane = ltid() & 63, wid = ltid() >> 6;
  u16* xn16 = (u16*)(p.ws + OFF_XN);
  float* xres = (float*)(p.ws + OFF_X);
  const int* idxs = (const int*)(p.ws + OFF_IDX);
  const float* gates = (const float*)(p.ws + OFF_PGATE);
  const unsigned char* U = (const unsigned char*)(p.ws + OFF_U8);
  const unsigned char* V = (const unsigned char*)(p.ws + OFF_V8);
  const float* USC = (const float*)(p.ws + OFF_USC);
  const float* VSC = (const float*)(p.ws + OFF_VSC);
  for (int tb = blockIdx.x; tb < 4352; tb += gridDim.x) {
    const int t = tb * 4 + wid;
    v2f x2[8];
    {
      const uint4* xr = (const uint4*)(xn16 + (size_t)t * 1024 + lane * 16);
      uint4 xa = xr[0], xb = xr[1];
      x2[0] = v2f{bflo(xa.x), bfhi(xa.x)}; x2[1] = v2f{bflo(xa.y), bfhi(xa.y)};
      x2[2] = v2f{bflo(xa.z), bfhi(xa.z)}; x2[3] = v2f{bflo(xa.w), bfhi(xa.w)};
      x2[4] = v2f{bflo(xb.x), bfhi(xb.x)}; x2[5] = v2f{bflo(xb.y), bfhi(xb.y)};
      x2[6] = v2f{bflo(xb.z), bfhi(xb.z)}; x2[7] = v2f{bflo(xb.w), bfhi(xb.w)};
    }
    const int e_lo = idxs[(size_t)t * 128 + lane], e_hi = idxs[(size_t)t * 128 + 64 + lane];
    const float g_lo = gates[(size_t)t * 128 + lane], g_hi = gates[(size_t)t * 128 + 64 + lane];
    const float vs_lo = VSC[e_lo], vs_hi = VSC[e_hi];
    float h_lo = 0.f, h_hi = 0.f;
    {
      uint4 ba[8], bb[8]; float sa[8], sb[8];
      EXP_LOAD(ba, sa, U, USC, 0, e_lo)
#pragma unroll 1
      for (int kb = 0; kb < 64; kb += 16) {
        EXP_LOAD(bb, sb, U, USC, kb + 8, e_lo)
        EXP_UDOT(ba, sa, kb)
        if (kb + 16 < 64) { EXP_LOAD(ba, sa, U, USC, kb + 16, e_lo) } else { EXP_LOAD(ba, sa, U, USC, 0, e_hi) }
        EXP_UDOT(bb, sb, kb + 8)
      }
#pragma unroll 1
      for (int kb = 64; kb < 128; kb += 16) {
        EXP_LOAD(bb, sb, U, USC, kb + 8, e_hi)
        EXP_UDOT(ba, sa, kb)
        if (kb + 16 < 128) { EXP_LOAD(ba, sa, U, USC, kb + 16, e_hi) }
        EXP_UDOT(bb, sb, kb + 8)
      }
    }
    const float w_lo = 0.5f * h_lo * (1.f + erff(h_lo * 0.70710678118654752f)) * g_lo * vs_lo;
    const float w_hi = 0.5f * h_hi * (1.f + erff(h_hi * 0.70710678118654752f)) * g_hi * vs_hi;
    v2f o2[8];
#pragma unroll
    for (int i = 0; i < 8; ++i) o2[i] = v2f{0.f, 0.f};
    {
      uint4 ba[8], bb[8];
      EXP_LOADV(ba, V, 0, e_lo)
#pragma unroll 1
      for (int kb = 0; kb < 64; kb += 16) {
        EXP_LOADV(bb, V, kb + 8, e_lo)
        EXP_VACC(ba, kb, w_lo)
        if (kb + 16 < 64) { EXP_LOADV(ba, V, kb + 16, e_lo) } else { EXP_LOADV(ba, V, 0, e_hi) }
        EXP_VACC(bb, kb + 8, w_lo)
      }
#pragma unroll 1
      for (int kb = 64; kb < 128; kb += 16) {
        EXP_LOADV(bb, V, kb + 8, e_hi)
        EXP_VACC(ba, kb, w_hi)
        if (kb + 16 < 128) { EXP_LOADV(ba, V, kb + 16, e_hi) }
        EXP_VACC(bb, kb + 8, w_hi)
      }
    }
    float o[16];
#pragma unroll
    for (int i = 0; i < 8; ++i) { o[2 * i] = o2[i].x; o[2 * i + 1] = o2[i].y; }
    float* xr = xres + (size_t)t * 1024 + lane * 16;
    float ss = 0.f;
#pragma unroll
    for (int i = 0; i < 4; ++i) {
      float4 r = *(const float4*)(xr + i * 4);
      o[4 * i] += r.x; o[4 * i + 1] += r.y; o[4 * i + 2] += r.z; o[4 * i + 3] += r.w;
      ss += o[4 * i] * o[4 * i] + o[4 * i + 1] * o[4 * i + 1] + o[4 * i + 2] * o[4 * i + 2] + o[4 * i + 3] * o[4 * i + 3];
    }
    ss = wave_sum(ss);
    const float rs = rsqrtf(ss * (1.f / 1024.f) + 1e-6f);
    if (layer == 0) {
#pragma unroll
      for (int i = 0; i < 4; ++i) *(float4*)(xr + i * 4) = make_float4(o[4 * i], o[4 * i + 1], o[4 * i + 2], o[4 * i + 3]);
      uint4 wa, wb;
      wa.x = pack2(o[0] * rs, o[1] * rs); wa.y = pack2(o[2] * rs, o[3] * rs); wa.z = pack2(o[4] * rs, o[5] * rs); wa.w = pack2(o[6] * rs, o[7] * rs);
      wb.x = pack2(o[8] * rs, o[9] * rs); wb.y = pack2(o[10] * rs, o[11] * rs); wb.z = pack2(o[12] * rs, o[13] * rs); wb.w = pack2(o[14] * rs, o[15] * rs);
      uint4* xw = (uint4*)(xn16 + (size_t)t * 1024 + lane * 16);
      xw[0] = wa; xw[1] = wb;
    } else {
      const float* fg = p.final_norm + lane * 16;
      float* y = p.out + OUT_Y + (size_t)t * 1024 + lane * 16;
#pragma unroll
      for (int i = 0; i < 4; ++i) {
        float4 g = *(const float4*)(fg + i * 4);
        *(float4*)(y + i * 4) = make_float4(o[4 * i] * rs * g.x, o[4 * i + 1] * rs * g.y, o[4 * i + 2] * rs * g.z, o[4 * i + 3] * rs * g.w);
      }
    }
  }
}

struct XInfo { int nloc, nx, rank, xr; };
__device__ __forceinline__ float reduce8(float v) {
  v += dpp_f<0xB1>(v); v += dpp_f<0x4E>(v); v += dpp_f<0x141>(v);
  return v;
}
__device__ __forceinline__ void ph_expert_u(const Params& p, const XInfo xi) {
  const int lane = ltid() & 63, wid = ltid() >> 6, g = lane >> 3, i8 = lane & 7;
  const u16* xn16 = (const u16*)(p.ws + OFF_XN);
  const int* idxs = (const int*)(p.ws + OFF_IDX);
  float* ph = (float*)(p.ws + OFF_PH);
  for (int c = xi.xr; c < 8; c += xi.nx) {
    const unsigned char* Us = (const unsigned char*)(p.ws + OFF_U8) + (size_t)c * 2097152;
    const unsigned lo = (unsigned)i8 * 16u;
    int t = xi.rank * 4 + wid;
    int e[16];
    {
      const int t0 = min(t, NTOK - 1);
      const int4* ip = (const int4*)(idxs + (size_t)t0 * 128 + g * 16);
#pragma unroll
      for (int j = 0; j < 4; ++j) { int4 q = ip[j]; e[4 * j] = q.x; e[4 * j + 1] = q.y; e[4 * j + 2] = q.z; e[4 * j + 3] = q.w; }
    }
    for (; t < NTOK; t += xi.nloc * 4) {
      uint4 seg[16];
#pragma unroll
      for (int j = 0; j < 16; ++j) seg[j] = *(const uint4*)(Us + ((unsigned)e[j] * 128u + lo));
      v2f x2[8];
      {
        const uint4* xr = (const uint4*)(xn16 + (size_t)t * 1024 + c * 128 + i8 * 16);
        uint4 xa = xr[0], xb = xr[1];
        x2[0] = v2f{bflo(xa.x), bfhi(xa.x)}; x2[1] = v2f{bflo(xa.y), bfhi(xa.y)};
        x2[2] = v2f{bflo(xa.z), bfhi(xa.z)}; x2[3] = v2f{bflo(xa.w), bfhi(xa.w)};
        x2[4] = v2f{bflo(xb.x), bfhi(xb.x)}; x2[5] = v2f{bflo(xb.y), bfhi(xb.y)};
        x2[6] = v2f{bflo(xb.z), bfhi(xb.z)}; x2[7] = v2f{bflo(xb.w), bfhi(xb.w)};
      }
      {
        const int tn = min(t + xi.nloc * 4, NTOK - 1);
        const int4* ip = (const int4*)(idxs + (size_t)tn * 128 + g * 16);
#pragma unroll
        for (int j = 0; j < 4; ++j) { int4 q = ip[j]; e[4 * j] = q.x; e[4 * j + 1] = q.y; e[4 * j + 2] = q.z; e[4 * j + 3] = q.w; }
      }
      float d[16];
#pragma unroll
      for (int j = 0; j < 16; ++j) d[j] = reduce8(dot16_fp8(seg[j], x2));
      if (i8 == 0) {
        float* o = ph + ((size_t)c * NTOK + t) * 128 + g * 16;
#pragma unroll
        for (int j = 0; j < 4; ++j) *(float4*)(o + 4 * j) = make_float4(d[4 * j], d[4 * j + 1], d[4 * j + 2], d[4 * j + 3]);
      }
    }
  }
}
__device__ __forceinline__ void ph_expert_combine(const Params& p) {
  const int* idxs = (const int*)(p.ws + OFF_IDX);
  float* gates = (float*)(p.ws + OFF_PGATE);
  const float* ph = (const float*)(p.ws + OFF_PH);
  const float* USC = (const float*)(p.ws + OFF_USC);
  const float* VSC = (const float*)(p.ws + OFF_VSC);
  for (int i = blockIdx.x * 256 + ltid(); i < NTOK * 128; i += gridDim.x * 256) {
    float s = 0.f;
#pragma unroll
    for (int c = 0; c < 8; ++c) s += ph[(size_t)c * NTOK * 128 + i];
    const int e = idxs[i];
    const float h = s * USC[e];
    gates[i] = 0.5f * h * (1.f + erff(h * 0.70710678118654752f)) * gates[i] * VSC[e];
  }
}
__device__ __forceinline__ void ph_expert_v(const Params& p, const XInfo xi) {
  const int lane = ltid() & 63, wid = ltid() >> 6, g = lane >> 3, i8 = lane & 7;
  const int* idxs = (const int*)(p.ws + OFF_IDX);
  const float* wts = (const float*)(p.ws + OFF_PGATE);
  float* xres = (float*)(p.ws + OFF_X);
  for (int c = xi.xr; c < 8; c += xi.nx) {
    const unsigned char* Vs = (const unsigned char*)(p.ws + OFF_V8) + (size_t)c * 2097152;
    const unsigned lo = (unsigned)i8 * 16u;
    int t = xi.rank * 4 + wid;
    int e[16]; float w[16];
    {
      const int t0 = min(t, NTOK - 1);
      const int4* ip = (const int4*)(idxs + (size_t)t0 * 128 + g * 16);
      const float4* wp = (const float4*)(wts + (size_t)t0 * 128 + g * 16);
#pragma unroll
      for (int j = 0; j < 4; ++j) { int4 q = ip[j]; float4 r = wp[j]; e[4 * j] = q.x; e[4 * j + 1] = q.y; e[4 * j + 2] = q.z; e[4 * j + 3] = q.w; w[4 * j] = r.x; w[4 * j + 1] = r.y; w[4 * j + 2] = r.z; w[4 * j + 3] = r.w; }
    }
    for (; t < NTOK; t += xi.nloc * 4) {
      v2f o2[8];
#pragma unroll
      for (int i = 0; i < 8; ++i) o2[i] = v2f{0.f, 0.f};
#pragma unroll
      for (int hb = 0; hb < 2; ++hb) {
        uint4 seg[8];
#pragma unroll
        for (int j = 0; j < 8; ++j) seg[j] = *(const uint4*)(Vs + ((unsigned)e[hb * 8 + j] * 128u + lo));
#pragma unroll
        for (int j = 0; j < 8; ++j) axpy16_fp8(w[hb * 8 + j], seg[j], o2);
        __builtin_amdgcn_sched_barrier(0);
      }
      {
        const int tn = min(t + xi.nloc * 4, NTOK - 1);
        const int4* ip = (const int4*)(idxs + (size_t)tn * 128 + g * 16);
        const float4* wp = (const float4*)(wts + (size_t)tn * 128 + g * 16);
#pragma unroll
        for (int j = 0; j < 4; ++j) { int4 q = ip[j]; float4 r = wp[j]; e[4 * j] = q.x; e[4 * j + 1] = q.y; e[4 * j + 2] = q.z; e[4 * j + 3] = q.w; w[4 * j] = r.x; w[4 * j + 1] = r.y; w[4 * j + 2] = r.z; w[4 * j + 3] = r.w; }
      }
      float o[16];
#pragma unroll
      for (int i = 0; i < 8; ++i) { o[2 * i] = o2[i].x; o[2 * i + 1] = o2[i].y; }
#pragma unroll
      for (int i = 0; i < 16; ++i) {
        float v = o[i];
        v += dpp_f<0x128>(v);
        v += __shfl_xor(v, 16);
        v += __shfl_xor(v, 32);
        o[i] = v;
        if ((i & 3) == 3) __builtin_amdgcn_sched_barrier(0);
      }
      if (g == 0) {
        float* xr = xres + (size_t)t * 1024 + c * 128 + i8 * 16;
#pragma unroll
        for (int i = 0; i < 4; ++i) {
          float4 r = *(const float4*)(xr + i * 4);
          *(float4*)(xr + i * 4) = make_float4(r.x + o[4 * i], r.y + o[4 * i + 1], r.z + o[4 * i + 2], r.w + o[4 * i + 3]);
        }
      }
    }
  }
}
__device__ __forceinline__ void ph_post_norm(const Params& p, int layer) {
  const int lane = ltid() & 63, wid = ltid() >> 6;
  const float* xres = (const float*)(p.ws + OFF_X);
  u16* xn16 = (u16*)(p.ws + OFF_XN);
  for (int u = blockIdx.x; u < 4352; u += gridDim.x) {
    const int t = u * 4 + wid;
    const float* x = xres + (size_t)t * 1024;
    float4 v[4]; float ss = 0.f;
#pragma unroll
    for (int i = 0; i < 4; ++i) {
      v[i] = *(const float4*)(x + i * 256 + lane * 4);
      ss += v[i].x * v[i].x + v[i].y * v[i].y + v[i].z * v[i].z + v[i].w * v[i].w;
    }
    ss = wave_sum(ss);
    const float r = rsqrtf(ss * (1.f / 1024.f) + 1e-6f);
    if (layer == 0) {
#pragma unroll
      for (int i = 0; i < 4; ++i) {
        uint2 w; w.x = pack2(v[i].x * r, v[i].y * r); w.y = pack2(v[i].z * r, v[i].w * r);
        *(uint2*)(xn16 + (size_t)t * 1024 + i * 256 + lane * 4) = w;
      }
    } else {
      float* y = p.out + OUT_Y + (size_t)t * 1024;
#pragma unroll
      for (int i = 0; i < 4; ++i) {
        float4 gg = *(const float4*)(p.final_norm + i * 256 + lane * 4);
        *(float4*)(y + i * 256 + lane * 4) = make_float4(v[i].x * r * gg.x, v[i].y * r * gg.y, v[i].z * r * gg.z, v[i].w * r * gg.w);
      }
    }
  }
}

__device__ __forceinline__ void ph_attn(const Params& p, char* smem) {
  const int tid = ltid(), lane = tid & 63, wid = tid >> 6, fr = lane & 15, fq = lane >> 4;
  const u16* k16 = (const u16*)(p.ws + OFF_K16);
  const u16* v16 = (const u16*)(p.ws + OFF_V16A);
  const u16* q16 = (const u16*)(p.ws + OFF_Q16);
  u16* o16 = (u16*)(p.ws + OFF_O16);
  u16* Ks = (u16*)smem;
  u16* Vt = (u16*)(smem + 27648);
  for (int item = blockIdx.x; item < 1536; item += gridDim.x) {
    const bool is_p = item < 1024;
    int b, kvh, q0 = 0, nsub, nvalid, kpos0, minpos, tokbase;
    if (is_p) { b = item >> 7; kvh = (item >> 5) & 3; q0 = (item & 31) * 64; nsub = 4; nvalid = 192; kpos0 = q0 - 128; minpos = 0; tokbase = b * 2048; }
    else { int it2 = item - 1024; b = it2 >> 2; kvh = it2 & 3; nsub = 1; nvalid = 136; kpos0 = -128; minpos = -100000; tokbase = NTP + b * 8; }
    __syncthreads();
#pragma unroll 1
    for (int c = tid; c < 1536; c += 256) {
      const int j = c >> 3, ch = c & 7;
      uint4 kk = make_uint4(0, 0, 0, 0), vv = make_uint4(0, 0, 0, 0);
      if (is_p) {
        const int kp = kpos0 + j;
        if (kp >= 0) {
          const size_t off = (size_t)(tokbase + kp) * 256 + kvh * 64 + ch * 8;
          kk = *(const uint4*)(k16 + off); vv = *(const uint4*)(v16 + off);
        }
      } else {
        if (j < 128) {
          const size_t off = ((size_t)(b * 128 + j) * 4 + kvh) * 64 + ch * 8;
          float4 a0 = *(const float4*)(p.cache_k + off), a1 = *(const float4*)(p.cache_k + off + 4);
          float4 c0 = *(const float4*)(p.cache_v + off), c1 = *(const float4*)(p.cache_v + off + 4);
          kk.x = pack2(a0.x, a0.y); kk.y = pack2(a0.z, a0.w); kk.z = pack2(a1.x, a1.y); kk.w = pack2(a1.z, a1.w);
          vv.x = pack2(c0.x, c0.y); vv.y = pack2(c0.z, c0.w); vv.z = pack2(c1.x, c1.y); vv.w = pack2(c1.z, c1.w);
        } else if (j < 136) {
          const size_t off = (size_t)(tokbase + j - 128) * 256 + kvh * 64 + ch * 8;
          kk = *(const uint4*)(k16 + off); vv = *(const uint4*)(v16 + off);
        }
      }
      *(uint4*)(Ks + j * 72 + ch * 8) = kk;
      u16* vd = Vt + (ch * 8) * 200 + j;
      vd[0] = (u16)(vv.x & 0xffff); vd[200] = (u16)(vv.x >> 16);
      vd[400] = (u16)(vv.y & 0xffff); vd[600] = (u16)(vv.y >> 16);
      vd[800] = (u16)(vv.z & 0xffff); vd[1000] = (u16)(vv.z >> 16);
      vd[1200] = (u16)(vv.w & 0xffff); vd[1400] = (u16)(vv.w >> 16);
    }
    __syncthreads();
    const int head = kvh * 4 + wid;
    const float sink = p.sinks[head];
#pragma unroll 1
    for (int sub = 0; sub < nsub; ++sub) {
      int qtok, qp;
      if (is_p) { qp = q0 + sub * 16 + fr; qtok = tokbase + qp; }
      else { qp = fr & 7; qtok = tokbase + (fr & 7); }
      const u16* qrow = q16 + (size_t)qtok * 1024 + head * 64;
      const bf16x8 qf0 = *(const bf16x8*)(qrow + fq * 8);
      const bf16x8 qf1 = *(const bf16x8*)(qrow + 32 + fq * 8);
      f32x4 s[12];
#pragma unroll
      for (int ks = 0; ks < 12; ++ks) {
        const bf16x8 kf0 = *(const bf16x8*)(Ks + (ks * 16 + fr) * 72 + fq * 8);
        const bf16x8 kf1 = *(const bf16x8*)(Ks + (ks * 16 + fr) * 72 + 32 + fq * 8);
        f32x4 z = {0.f, 0.f, 0.f, 0.f};
        z = __builtin_amdgcn_mfma_f32_16x16x32_bf16(kf0, qf0, z, 0, 0, 0);
        s[ks] = __builtin_amdgcn_mfma_f32_16x16x32_bf16(kf1, qf1, z, 0, 0, 0);
        if ((ks & 3) == 3) __builtin_amdgcn_sched_barrier(0);
      }
      float mx = sink;
      const int lo_ = max(minpos, qp - 127), hi_ = min(qp, kpos0 + nvalid - 1);
      const unsigned span_ = (unsigned)(hi_ - lo_);
      const int kp0_ = kpos0 + fq * 4 - lo_;
#pragma unroll
      for (int ks = 0; ks < 12; ++ks)
#pragma unroll
        for (int j = 0; j < 4; ++j) {
          const bool valid = (unsigned)(kp0_ + ks * 16 + j) <= span_;
          const float v = valid ? s[ks][j] : -1.0e30f;
          s[ks][j] = v;
          mx = fmaxf(mx, v);
          if (j == 3) __builtin_amdgcn_sched_barrier(0);
        }
      mx = fmaxf(mx, __shfl_xor(mx, 16));
      mx = fmaxf(mx, __shfl_xor(mx, 32));
      float sum = 0.f;
#pragma unroll
      for (int ks = 0; ks < 12; ++ks)
#pragma unroll
        for (int j = 0; j < 4; ++j) {
          const float pv = (s[ks][j] > -1.0e29f) ? __expf(s[ks][j] - mx) : 0.f;
          s[ks][j] = pv;
          sum += pv;
          if (j == 3) __builtin_amdgcn_sched_barrier(0);
        }
      sum += __shfl_xor(sum, 16);
      sum += __shfl_xor(sum, 32);
      sum += __expf(sink - mx);
      const float inv = 1.f / sum;
      f32x4 o[4];
#pragma unroll
      for (int d = 0; d < 4; ++d) o[d] = f32x4{0.f, 0.f, 0.f, 0.f};
#pragma unroll
      for (int kk = 0; kk < 6; ++kk) {
        union { bf16x8 v; unsigned u[4]; } pb;
        pb.u[0] = pack2(s[2 * kk][0], s[2 * kk][1]); pb.u[1] = pack2(s[2 * kk][2], s[2 * kk][3]);
        pb.u[2] = pack2(s[2 * kk + 1][0], s[2 * kk + 1][1]); pb.u[3] = pack2(s[2 * kk + 1][2], s[2 * kk + 1][3]);
#pragma unroll
        for (int d = 0; d < 4; ++d) {
          union { bf16x8 v; uint2 h[2]; } vf;
          const u16* vr = Vt + (d * 16 + fr) * 200 + fq * 4;
          vf.h[0] = *(const uint2*)(vr + (2 * kk) * 16);
          vf.h[1] = *(const uint2*)(vr + (2 * kk + 1) * 16);
          o[d] = __builtin_amdgcn_mfma_f32_16x16x32_bf16(vf.v, pb.v, o[d], 0, 0, 0);
        }
        __builtin_amdgcn_sched_barrier(0);
      }
      if (is_p || fr < 8) {
#pragma unroll
        for (int d = 0; d < 4; ++d) {
          uint2 w; w.x = pack2(o[d][0] * inv, o[d][1] * inv); w.y = pack2(o[d][2] * inv, o[d][3] * inv);
          *(uint2*)(o16 + (size_t)qtok * 1024 + head * 64 + d * 16 + fq * 4) = w;
        }
      }
    }
  }
}


#define XB_TMO      128
#define XB_XCNT(j)  (256  + 64 * (j))
#define XB_XSUB(j)  (1280 + 64 * (j))
#define XB_XGEN(j)  (2304 + 64 * (j))
#define XB_TOP      3328
#define XB_TOPGEN   3392
#define XCD_BAR_WORDS 3456
#define XB_SPIN_CAP (1u << 20)
#define LAS __attribute__((address_space(3)))
__device__ __forceinline__ unsigned xb_ld(unsigned* p) { return __hip_atomic_load(p, __ATOMIC_RELAXED, __HIP_MEMORY_SCOPE_AGENT); }
__device__ __forceinline__ unsigned xb_add(unsigned* p, unsigned v) { return __hip_atomic_fetch_add(p, v, __ATOMIC_RELAXED, __HIP_MEMORY_SCOPE_AGENT); }
__device__ __forceinline__ unsigned xb_xcc_id() { return (unsigned)__builtin_amdgcn_s_getreg((3 << 11) | 20) & 0xFu; }
#define XB_SPIN(cond, bar) do { unsigned _sp = 0; while (cond) { __builtin_amdgcn_s_sleep(1); \
    if ((++_sp & 255u) == 0u) { if (xb_ld(&(bar)[XB_TMO])) break; if (_sp > XB_SPIN_CAP) { atomicAdd(&(bar)[XB_TMO], 1u); break; } } } } while (0)
struct XcdBarrier { unsigned* bar; unsigned x; volatile LAS unsigned* st; };
__device__ __forceinline__ XcdBarrier xcd_barrier_post(unsigned* bar, volatile LAS unsigned* st) {
  XcdBarrier b; b.bar = bar; b.x = xb_xcc_id(); b.st = st;
  if (threadIdx.x == 0) st[2] = xb_add(&bar[XB_XCNT(b.x)], 1u);
  return b;
}
__device__ __forceinline__ void xcd_barrier_complete(unsigned* bar, unsigned x, unsigned& nloc, unsigned& nx, unsigned& xr) {
  const unsigned G = gridDim.x * gridDim.y * gridDim.z;
  unsigned sum, cnt, mine, below, sp = 0u;
  for (;;) {
    sum = 0u; cnt = 0u; mine = 0u; below = 0u;
#pragma unroll
    for (unsigned j = 0; j < 16; ++j) { const unsigned c = xb_ld(&bar[XB_XCNT(j)]); sum += c; cnt += (c > 0u) ? 1u : 0u; mine = (j == x) ? c : mine; below += (j < x && c > 0u) ? 1u : 0u; }
    if (sum == G) break;
    __builtin_amdgcn_s_sleep(1);
    if ((++sp & 255u) == 0u) { if (xb_ld(&bar[XB_TMO])) break; if (sp > XB_SPIN_CAP) { atomicAdd(&bar[XB_TMO], 1u); break; } }
  }
  nloc = mine > 0u ? mine : 1u; nx = cnt > 0u ? cnt : 1u; xr = below;
}
__device__ __forceinline__ void xcd_barrier(const XcdBarrier& b) {
  asm volatile("s_waitcnt vmcnt(0)" ::: "memory");
  __syncthreads();
  if (threadIdx.x == 0) {
    unsigned* bar = b.bar;
    __builtin_amdgcn_s_waitcnt(0);
    unsigned nloc = b.st[0], nx = b.st[1];
    if (nloc == 0u) { unsigned xr; xcd_barrier_complete(bar, b.x, nloc, nx, xr); b.st[0] = nloc; b.st[1] = nx; b.st[3] = xr; }
    const unsigned old = xb_add(&bar[XB_XSUB(b.x)], 1u);
    const unsigned gen = old / nloc;
    if (old + 1u == (gen + 1u) * nloc) {
      __builtin_amdgcn_fence(__ATOMIC_RELEASE, "agent");
      asm volatile("s_waitcnt vmcnt(0)" ::: "memory");
      const unsigned og = xb_add(&bar[XB_TOP], 1u);
      const unsigned tg = og / nx;
      if (og + 1u == (tg + 1u) * nx) xb_add(&bar[XB_TOPGEN], 1u);
      else XB_SPIN(xb_ld(&bar[XB_TOPGEN]) == tg, bar);
      __builtin_amdgcn_fence(__ATOMIC_ACQUIRE, "agent");
      xb_add(&bar[XB_XGEN(b.x)], 1u);
      asm volatile("s_waitcnt vmcnt(0)" ::: "memory");
    } else {
      XB_SPIN(xb_ld(&bar[XB_XGEN(b.x)]) == gen, bar);
      __builtin_amdgcn_fence(__ATOMIC_ACQUIRE, "agent");
      asm volatile("s_waitcnt vmcnt(0)" ::: "memory");
    }
  }
  __syncthreads();
}

typedef const Params __attribute__((address_space(4))) CParams;
__device__ __forceinline__ Params load_params(CParams* q) {
  Params r;
  r.x_prompt = q->x_prompt;
  r.x_sample = q->x_sample;
  r.state_conv = q->state_conv;
  r.state_h = q->state_h;
  r.cache_k = q->cache_k;
  r.cache_v = q->cache_v;
  r.rg_norm = q->rg_norm;
  r.rg_w_in = q->rg_w_in;
  r.rg_conv_w = q->rg_conv_w;
  r.rg_conv_b = q->rg_conv_b;
  r.rg_wa = q->rg_wa;
  r.rg_ba = q->rg_ba;
  r.rg_wx = q->rg_wx;
  r.rg_bx = q->rg_bx;
  r.rg_lambda = q->rg_lambda;
  r.rg_w_out = q->rg_w_out;
  r.kv_norm = q->kv_norm;
  r.w_kv = q->w_kv;
  r.attn_norm = q->attn_norm;
  r.w_q = q->w_q;
  r.sinks = q->sinks;
  r.w_o = q->w_o;
  r.ffn_norm = q->ffn_norm;
  r.peer_wq = q->peer_wq;
  r.peer_subkeys = q->peer_subkeys;
  r.peer_u = q->peer_u;
  r.peer_v = q->peer_v;
  r.final_norm = q->final_norm;
  r.out = q->out;
  r.ws = q->ws;
  r.ph_begin = q->ph_begin;
  r.ph_end = q->ph_end;
  return r;
}

template <int ph>
__device__ __forceinline__ void run_phase(const Params& p, char* smem, const XInfo xi) {
  char* ws = p.ws;
  switch (ph) {
    case 0: ph_convert0(p, smem); break;
    case 1: {
      EpiWin e{(u16*)(ws + OFF_GATE16), (float*)(ws + OFF_REC32)};
      gemm_tiles((const u16*)(ws + OFF_XN), 1024, (const u16*)(ws + OFF_WT_IN), 1024, 1024, 0, 16, e, smem);
    } break;
    case 2: ph_conv(p); break;
    case 3: {
      EpiBd e{(float*)(ws + OFF_LOGA), (u16*)(ws + OFF_IG16), p.rg_ba, p.rg_bx, p.rg_lambda};
      gemm_tiles((const u16*)(ws + OFF_XC16), 1024, (const u16*)(ws + OFF_WT_BD), 128, 128, 8, 16, e, smem);
    } break;
    case 4: ph_scanA(p); break;
    case 20: ph_scanA2(p); break;
    case 5: ph_scanB(p); break;
    case 6: {
      EpiResid e{p.x_prompt, p.x_sample, (float*)(ws + OFF_X), 1};
      gemm_tiles((const u16*)(ws + OFF_HG16), 1024, (const u16*)(ws + OFF_WT_OUT), 1024, 1024, 0, 8, e, smem);
      ph_cvt_tables(p, 0);
    } break;
    case 7: ph_rmsnorm(p, p.ffn_norm); break;
    case 8: case 16: {
      EpiScoresTopk e{(const u16*)(ws + (ph == 8 ? OFF_WT_SK0 : OFF_WT_SK1)), (int*)(ws + OFF_TKEY), smem};
      gemm_tiles((const u16*)(ws + OFF_XN), 1024, (const u16*)(ws + (ph == 8 ? OFF_WT_PQ0 : OFF_WT_PQ1)), 1024, 1024, 0, 16, e, smem);
    } break;
    case 9: case 17: {
      EpiTopk e{(int*)(ws + OFF_TKEY), smem};
      gemm_tiles((const u16*)(ws + OFF_QP16), 2048, (const u16*)(ws + (ph == 9 ? OFF_WT_SK0 : OFF_WT_SK1)), 128, 128, 16, 16, e, smem);
    } break;
    case 10: case 18: ph_topk(p, smem); break;
    case 11: case 19: ph_expert_u(p, xi); break;
    case 21: case 24: ph_expert_combine(p); break;
    case 22: case 25: ph_expert_v(p, xi); break;
    case 23: ph_post_norm(p, 0); break;
    case 26: ph_post_norm(p, 1); break;
    case 12: {
      EpiKvq e{(u16*)(ws + OFF_K16), (u16*)(ws + OFF_V16A), (u16*)(ws + OFF_Q16), (const float2*)(ws + OFF_ROPE), p.out};
      gemm_tiles((const u16*)(ws + OFF_XN), 1024, (const u16*)(ws + OFF_WT_KVQ), 1024, 1024, 0, 12, e, smem);
      ph_cvt_tables(p, 1);
    } break;
    case 13: ph_attn(p, smem); break;
    case 14: {
      EpiResid e{p.x_prompt, p.x_sample, (float*)(ws + OFF_X), 0};
      gemm_tiles((const u16*)(ws + OFF_O16), 1024, (const u16*)(ws + OFF_WT_O), 1024, 1024, 0, 8, e, smem);
    } break;
    case 15: ph_rmsnorm(p, p.ffn_norm + 1024); break;
    default: break;
  }
}

__global__ void __launch_bounds__(256, 3) yoco_megakernel(Params p) {
  __shared__ __attribute__((aligned(16))) char smem[53376];
  __shared__ uint4 xb_words;
  cg::grid_group grid = cg::this_grid();
  if (threadIdx.x == 0) xb_words = make_uint4(0u, 0u, 0u, 0u);
  __syncthreads();
  XcdBarrier xb = xcd_barrier_post((unsigned*)(p.ws + OFF_BAR), (volatile LAS unsigned*)&xb_words);
  if (p.ph_end > 1000) grid.sync();
#define LAUNDER(q) CParams* q = (CParams*)__builtin_amdgcn_kernarg_segment_ptr(); asm volatile("" : "+s"(q));
#define LOAD_XI() XInfo xi; { volatile LAS unsigned* st_ = (volatile LAS unsigned*)&xb_words; xi.nloc = __builtin_amdgcn_readfirstlane((int)st_[0]); xi.nx = __builtin_amdgcn_readfirstlane((int)st_[1]); xi.rank = __builtin_amdgcn_readfirstlane((int)st_[2]); xi.xr = __builtin_amdgcn_readfirstlane((int)st_[3]); if (xi.nloc < 1) xi.nloc = 1; if (xi.nx < 1) xi.nx = 1; }
#define PH(k) { typedef const Params __attribute__((address_space(4))) CP_; CP_* q_ = (CP_*)__builtin_amdgcn_kernarg_segment_ptr(); asm volatile("" : "+s"(q_)); Params pl_; pl_.ws = q_->ws; pl_.out = q_->out; pl_.final_norm = q_->final_norm; pl_.ffn_norm = q_->ffn_norm; LOAD_XI() if (k == 19 || k == 24 || k == 25 || k == 26) { run_phase<k>(pl_, smem, xi); } else { run_phase<k>(p, smem, xi); } } xcd_barrier(xb);
  PH(0)
  PH(1) PH(2) PH(3) PH(4) PH(20) PH(5) PH(6) PH(7) PH(8)
  PH(10) PH(11) PH(21) PH(22) PH(23) PH(12) PH(13) PH(14) PH(15) PH(16) PH(18) PH(19) PH(24) PH(25)
  { LOAD_XI() run_phase<26>(p, smem, xi); }
}

extern "C" void kernel_launch(void* const* d_in, const int* in_sizes, int n_in, void* d_out, int out_size,
                              void* d_ws, size_t ws_size, hipStream_t stream) {
  static int grid_blocks = 0;
  if (!grid_blocks) {
    int dev = 0, cus = 0, per_cu = 0;
    hipGetDevice(&dev);
    hipDeviceGetAttribute(&cus, hipDeviceAttributeMultiprocessorCount, dev);
    hipOccupancyMaxActiveBlocksPerMultiprocessor(&per_cu, yoco_megakernel, 256, 0);
    if (per_cu > 3) per_cu = 3;
    if (per_cu < 1) per_cu = 1;
    grid_blocks = cus * per_cu;
    if (ws_size < WS_NEEDED) fprintf(stderr, "workspace too small: %zu < %llu\n", ws_size, (unsigned long long)WS_NEEDED);
  }
  Params p{};
  const float** f = (const float**)&p;
  for (int i = 0; i < 28; ++i) f[i] = (const float*)d_in[i];
  p.out = (float*)d_out;
  p.ws = (char*)d_ws;
  hipMemsetAsync((char*)d_ws + OFF_BAR, 0, XCD_BAR_WORDS * sizeof(unsigned), stream);
#if MULTI_LAUNCH
  for (int ph = 0; ph < NPHASE; ++ph) {
    p.ph_begin = ph; p.ph_end = ph + 1;
    hipLaunchKernelGGL(yoco_megakernel, dim3(grid_blocks), dim3(256), 0, stream, p);
  }
#else
  p.ph_begin = 0; p.ph_end = NPHASE;
  void* args[] = {&p};
  hipError_t e = hipLaunchCooperativeKernel((void*)yoco_megakernel, dim3(grid_blocks), dim3(256), args, 0, stream);
  if (e != hipSuccess) fprintf(stderr, "cooperative launch failed: %s (grid %d)\n", hipGetErrorString(e), grid_blocks);
#endif
}
```

```cpp
#include <hip/hip_runtime.h>
#include <hip/hip_cooperative_groups.h>
#include <cstdio>
#include <cstdint>
namespace cg = cooperative_groups;

typedef unsigned short u16;
typedef __attribute__((ext_vector_type(8))) short bf16x8;
typedef __attribute__((ext_vector_type(4))) float f32x4;

#define NTOK 17408
#define NTP 16384
#define MIB 1048576ull
#define NPHASE 20
#ifndef MULTI_LAUNCH
#define MULTI_LAUNCH 0
#endif

#define OFF_WT_IN   (0 * MIB)
#define OFF_WT_OUT  (4 * MIB)
#define OFF_WT_BD   (6 * MIB)
#define OFF_WT_PQ0  (7 * MIB)
#define OFF_WT_PQ1  (11 * MIB)
#define OFF_WT_KVQ  (15 * MIB)
#define OFF_WT_O    (18 * MIB)
#define OFF_WT_SK0  (20 * MIB)
#define OFF_WT_SK1  (20 * MIB + 524288ull)
#define OFF_ROPE    (21 * MIB)
#define OFF_USC     (21 * MIB + 655360ull)
#define OFF_VSC     (21 * MIB + 655360ull + 65536ull)
#define OFF_U8      (22 * MIB)
#define OFF_V8      (38 * MIB)
#define OFF_XN      (86 * MIB)
#define OFF_X       (120 * MIB)
#define OFF_GATE16  (188 * MIB)
#define OFF_REC32   (222 * MIB)
#define OFF_XC32    (290 * MIB)
#define OFF_XC16    (358 * MIB)
#define OFF_LOGA    (222 * MIB)
#define OFF_IG16    (22 * MIB)
#define OFF_AGGA    (56 * MIB)
#define OFF_AGGB    (60 * MIB)
#define OFF_HG16    (358 * MIB)
#define OFF_QP16    (188 * MIB)
#define OFF_S32     (256 * MIB)
#define OFF_PH      (256 * MIB)
#define OFF_TKEY    (256 * MIB)
#define OFF_IDX     (188 * MIB)
#define OFF_PGATE   (197 * MIB)
#define OFF_K16     (188 * MIB)
#define OFF_V16A    (197 * MIB)
#define OFF_Q16     (206 * MIB)
#define OFF_O16     (240 * MIB)
#define OFF_BAR     (392 * MIB)
#define WS_NEEDED   (392 * MIB + 16384ull)

#define OUT_Y      0
#define OUT_CONVP  17825792
#define OUT_HP     17850368
#define OUT_KP     17858560
#define OUT_VP     18120704
#define OUT_CONVS  18382848
#define OUT_HS     18776064
#define OUT_KS     18907136
#define OUT_VS     23101440

struct Params {
  const float *x_prompt, *x_sample, *state_conv, *state_h, *cache_k, *cache_v;
  const float *rg_norm, *rg_w_in, *rg_conv_w, *rg_conv_b, *rg_wa, *rg_ba, *rg_wx, *rg_bx, *rg_lambda, *rg_w_out;
  const float *kv_norm, *w_kv, *attn_norm, *w_q, *sinks, *w_o, *ffn_norm, *peer_wq, *peer_subkeys, *peer_u, *peer_v, *final_norm;
  float* out;
  char* ws;
  int ph_begin, ph_end;
};


__device__ __forceinline__ int ltid() { int t = threadIdx.x; asm volatile("" : "+v"(t)); return t; }
__device__ __forceinline__ u16 f2bf(float f) {
  unsigned u = __float_as_uint(f);
  u += 0x7fffu + ((u >> 16) & 1u);
  return (u16)(u >> 16);
}
__device__ __forceinline__ float bf2f(u16 h) { return __uint_as_float(((unsigned)h) << 16); }
__device__ __forceinline__ unsigned pack2(float a, float b) { return (unsigned)f2bf(a) | ((unsigned)f2bf(b) << 16); }
__device__ __forceinline__ float bflo(unsigned u) { return __uint_as_float(u << 16); }
__device__ __forceinline__ float bfhi(unsigned u) { return __uint_as_float(u & 0xffff0000u); }
__device__ __forceinline__ float wave_sum(float v) {
#pragma unroll
  for (int o = 32; o > 0; o >>= 1) v += __shfl_xor(v, o);
  return v;
}
__device__ __forceinline__ const float* xin_row(const Params& p, int token) {
  return token < NTP ? p.x_prompt + (size_t)token * 1024 : p.x_sample + (size_t)(token - NTP) * 1024;
}
__device__ __forceinline__ float gelu_tanh(float x) {
  float u = 0.7978845608028654f * (x + 0.044715f * x * x * x);
  float e = __expf(2.f * u);
  float th = 1.f - 2.f / (e + 1.f);
  return 0.5f * x * (1.f + th);
}
__device__ __forceinline__ float sigmoidf_(float x) { return 1.f / (1.f + __expf(-x)); }

template <int CTRL>
__device__ __forceinline__ int dpp_i(int v) { return __builtin_amdgcn_update_dpp(v, v, CTRL, 0xf, 0xf, false); }
__device__ __forceinline__ int grp_max_i(int v) {
  v = max(v, dpp_i<0xB1>(v));
  v = max(v, dpp_i<0x4E>(v));
  v = max(v, dpp_i<0x141>(v));
  v = max(v, dpp_i<0x140>(v));
  return v;
}
__device__ __forceinline__ float grp_max_f(float v) {
  v = fmaxf(v, __int_as_float(dpp_i<0xB1>(__float_as_int(v))));
  v = fmaxf(v, __int_as_float(dpp_i<0x4E>(__float_as_int(v))));
  v = fmaxf(v, __int_as_float(dpp_i<0x141>(__float_as_int(v))));
  v = fmaxf(v, __int_as_float(dpp_i<0x140>(__float_as_int(v))));
  return v;
}
__device__ __forceinline__ float grp_sum_f(float v) {
  v += __int_as_float(dpp_i<0xB1>(__float_as_int(v)));
  v += __int_as_float(dpp_i<0x4E>(__float_as_int(v)));
  v += __int_as_float(dpp_i<0x141>(__float_as_int(v)));
  v += __int_as_float(dpp_i<0x140>(__float_as_int(v)));
  return v;
}

__device__ __forceinline__ void transpose_unit(const float* __restrict__ src, int ld_src, u16* __restrict__ dst, int ld_dst,
                               int kt, int nt, const float* __restrict__ gain, float* lds) {
  const int tid = ltid();
#pragma unroll
  for (int j = 0; j < 4; ++j) {
    int idx = tid + j * 256;
    int k = idx >> 4, c4 = idx & 15;
    float4 v = *(const float4*)(src + (size_t)(kt * 64 + k) * ld_src + nt * 64 + c4 * 4);
    float g = gain ? gain[kt * 64 + k] : 1.f;
    float* d = lds + k * 65 + c4 * 4;
    d[0] = v.x * g; d[1] = v.y * g; d[2] = v.z * g; d[3] = v.w * g;
  }
  __syncthreads();
#pragma unroll
  for (int j = 0; j < 2; ++j) {
    int c = tid + j * 256;
    int n = c >> 3, kc = c & 7;
    uint4 o;
    o.x = pack2(lds[(kc * 8 + 0) * 65 + n], lds[(kc * 8 + 1) * 65 + n]);
    o.y = pack2(lds[(kc * 8 + 2) * 65 + n], lds[(kc * 8 + 3) * 65 + n]);
    o.z = pack2(lds[(kc * 8 + 4) * 65 + n], lds[(kc * 8 + 5) * 65 + n]);
    o.w = pack2(lds[(kc * 8 + 6) * 65 + n], lds[(kc * 8 + 7) * 65 + n]);
    *(uint4*)(dst + (size_t)(nt * 64 + n) * ld_dst + kt * 64 + kc * 8) = o;
  }
  __syncthreads();
}

__device__ __forceinline__ void transpose_job(const Params& p, int u, float* lds) {
  char* ws = p.ws;
  if (u < 512) { transpose_unit(p.rg_w_in, 2048, (u16*)(ws + OFF_WT_IN), 1024, u >> 5, u & 31, nullptr, lds); return; }
  u -= 512;
  if (u < 256) { transpose_unit(p.rg_w_out, 1024, (u16*)(ws + OFF_WT_OUT), 1024, u >> 4, u & 15, nullptr, lds); return; }
  u -= 256;
  if (u < 64) {
    int which = u >> 5; int r = u & 31; int bi = r >> 2; int t = r & 3;
    const float* src = (which ? p.rg_wx : p.rg_wa) + (size_t)bi * 16384;
    u16* dst = (u16*)(ws + OFF_WT_BD) + (size_t)(which * 1024 + bi * 128) * 128;
    transpose_unit(src, 128, dst, 128, t >> 1, t & 1, nullptr, lds); return;
  }
  u -= 64;
  if (u < 1024) {
    int l = u >> 9; int r = u & 511;
    transpose_unit(p.peer_wq + (size_t)l * 2097152, 2048, (u16*)(ws + (l ? OFF_WT_PQ1 : OFF_WT_PQ0)), 1024, r >> 5, r & 31, nullptr, lds); return;
  }
  u -= 1024;
  if (u < 128) { transpose_unit(p.w_kv, 512, (u16*)(ws + OFF_WT_KVQ), 1024, u >> 3, u & 7, p.kv_norm, lds); return; }
  u -= 128;
  if (u < 256) { transpose_unit(p.w_q, 1024, (u16*)(ws + OFF_WT_KVQ) + (size_t)512 * 1024, 1024, u >> 4, u & 15, p.attn_norm, lds); return; }
  u -= 256;
  transpose_unit(p.w_o, 1024, (u16*)(ws + OFF_WT_O), 1024, u >> 4, u & 15, nullptr, lds);
}

__device__ __forceinline__ void cvt_unit(const float* __restrict__ src, u16* __restrict__ dst, size_t base) {
  const int tid = ltid();
#pragma unroll
  for (int j = 0; j < 2; ++j) {
    size_t o = base + j * 1024 + tid * 4;
    float4 v = *(const float4*)(src + o);
    uint2 w; w.x = pack2(v.x, v.y); w.y = pack2(v.z, v.w);
    *(uint2*)(dst + o) = w;
  }
}

__device__ __forceinline__ void rmsnorm_row(const float* __restrict__ x, const float* __restrict__ g, u16* __restrict__ o, int lane) {
  float4 v[4];
  float ss = 0.f;
#pragma unroll
  for (int i = 0; i < 4; ++i) {
    v[i] = *(const float4*)(x + i * 256 + lane * 4);
    ss += v[i].x * v[i].x + v[i].y * v[i].y + v[i].z * v[i].z + v[i].w * v[i].w;
  }
  ss = wave_sum(ss);
  float r = rsqrtf(ss * (1.f / 1024.f) + 1e-6f);
#pragma unroll
  for (int i = 0; i < 4; ++i) {
    float4 gg = *(const float4*)(g + i * 256 + lane * 4);
    uint2 w; w.x = pack2(v[i].x * r * gg.x, v[i].y * r * gg.y); w.y = pack2(v[i].z * r * gg.z, v[i].w * r * gg.w);
    *(uint2*)(o + i * 256 + lane * 4) = w;
  }
}

__device__ __forceinline__ void ph_convert0(const Params& p, char* smem) {
  const int tid = ltid(), lane = tid & 63, wid = tid >> 6;
  const int NT = 2496, NSK = 256, NROPE = 257, NRMS = 4352, NCACHE = 3840;
  const int total = NT + NSK + NROPE + NRMS + NCACHE;
  for (int u0 = blockIdx.x; u0 < total; u0 += gridDim.x) {
    int u = u0;
    if (u < NT) { transpose_job(p, u, (float*)smem); continue; }
    u -= NT;
    if (u < NSK) {
      int l = u >> 7; int r = u & 127;
      const float* src = p.peer_subkeys + (size_t)l * 32768;
      u16* dst = (u16*)(p.ws + (l ? OFF_WT_SK1 : OFF_WT_SK0));
#pragma unroll
      for (int j = 0; j < 2; ++j) {
        int i = r * 2048 + j * 1024 + tid * 4;
        int s = ((i >> 14) & 1) * 16384 + (i & 16383);
        float4 v = *(const float4*)(src + s);
        uint2 w; w.x = pack2(v.x, v.y); w.y = pack2(v.z, v.w);
        *(uint2*)(dst + i) = w;
      }
      continue;
    }
    u -= NSK;
    if (u < NROPE) {
      int i = u * 256 + tid;
      if (i < 2056 * 32) {
        int pi = i >> 5, d = i & 31;
        int pos = pi < 2048 ? pi : (16384 + pi - 2048);
        float inv = (float)pow(10000.0, -(double)d / 32.0);
        float ang = (float)pos * inv;
        double sn, cs;
        sincos((double)ang, &sn, &cs);
        float2* rt = (float2*)(p.ws + OFF_ROPE);
        rt[i] = make_float2((float)cs, (float)sn);
      }
      continue;
    }
    u -= NROPE;
    if (u < NRMS) {
      int t = u * 4 + wid;
      rmsnorm_row(xin_row(p, t), p.rg_norm, (u16*)(p.ws + OFF_XN) + (size_t)t * 1024, lane);
      continue;
    }
    u -= NRMS;
    {
      int which = u / 1920; int r = u - which * 1920;
      int b = r / 15, c = r - b * 15;
      const float* src = (which ? p.cache_v : p.cache_k) + (size_t)b * 32768 + 2048 + c * 2048;
      float* dst = p.out + (which ? OUT_VS : OUT_KS) + (size_t)b * 32768 + c * 2048;
#pragma unroll
      for (int j = 0; j < 2; ++j) {
        int o = j * 1024 + tid * 4;
        *(float4*)(dst + o) = *(const float4*)(src + o);
      }
    }
  }
}

__device__ __forceinline__ void ph_cvt_tables(const Params& p, int layer) {
  const int lane = ltid() & 63, wid = ltid() >> 6;
  for (int u = blockIdx.x; u < 8192; u += gridDim.x) {
    const int which = u >> 12; const int row = (u & 4095) * 4 + wid;
    const float* src = (which ? p.peer_v : p.peer_u) + (size_t)layer * 16777216 + (size_t)row * 1024 + lane * 16;
    unsigned char* dst = (unsigned char*)(p.ws + (which ? OFF_V8 : OFF_U8)) + (size_t)(lane >> 3) * 2097152 + (size_t)row * 128 + (lane & 7) * 16;
    float* sc = (float*)(p.ws + (which ? OFF_VSC : OFF_USC));
    float4 a = *(const float4*)(src), b = *(const float4*)(src + 4), c = *(const float4*)(src + 8), d = *(const float4*)(src + 12);
    float m = fmaxf(fmaxf(fmaxf(fabsf(a.x), fabsf(a.y)), fmaxf(fabsf(a.z), fabsf(a.w))), fmaxf(fmaxf(fabsf(b.x), fabsf(b.y)), fmaxf(fabsf(b.z), fabsf(b.w))));
    m = fmaxf(m, fmaxf(fmaxf(fmaxf(fabsf(c.x), fabsf(c.y)), fmaxf(fabsf(c.z), fabsf(c.w))), fmaxf(fmaxf(fabsf(d.x), fabsf(d.y)), fmaxf(fabsf(d.z), fabsf(d.w)))));
#pragma unroll
    for (int o = 32; o > 0; o >>= 1) m = fmaxf(m, __shfl_xor(m, o));
    const float scl = m > 0.f ? 440.f / m : 1.f;
    uint4 w; int t;
    t = 0; t = __builtin_amdgcn_cvt_pk_fp8_f32(a.x * scl, a.y * scl, t, false); t = __builtin_amdgcn_cvt_pk_fp8_f32(a.z * scl, a.w * scl, t, true); w.x = (unsigned)t;
    t = 0; t = __builtin_amdgcn_cvt_pk_fp8_f32(b.x * scl, b.y * scl, t, false); t = __builtin_amdgcn_cvt_pk_fp8_f32(b.z * scl, b.w * scl, t, true); w.y = (unsigned)t;
    t = 0; t = __builtin_amdgcn_cvt_pk_fp8_f32(c.x * scl, c.y * scl, t, false); t = __builtin_amdgcn_cvt_pk_fp8_f32(c.z * scl, c.w * scl, t, true); w.z = (unsigned)t;
    t = 0; t = __builtin_amdgcn_cvt_pk_fp8_f32(d.x * scl, d.y * scl, t, false); t = __builtin_amdgcn_cvt_pk_fp8_f32(d.z * scl, d.w * scl, t, true); w.w = (unsigned)t;
    *(uint4*)dst = w;
    if (lane == 0) sc[row] = m > 0.f ? m / 440.f : 1.f;
  }
}

__device__ __forceinline__ void ph_rmsnorm(const Params& p, const float* g) {
  const int lane = ltid() & 63, wid = ltid() >> 6;
  const float* x = (const float*)(p.ws + OFF_X);
  u16* xn = (u16*)(p.ws + OFF_XN);
  for (int u = blockIdx.x; u < 4352; u += gridDim.x) {
    int t = u * 4 + wid;
    rmsnorm_row(x + (size_t)t * 1024, g, xn + (size_t)t * 1024, lane);
  }
}

#define LASP __attribute__((address_space(3)))
template <class Epi>
__device__ __forceinline__ void gemm_tiles(const u16* __restrict__ A, int lda, const u16* __restrict__ W, int ldw,
                                           int K, int kmod, int ntn, const Epi& epi, char* smem_g) {
  LASP unsigned char* smem = (LASP unsigned char*)smem_g;
  const int tid = ltid(), lane = tid & 63, wid = tid >> 6;
  const int wr = wid >> 1, wc = wid & 1, fr = lane & 15, fq = lane >> 4;
  const int total = 136 * ntn;
  const int nk = K >> 6;
  int offA[4], offW[4];
#pragma unroll
  for (int i = 0; i < 4; ++i) {
    const int R = (i * 4 + wid) * 8 + (lane >> 3), C = ((lane & 7) ^ (lane >> 3)) * 8;
    offA[i] = R * lda + C; offW[i] = R * ldw + C;
  }
  const int lo0 = (fr >> 3) * 1024 + (fr & 7) * 128 + ((fq ^ (fr & 7)) * 16);
  const int lo1 = (fr >> 3) * 1024 + (fr & 7) * 128 + (((4 + fq) ^ (fr & 7)) * 16);
  for (int tile = blockIdx.x; tile < total; tile += gridDim.x) {
    const int tm = tile / ntn, tn = tile - tm * ntn;
    const u16* Ag = A + (size_t)(tm * 128) * lda + (kmod ? (tn % kmod) * 128 : 0);
    const u16* Wg = W + (size_t)(tn * 128) * ldw;
    f32x4 acc[4][4];
#pragma unroll
    for (int m = 0; m < 4; ++m)
#pragma unroll
      for (int n = 0; n < 4; ++n) acc[m][n] = f32x4{0.f, 0.f, 0.f, 0.f};
    for (int kt = 0; kt < nk; ++kt) {
      __syncthreads();
#pragma unroll
      for (int i = 0; i < 4; ++i) {
        __builtin_amdgcn_global_load_lds((const unsigned*)(Wg + offW[i] + kt * 64), (LASP unsigned*)(smem + i * 4096 + wid * 1024), 16, 0, 0);
        __builtin_amdgcn_global_load_lds((const unsigned*)(Ag + offA[i] + kt * 64), (LASP unsigned*)(smem + 16384 + i * 4096 + wid * 1024), 16, 0, 0);
      }
      asm volatile("s_waitcnt vmcnt(0)" ::: "memory");
      __syncthreads();
      const LASP unsigned char* sW = smem + wr * 8192;
      const LASP unsigned char* sA = smem + 16384 + wc * 8192;
#pragma unroll
      for (int ks = 0; ks < 2; ++ks) {
        const int lo = ks ? lo1 : lo0;
        bf16x8 a[4], b[4];
#pragma unroll
        for (int m = 0; m < 4; ++m) a[m] = *(const LASP bf16x8*)(sW + m * 2048 + lo);
#pragma unroll
        for (int n = 0; n < 4; ++n) b[n] = *(const LASP bf16x8*)(sA + n * 2048 + lo);
        __builtin_amdgcn_s_setprio(1);
#pragma unroll
        for (int m = 0; m < 4; ++m)
#pragma unroll
          for (int n = 0; n < 4; ++n) acc[m][n] = __builtin_amdgcn_mfma_f32_16x16x32_bf16(a[m], b[n], acc[m][n], 0, 0, 0);
        __builtin_amdgcn_s_setprio(0);
      }
    }
    epi(acc, tm * 128 + wc * 64, tn * 128 + wr * 64, fr, fq);
  }
}

struct EpiWin {
  u16* gate16; float* rec32;
  __device__ __forceinline__ void operator()(const f32x4 (&acc)[4][4], int tok0, int feat0, int fr, int fq) const {
#pragma unroll
    for (int n = 0; n < 4; ++n) {
      const int tok = tok0 + n * 16 + fr;
#pragma unroll
      for (int m = 0; m < 4; ++m) {
        const int f = feat0 + m * 16 + fq * 4;
        f32x4 v = acc[m][n];
        if (feat0 < 1024) {
          uint2 w; w.x = pack2(gelu_tanh(v[0]), gelu_tanh(v[1])); w.y = pack2(gelu_tanh(v[2]), gelu_tanh(v[3]));
          *(uint2*)(gate16 + (size_t)tok * 1024 + f) = w;
        } else {
          *(float4*)(rec32 + (size_t)tok * 1024 + (f - 1024)) = make_float4(v[0], v[1], v[2], v[3]);
        }
      }
    }
  }
};
struct EpiBd {
  float* loga; u16* ig16; const float *ba, *bx, *lam;
  __device__ __forceinline__ void operator()(const f32x4 (&acc)[4][4], int tok0, int feat0, int fr, int fq) const {
#pragma unroll
    for (int m = 0; m < 4; ++m) {
      const int f = feat0 + m * 16 + fq * 4;
      if (feat0 < 1024) {
        float4 b4 = *(const float4*)(ba + f);
        float4 l4 = *(const float4*)(lam + f);
        float sp0 = log1pf(__expf(-l4.x)), sp1 = log1pf(__expf(-l4.y)), sp2 = log1pf(__expf(-l4.z)), sp3 = log1pf(__expf(-l4.w));
#pragma unroll
        for (int n = 0; n < 4; ++n) {
          const int tok = tok0 + n * 16 + fr;
          f32x4 v = acc[m][n];
          float4 o;
          o.x = -8.f * sigmoidf_(v[0] + b4.x) * sp0;
          o.y = -8.f * sigmoidf_(v[1] + b4.y) * sp1;
          o.z = -8.f * sigmoidf_(v[2] + b4.z) * sp2;
          o.w = -8.f * sigmoidf_(v[3] + b4.w) * sp3;
          *(float4*)(loga + (size_t)tok * 1024 + f) = o;
        }
      } else {
        float4 b4 = *(const float4*)(bx + (f - 1024));
#pragma unroll
        for (int n = 0; n < 4; ++n) {
          const int tok = tok0 + n * 16 + fr;
          f32x4 v = acc[m][n];
          uint2 w;
          w.x = pack2(sigmoidf_(v[0] + b4.x), sigmoidf_(v[1] + b4.y));
          w.y = pack2(sigmoidf_(v[2] + b4.z), sigmoidf_(v[3] + b4.w));
          *(uint2*)(ig16 + (size_t)tok * 1024 + (f - 1024)) = w;
        }
      }
    }
  }
};
struct EpiResid {
  const float* xp; const float* xs; float* xres; int first;
  __device__ __forceinline__ void operator()(const f32x4 (&acc)[4][4], int tok0, int feat0, int fr, int fq) const {
#pragma unroll
    for (int n = 0; n < 4; ++n) {
      const int tok = tok0 + n * 16 + fr;
      const float* base = first ? (tok < NTP ? xp + (size_t)tok * 1024 : xs + (size_t)(tok - NTP) * 1024) : (xres + (size_t)tok * 1024);
#pragma unroll
      for (int m = 0; m < 4; ++m) {
        const int f = feat0 + m * 16 + fq * 4;
        float4 b = *(const float4*)(base + f);
        f32x4 v = acc[m][n];
        *(float4*)(xres + (size_t)tok * 1024 + f) = make_float4(b.x + v[0], b.y + v[1], b.z + v[2], b.w + v[3]);
      }
    }
  }
};
struct EpiBf16 {
  u16* o; int ld;
  __device__ __forceinline__ void operator()(const f32x4 (&acc)[4][4], int tok0, int feat0, int fr, int fq) const {
#pragma unroll
    for (int n = 0; n < 4; ++n) {
      const int tok = tok0 + n * 16 + fr;
#pragma unroll
      for (int m = 0; m < 4; ++m) {
        const int f = feat0 + m * 16 + fq * 4;
        f32x4 v = acc[m][n];
        uint2 w; w.x = pack2(v[0], v[1]); w.y = pack2(v[2], v[3]);
        *(uint2*)(o + (size_t)tok * ld + f) = w;
      }
    }
  }
};
struct EpiF32 {
  float* o; int ld;
  __device__ __forceinline__ void operator()(const f32x4 (&acc)[4][4], int tok0, int feat0, int fr, int fq) const {
#pragma unroll
    for (int n = 0; n < 4; ++n) {
      const int tok = tok0 + n * 16 + fr;
#pragma unroll
      for (int m = 0; m < 4; ++m) {
        const int f = feat0 + m * 16 + fq * 4;
        f32x4 v = acc[m][n];
        *(float4*)(o + (size_t)tok * ld + f) = make_float4(v[0], v[1], v[2], v[3]);
      }
    }
  }
};
__device__ __forceinline__ int mkkey(float v, int n) {
  int i = __float_as_int(v);
  i ^= (i >> 31) & 0x7fffffff;
  return (i & ~127) | (127 - n);
}
__device__ __forceinline__ float keyval(int k) {
  int i = (k & ~127) | 64;
  i ^= (i >> 31) & 0x7fffffff;
  return __int_as_float(i);
}
__device__ __forceinline__ int keyidx(int k) { return 127 - (k & 127); }
#define CE(i, j) { int hi_ = max(k[i], k[j]); int lo_ = min(k[i], k[j]); k[i] = hi_; k[j] = lo_; }

struct EpiTopk {
  int* tkey; char* smem;
  __device__ __forceinline__ void operator()(const f32x4 (&acc)[4][4], int tok0, int feat0, int fr, int fq) const {
    float* S = (float*)smem;
    const int tid = ltid(), lane = tid & 63, wid = tid >> 6, g = lane >> 4, li = lane & 15;
    const int wc = (tok0 >> 6) & 1, wr64 = feat0 & 127;
    const int tokbase = tok0 & ~127, hp = feat0 >> 7;
#pragma unroll 1
    for (int half = 0; half < 2; ++half) {
      __syncthreads();
      if (wc == half) {
#pragma unroll
        for (int n = 0; n < 4; ++n)
#pragma unroll
          for (int m = 0; m < 4; ++m) {
            f32x4 v = acc[m][n];
            *(float4*)(S + (n * 16 + fr) * 132 + wr64 + m * 16 + fq * 4) = make_float4(v[0], v[1], v[2], v[3]);
          }
      }
      __syncthreads();
#pragma unroll 1
      for (int pass = 0; pass < 4; ++pass) {
        const int row = pass * 16 + wid * 4 + g;
        const float* r = S + row * 132;
        float4 v0 = *(const float4*)(r + li * 4), v1 = *(const float4*)(r + 64 + li * 4);
        int k[8];
        k[0] = mkkey(v0.x, li * 4 + 0); k[1] = mkkey(v0.y, li * 4 + 1); k[2] = mkkey(v0.z, li * 4 + 2); k[3] = mkkey(v0.w, li * 4 + 3);
        k[4] = mkkey(v1.x, 64 + li * 4 + 0); k[5] = mkkey(v1.y, 64 + li * 4 + 1); k[6] = mkkey(v1.z, 64 + li * 4 + 2); k[7] = mkkey(v1.w, 64 + li * 4 + 3);
        CE(0, 1) CE(2, 3) CE(4, 5) CE(6, 7)
        CE(0, 2) CE(1, 3) CE(4, 6) CE(5, 7)
        CE(1, 2) CE(5, 6)
        CE(0, 4) CE(1, 5) CE(2, 6) CE(3, 7)
        CE(2, 4) CE(3, 5)
        CE(1, 2) CE(3, 4) CE(5, 6)
        int res = (int)0x80000000;
#pragma unroll
        for (int it = 0; it < 16; ++it) {
          const int M = grp_max_i(k[0]);
          const bool win = (k[0] == M);
          if (li == it) res = M;
#pragma unroll
          for (int i = 0; i < 7; ++i) k[i] = win ? k[i + 1] : k[i];
          k[7] = win ? (int)0x80000000 : k[7];
        }
        tkey[((size_t)(tokbase + half * 64 + row) * 16 + hp) * 16 + li] = res;
      }
    }
  }
};
struct EpiScoresTopk {
  const u16* sk; int* tkey; char* smem_g;
  __device__ __forceinline__ void operator()(const f32x4 (&acc)[4][4], int tok0, int feat0, int fr, int fq) const {
    LASP unsigned char* smem = (LASP unsigned char*)smem_g;
    const int tid = ltid(), lane = tid & 63, wid = tid >> 6, wr = wid >> 1, wc = wid & 1;
    const int tn = feat0 >> 7;
    const int swz = (lane * 16) ^ ((lane >> 5) << 5);
    __syncthreads();
#define SK_STAGE(kt2_)                                                                                           \
    _Pragma("unroll") for (int i = 0; i < 4; ++i) {                                                              \
      const int st = i * 4 + wid;                                                                                \
      const int R = (st >> 1) * 16 + (swz >> 6), C = (st & 1) * 32 + ((swz & 63) >> 1);                          \
      __builtin_amdgcn_global_load_lds((const unsigned*)(sk + (size_t)(tn * 128 + R) * 128 + (kt2_) * 64 + C),   \
                                       (LASP unsigned*)(smem + 32768 + i * 4096 + wid * 1024), 16, 0, 0);        \
    }
    SK_STAGE(0)
#pragma unroll
    for (int n = 0; n < 4; ++n)
#pragma unroll
      for (int m = 0; m < 4; ++m) {
        const int r = wc * 64 + n * 16 + fr, c = m * 16 + fq * 4;
        int ob = (r & 15) * 64 + (c & 31) * 2;
        ob ^= ((ob >> 9) & 1) << 5;
        const int off = wr * 16384 + ((r >> 4) * 2 + (c >> 5)) * 1024 + ob;
        f32x4 v = acc[m][n];
        typedef unsigned u32x2_t __attribute__((ext_vector_type(2)));
        u32x2_t w; w.x = pack2(v[0], v[1]); w.y = pack2(v[2], v[3]);
        *(LASP u32x2_t*)(smem + off) = w;
      }
    __builtin_amdgcn_sched_barrier(0);
    f32x4 acc2[4][4];
#pragma unroll
    for (int m = 0; m < 4; ++m)
#pragma unroll
      for (int n = 0; n < 4; ++n) acc2[m][n] = f32x4{0.f, 0.f, 0.f, 0.f};
    const int lane_off = (fr * 64 + fq * 16) ^ ((fr >> 3) << 5);
#pragma unroll 1
    for (int kt2 = 0; kt2 < 2; ++kt2) {
      asm volatile("s_waitcnt vmcnt(0)" ::: "memory");
      __syncthreads();
      const LASP unsigned char* sW = smem + 32768;
      const LASP unsigned char* sA = smem + kt2 * 16384;
      bf16x8 a[2][4];
#pragma unroll
      for (int ks = 0; ks < 2; ++ks)
#pragma unroll
        for (int m = 0; m < 4; ++m) a[ks][m] = *(const LASP bf16x8*)(sW + (wr * 8 + m * 2 + ks) * 1024 + lane_off);
      __syncthreads();
      if (kt2 == 0) { SK_STAGE(1) }
#pragma unroll
      for (int ks = 0; ks < 2; ++ks) {
        bf16x8 b[4];
#pragma unroll
        for (int n = 0; n < 4; ++n) b[n] = *(const LASP bf16x8*)(sA + (wc * 8 + n * 2 + ks) * 1024 + lane_off);
#pragma unroll
        for (int m = 0; m < 4; ++m)
#pragma unroll
          for (int n = 0; n < 4; ++n) acc2[m][n] = __builtin_amdgcn_mfma_f32_16x16x32_bf16(a[ks][m], b[n], acc2[m][n], 0, 0, 0);
        __builtin_amdgcn_sched_barrier(0);
      }
    }
#undef SK_STAGE
    EpiTopk e{tkey, smem_g};
    e(acc2, tok0, feat0, fr, fq);
  }
};
struct EpiKvq {
  u16 *k16, *v16, *q16; const float2* rope; float* out;
  __device__ __forceinline__ void operator()(const f32x4 (&acc)[4][4], int tok0, int feat0, int fr, int fq) const {
#pragma unroll
    for (int n = 0; n < 4; ++n) {
      const int tok = tok0 + n * 16 + fr;
      int b, t, pi, orow; bool is_p = tok < NTP;
      if (is_p) { b = tok >> 11; t = tok & 2047; pi = t; orow = t - 1920; }
      else { int ts = tok - NTP; b = ts >> 3; t = ts & 7; pi = 2048 + t; orow = 120 + t; }
      if (feat0 >= 256 && feat0 < 512) {
        const int kvh = (feat0 - 256) >> 6;
#pragma unroll
        for (int m = 0; m < 4; ++m) {
          const int d = m * 16 + fq * 4;
          f32x4 v = acc[m][n];
          uint2 w; w.x = pack2(v[0], v[1]); w.y = pack2(v[2], v[3]);
          *(uint2*)(v16 + (size_t)tok * 256 + kvh * 64 + d) = w;
          if (orow >= 0) {
            float* dst = out + (is_p ? OUT_VP : OUT_VS) + ((size_t)(b * 128 + orow) * 4 + kvh) * 64 + d;
            *(float4*)dst = make_float4(v[0], v[1], v[2], v[3]);
          }
        }
      } else {
        const bool isk = feat0 < 256;
        const float sc = isk ? 1.f : 0.125f;
#pragma unroll
        for (int m = 0; m < 2; ++m) {
          const int d = m * 16 + fq * 4;
          f32x4 x1 = acc[m][n], x2 = acc[m + 2][n];
          const float2* rp = rope + pi * 32 + d;
          float o1[4], o2[4];
#pragma unroll
          for (int j = 0; j < 4; ++j) {
            float2 csn = rp[j];
            o1[j] = (x1[j] * csn.x - x2[j] * csn.y) * sc;
            o2[j] = (x2[j] * csn.x + x1[j] * csn.y) * sc;
          }
          uint2 w1, w2;
          w1.x = pack2(o1[0], o1[1]); w1.y = pack2(o1[2], o1[3]);
          w2.x = pack2(o2[0], o2[1]); w2.y = pack2(o2[2], o2[3]);
          if (isk) {
            const int kvh = feat0 >> 6;
            *(uint2*)(k16 + (size_t)tok * 256 + kvh * 64 + d) = w1;
            *(uint2*)(k16 + (size_t)tok * 256 + kvh * 64 + d + 32) = w2;
            if (orow >= 0) {
              float* dst = out + (is_p ? OUT_KP : OUT_KS) + ((size_t)(b * 128 + orow) * 4 + kvh) * 64 + d;
              *(float4*)dst = make_float4(o1[0], o1[1], o1[2], o1[3]);
              *(float4*)(dst + 32) = make_float4(o2[0], o2[1], o2[2], o2[3]);
            }
          } else {
            const int f = feat0 - 512;
            *(uint2*)(q16 + (size_t)tok * 1024 + f + d) = w1;
            *(uint2*)(q16 + (size_t)tok * 1024 + f + d + 32) = w2;
          }
        }
      }
    }
  }
};

__device__ __forceinline__ void ph_conv(const Params& p) {
  const float* rec = (const float*)(p.ws + OFF_REC32);
  float* xc32 = (float*)(p.ws + OFF_XC32);
  u16* xc16 = (u16*)(p.ws + OFF_XC16);
  const int c = ltid() * 4;
  const float4 w0 = *(const float4*)(p.rg_conv_w + c), w1 = *(const float4*)(p.rg_conv_w + 1024 + c);
  const float4 w2 = *(const float4*)(p.rg_conv_w + 2048 + c), w3 = *(const float4*)(p.rg_conv_w + 3072 + c);
  const float4 cb = *(const float4*)(p.rg_conv_b + c);
  for (int u = blockIdx.x; u < NTOK / 8; u += gridDim.x) {
    const int tok0 = u * 8;
    int b, t0; const float* buf = nullptr;
    if (tok0 < NTP) { b = tok0 >> 11; t0 = tok0 & 2047; }
    else { b = (tok0 - NTP) >> 3; t0 = 0; buf = p.state_conv + (size_t)b * 3072; }
    float4 r1, r2, r3;
    const float4 z = make_float4(0.f, 0.f, 0.f, 0.f);
    if (t0 >= 3) {
      r1 = *(const float4*)(rec + (size_t)(tok0 - 1) * 1024 + c);
      r2 = *(const float4*)(rec + (size_t)(tok0 - 2) * 1024 + c);
      r3 = *(const float4*)(rec + (size_t)(tok0 - 3) * 1024 + c);
    } else if (buf) {
      r1 = *(const float4*)(buf + 2048 + c); r2 = *(const float4*)(buf + 1024 + c); r3 = *(const float4*)(buf + c);
    } else { r1 = z; r2 = z; r3 = z; }
    float4 r0[8];
#pragma unroll
    for (int s = 0; s < 8; ++s) r0[s] = *(const float4*)(rec + (size_t)(tok0 + s) * 1024 + c);
#pragma unroll
    for (int s = 0; s < 8; ++s) {
      const float4 x = r0[s];
      float4 o;
      o.x = cb.x + w3.x * x.x + w2.x * r1.x + w1.x * r2.x + w0.x * r3.x;
      o.y = cb.y + w3.y * x.y + w2.y * r1.y + w1.y * r2.y + w0.y * r3.y;
      o.z = cb.z + w3.z * x.z + w2.z * r1.z + w1.z * r2.z + w0.z * r3.z;
      o.w = cb.w + w3.w * x.w + w2.w * r1.w + w1.w * r2.w + w0.w * r3.w;
      const size_t off = (size_t)(tok0 + s) * 1024 + c;
      *(float4*)(xc32 + off) = o;
      uint2 w; w.x = pack2(o.x, o.y); w.y = pack2(o.z, o.w);
      *(uint2*)(xc16 + off) = w;
      const int t = t0 + s;
      if (tok0 < NTP) {
        if (t >= 2045) *(float4*)(p.out + OUT_CONVP + ((size_t)b * 3 + (t - 2045)) * 1024 + c) = x;
      } else {
        if (t >= 5) *(float4*)(p.out + OUT_CONVS + ((size_t)b * 3 + (t - 5)) * 1024 + c) = x;
      }
      r3 = r2; r2 = r1; r1 = x;
    }
  }
}

__device__ __forceinline__ float rg_mult(float la) {
  const float t = 2.f * la;
  const float ser = -t * (1.f + t * (0.5f + t * (0.16666667f + t * (0.041666668f + t * 0.0083333333f))));
  const float dir = 1.f - __expf(t);
  return __builtin_amdgcn_sqrtf(t > -0.25f ? ser : dir);
}
__device__ __forceinline__ void scan_step(const float* loga, const u16* ig16, const float* xc32, size_t off, float4& a, float4& bt) {
  float4 la = *(const float4*)(loga + off);
  uint2 gi = *(const uint2*)(ig16 + off);
  float4 xc = *(const float4*)(xc32 + off);
  a.x = __expf(la.x); a.y = __expf(la.y); a.z = __expf(la.z); a.w = __expf(la.w);
  bt.x = rg_mult(la.x) * bflo(gi.x) * xc.x;
  bt.y = rg_mult(la.y) * bfhi(gi.x) * xc.y;
  bt.z = rg_mult(la.z) * bflo(gi.y) * xc.z;
  bt.w = rg_mult(la.w) * bfhi(gi.y) * xc.w;
}
__device__ __forceinline__ void ph_scanA(const Params& p) {
  const float* loga = (const float*)(p.ws + OFF_LOGA);
  const u16* ig16 = (const u16*)(p.ws + OFF_IG16);
  const float* xc32 = (const float*)(p.ws + OFF_XC32);
  float* aggA = (float*)(p.ws + OFF_AGGA);
  float* aggB = (float*)(p.ws + OFF_AGGB);
  const int c = ltid() * 4;
  for (int item = blockIdx.x; item < 1024; item += gridDim.x) {
    const int b = item >> 7, ch = item & 127;
    float4 A = make_float4(1.f, 1.f, 1.f, 1.f), B = make_float4(0.f, 0.f, 0.f, 0.f);
    const size_t tok0 = (size_t)b * 2048 + ch * 16;
#pragma unroll 8
    for (int s = 0; s < 16; ++s) {
      float4 a, bt;
      scan_step(loga, ig16, xc32, (tok0 + s) * 1024 + c, a, bt);
      A.x *= a.x; A.y *= a.y; A.z *= a.z; A.w *= a.w;
      B.x = a.x * B.x + bt.x; B.y = a.y * B.y + bt.y; B.z = a.z * B.z + bt.z; B.w = a.w * B.w + bt.w;
    }
    *(float4*)(aggA + (size_t)item * 1024 + c) = A;
    *(float4*)(aggB + (size_t)item * 1024 + c) = B;
  }
}
__device__ __forceinline__ void ph_scanA2(const Params& p) {
  const float* aggA = (const float*)(p.ws + OFF_AGGA);
  float* aggB = (float*)(p.ws + OFF_AGGB);
  for (int u = blockIdx.x; u < 32; u += gridDim.x) {
    const int b = u >> 2, c = (u & 3) * 256 + ltid();
    float h = 0.f;
#pragma unroll 16
    for (int ch = 0; ch < 128; ++ch) {
      const size_t o = (size_t)(b * 128 + ch) * 1024 + c;
      const float A = aggA[o], B = aggB[o];
      aggB[o] = h;
      h = A * h + B;
    }
  }
}
__device__ __forceinline__ void ph_scanB(const Params& p) {
  const float* loga = (const float*)(p.ws + OFF_LOGA);
  const u16* ig16 = (const u16*)(p.ws + OFF_IG16);
  const float* xc32 = (const float*)(p.ws + OFF_XC32);
  const u16* gate16 = (const u16*)(p.ws + OFF_GATE16);
  u16* hg16 = (u16*)(p.ws + OFF_HG16);
  const float* aggB = (const float*)(p.ws + OFF_AGGB);
  const int c = ltid() * 4;
  for (int item = blockIdx.x; item < 1088; item += gridDim.x) {
    float4 h; size_t tok0; float* hout = nullptr;
    if (item < 1024) {
      const int b = item >> 7, ch = item & 127;
      h = *(const float4*)(aggB + (size_t)item * 1024 + c);
      tok0 = (size_t)b * 2048 + ch * 16;
      if (ch == 127) hout = p.out + OUT_HP + (size_t)b * 1024 + c;
    } else {
      tok0 = (size_t)NTP + (size_t)(item - 1024) * 16;
      h = make_float4(0.f, 0.f, 0.f, 0.f);
    }
#pragma unroll 8
    for (int s = 0; s < 16; ++s) {
      float4 a, bt;
      const size_t off = (tok0 + s) * 1024 + c;
      if (item >= 1024 && (s & 7) == 0) h = *(const float4*)(p.state_h + (size_t)((item - 1024) * 2 + (s >> 3)) * 1024 + c);
      scan_step(loga, ig16, xc32, off, a, bt);
      h.x = a.x * h.x + bt.x; h.y = a.y * h.y + bt.y; h.z = a.z * h.z + bt.z; h.w = a.w * h.w + bt.w;
      uint2 g = *(const uint2*)(gate16 + off);
      uint2 w; w.x = pack2(h.x * bflo(g.x), h.y * bfhi(g.x)); w.y = pack2(h.z * bflo(g.y), h.w * bfhi(g.y));
      *(uint2*)(hg16 + off) = w;
      if (item >= 1024 && (s & 7) == 7) *(float4*)(p.out + OUT_HS + (size_t)((item - 1024) * 2 + (s >> 3)) * 1024 + c) = h;
    }
    if (hout) *(float4*)hout = h;
  }
}

__device__ __forceinline__ int mkkey8(float v, int code) {
  int i = __float_as_int(v);
  i ^= (i >> 31) & 0x7fffffff;
  return (i & ~255) | code;
}
__device__ __forceinline__ float keyval8(int k) {
  int i = (k & ~255) | 128;
  i ^= (i >> 31) & 0x7fffffff;
  return __int_as_float(i);
}
__device__ __forceinline__ void ph_topk(const Params& p, char* smem) {
  const int tid = ltid(), lane = tid & 63, wid = tid >> 6, g = lane >> 4, li = lane & 15;
  const int* tkg = (const int*)(p.ws + OFF_TKEY);
  int* idx_out = (int*)(p.ws + OFF_IDX);
  float* gate_out = (float*)(p.ws + OFF_PGATE);
  int* tkey = (int*)smem + wid * 1024;
  float* tval = (float*)(tkey + 512);
  for (int tb = blockIdx.x; tb < 2176; tb += gridDim.x) {
    const int tbase = tb * 8 + wid * 2;
#pragma unroll
    for (int j = 0; j < 2; ++j) {
      const int4 kk = ((const int4*)(tkg + (size_t)tbase * 256))[j * 64 + lane];
      ((int4*)tkey)[j * 64 + lane] = kk;
      ((float4*)tval)[j * 64 + lane] = make_float4(keyval(kk.x), keyval(kk.y), keyval(kk.z), keyval(kk.w));
    }
    __syncthreads();
    const float* v1[4];
    float sv0[4]; int key[4], rk[4], ptr[4];
#pragma unroll
    for (int q = 0; q < 4; ++q) {
      const int h = (q & 1) * 4 + g;
      const float* v0 = tval + (q >> 1) * 256 + (h * 2) * 16;
      v1[q] = v0 + 16;
      sv0[q] = v0[li];
      ptr[q] = 0; rk[q] = 0;
      key[q] = mkkey8(sv0[q] + v1[q][0], 255 - li * 16);
    }
#pragma unroll 1
    for (int it = 0; it < 16; ++it) {
#pragma unroll
      for (int q = 0; q < 4; ++q) {
        const int M = grp_max_i(key[q]);
        const bool win = (key[q] == M);
        if (li == it) rk[q] = M;
        const int np = ptr[q] + (win ? 1 : 0);
        const int nk = (np < 16) ? mkkey8(sv0[q] + v1[q][np & 15], 255 - (li * 16 + np)) : (int)0x80000000;
        key[q] = win ? nk : key[q];
        ptr[q] = np;
      }
    }
#pragma unroll
    for (int q = 0; q < 4; ++q) {
      const int h = (q & 1) * 4 + g;
      const int t = tbase + (q >> 1);
      const int* t0 = tkey + (q >> 1) * 256 + (h * 2) * 16;
      const int rc = 255 - (rk[q] & 255);
      const float rv = keyval8(rk[q]);
      const int ia = keyidx(t0[rc >> 4]);
      const int ib = keyidx(t0[16 + (rc & 15)]);
      const float mx = grp_max_f(rv);
      const float ex = __expf(rv - mx);
      const float sm = grp_sum_f(ex);
      idx_out[(size_t)t * 128 + h * 16 + li] = ia * 128 + ib;
      gate_out[(size_t)t * 128 + h * 16 + li] = ex / sm;
    }
    __syncthreads();
  }
}

typedef float v2f __attribute__((ext_vector_type(2)));
template <int CTRL>
__device__ __forceinline__ float dpp_f(float v) { return __int_as_float(__builtin_amdgcn_update_dpp(0, __float_as_int(v), CTRL, 0xf, 0xf, false)); }
__device__ __forceinline__ float dot16_fp8(uint4 u, const v2f* x2) {
  v2f acc = {0.f, 0.f};
  acc = __builtin_elementwise_fma(__builtin_amdgcn_cvt_pk_f32_fp8((int)u.x, false), x2[0], acc);
  acc = __builtin_elementwise_fma(__builtin_amdgcn_cvt_pk_f32_fp8((int)u.x, true), x2[1], acc);
  acc = __builtin_elementwise_fma(__builtin_amdgcn_cvt_pk_f32_fp8((int)u.y, false), x2[2], acc);
  acc = __builtin_elementwise_fma(__builtin_amdgcn_cvt_pk_f32_fp8((int)u.y, true), x2[3], acc);
  acc = __builtin_elementwise_fma(__builtin_amdgcn_cvt_pk_f32_fp8((int)u.z, false), x2[4], acc);
  acc = __builtin_elementwise_fma(__builtin_amdgcn_cvt_pk_f32_fp8((int)u.z, true), x2[5], acc);
  acc = __builtin_elementwise_fma(__builtin_amdgcn_cvt_pk_f32_fp8((int)u.w, false), x2[6], acc);
  acc = __builtin_elementwise_fma(__builtin_amdgcn_cvt_pk_f32_fp8((int)u.w, true), x2[7], acc);
  return acc.x + acc.y;
}
__device__ __forceinline__ void axpy16_fp8(float w, uint4 u, v2f* o2) {
  const v2f w2 = {w, w};
  o2[0] = __builtin_elementwise_fma(__builtin_amdgcn_cvt_pk_f32_fp8((int)u.x, false), w2, o2[0]);
  o2[1] = __builtin_elementwise_fma(__builtin_amdgcn_cvt_pk_f32_fp8((int)u.x, true), w2, o2[1]);
  o2[2] = __builtin_elementwise_fma(__builtin_amdgcn_cvt_pk_f32_fp8((int)u.y, false), w2, o2[2]);
  o2[3] = __builtin_elementwise_fma(__builtin_amdgcn_cvt_pk_f32_fp8((int)u.y, true), w2, o2[3]);
  o2[4] = __builtin_elementwise_fma(__builtin_amdgcn_cvt_pk_f32_fp8((int)u.z, false), w2, o2[4]);
  o2[5] = __builtin_elementwise_fma(__builtin_amdgcn_cvt_pk_f32_fp8((int)u.z, true), w2, o2[5]);
  o2[6] = __builtin_elementwise_fma(__builtin_amdgcn_cvt_pk_f32_fp8((int)u.w, false), w2, o2[6]);
  o2[7] = __builtin_elementwise_fma(__builtin_amdgcn_cvt_pk_f32_fp8((int)u.w, true), w2, o2[7]);
}
__device__ __forceinline__ float reduce4_row(float d0, float d1, float d2, float d3, int lane) {
  const bool b0 = lane & 1, b1 = lane & 2;
  const float k0 = b0 ? d1 : d0, s0 = b0 ? d0 : d1;
  const float k1 = b0 ? d3 : d2, s1 = b0 ? d2 : d3;
  const float r0 = k0 + dpp_f<0xB1>(s0);
  const float r1 = k1 + dpp_f<0xB1>(s1);
  const float kk = b1 ? r1 : r0, ss = b1 ? r0 : r1;
  float q = kk + dpp_f<0x4E>(ss);
  q += dpp_f<0x128>(q);
  q += dpp_f<0x124>(q);
  return q;
}
#define EXP_LOAD(dst, dsc, TAB, SC, kbase, esrc)                                     \
  _Pragma("unroll") for (int j = 0; j < 8; ++j) {                                   \
    const int e = __builtin_amdgcn_readlane(esrc, ((kbase) + j) & 63);              \
    dst[j] = ((const uint4*)(TAB + (size_t)e * 1024))[lane];                        \
    dsc[j] = SC[e];                                                                  \
  }
#define EXP_LOADV(dst, TAB, kbase, esrc)                                             \
  _Pragma("unroll") for (int j = 0; j < 8; ++j) {                                   \
    const int e = __builtin_amdgcn_readlane(esrc, ((kbase) + j) & 63);              \
    dst[j] = ((const uint4*)(TAB + (size_t)e * 1024))[lane];                        \
  }
#define EXP_UDOT(src, ssc, kbase)                                                    \
  {                                                                                  \
    float d[8];                                                                      \
    _Pragma("unroll") for (int j = 0; j < 8; ++j) d[j] = dot16_fp8(src[j], x2) * ssc[j]; \
    const float qa = reduce4_row(d[0], d[1], d[2], d[3], lane);                      \
    const float qb = reduce4_row(d[4], d[5], d[6], d[7], lane);                      \
    float q = (lane & 4) ? qb : qa;                                                  \
    q += __shfl_xor(q, 16);                                                          \
    q += __shfl_xor(q, 32);                                                          \
    if ((lane >> 3) == ((((kbase)) & 63) >> 3)) { if ((kbase) < 64) h_lo = q; else h_hi = q; } \
  }
#define EXP_VACC(src, kbase, wsrc)                                                   \
  _Pragma("unroll") for (int j = 0; j < 8; ++j) {                                   \
    const float w = __int_as_float(__builtin_amdgcn_readlane(__float_as_int(wsrc), ((kbase) + j) & 63)); \
    axpy16_fp8(w, src[j], o2);                                                       \
  }

__device__ __forceinline__ void ph_expert(const Params& p, int layer) {
  const int lane = ltid() & 63, wid = ltid() >> 6;
  u16* xn16 = (u16*)(p.ws + OFF_XN);
  float* xres = (float*)(p.ws + OFF_X);
  const int* idxs = (const int*)(p.ws + OFF_IDX);
  const float* gates = (const float*)(p.ws + OFF_PGATE);
  const unsigned char* U = (const unsigned char*)(p.ws + OFF_U8);
  const unsigned char* V = (const unsigned char*)(p.ws + OFF_V8);
  const float* USC = (const float*)(p.ws + OFF_USC);
  const float* VSC = (const float*)(p.ws + OFF_VSC);
  for (int tb = blockIdx.x; tb < 4352; tb += gridDim.x) {
    const int t = tb * 4 + wid;
    v2f x2[8];
    {
      const uint4* xr = (const uint4*)(xn16 + (size_t)t * 1024 + lane * 16);
      uint4 xa = xr[0], xb = xr[1];
      x2[0] = v2f{bflo(xa.x), bfhi(xa.x)}; x2[1] = v2f{bflo(xa.y), bfhi(xa.y)};
      x2[2] = v2f{bflo(xa.z), bfhi(xa.z)}; x2[3] = v2f{bflo(xa.w), bfhi(xa.w)};
      x2[4] = v2f{bflo(xb.x), bfhi(xb.x)}; x2[5] = v2f{bflo(xb.y), bfhi(xb.y)};
      x2[6] = v2f{bflo(xb.z), bfhi(xb.z)}; x2[7] = v2f{bflo(xb.w), bfhi(xb.w)};
    }
    const int e_lo = idxs[(size_t)t * 128 + lane], e_hi = idxs[(size_t)t * 128 + 64 + lane];
    const float g_lo = gates[(size_t)t * 128 + lane], g_hi = gates[(size_t)t * 128 + 64 + lane];
    const float vs_lo = VSC[e_lo], vs_hi = VSC[e_hi];
    float h_lo = 0.f, h_hi = 0.f;
    {
      uint4 ba[8], bb[8]; float sa[8], sb[8];
      EXP_LOAD(ba, sa, U, USC, 0, e_lo)
#pragma unroll 1
      for (int kb = 0; kb < 64; kb += 16) {
        EXP_LOAD(bb, sb, U, USC, kb + 8, e_lo)
        EXP_UDOT(ba, sa, kb)
        if (kb + 16 < 64) { EXP_LOAD(ba, sa, U, USC, kb + 16, e_lo) } else { EXP_LOAD(ba, sa, U, USC, 0, e_hi) }
        EXP_UDOT(bb, sb, kb + 8)
      }
#pragma unroll 1
      for (int kb = 64; kb < 128; kb += 16) {
        EXP_LOAD(bb, sb, U, USC, kb + 8, e_hi)
        EXP_UDOT(ba, sa, kb)
        if (kb + 16 < 128) { EXP_LOAD(ba, sa, U, USC, kb + 16, e_hi) }
        EXP_UDOT(bb, sb, kb + 8)
      }
    }
    const float w_lo = 0.5f * h_lo * (1.f + erff(h_lo * 0.70710678118654752f)) * g_lo * vs_lo;
    const float w_hi = 0.5f * h_hi * (1.f + erff(h_hi * 0.70710678118654752f)) * g_hi * vs_hi;
    v2f o2[8];
#pragma unroll
    for (int i = 0; i < 8; ++i) o2[i] = v2f{0.f, 0.f};
    {
      uint4 ba[8], bb[8];
      EXP_LOADV(ba, V, 0, e_lo)
#pragma unroll 1
      for (int kb = 0; kb < 64; kb += 16) {
        EXP_LOADV(bb, V, kb + 8, e_lo)
        EXP_VACC(ba, kb, w_lo)
        if (kb + 16 < 64) { EXP_LOADV(ba, V, kb + 16, e_lo) } else { EXP_LOADV(ba, V, 0, e_hi) }
        EXP_VACC(bb, kb + 8, w_lo)
      }
#pragma unroll 1
      for (int kb = 64; kb < 128; kb += 16) {
        EXP_LOADV(bb, V, kb + 8, e_hi)
        EXP_VACC(ba, kb, w_hi)
        if (kb + 16 < 128) { EXP_LOADV(ba, V, kb + 16, e_hi) }
        EXP_VACC(bb, kb + 8, w_hi)
      }
    }
    float o[16];
#pragma unroll
    for (int i = 0; i < 8; ++i) { o[2 * i] = o2[i].x; o[2 * i + 1] = o2[i].y; }
    float* xr = xres + (size_t)t * 1024 + lane * 16;
    float ss = 0.f;
#pragma unroll
    for (int i = 0; i < 4; ++i) {
      float4 r = *(const float4*)(xr + i * 4);
      o[4 * i] += r.x; o[4 * i + 1] += r.y; o[4 * i + 2] += r.z; o[4 * i + 3] += r.w;
      ss += o[4 * i] * o[4 * i] + o[4 * i + 1] * o[4 * i + 1] + o[4 * i + 2] * o[4 * i + 2] + o[4 * i + 3] * o[4 * i + 3];
    }
    ss = wave_sum(ss);
    const float rs = rsqrtf(ss * (1.f / 1024.f) + 1e-6f);
    if (layer == 0) {
#pragma unroll
      for (int i = 0; i < 4; ++i) *(float4*)(xr + i * 4) = make_float4(o[4 * i], o[4 * i + 1], o[4 * i + 2], o[4 * i + 3]);
      uint4 wa, wb;
      wa.x = pack2(o[0] * rs, o[1] * rs); wa.y = pack2(o[2] * rs, o[3] * rs); wa.z = pack2(o[4] * rs, o[5] * rs); wa.w = pack2(o[6] * rs, o[7] * rs);
      wb.x = pack2(o[8] * rs, o[9] * rs); wb.y = pack2(o[10] * rs, o[11] * rs); wb.z = pack2(o[12] * rs, o[13] * rs); wb.w = pack2(o[14] * rs, o[15] * rs);
      uint4* xw = (uint4*)(xn16 + (size_t)t * 1024 + lane * 16);
      xw[0] = wa; xw[1] = wb;
    } else {
      const float* fg = p.final_norm + lane * 16;
      float* y = p.out + OUT_Y + (size_t)t * 1024 + lane * 16;
#pragma unroll
      for (int i = 0; i < 4; ++i) {
        float4 g = *(const float4*)(fg + i * 4);
        *(float4*)(y + i * 4) = make_float4(o[4 * i] * rs * g.x, o[4 * i + 1] * rs * g.y, o[4 * i + 2] * rs * g.z, o[4 * i + 3] * rs * g.w);
      }
    }
  }
}

struct XInfo { int nloc, nx, rank, xr; };
__device__ __forceinline__ float reduce8(float v) {
  v += dpp_f<0xB1>(v); v += dpp_f<0x4E>(v); v += dpp_f<0x141>(v);
  return v;
}
__device__ __forceinline__ void ph_expert_u(const Params& p, const XInfo xi) {
  const int lane = ltid() & 63, wid = ltid() >> 6, g = lane >> 3, i8 = lane & 7;
  const u16* xn16 = (const u16*)(p.ws + OFF_XN);
  const int* idxs = (const int*)(p.ws + OFF_IDX);
  float* ph = (float*)(p.ws + OFF_PH);
  for (int c = xi.xr; c < 8; c += xi.nx) {
    const unsigned char* Us = (const unsigned char*)(p.ws + OFF_U8) + (size_t)c * 2097152;
    const unsigned lo = (unsigned)i8 * 16u;
    int t = xi.rank * 4 + wid;
    int e[16];
    {
      const int t0 = min(t, NTOK - 1);
      const int4* ip = (const int4*)(idxs + (size_t)t0 * 128 + g * 16);
#pragma unroll
      for (int j = 0; j < 4; ++j) { int4 q = ip[j]; e[4 * j] = q.x; e[4 * j + 1] = q.y; e[4 * j + 2] = q.z; e[4 * j + 3] = q.w; }
    }
    for (; t < NTOK; t += xi.nloc * 4) {
      uint4 seg[16];
#pragma unroll
      for (int j = 0; j < 16; ++j) seg[j] = *(const uint4*)(Us + ((unsigned)e[j] * 128u + lo));
      v2f x2[8];
      {
        const uint4* xr = (const uint4*)(xn16 + (size_t)t * 1024 + c * 128 + i8 * 16);
        uint4 xa = xr[0], xb = xr[1];
        x2[0] = v2f{bflo(xa.x), bfhi(xa.x)}; x2[1] = v2f{bflo(xa.y), bfhi(xa.y)};
        x2[2] = v2f{bflo(xa.z), bfhi(xa.z)}; x2[3] = v2f{bflo(xa.w), bfhi(xa.w)};
        x2[4] = v2f{bflo(xb.x), bfhi(xb.x)}; x2[5] = v2f{bflo(xb.y), bfhi(xb.y)};
        x2[6] = v2f{bflo(xb.z), bfhi(xb.z)}; x2[7] = v2f{bflo(xb.w), bfhi(xb.w)};
      }
      {
        const int tn = min(t + xi.nloc * 4, NTOK - 1);
        const int4* ip = (const int4*)(idxs + (size_t)tn * 128 + g * 16);
#pragma unroll
        for (int j = 0; j < 4; ++j) { int4 q = ip[j]; e[4 * j] = q.x; e[4 * j + 1] = q.y; e[4 * j + 2] = q.z; e[4 * j + 3] = q.w; }
      }
      float d[16];
#pragma unroll
      for (int j = 0; j < 16; ++j) d[j] = reduce8(dot16_fp8(seg[j], x2));
      if (i8 == 0) {
        float* o = ph + ((size_t)c * NTOK + t) * 128 + g * 16;
#pragma unroll
        for (int j = 0; j < 4; ++j) *(float4*)(o + 4 * j) = make_float4(d[4 * j], d[4 * j + 1], d[4 * j + 2], d[4 * j + 3]);
      }
    }
  }
}
__device__ __forceinline__ void ph_expert_combine(const Params& p) {
  const int* idxs = (const int*)(p.ws + OFF_IDX);
  float* gates = (float*)(p.ws + OFF_PGATE);
  const float* ph = (const float*)(p.ws + OFF_PH);
  const float* USC = (const float*)(p.ws + OFF_USC);
  const float* VSC = (const float*)(p.ws + OFF_VSC);
  for (int i = blockIdx.x * 256 + ltid(); i < NTOK * 128; i += gridDim.x * 256) {
    float s = 0.f;
#pragma unroll
    for (int c = 0; c < 8; ++c) s += ph[(size_t)c * NTOK * 128 + i];
    const int e = idxs[i];
    const float h = s * USC[e];
    gates[i] = 0.5f * h * (1.f + erff(h * 0.70710678118654752f)) * gates[i] * VSC[e];
  }
}
__device__ __forceinline__ void ph_expert_v(const Params& p, const XInfo xi) {
  const int lane = ltid() & 63, wid = ltid() >> 6, g = lane >> 3, i8 = lane & 7;
  const int* idxs = (const int*)(p.ws + OFF_IDX);
  const float* wts = (const float*)(p.ws + OFF_PGATE);
  float* xres = (float*)(p.ws + OFF_X);
  for (int c = xi.xr; c < 8; c += xi.nx) {
    const unsigned char* Vs = (const unsigned char*)(p.ws + OFF_V8) + (size_t)c * 2097152;
    const unsigned lo = (unsigned)i8 * 16u;
    int t = xi.rank * 4 + wid;
    int e[16]; float w[16];
    {
      const int t0 = min(t, NTOK - 1);
      const int4* ip = (const int4*)(idxs + (size_t)t0 * 128 + g * 16);
      const float4* wp = (const float4*)(wts + (size_t)t0 * 128 + g * 16);
#pragma unroll
      for (int j = 0; j < 4; ++j) { int4 q = ip[j]; float4 r = wp[j]; e[4 * j] = q.x; e[4 * j + 1] = q.y; e[4 * j + 2] = q.z; e[4 * j + 3] = q.w; w[4 * j] = r.x; w[4 * j + 1] = r.y; w[4 * j + 2] = r.z; w[4 * j + 3] = r.w; }
    }
    for (; t < NTOK; t += xi.nloc * 4) {
      v2f o2[8];
#pragma unroll
      for (int i = 0; i < 8; ++i) o2[i] = v2f{0.f, 0.f};
#pragma unroll
      for (int hb = 0; hb < 2; ++hb) {
        uint4 seg[8];
#pragma unroll
        for (int j = 0; j < 8; ++j) seg[j] = *(const uint4*)(Vs + ((unsigned)e[hb * 8 + j] * 128u + lo));
#pragma unroll
        for (int j = 0; j < 8; ++j) axpy16_fp8(w[hb * 8 + j], seg[j], o2);
        __builtin_amdgcn_sched_barrier(0);
      }
      {
        const int tn = min(t + xi.nloc * 4, NTOK - 1);
        const int4* ip = (const int4*)(idxs + (size_t)tn * 128 + g * 16);
        const float4* wp = (const float4*)(wts + (size_t)tn * 128 + g * 16);
#pragma unroll
        for (int j = 0; j < 4; ++j) { int4 q = ip[j]; float4 r = wp[j]; e[4 * j] = q.x; e[4 * j + 1] = q.y; e[4 * j + 2] = q.z; e[4 * j + 3] = q.w; w[4 * j] = r.x; w[4 * j + 1] = r.y; w[4 * j + 2] = r.z; w[4 * j + 3] = r.w; }
      }
      float o[16];
#pragma unroll
      for (int i = 0; i < 8; ++i) { o[2 * i] = o2[i].x; o[2 * i + 1] = o2[i].y; }
#pragma unroll
      for (int i = 0; i < 16; ++i) {
        float v = o[i];
        v += dpp_f<0x128>(v);
        v += __shfl_xor(v, 16);
        v += __shfl_xor(v, 32);
        o[i] = v;
        if ((i & 3) == 3) __builtin_amdgcn_sched_barrier(0);
      }
      if (g == 0) {
        float* xr = xres + (size_t)t * 1024 + c * 128 + i8 * 16;
#pragma unroll
        for (int i = 0; i < 4; ++i) {
          float4 r = *(const float4*)(xr + i * 4);
          *(float4*)(xr + i * 4) = make_float4(r.x + o[4 * i], r.y + o[4 * i + 1], r.z + o[4 * i + 2], r.w + o[4 * i + 3]);
        }
      }
    }
  }
}
__device__ __forceinline__ void ph_post_norm(const Params& p, int layer) {
  const int lane = ltid() & 63, wid = ltid() >> 6;
  const float* xres = (const float*)(p.ws + OFF_X);
  u16* xn16 = (u16*)(p.ws + OFF_XN);
  for (int u = blockIdx.x; u < 4352; u += gridDim.x) {
    const int t = u * 4 + wid;
    const float* x = xres + (size_t)t * 1024;
    float4 v[4]; float ss = 0.f;
#pragma unroll
    for (int i = 0; i < 4; ++i) {
      v[i] = *(const float4*)(x + i * 256 + lane * 4);
      ss += v[i].x * v[i].x + v[i].y * v[i].y + v[i].z * v[i].z + v[i].w * v[i].w;
    }
    ss = wave_sum(ss);
    const float r = rsqrtf(ss * (1.f / 1024.f) + 1e-6f);
    if (layer == 0) {
#pragma unroll
      for (int i = 0; i < 4; ++i) {
        uint2 w; w.x = pack2(v[i].x * r, v[i].y * r); w.y = pack2(v[i].z * r, v[i].w * r);
        *(uint2*)(xn16 + (size_t)t * 1024 + i * 256 + lane * 4) = w;
      }
    } else {
      float* y = p.out + OUT_Y + (size_t)t * 1024;
#pragma unroll
      for (int i = 0; i < 4; ++i) {
        float4 gg = *(const float4*)(p.final_norm + i * 256 + lane * 4);
        *(float4*)(y + i * 256 + lane * 4) = make_float4(v[i].x * r * gg.x, v[i].y * r * gg.y, v[i].z * r * gg.z, v[i].w * r * gg.w);
      }
    }
  }
}

__device__ __forceinline__ void ph_attn(const Params& p, char* smem) {
  const int tid = ltid(), lane = tid & 63, wid = tid >> 6, fr = lane & 15, fq = lane >> 4;
  const u16* k16 = (const u16*)(p.ws + OFF_K16);
  const u16* v16 = (const u16*)(p.ws + OFF_V16A);
  const u16* q16 = (const u16*)(p.ws + OFF_Q16);
  u16* o16 = (u16*)(p.ws + OFF_O16);
  u16* Ks = (u16*)smem;
  u16* Vt = (u16*)(smem + 27648);
  for (int item = blockIdx.x; item < 1536; item += gridDim.x) {
    const bool is_p = item < 1024;
    int b, kvh, q0 = 0, nsub, nvalid, kpos0, minpos, tokbase;
    if (is_p) { b = item >> 7; kvh = (item >> 5) & 3; q0 = (item & 31) * 64; nsub = 4; nvalid = 192; kpos0 = q0 - 128; minpos = 0; tokbase = b * 2048; }
    else { int it2 = item - 1024; b = it2 >> 2; kvh = it2 & 3; nsub = 1; nvalid = 136; kpos0 = -128; minpos = -100000; tokbase = NTP + b * 8; }
    __syncthreads();
#pragma unroll 1
    for (int c = tid; c < 1536; c += 256) {
      const int j = c >> 3, ch = c & 7;
      uint4 kk = make_uint4(0, 0, 0, 0), vv = make_uint4(0, 0, 0, 0);
      if (is_p) {
        const int kp = kpos0 + j;
        if (kp >= 0) {
          const size_t off = (size_t)(tokbase + kp) * 256 + kvh * 64 + ch * 8;
          kk = *(const uint4*)(k16 + off); vv = *(const uint4*)(v16 + off);
        }
      } else {
        if (j < 128) {
          const size_t off = ((size_t)(b * 128 + j) * 4 + kvh) * 64 + ch * 8;
          float4 a0 = *(const float4*)(p.cache_k + off), a1 = *(const float4*)(p.cache_k + off + 4);
          float4 c0 = *(const float4*)(p.cache_v + off), c1 = *(const float4*)(p.cache_v + off + 4);
          kk.x = pack2(a0.x, a0.y); kk.y = pack2(a0.z, a0.w); kk.z = pack2(a1.x, a1.y); kk.w = pack2(a1.z, a1.w);
          vv.x = pack2(c0.x, c0.y); vv.y = pack2(c0.z, c0.w); vv.z = pack2(c1.x, c1.y); vv.w = pack2(c1.z, c1.w);
        } else if (j < 136) {
          const size_t off = (size_t)(tokbase + j - 128) * 256 + kvh * 64 + ch * 8;
          kk = *(const uint4*)(k16 + off); vv = *(const uint4*)(v16 + off);
        }
      }
      *(uint4*)(Ks + j * 72 + ch * 8) = kk;
      u16* vd = Vt + (ch * 8) * 200 + j;
      vd[0] = (u16)(vv.x & 0xffff); vd[200] = (u16)(vv.x >> 16);
      vd[400] = (u16)(vv.y & 0xffff); vd[600] = (u16)(vv.y >> 16);
      vd[800] = (u16)(vv.z & 0xffff); vd[1000] = (u16)(vv.z >> 16);
      vd[1200] = (u16)(vv.w & 0xffff); vd[1400] = (u16)(vv.w >> 16);
    }
    __syncthreads();
    const int head = kvh * 4 + wid;
    const float sink = p.sinks[head];
#pragma unroll 1
    for (int sub = 0; sub < nsub; ++sub) {
      int qtok, qp;
      if (is_p) { qp = q0 + sub * 16 + fr; qtok = tokbase + qp; }
      else { qp = fr & 7; qtok = tokbase + (fr & 7); }
      const u16* qrow = q16 + (size_t)qtok * 1024 + head * 64;
      const bf16x8 qf0 = *(const bf16x8*)(qrow + fq * 8);
      const bf16x8 qf1 = *(const bf16x8*)(qrow + 32 + fq * 8);
      f32x4 s[12];
#pragma unroll
      for (int ks = 0; ks < 12; ++ks) {
        const bf16x8 kf0 = *(const bf16x8*)(Ks + (ks * 16 + fr) * 72 + fq * 8);
        const bf16x8 kf1 = *(const bf16x8*)(Ks + (ks * 16 + fr) * 72 + 32 + fq * 8);
        f32x4 z = {0.f, 0.f, 0.f, 0.f};
        z = __builtin_amdgcn_mfma_f32_16x16x32_bf16(kf0, qf0, z, 0, 0, 0);
        s[ks] = __builtin_amdgcn_mfma_f32_16x16x32_bf16(kf1, qf1, z, 0, 0, 0);
        if ((ks & 3) == 3) __builtin_amdgcn_sched_barrier(0);
      }
      float mx = sink;
      const int lo_ = max(minpos, qp - 127), hi_ = min(qp, kpos0 + nvalid - 1);
      const unsigned span_ = (unsigned)(hi_ - lo_);
      const int kp0_ = kpos0 + fq * 4 - lo_;
#pragma unroll
      for (int ks = 0; ks < 12; ++ks)
#pragma unroll
        for (int j = 0; j < 4; ++j) {
          const bool valid = (unsigned)(kp0_ + ks * 16 + j) <= span_;
          const float v = valid ? s[ks][j] : -1.0e30f;
          s[ks][j] = v;
          mx = fmaxf(mx, v);
          if (j == 3) __builtin_amdgcn_sched_barrier(0);
        }
      mx = fmaxf(mx, __shfl_xor(mx, 16));
      mx = fmaxf(mx, __shfl_xor(mx, 32));
      float sum = 0.f;
#pragma unroll
      for (int ks = 0; ks < 12; ++ks)
#pragma unroll
        for (int j = 0; j < 4; ++j) {
          const float pv = (s[ks][j] > -1.0e29f) ? __expf(s[ks][j] - mx) : 0.f;
          s[ks][j] = pv;
          sum += pv;
          if (j == 3) __builtin_amdgcn_sched_barrier(0);
        }
      sum += __shfl_xor(sum, 16);
      sum += __shfl_xor(sum, 32);
      sum += __expf(sink - mx);
      const float inv = 1.f / sum;
      f32x4 o[4];
#pragma unroll
      for (int d = 0; d < 4; ++d) o[d] = f32x4{0.f, 0.f, 0.f, 0.f};
#pragma unroll
      for (int kk = 0; kk < 6; ++kk) {
        union { bf16x8 v; unsigned u[4]; } pb;
        pb.u[0] = pack2(s[2 * kk][0], s[2 * kk][1]); pb.u[1] = pack2(s[2 * kk][2], s[2 * kk][3]);
        pb.u[2] = pack2(s[2 * kk + 1][0], s[2 * kk + 1][1]); pb.u[3] = pack2(s[2 * kk + 1][2], s[2 * kk + 1][3]);
#pragma unroll
        for (int d = 0; d < 4; ++d) {
          union { bf16x8 v; uint2 h[2]; } vf;
          const u16* vr = Vt + (d * 16 + fr) * 200 + fq * 4;
          vf.h[0] = *(const uint2*)(vr + (2 * kk) * 16);
          vf.h[1] = *(const uint2*)(vr + (2 * kk + 1) * 16);
          o[d] = __builtin_amdgcn_mfma_f32_16x16x32_bf16(vf.v, pb.v, o[d], 0, 0, 0);
        }
        __builtin_amdgcn_sched_barrier(0);
      }
      if (is_p || fr < 8) {
#pragma unroll
        for (int d = 0; d < 4; ++d) {
          uint2 w; w.x = pack2(o[d][0] * inv, o[d][1] * inv); w.y = pack2(o[d][2] * inv, o[d][3] * inv);
          *(uint2*)(o16 + (size_t)qtok * 1024 + head * 64 + d * 16 + fq * 4) = w;
        }
      }
    }
  }
}


#define XB_TMO      128
#define XB_XCNT(j)  (256  + 64 * (j))
#define XB_XSUB(j)  (1280 + 64 * (j))
#define XB_XGEN(j)  (2304 + 64 * (j))
#define XB_TOP      3328
#define XB_TOPGEN   3392
#define XCD_BAR_WORDS 3456
#define XB_SPIN_CAP (1u << 20)
#define LAS __attribute__((address_space(3)))
__device__ __forceinline__ unsigned xb_ld(unsigned* p) { return __hip_atomic_load(p, __ATOMIC_RELAXED, __HIP_MEMORY_SCOPE_AGENT); }
__device__ __forceinline__ unsigned xb_add(unsigned* p, unsigned v) { return __hip_atomic_fetch_add(p, v, __ATOMIC_RELAXED, __HIP_MEMORY_SCOPE_AGENT); }
__device__ __forceinline__ unsigned xb_xcc_id() { return (unsigned)__builtin_amdgcn_s_getreg((3 << 11) | 20) & 0xFu; }
#define XB_SPIN(cond, bar) do { unsigned _sp = 0; while (cond) { __builtin_amdgcn_s_sleep(1); \
    if ((++_sp & 255u) == 0u) { if (xb_ld(&(bar)[XB_TMO])) break; if (_sp > XB_SPIN_CAP) { atomicAdd(&(bar)[XB_TMO], 1u); break; } } } } while (0)
struct XcdBarrier { unsigned* bar; unsigned x; volatile LAS unsigned* st; };
__device__ __forceinline__ XcdBarrier xcd_barrier_post(unsigned* bar, volatile LAS unsigned* st) {
  XcdBarrier b; b.bar = bar; b.x = xb_xcc_id(); b.st = st;
  if (threadIdx.x == 0) st[2] = xb_add(&bar[XB_XCNT(b.x)], 1u);
  return b;
}
__device__ __forceinline__ void xcd_barrier_complete(unsigned* bar, unsigned x, unsigned& nloc, unsigned& nx, unsigned& xr) {
  const unsigned G = gridDim.x * gridDim.y * gridDim.z;
  unsigned sum, cnt, mine, below, sp = 0u;
  for (;;) {
    sum = 0u; cnt = 0u; mine = 0u; below = 0u;
#pragma unroll
    for (unsigned j = 0; j < 16; ++j) { const unsigned c = xb_ld(&bar[XB_XCNT(j)]); sum += c; cnt += (c > 0u) ? 1u : 0u; mine = (j == x) ? c : mine; below += (j < x && c > 0u) ? 1u : 0u; }
    if (sum == G) break;
    __builtin_amdgcn_s_sleep(1);
    if ((++sp & 255u) == 0u) { if (xb_ld(&bar[XB_TMO])) break; if (sp > XB_SPIN_CAP) { atomicAdd(&bar[XB_TMO], 1u); break; } }
  }
  nloc = mine > 0u ? mine : 1u; nx = cnt > 0u ? cnt : 1u; xr = below;
}
__device__ __forceinline__ void xcd_barrier(const XcdBarrier& b) {
  asm volatile("s_waitcnt vmcnt(0)" ::: "memory");
  __syncthreads();
  if (threadIdx.x == 0) {
    unsigned* bar = b.bar;
    __builtin_amdgcn_s_waitcnt(0);
    unsigned nloc = b.st[0], nx = b.st[1];
    if (nloc == 0u) { unsigned xr; xcd_barrier_complete(bar, b.x, nloc, nx, xr); b.st[0] = nloc; b.st[1] = nx; b.st[3] = xr; }
    const unsigned old = xb_add(&bar[XB_XSUB(b.x)], 1u);
    const unsigned gen = old / nloc;
    if (old + 1u == (gen + 1u) * nloc) {
      __builtin_amdgcn_fence(__ATOMIC_RELEASE, "agent");
      asm volatile("s_waitcnt vmcnt(0)" ::: "memory");
      const unsigned og = xb_add(&bar[XB_TOP], 1u);
      const unsigned tg = og / nx;
      if (og + 1u == (tg + 1u) * nx) xb_add(&bar[XB_TOPGEN], 1u);
      else XB_SPIN(xb_ld(&bar[XB_TOPGEN]) == tg, bar);
      __builtin_amdgcn_fence(__ATOMIC_ACQUIRE, "agent");
      xb_add(&bar[XB_XGEN(b.x)], 1u);
      asm volatile("s_waitcnt vmcnt(0)" ::: "memory");
    } else {
      XB_SPIN(xb_ld(&bar[XB_XGEN(b.x)]) == gen, bar);
      __builtin_amdgcn_fence(__ATOMIC_ACQUIRE, "agent");
      asm volatile("s_waitcnt vmcnt(0)" ::: "memory");
    }
  }
  __syncthreads();
}

typedef const Params __attribute__((address_space(4))) CParams;
__device__ __forceinline__ Params load_params(CParams* q) {
  Params r;
  r.x_prompt = q->x_prompt;
  r.x_sample = q->x_sample;
  r.state_conv = q->state_conv;
  r.state_h = q->state_h;
  r.cache_k = q->cache_k;
  r.cache_v = q->cache_v;
  r.rg_norm = q->rg_norm;
  r.rg_w_in = q->rg_w_in;
  r.rg_conv_w = q->rg_conv_w;
  r.rg_conv_b = q->rg_conv_b;
  r.rg_wa = q->rg_wa;
  r.rg_ba = q->rg_ba;
  r.rg_wx = q->rg_wx;
  r.rg_bx = q->rg_bx;
  r.rg_lambda = q->rg_lambda;
  r.rg_w_out = q->rg_w_out;
  r.kv_norm = q->kv_norm;
  r.w_kv = q->w_kv;
  r.attn_norm = q->attn_norm;
  r.w_q = q->w_q;
  r.sinks = q->sinks;
  r.w_o = q->w_o;
  r.ffn_norm = q->ffn_norm;
  r.peer_wq = q->peer_wq;
  r.peer_subkeys = q->peer_subkeys;
  r.peer_u = q->peer_u;
  r.peer_v = q->peer_v;
  r.final_norm = q->final_norm;
  r.out = q->out;
  r.ws = q->ws;
  r.ph_begin = q->ph_begin;
  r.ph_end = q->ph_end;
  return r;
}

template <int ph>
__device__ __forceinline__ void run_phase(const Params& p, char* smem, const XInfo xi) {
  char* ws = p.ws;
  switch (ph) {
    case 0: ph_convert0(p, smem); break;
    case 1: {
      EpiWin e{(u16*)(ws + OFF_GATE16), (float*)(ws + OFF_REC32)};
      gemm_tiles((const u16*)(ws + OFF_XN), 1024, (const u16*)(ws + OFF_WT_IN), 1024, 1024, 0, 16, e, smem);
    } break;
    case 2: ph_conv(p); break;
    case 3: {
      EpiBd e{(float*)(ws + OFF_LOGA), (u16*)(ws + OFF_IG16), p.rg_ba, p.rg_bx, p.rg_lambda};
      gemm_tiles((const u16*)(ws + OFF_XC16), 1024, (const u16*)(ws + OFF_WT_BD), 128, 128, 8, 16, e, smem);
    } break;
    case 4: ph_scanA(p); break;
    case 20: ph_scanA2(p); break;
    case 5: ph_scanB(p); break;
    case 6: {
      EpiResid e{p.x_prompt, p.x_sample, (float*)(ws + OFF_X), 1};
      gemm_tiles((const u16*)(ws + OFF_HG16), 1024, (const u16*)(ws + OFF_WT_OUT), 1024, 1024, 0, 8, e, smem);
      ph_cvt_tables(p, 0);
    } break;
    case 7: ph_rmsnorm(p, p.ffn_norm); break;
    case 8: case 16: {
      EpiScoresTopk e{(const u16*)(ws + (ph == 8 ? OFF_WT_SK0 : OFF_WT_SK1)), (int*)(ws + OFF_TKEY), smem};
      gemm_tiles((const u16*)(ws + OFF_XN), 1024, (const u16*)(ws + (ph == 8 ? OFF_WT_PQ0 : OFF_WT_PQ1)), 1024, 1024, 0, 16, e, smem);
    } break;
    case 9: case 17: {
      EpiTopk e{(int*)(ws + OFF_TKEY), smem};
      gemm_tiles((const u16*)(ws + OFF_QP16), 2048, (const u16*)(ws + (ph == 9 ? OFF_WT_SK0 : OFF_WT_SK1)), 128, 128, 16, 16, e, smem);
    } break;
    case 10: case 18: ph_topk(p, smem); break;
    case 11: case 19: ph_expert_u(p, xi); break;
    case 21: case 24: ph_expert_combine(p); break;
    case 22: case 25: ph_expert_v(p, xi); break;
    case 23: ph_post_norm(p, 0); break;
    case 26: ph_post_norm(p, 1); break;
    case 12: {
      EpiKvq e{(u16*)(ws + OFF_K16), (u16*)(ws + OFF_V16A), (u16*)(ws + OFF_Q16), (const float2*)(ws + OFF_ROPE), p.out};
      gemm_tiles((const u16*)(ws + OFF_XN), 1024, (const u16*)(ws + OFF_WT_KVQ), 1024, 1024, 0, 12, e, smem);
      ph_cvt_tables(p, 1);
    } break;
    case 13: ph_attn(p, smem); break;
    case 14: {
      EpiResid e{p.x_prompt, p.x_sample, (float*)(ws + OFF_X), 0};
      gemm_tiles((const u16*)(ws + OFF_O16), 1024, (const u16*)(ws + OFF_WT_O), 1024, 1024, 0, 8, e, smem);
    } break;
    case 15: ph_rmsnorm(p, p.ffn_norm + 1024); break;
    default: break;
  }
}

__global__ void __launch_bounds__(256, 3) yoco_megakernel(Params p) {
  __shared__ __attribute__((aligned(16))) char smem[53376];
  __shared__ uint4 xb_words;
  cg::grid_group grid = cg::this_grid();
  if (threadIdx.x == 0) xb_words = make_uint4(0u, 0u, 0u, 0u);
  __syncthreads();
  XcdBarrier xb = xcd_barrier_post((unsigned*)(p.ws + OFF_BAR), (volatile LAS unsigned*)&xb_words);
  if (p.ph_end > 1000) grid.sync();
#define LAUNDER(q) CParams* q = (CParams*)__builtin_amdgcn_kernarg_segment_ptr(); asm volatile("" : "+s"(q));
#define LOAD_XI() XInfo xi; { volatile LAS unsigned* st_ = (volatile LAS unsigned*)&xb_words; xi.nloc = __builtin_amdgcn_readfirstlane((int)st_[0]); xi.nx = __builtin_amdgcn_readfirstlane((int)st_[1]); xi.rank = __builtin_amdgcn_readfirstlane((int)st_[2]); xi.xr = __builtin_amdgcn_readfirstlane((int)st_[3]); if (xi.nloc < 1) xi.nloc = 1; if (xi.nx < 1) xi.nx = 1; }
#define PH(k) { typedef const Params __attribute__((address_space(4))) CP_; CP_* q_ = (CP_*)__builtin_amdgcn_kernarg_segment_ptr(); asm volatile("" : "+s"(q_)); Params pl_; pl_.ws = q_->ws; pl_.out = q_->out; pl_.final_norm = q_->final_norm; pl_.ffn_norm = q_->ffn_norm; LOAD_XI() if (k == 19 || k == 24 || k == 25 || k == 26) { run_phase<k>(pl_, smem, xi); } else { run_phase<k>(p, smem, xi); } } xcd_barrier(xb);
  PH(0)
  PH(1) PH(2) PH(3) PH(4) PH(20) PH(5) PH(6) PH(7) PH(8)
  PH(10) PH(11) PH(21) PH(22) PH(23) PH(12) PH(13) PH(14) PH(15) PH(16) PH(18) PH(19) PH(24) PH(25)
  { LOAD_XI() run_phase<26>(p, smem, xi); }
}

extern "C" void kernel_launch(void* const* d_in, const int* in_sizes, int n_in, void* d_out, int out_size,
                              void* d_ws, size_t ws_size, hipStream_t stream) {
  static int grid_blocks = 0;
  if (!grid_blocks) {
    int dev = 0, cus = 0, per_cu = 0;
    hipGetDevice(&dev);
    hipDeviceGetAttribute(&cus, hipDeviceAttributeMultiprocessorCount, dev);
    hipOccupancyMaxActiveBlocksPerMultiprocessor(&per_cu, yoco_megakernel, 256, 0);
    if (per_cu > 3) per_cu = 3;
    if (per_cu < 1) per_cu = 1;
    grid_blocks = cus * per_cu;
    if (ws_size < WS_NEEDED) fprintf(stderr, "workspace too small: %zu < %llu\n", ws_size, (unsigned long long)WS_NEEDED);
  }
  Params p{};
  const float** f = (const float**)&p;
  for (int i = 0; i < 28; ++i) f[i] = (const float*)d_in[i];
  p.out = (float*)d_out;
  p.ws = (char*)d_ws;
  hipMemsetAsync((char*)d_ws + OFF_BAR, 0, XCD_BAR_WORDS * sizeof(unsigned), stream);
#if MULTI_LAUNCH
  for (int ph = 0; ph < NPHASE; ++ph) {
    p.ph_begin = ph; p.ph_end = ph + 1;
    hipLaunchKernelGGL(yoco_megakernel, dim3(grid_blocks), dim3(256), 0, stream, p);
  }
#else
  p.ph_begin = 0; p.ph_end = NPHASE;
  void* args[] = {&p};
  hipError_t e = hipLaunchCooperativeKernel((void*)yoco_megakernel, dim3(grid_blocks), dim3(256), args, 0, stream);
  if (e != hipSuccess) fprintf(stderr, "cooperative launch failed: %s (grid %d)\n", hipGetErrorString(e), grid_blocks);
#endif
}
```

```cpp
#include <hip/hip_runtime.h>
#include <hip/hip_cooperative_groups.h>
#include <cstdio>
#include <cstdint>
namespace cg = cooperative_groups;

typedef unsigned short u16;
typedef __attribute__((ext_vector_type(8))) short bf16x8;
typedef __attribute__((ext_vector_type(4))) float f32x4;

#define NTOK 17408
#define NTP 16384
#define MIB 1048576ull
#define NPHASE 20
#ifndef MULTI_LAUNCH
#define MULTI_LAUNCH 0
#endif

#define OFF_WT_IN   (0 * MIB)
#define OFF_WT_OUT  (4 * MIB)
#define OFF_WT_BD   (6 * MIB)
#define OFF_WT_PQ0  (7 * MIB)
#define OFF_WT_PQ1  (11 * MIB)
#define OFF_WT_KVQ  (15 * MIB)
#define OFF_WT_O    (18 * MIB)
#define OFF_WT_SK0  (20 * MIB)
#define OFF_WT_SK1  (20 * MIB + 524288ull)
#define OFF_ROPE    (21 * MIB)
#define OFF_USC     (21 * MIB + 655360ull)
#define OFF_VSC     (21 * MIB + 655360ull + 65536ull)
#define OFF_U8      (22 * MIB)
#define OFF_V8      (38 * MIB)
#define OFF_XN      (86 * MIB)
#define OFF_X       (120 * MIB)
#define OFF_GATE16  (188 * MIB)
#define OFF_REC32   (222 * MIB)
#define OFF_XC32    (290 * MIB)
#define OFF_XC16    (358 * MIB)
#define OFF_LOGA    (222 * MIB)
#define OFF_IG16    (22 * MIB)
#define OFF_AGGA    (56 * MIB)
#define OFF_AGGB    (60 * MIB)
#define OFF_HG16    (358 * MIB)
#define OFF_QP16    (188 * MIB)
#define OFF_S32     (256 * MIB)
#define OFF_PH      (256 * MIB)
#define OFF_TKEY    (256 * MIB)
#define OFF_IDX     (188 * MIB)
#define OFF_PGATE   (197 * MIB)
#define OFF_K16     (188 * MIB)
#define OFF_V16A    (197 * MIB)
#define OFF_Q16     (206 * MIB)
#define OFF_O16     (240 * MIB)
#define OFF_BAR     (392 * MIB)
#define WS_NEEDED   (392 * MIB + 16384ull)

#define OUT_Y      0
#define OUT_CONVP  17825792
#define OUT_HP     17850368
#define OUT_KP     17858560
#define OUT_VP     18120704
#define OUT_CONVS  18382848
#define OUT_HS     18776064
#define OUT_KS     18907136
#define OUT_VS     23101440

struct Params {
  const float *x_prompt, *x_sample, *state_conv, *state_h, *cache_k, *cache_v;
  const float *rg_norm, *rg_w_in, *rg_conv_w, *rg_conv_b, *rg_wa, *rg_ba, *rg_wx, *rg_bx, *rg_lambda, *rg_w_out;
  const float *kv_norm, *w_kv, *attn_norm, *w_q, *sinks, *w_o, *ffn_norm, *peer_wq, *peer_subkeys, *peer_u, *peer_v, *final_norm;
  float* out;
  char* ws;
  int ph_begin, ph_end;
};


__device__ __forceinline__ int ltid() { int t = threadIdx.x; asm volatile("" : "+v"(t)); return t; }
__device__ __forceinline__ u16 f2bf(float f) {
  unsigned u = __float_as_uint(f);
  u += 0x7fffu + ((u >> 16) & 1u);
  return (u16)(u >> 16);
}
__device__ __forceinline__ float bf2f(u16 h) { return __uint_as_float(((unsigned)h) << 16); }
__device__ __forceinline__ unsigned pack2(float a, float b) { return (unsigned)f2bf(a) | ((unsigned)f2bf(b) << 16); }
__device__ __forceinline__ float bflo(unsigned u) { return __uint_as_float(u << 16); }
__device__ __forceinline__ float bfhi(unsigned u) { return __uint_as_float(u & 0xffff0000u); }
__device__ __forceinline__ float wave_sum(float v) {
#pragma unroll
  for (int o = 32; o > 0; o >>= 1) v += __shfl_xor(v, o);
  return v;
}
__device__ __forceinline__ const float* xin_row(const Params& p, int token) {
  return token < NTP ? p.x_prompt + (size_t)token * 1024 : p.x_sample + (size_t)(token - NTP) * 1024;
}
__device__ __forceinline__ float gelu_tanh(float x) {
  float u = 0.7978845608028654f * (x + 0.044715f * x * x * x);
  float e = __expf(2.f * u);
  float th = 1.f - 2.f / (e + 1.f);
  return 0.5f * x * (1.f + th);
}
__device__ __forceinline__ float sigmoidf_(float x) { return 1.f / (1.f + __expf(-x)); }

template <int CTRL>
__device__ __forceinline__ int dpp_i(int v) { return __builtin_amdgcn_update_dpp(v, v, CTRL, 0xf, 0xf, false); }
__device__ __forceinline__ int grp_max_i(int v) {
  v = max(v, dpp_i<0xB1>(v));
  v = max(v, dpp_i<0x4E>(v));
  v = max(v, dpp_i<0x141>(v));
  v = max(v, dpp_i<0x140>(v));
  return v;
}
__device__ __forceinline__ float grp_max_f(float v) {
  v = fmaxf(v, __int_as_float(dpp_i<0xB1>(__float_as_int(v))));
  v = fmaxf(v, __int_as_float(dpp_i<0x4E>(__float_as_int(v))));
  v = fmaxf(v, __int_as_float(dpp_i<0x141>(__float_as_int(v))));
  v = fmaxf(v, __int_as_float(dpp_i<0x140>(__float_as_int(v))));
  return v;
}
__device__ __forceinline__ float grp_sum_f(float v) {
  v += __int_as_float(dpp_i<0xB1>(__float_as_int(v)));
  v += __int_as_float(dpp_i<0x4E>(__float_as_int(v)));
  v += __int_as_float(dpp_i<0x141>(__float_as_int(v)));
  v += __int_as_float(dpp_i<0x140>(__float_as_int(v)));
  return v;
}

__device__ __forceinline__ void transpose_unit(const float* __restrict__ src, int ld_src, u16* __restrict__ dst, int ld_dst,
                               int kt, int nt, const float* __restrict__ gain, float* lds) {
  const int tid = ltid();
#pragma unroll
  for (int j = 0; j < 4; ++j) {
    int idx = tid + j * 256;
    int k = idx >> 4, c4 = idx & 15;
    float4 v = *(const float4*)(src + (size_t)(kt * 64 + k) * ld_src + nt * 64 + c4 * 4);
    float g = gain ? gain[kt * 64 + k] : 1.f;
    float* d = lds + k * 65 + c4 * 4;
    d[0] = v.x * g; d[1] = v.y * g; d[2] = v.z * g; d[3] = v.w * g;
  }
  __syncthreads();
#pragma unroll
  for (int j = 0; j < 2; ++j) {
    int c = tid + j * 256;
    int n = c >> 3, kc = c & 7;
    uint4 o;
    o.x = pack2(lds[(kc * 8 + 0) * 65 + n], lds[(kc * 8 + 1) * 65 + n]);
    o.y = pack2(lds[(kc * 8 + 2) * 65 + n], lds[(kc * 8 + 3) * 65 + n]);
    o.z = pack2(lds[(kc * 8 + 4) * 65 + n], lds[(kc * 8 + 5) * 65 + n]);
    o.w = pack2(lds[(kc * 8 + 6) * 65 + n], lds[(kc * 8 + 7) * 65 + n]);
    *(uint4*)(dst + (size_t)(nt * 64 + n) * ld_dst + kt * 64 + kc * 8) = o;
  }
  __syncthreads();
}

__device__ __forceinline__ void transpose_job(const Params& p, int u, float* lds) {
  char* ws = p.ws;
  if (u < 512) { transpose_unit(p.rg_w_in, 2048, (u16*)(ws + OFF_WT_IN), 1024, u >> 5, u & 31, nullptr, lds); return; }
  u -= 512;
  if (u < 256) { transpose_unit(p.rg_w_out, 1024, (u16*)(ws + OFF_WT_OUT), 1024, u >> 4, u & 15, nullptr, lds); return; }
  u -= 256;
  if (u < 64) {
    int which = u >> 5; int r = u & 31; int bi = r >> 2; int t = r & 3;
    const float* src = (which ? p.rg_wx : p.rg_wa) + (size_t)bi * 16384;
    u16* dst = (u16*)(ws + OFF_WT_BD) + (size_t)(which * 1024 + bi * 128) * 128;
    transpose_unit(src, 128, dst, 128, t >> 1, t & 1, nullptr, lds); return;
  }
  u -= 64;
  if (u < 1024) {
    int l = u >> 9; int r = u & 511;
    transpose_unit(p.peer_wq + (size_t)l * 2097152, 2048, (u16*)(ws + (l ? OFF_WT_PQ1 : OFF_WT_PQ0)), 1024, r >> 5, r & 31, nullptr, lds); return;
  }
  u -= 1024;
  if (u < 128) { transpose_unit(p.w_kv, 512, (u16*)(ws + OFF_WT_KVQ), 1024, u >> 3, u & 7, p.kv_norm, lds); return; }
  u -= 128;
  if (u < 256) { transpose_unit(p.w_q, 1024, (u16*)(ws + OFF_WT_KVQ) + (size_t)512 * 1024, 1024, u >> 4, u & 15, p.attn_norm, lds); return; }
  u -= 256;
  transpose_unit(p.w_o, 1024, (u16*)(ws + OFF_WT_O), 1024, u >> 4, u & 15, nullptr, lds);
}

__device__ __forceinline__ void cvt_unit(const float* __restrict__ src, u16* __restrict__ dst, size_t base) {
  const int tid = ltid();
#pragma unroll
  for (int j = 0; j < 2; ++j) {
    size_t o = base + j * 1024 + tid * 4;
    float4 v = *(const float4*)(src + o);
    uint2 w; w.x = pack2(v.x, v.y); w.y = pack2(v.z, v.w);
    *(uint2*)(dst + o) = w;
  }
}

__device__ __forceinline__ void rmsnorm_row(const float* __restrict__ x, const float* __restrict__ g, u16* __restrict__ o, int lane) {
  float4 v[4];
  float ss = 0.f;
#pragma unroll
  for (int i = 0; i < 4; ++i) {
    v[i] = *(const float4*)(x + i * 256 + lane * 4);
    ss += v[i].x * v[i].x + v[i].y * v[i].y + v[i].z * v[i].z + v[i].w * v[i].w;
  }
  ss = wave_sum(ss);
  float r = rsqrtf(ss * (1.f / 1024.f) + 1e-6f);
#pragma unroll
  for (int i = 0; i < 4; ++i) {
    float4 gg = *(const float4*)(g + i * 256 + lane * 4);
    uint2 w; w.x = pack2(v[i].x * r * gg.x, v[i].y * r * gg.y); w.y = pack2(v[i].z * r * gg.z, v[i].w * r * gg.w);
    *(uint2*)(o + i * 256 + lane * 4) = w;
  }
}

__device__ __forceinline__ void ph_convert0(const Params& p, char* smem) {
  const int tid = ltid(), lane = tid & 63, wid = tid >> 6;
  const int NT = 2496, NSK = 256, NROPE = 257, NRMS = 4352, NCACHE = 3840;
  const int total = NT + NSK + NROPE + NRMS + NCACHE;
  for (int u0 = blockIdx.x; u0 < total; u0 += gridDim.x) {
    int u = u0;
    if (u < NT) { transpose_job(p, u, (float*)smem); continue; }
    u -= NT;
    if (u < NSK) {
      int l = u >> 7; int r = u & 127;
      const float* src = p.peer_subkeys + (size_t)l * 32768;
      u16* dst = (u16*)(p.ws + (l ? OFF_WT_SK1 : OFF_WT_SK0));
#pragma unroll
      for (int j = 0; j < 2; ++j) {
        int i = r * 2048 + j * 1024 + tid * 4;
        int s = ((i >> 14) & 1) * 16384 + (i & 16383);
        float4 v = *(const float4*)(src + s);
        uint2 w; w.x = pack2(v.x, v.y); w.y = pack2(v.z, v.w);
        *(uint2*)(dst + i) = w;
      }
      continue;
    }
    u -= NSK;
    if (u < NROPE) {
      int i = u * 256 + tid;
      if (i < 2056 * 32) {
        int pi = i >> 5, d = i & 31;
        int pos = pi < 2048 ? pi : (16384 + pi - 2048);
        float inv = (float)pow(10000.0, -(double)d / 32.0);
        float ang = (float)pos * inv;
        double sn, cs;
        sincos((double)ang, &sn, &cs);
        float2* rt = (float2*)(p.ws + OFF_ROPE);
        rt[i] = make_float2((float)cs, (float)sn);
      }
      continue;
    }
    u -= NROPE;
    if (u < NRMS) {
      int t = u * 4 + wid;
      rmsnorm_row(xin_row(p, t), p.rg_norm, (u16*)(p.ws + OFF_XN) + (size_t)t * 1024, lane);
      continue;
    }
    u -= NRMS;
    {
      int which = u / 1920; int r = u - which * 1920;
      int b = r / 15, c = r - b * 15;
      const float* src = (which ? p.cache_v : p.cache_k) + (size_t)b * 32768 + 2048 + c * 2048;
      float* dst = p.out + (which ? OUT_VS : OUT_KS) + (size_t)b * 32768 + c * 2048;
#pragma unroll
      for (int j = 0; j < 2; ++j) {
        int o = j * 1024 + tid * 4;
        *(float4*)(dst + o) = *(const float4*)(src + o);
      }
    }
  }
}

__device__ __forceinline__ void ph_cvt_tables(const Params& p, int layer) {
  const int lane = ltid() & 63, wid = ltid() >> 6;
  for (int u = blockIdx.x; u < 8192; u += gridDim.x) {
    const int which = u >> 12; const int row = (u & 4095) * 4 + wid;
    const float* src = (which ? p.peer_v : p.peer_u) + (size_t)layer * 16777216 + (size_t)row * 1024 + lane * 16;
    unsigned char* dst = (unsigned char*)(p.ws + (which ? OFF_V8 : OFF_U8)) + (size_t)(lane >> 3) * 2097152 + (size_t)row * 128 + (lane & 7) * 16;
    float* sc = (float*)(p.ws + (which ? OFF_VSC : OFF_USC));
    float4 a = *(const float4*)(src), b = *(const float4*)(src + 4), c = *(const float4*)(src + 8), d = *(const float4*)(src + 12);
    float m = fmaxf(fmaxf(fmaxf(fabsf(a.x), fabsf(a.y)), fmaxf(fabsf(a.z), fabsf(a.w))), fmaxf(fmaxf(fabsf(b.x), fabsf(b.y)), fmaxf(fabsf(b.z), fabsf(b.w))));
    m = fmaxf(m, fmaxf(fmaxf(fmaxf(fabsf(c.x), fabsf(c.y)), fmaxf(fabsf(c.z), fabsf(c.w))), fmaxf(fmaxf(fabsf(d.x), fabsf(d.y)), fmaxf(fabsf(d.z), fabsf(d.w)))));
#pragma unroll
    for (int o = 32; o > 0; o >>= 1) m = fmaxf(m, __shfl_xor(m, o));
    const float scl = m > 0.f ? 440.f / m : 1.f;
    uint4 w; int t;
    t = 0; t = __builtin_amdgcn_cvt_pk_fp8_f32(a.x * scl, a.y * scl, t, false); t = __builtin_amdgcn_cvt_pk_fp8_f32(a.z * scl, a.w * scl, t, true); w.x = (unsigned)t;
    t = 0; t = __builtin_amdgcn_cvt_pk_fp8_f32(b.x * scl, b.y * scl, t, false); t = __builtin_amdgcn_cvt_pk_fp8_f32(b.z * scl, b.w * scl, t, true); w.y = (unsigned)t;
    t = 0; t = __builtin_amdgcn_cvt_pk_fp8_f32(c.x * scl, c.y * scl, t, false); t = __builtin_amdgcn_cvt_pk_fp8_f32(c.z * scl, c.w * scl, t, true); w.z = (unsigned)t;
    t = 0; t = __builtin_amdgcn_cvt_pk_fp8_f32(d.x * scl, d.y * scl, t, false); t = __builtin_amdgcn_cvt_pk_fp8_f32(d.z * scl, d.w * scl, t, true); w.w = (unsigned)t;
    *(uint4*)dst = w;
    if (lane == 0) sc[row] = m > 0.f ? m / 440.f : 1.f;
  }
}

__device__ __forceinline__ void ph_rmsnorm(const Params& p, const float* g) {
  const int lane = ltid() & 63, wid = ltid() >> 6;
  const float* x = (const float*)(p.ws + OFF_X);
  u16* xn = (u16*)(p.ws + OFF_XN);
  for (int u = blockIdx.x; u < 4352; u += gridDim.x) {
    int t = u * 4 + wid;
    rmsnorm_row(x + (size_t)t * 1024, g, xn + (size_t)t * 1024, lane);
  }
}

#define LASP __attribute__((address_space(3)))
template <class Epi>
__device__ __forceinline__ void gemm_tiles(const u16* __restrict__ A, int lda, const u16* __restrict__ W, int ldw,
                                           int K, int kmod, int ntn, const Epi& epi, char* smem_g) {
  LASP unsigned char* smem = (LASP unsigned char*)smem_g;
  const int tid = ltid(), lane = tid & 63, wid = tid >> 6;
  const int wr = wid >> 1, wc = wid & 1, fr = lane & 15, fq = lane >> 4;
  const int total = 136 * ntn;
  const int nk = K >> 6;
  int offA[4], offW[4];
#pragma unroll
  for (int i = 0; i < 4; ++i) {
    const int R = (i * 4 + wid) * 8 + (lane >> 3), C = ((lane & 7) ^ (lane >> 3)) * 8;
    offA[i] = R * lda + C; offW[i] = R * ldw + C;
  }
  const int lo0 = (fr >> 3) * 1024 + (fr & 7) * 128 + ((fq ^ (fr & 7)) * 16);
  const int lo1 = (fr >> 3) * 1024 + (fr & 7) * 128 + (((4 + fq) ^ (fr & 7)) * 16);
  for (int tile = blockIdx.x; tile < total; tile += gridDim.x) {
    const int tm = tile / ntn, tn = tile - tm * ntn;
    const u16* Ag = A + (size_t)(tm * 128) * lda + (kmod ? (tn % kmod) * 128 : 0);
    const u16* Wg = W + (size_t)(tn * 128) * ldw;
    f32x4 acc[4][4];
#pragma unroll
    for (int m = 0; m < 4; ++m)
#pragma unroll
      for (int n = 0; n < 4; ++n) acc[m][n] = f32x4{0.f, 0.f, 0.f, 0.f};
    for (int kt = 0; kt < nk; ++kt) {
      __syncthreads();
#pragma unroll
      for (int i = 0; i < 4; ++i) {
        __builtin_amdgcn_global_load_lds((const unsigned*)(Wg + offW[i] + kt * 64), (LASP unsigned*)(smem + i * 4096 + wid * 1024), 16, 0, 0);
        __builtin_amdgcn_global_load_lds((const unsigned*)(Ag + offA[i] + kt * 64), (LASP unsigned*)(smem + 16384 + i * 4096 + wid * 1024), 16, 0, 0);
      }
      asm volatile("s_waitcnt vmcnt(0)" ::: "memory");
      __syncthreads();
      const LASP unsigned char* sW = smem + wr * 8192;
      const LASP unsigned char* sA = smem + 16384 + wc * 8192;
#pragma unroll
      for (int ks = 0; ks < 2; ++ks) {
        const int lo = ks ? lo1 : lo0;
        bf16x8 a[4], b[4];
#pragma unroll
        for (int m = 0; m < 4; ++m) a[m] = *(const LASP bf16x8*)(sW + m * 2048 + lo);
#pragma unroll
        for (int n = 0; n < 4; ++n) b[n] = *(const LASP bf16x8*)(sA + n * 2048 + lo);
        __builtin_amdgcn_s_setprio(1);
#pragma unroll
        for (int m = 0; m < 4; ++m)
#pragma unroll
          for (int n = 0; n < 4; ++n) acc[m][n] = __builtin_amdgcn_mfma_f32_16x16x32_bf16(a[m], b[n], acc[m][n], 0, 0, 0);
        __builtin_amdgcn_s_setprio(0);
      }
    }
    epi(acc, tm * 128 + wc * 64, tn * 128 + wr * 64, fr, fq);
  }
}

struct EpiWin {
  u16* gate16; float* rec32;
  __device__ __forceinline__ void operator()(const f32x4 (&acc)[4][4], int tok0, int feat0, int fr, int fq) const {
#pragma unroll
    for (int n = 0; n < 4; ++n) {
      const int tok = tok0 + n * 16 + fr;
#pragma unroll
      for (int m = 0; m < 4; ++m) {
        const int f = feat0 + m * 16 + fq * 4;
        f32x4 v = acc[m][n];
        if (feat0 < 1024) {
          uint2 w; w.x = pack2(gelu_tanh(v[0]), gelu_tanh(v[1])); w.y = pack2(gelu_tanh(v[2]), gelu_tanh(v[3]));
          *(uint2*)(gate16 + (size_t)tok * 1024 + f) = w;
        } else {
          *(float4*)(rec32 + (size_t)tok * 1024 + (f - 1024)) = make_float4(v[0], v[1], v[2], v[3]);
        }
      }
    }
  }
};
struct EpiBd {
  float* loga; u16* ig16; const float *ba, *bx, *lam;
  __device__ __forceinline__ void operator()(const f32x4 (&acc)[4][4], int tok0, int feat0, int fr, int fq) const {
#pragma unroll
    for (int m = 0; m < 4; ++m) {
      const int f = feat0 + m * 16 + fq * 4;
      if (feat0 < 1024) {
        float4 b4 = *(const float4*)(ba + f);
        float4 l4 = *(const float4*)(lam + f);
        float sp0 = log1pf(__expf(-l4.x)), sp1 = log1pf(__expf(-l4.y)), sp2 = log1pf(__expf(-l4.z)), sp3 = log1pf(__expf(-l4.w));
#pragma unroll
        for (int n = 0; n < 4; ++n) {
          const int tok = tok0 + n * 16 + fr;
          f32x4 v = acc[m][n];
          float4 o;
          o.x = -8.f * sigmoidf_(v[0] + b4.x) * sp0;
          o.y = -8.f * sigmoidf_(v[1] + b4.y) * sp1;
          o.z = -8.f * sigmoidf_(v[2] + b4.z) * sp2;
          o.w = -8.f * sigmoidf_(v[3] + b4.w) * sp3;
          *(float4*)(loga + (size_t)tok * 1024 + f) = o;
        }
      } else {
        float4 b4 = *(const float4*)(bx + (f - 1024));
#pragma unroll
        for (int n = 0; n < 4; ++n) {
          const int tok = tok0 + n * 16 + fr;
          f32x4 v = acc[m][n];
          uint2 w;
          w.x = pack2(sigmoidf_(v[0] + b4.x), sigmoidf_(v[1] + b4.y));
          w.y = pack2(sigmoidf_(v[2] + b4.z), sigmoidf_(v[3] + b4.w));
          *(uint2*)(ig16 + (size_t)tok * 1024 + (f - 1024)) = w;
        }
      }
    }
  }
};
struct EpiResid {
  const float* xp; const float* xs; float* xres; int first;
  __device__ __forceinline__ void operator()(const f32x4 (&acc)[4][4], int tok0, int feat0, int fr, int fq) const {
#pragma unroll
    for (int n = 0; n < 4; ++n) {
      const int tok = tok0 + n * 16 + fr;
      const float* base = first ? (tok < NTP ? xp + (size_t)tok * 1024 : xs + (size_t)(tok - NTP) * 1024) : (xres + (size_t)tok * 1024);
#pragma unroll
      for (int m = 0; m < 4; ++m) {
        const int f = feat0 + m * 16 + fq * 4;
        float4 b = *(const float4*)(base + f);
        f32x4 v = acc[m][n];
        *(float4*)(xres + (size_t)tok * 1024 + f) = make_float4(b.x + v[0], b.y + v[1], b.z + v[2], b.w + v[3]);
      }
    }
  }
};
struct EpiBf16 {
  u16* o; int ld;
  __device__ __forceinline__ void operator()(const f32x4 (&acc)[4][4], int tok0, int feat0, int fr, int fq) const {
#pragma unroll
    for (int n = 0; n < 4; ++n) {
      const int tok = tok0 + n * 16 + fr;
#pragma unroll
      for (int m = 0; m < 4; ++m) {
        const int f = feat0 + m * 16 + fq * 4;
        f32x4 v = acc[m][n];
        uint2 w; w.x = pack2(v[0], v[1]); w.y = pack2(v[2], v[3]);
        *(uint2*)(o + (size_t)tok * ld + f) = w;
      }
    }
  }
};
struct EpiF32 {
  float* o; int ld;
  __device__ __forceinline__ void operator()(const f32x4 (&acc)[4][4], int tok0, int feat0, int fr, int fq) const {
#pragma unroll
    for (int n = 0; n < 4; ++n) {
      const int tok = tok0 + n * 16 + fr;
#pragma unroll
      for (int m = 0; m < 4; ++m) {
        const int f = feat0 + m * 16 + fq * 4;
        f32x4 v = acc[m][n];
        *(float4*)(o + (size_t)tok * ld + f) = make_float4(v[0], v[1], v[2], v[3]);
      }
    }
  }
};
__device__ __forceinline__ int mkkey(float v, int n) {
  int i = __float_as_int(v);
  i ^= (i >> 31) & 0x7fffffff;
  return (i & ~127) | (127 - n);
}
__device__ __forceinline__ float keyval(int k) {
  int i = (k & ~127) | 64;
  i ^= (i >> 31) & 0x7fffffff;
  return __int_as_float(i);
}
__device__ __forceinline__ int keyidx(int k) { return 127 - (k & 127); }
#define CE(i, j) { int hi_ = max(k[i], k[j]); int lo_ = min(k[i], k[j]); k[i] = hi_; k[j] = lo_; }

struct EpiTopk {
  int* tkey; char* smem;
  __device__ __forceinline__ void operator()(const f32x4 (&acc)[4][4], int tok0, int feat0, int fr, int fq) const {
    float* S = (float*)smem;
    const int tid = ltid(), lane = tid & 63, wid = tid >> 6, g = lane >> 4, li = lane & 15;
    const int wc = (tok0 >> 6) & 1, wr64 = feat0 & 127;
    const int tokbase = tok0 & ~127, hp = feat0 >> 7;
#pragma unroll 1
    for (int half = 0; half < 2; ++half) {
      __syncthreads();
      if (wc == half) {
#pragma unroll
        for (int n = 0; n < 4; ++n)
#pragma unroll
          for (int m = 0; m < 4; ++m) {
            f32x4 v = acc[m][n];
            *(float4*)(S + (n * 16 + fr) * 132 + wr64 + m * 16 + fq * 4) = make_float4(v[0], v[1], v[2], v[3]);
          }
      }
      __syncthreads();
#pragma unroll 1
      for (int pass = 0; pass < 4; ++pass) {
        const int row = pass * 16 + wid * 4 + g;
        const float* r = S + row * 132;
        float4 v0 = *(const float4*)(r + li * 4), v1 = *(const float4*)(r + 64 + li * 4);
        int k[8];
        k[0] = mkkey(v0.x, li * 4 + 0); k[1] = mkkey(v0.y, li * 4 + 1); k[2] = mkkey(v0.z, li * 4 + 2); k[3] = mkkey(v0.w, li * 4 + 3);
        k[4] = mkkey(v1.x, 64 + li * 4 + 0); k[5] = mkkey(v1.y, 64 + li * 4 + 1); k[6] = mkkey(v1.z, 64 + li * 4 + 2); k[7] = mkkey(v1.w, 64 + li * 4 + 3);
        CE(0, 1) CE(2, 3) CE(4, 5) CE(6, 7)
        CE(0, 2) CE(1, 3) CE(4, 6) CE(5, 7)
        CE(1, 2) CE(5, 6)
        CE(0, 4) CE(1, 5) CE(2, 6) CE(3, 7)
        CE(2, 4) CE(3, 5)
        CE(1, 2) CE(3, 4) CE(5, 6)
        int res = (int)0x80000000;
#pragma unroll
        for (int it = 0; it < 16; ++it) {
          const int M = grp_max_i(k[0]);
          const bool win = (k[0] == M);
          if (li == it) res = M;
#pragma unroll
          for (int i = 0; i < 7; ++i) k[i] = win ? k[i + 1] : k[i];
          k[7] = win ? (int)0x80000000 : k[7];
        }
        tkey[((size_t)(tokbase + half * 64 + row) * 16 + hp) * 16 + li] = res;
      }
    }
  }
};
struct EpiScoresTopk {
  const u16* sk; int* tkey; char* smem_g;
  __device__ __forceinline__ void operator()(const f32x4 (&acc)[4][4], int tok0, int feat0, int fr, int fq) const {
    LASP unsigned char* smem = (LASP unsigned char*)smem_g;
    const int tid = ltid(), lane = tid & 63, wid = tid >> 6, wr = wid >> 1, wc = wid & 1;
    const int tn = feat0 >> 7;
    const int swz = (lane * 16) ^ ((lane >> 5) << 5);
    __syncthreads();
#define SK_STAGE(kt2_)                                                                                           \
    _Pragma("unroll") for (int i = 0; i < 4; ++i) {                                                              \
      const int st = i * 4 + wid;                                                                                \
      const int R = (st >> 1) * 16 + (swz >> 6), C = (st & 1) * 32 + ((swz & 63) >> 1);                          \
      __builtin_amdgcn_global_load_lds((const unsigned*)(sk + (size_t)(tn * 128 + R) * 128 + (kt2_) * 64 + C),   \
                                       (LASP unsigned*)(smem + 32768 + i * 4096 + wid * 1024), 16, 0, 0);        \
    }
    SK_STAGE(0)
#pragma unroll
    for (int n = 0; n < 4; ++n)
#pragma unroll
      for (int m = 0; m < 4; ++m) {
        const int r = wc * 64 + n * 16 + fr, c = m * 16 + fq * 4;
        int ob = (r & 15) * 64 + (c & 31) * 2;
        ob ^= ((ob >> 9) & 1) << 5;
        const int off = wr * 16384 + ((r >> 4) * 2 + (c >> 5)) * 1024 + ob;
        f32x4 v = acc[m][n];
        typedef unsigned u32x2_t __attribute__((ext_vector_type(2)));
        u32x2_t w; w.x = pack2(v[0], v[1]); w.y = pack2(v[2], v[3]);
        *(LASP u32x2_t*)(smem + off) = w;
      }
    __builtin_amdgcn_sched_barrier(0);
    f32x4 acc2[4][4];
#pragma unroll
    for (int m = 0; m < 4; ++m)
#pragma unroll
      for (int n = 0; n < 4; ++n) acc2[m][n] = f32x4{0.f, 0.f, 0.f, 0.f};
    const int lane_off = (fr * 64 + fq * 16) ^ ((fr >> 3) << 5);
#pragma unroll 1
    for (int kt2 = 0; kt2 < 2; ++kt2) {
      asm volatile("s_waitcnt vmcnt(0)" ::: "memory");
      __syncthreads();
      const LASP unsigned char* sW = smem + 32768;
      const LASP unsigned char* sA = smem + kt2 * 16384;
      bf16x8 a[2][4];
#pragma unroll
      for (int ks = 0; ks < 2; ++ks)
#pragma unroll
        for (int m = 0; m < 4; ++m) a[ks][m] = *(const LASP bf16x8*)(sW + (wr * 8 + m * 2 + ks) * 1024 + lane_off);
      __syncthreads();
      if (kt2 == 0) { SK_STAGE(1) }
#pragma unroll
      for (int ks = 0; ks < 2; ++ks) {
        bf16x8 b[4];
#pragma unroll
        for (int n = 0; n < 4; ++n) b[n] = *(const LASP bf16x8*)(sA + (wc * 8 + n * 2 + ks) * 1024 + lane_off);
#pragma unroll
        for (int m = 0; m < 4; ++m)
#pragma unroll
          for (int n = 0; n < 4; ++n) acc2[m][n] = __builtin_amdgcn_mfma_f32_16x16x32_bf16(a[ks][m], b[n], acc2[m][n], 0, 0, 0);
        __builtin_amdgcn_sched_barrier(0);
      }
    }
#undef SK_STAGE
    EpiTopk e{tkey, smem_g};
    e(acc2, tok0, feat0, fr, fq);
  }
};
struct EpiKvq {
  u16 *k16, *v16, *q16; const float2* rope; float* out;
  __device__ __forceinline__ void operator()(const f32x4 (&acc)[4][4], int tok0, int feat0, int fr, int fq) const {
#pragma unroll
    for (int n = 0; n < 4; ++n) {
      const int tok = tok0 + n * 16 + fr;
      int b, t, pi, orow; bool is_p = tok < NTP;
      if (is_p) { b = tok >> 11; t = tok & 2047; pi = t; orow = t - 1920; }
      else { int ts = tok - NTP; b = ts >> 3; t = ts & 7; pi = 2048 + t; orow = 120 + t; }
      if (feat0 >= 256 && feat0 < 512) {
        const int kvh = (feat0 - 256) >> 6;
#pragma unroll
        for (int m = 0; m < 4; ++m) {
          const int d = m * 16 + fq * 4;
          f32x4 v = acc[m][n];
          uint2 w; w.x = pack2(v[0], v[1]); w.y = pack2(v[2], v[3]);
          *(uint2*)(v16 + (size_t)tok * 256 + kvh * 64 + d) = w;
          if (orow >= 0) {
            float* dst = out + (is_p ? OUT_VP : OUT_VS) + ((size_t)(b * 128 + orow) * 4 + kvh) * 64 + d;
            *(float4*)dst = make_float4(v[0], v[1], v[2], v[3]);
          }
        }
      } else {
        const bool isk = feat0 < 256;
        const float sc = isk ? 1.f : 0.125f;
#pragma unroll
        for (int m = 0; m < 2; ++m) {
          const int d = m * 16 + fq * 4;
          f32x4 x1 = acc[m][n], x2 = acc[m + 2][n];
          const float2* rp = rope + pi * 32 + d;
          float o1[4], o2[4];
#pragma unroll
          for (int j = 0; j < 4; ++j) {
            float2 csn = rp[j];
            o1[j] = (x1[j] * csn.x - x2[j] * csn.y) * sc;
            o2[j] = (x2[j] * csn.x + x1[j] * csn.y) * sc;
          }
          uint2 w1, w2;
          w1.x = pack2(o1[0], o1[1]); w1.y = pack2(o1[2], o1[3]);
          w2.x = pack2(o2[0], o2[1]); w2.y = pack2(o2[2], o2[3]);
          if (isk) {
            const int kvh = feat0 >> 6;
            *(uint2*)(k16 + (size_t)tok * 256 + kvh * 64 + d) = w1;
            *(uint2*)(k16 + (size_t)tok * 256 + kvh * 64 + d + 32) = w2;
            if (orow >= 0) {
              float* dst = out + (is_p ? OUT_KP : OUT_KS) + ((size_t)(b * 128 + orow) * 4 + kvh) * 64 + d;
              *(float4*)dst = make_float4(o1[0], o1[1], o1[2], o1[3]);
              *(float4*)(dst + 32) = make_float4(o2[0], o2[1], o2[2], o2[3]);
            }
          } else {
            const int f = feat0 - 512;
            *(uint2*)(q16 + (size_t)tok * 1024 + f + d) = w1;
            *(uint2*)(q16 + (size_t)tok * 1024 + f + d + 32) = w2;
          }
        }
      }
    }
  }
};

__device__ __forceinline__ void ph_conv(const Params& p) {
  const float* rec = (const float*)(p.ws + OFF_REC32);
  float* xc32 = (float*)(p.ws + OFF_XC32);
  u16* xc16 = (u16*)(p.ws + OFF_XC16);
  const int c = ltid() * 4;
  const float4 w0 = *(const float4*)(p.rg_conv_w + c), w1 = *(const float4*)(p.rg_conv_w + 1024 + c);
  const float4 w2 = *(const float4*)(p.rg_conv_w + 2048 + c), w3 = *(const float4*)(p.rg_conv_w + 3072 + c);
  const float4 cb = *(const float4*)(p.rg_conv_b + c);
  for (int u = blockIdx.x; u < NTOK / 8; u += gridDim.x) {
    const int tok0 = u * 8;
    int b, t0; const float* buf = nullptr;
    if (tok0 < NTP) { b = tok0 >> 11; t0 = tok0 & 2047; }
    else { b = (tok0 - NTP) >> 3; t0 = 0; buf = p.state_conv + (size_t)b * 3072; }
    float4 r1, r2, r3;
    const float4 z = make_float4(0.f, 0.f, 0.f, 0.f);
    if (t0 >= 3) {
      r1 = *(const float4*)(rec + (size_t)(tok0 - 1) * 1024 + c);
      r2 = *(const float4*)(rec + (size_t)(tok0 - 2) * 1024 + c);
      r3 = *(const float4*)(rec + (size_t)(tok0 - 3) * 1024 + c);
    } else if (buf) {
      r1 = *(const float4*)(buf + 2048 + c); r2 = *(const float4*)(buf + 1024 + c); r3 = *(const float4*)(buf + c);
    } else { r1 = z; r2 = z; r3 = z; }
    float4 r0[8];
#pragma unroll
    for (int s = 0; s < 8; ++s) r0[s] = *(const float4*)(rec + (size_t)(tok0 + s) * 1024 + c);
#pragma unroll
    for (int s = 0; s < 8; ++s) {
      const float4 x = r0[s];
      float4 o;
      o.x = cb.x + w3.x * x.x + w2.x * r1.x + w1.x * r2.x + w0.x * r3.x;
      o.y = cb.y + w3.y * x.y + w2.y * r1.y + w1.y * r2.y + w0.y * r3.y;
      o.z = cb.z + w3.z * x.z + w2.z * r1.z + w1.z * r2.z + w0.z * r3.z;
      o.w = cb.w + w3.w * x.w + w2.w * r1.w + w1.w * r2.w + w0.w * r3.w;
      const size_t off = (size_t)(tok0 + s) * 1024 + c;
      *(float4*)(xc32 + off) = o;
      uint2 w; w.x = pack2(o.x, o.y); w.y = pack2(o.z, o.w);
      *(uint2*)(xc16 + off) = w;
      const int t = t0 + s;
      if (tok0 < NTP) {
        if (t >= 2045) *(float4*)(p.out + OUT_CONVP + ((size_t)b * 3 + (t - 2045)) * 1024 + c) = x;
      } else {
        if (t >= 5) *(float4*)(p.out + OUT_CONVS + ((size_t)b * 3 + (t - 5)) * 1024 + c) = x;
      }
      r3 = r2; r2 = r1; r1 = x;
    }
  }
}

__device__ __forceinline__ float rg_mult(float la) {
  const float t = 2.f * la;
  const float ser = -t * (1.f + t * (0.5f + t * (0.16666667f + t * (0.041666668f + t * 0.0083333333f))));
  const float dir = 1.f - __expf(t);
  return __builtin_amdgcn_sqrtf(t > -0.25f ? ser : dir);
}
__device__ __forceinline__ void scan_step(const float* loga, const u16* ig16, const float* xc32, size_t off, float4& a, float4& bt) {
  float4 la = *(const float4*)(loga + off);
  uint2 gi = *(const uint2*)(ig16 + off);
  float4 xc = *(const float4*)(xc32 + off);
  a.x = __expf(la.x); a.y = __expf(la.y); a.z = __expf(la.z); a.w = __expf(la.w);
  bt.x = rg_mult(la.x) * bflo(gi.x) * xc.x;
  bt.y = rg_mult(la.y) * bfhi(gi.x) * xc.y;
  bt.z = rg_mult(la.z) * bflo(gi.y) * xc.z;
  bt.w = rg_mult(la.w) * bfhi(gi.y) * xc.w;
}
__device__ __forceinline__ void ph_scanA(const Params& p) {
  const float* loga = (const float*)(p.ws + OFF_LOGA);
  const u16* ig16 = (const u16*)(p.ws + OFF_IG16);
  const float* xc32 = (const float*)(p.ws + OFF_XC32);
  float* aggA = (float*)(p.ws + OFF_AGGA);
  float* aggB = (float*)(p.ws + OFF_AGGB);
  const int c = ltid() * 4;
  for (int item = blockIdx.x; item < 1024; item += gridDim.x) {
    const int b = item >> 7, ch = item & 127;
    float4 A = make_float4(1.f, 1.f, 1.f, 1.f), B = make_float4(0.f, 0.f, 0.f, 0.f);
    const size_t tok0 = (size_t)b * 2048 + ch * 16;
#pragma unroll 8
    for (int s = 0; s < 16; ++s) {
      float4 a, bt;
      scan_step(loga, ig16, xc32, (tok0 + s) * 1024 + c, a, bt);
      A.x *= a.x; A.y *= a.y; A.z *= a.z; A.w *= a.w;
      B.x = a.x * B.x + bt.x; B.y = a.y * B.y + bt.y; B.z = a.z * B.z + bt.z; B.w = a.w * B.w + bt.w;
    }
    *(float4*)(aggA + (size_t)item * 1024 + c) = A;
    *(float4*)(aggB + (size_t)item * 1024 + c) = B;
  }
}
__device__ __forceinline__ void ph_scanA2(const Params& p) {
  const float* aggA = (const float*)(p.ws + OFF_AGGA);
  float* aggB = (float*)(p.ws + OFF_AGGB);
  for (int u = blockIdx.x; u < 32; u += gridDim.x) {
    const int b = u >> 2, c = (u & 3) * 256 + ltid();
    float h = 0.f;
#pragma unroll 16
    for (int ch = 0; ch < 128; ++ch) {
      const size_t o = (size_t)(b * 128 + ch) * 1024 + c;
      const float A = aggA[o], B = aggB[o];
      aggB[o] = h;
      h = A * h + B;
    }
  }
}
__device__ __forceinline__ void ph_scanB(const Params& p) {
  const float* loga = (const float*)(p.ws + OFF_LOGA);
  const u16* ig16 = (const u16*)(p.ws + OFF_IG16);
  const float* xc32 = (const float*)(p.ws + OFF_XC32);
  const u16* gate16 = (const u16*)(p.ws + OFF_GATE16);
  u16* hg16 = (u16*)(p.ws + OFF_HG16);
  const float* aggB = (const float*)(p.ws + OFF_AGGB);
  const int c = ltid() * 4;
  for (int item = blockIdx.x; item < 1088; item += gridDim.x) {
    float4 h; size_t tok0; float* hout = nullptr;
    if (item < 1024) {
      const int b = item >> 7, ch = item & 127;
      h = *(const float4*)(aggB + (size_t)item * 1024 + c);
      tok0 = (size_t)b * 2048 + ch * 16;
      if (ch == 127) hout = p.out + OUT_HP + (size_t)b * 1024 + c;
    } else {
      tok0 = (size_t)NTP + (size_t)(item - 1024) * 16;
      h = make_float4(0.f, 0.f, 0.f, 0.f);
    }
#pragma unroll 8
    for (int s = 0; s < 16; ++s) {
      float4 a, bt;
      const size_t off = (tok0 + s) * 1024 + c;
      if (item >= 1024 && (s & 7) == 0) h = *(const float4*)(p.state_h + (size_t)((item - 1024) * 2 + (s >> 3)) * 1024 + c);
      scan_step(loga, ig16, xc32, off, a, bt);
      h.x = a.x * h.x + bt.x; h.y = a.y * h.y + bt.y; h.z = a.z * h.z + bt.z; h.w = a.w * h.w + bt.w;
      uint2 g = *(const uint2*)(gate16 + off);
      uint2 w; w.x = pack2(h.x * bflo(g.x), h.y * bfhi(g.x)); w.y = pack2(h.z * bflo(g.y), h.w * bfhi(g.y));
      *(uint2*)(hg16 + off) = w;
      if (item >= 1024 && (s & 7) == 7) *(float4*)(p.out + OUT_HS + (size_t)((item - 1024) * 2 + (s >> 3)) * 1024 + c) = h;
    }
    if (hout) *(float4*)hout = h;
  }
}

__device__ __forceinline__ int mkkey8(float v, int code) {
  int i = __float_as_int(v);
  i ^= (i >> 31) & 0x7fffffff;
  return (i & ~255) | code;
}
__device__ __forceinline__ float keyval8(int k) {
  int i = (k & ~255) | 128;
  i ^= (i >> 31) & 0x7fffffff;
  return __int_as_float(i);
}
__device__ __forceinline__ void ph_topk(const Params& p, char* smem) {
  const int tid = ltid(), lane = tid & 63, wid = tid >> 6, g = lane >> 4, li = lane & 15;
  const int* tkg = (const int*)(p.ws + OFF_TKEY);
  int* idx_out = (int*)(p.ws + OFF_IDX);
  float* gate_out = (float*)(p.ws + OFF_PGATE);
  int* tkey = (int*)smem + wid * 1024;
  float* tval = (float*)(tkey + 512);
  for (int tb = blockIdx.x; tb < 2176; tb += gridDim.x) {
    const int tbase = tb * 8 + wid * 2;
#pragma unroll
    for (int j = 0; j < 2; ++j) {
      const int4 kk = ((const int4*)(tkg + (size_t)tbase * 256))[j * 64 + lane];
      ((int4*)tkey)[j * 64 + lane] = kk;
      ((float4*)tval)[j * 64 + lane] = make_float4(keyval(kk.x), keyval(kk.y), keyval(kk.z), keyval(kk.w));
    }
    __syncthreads();
    const float* v1[4];
    float sv0[4]; int key[4], rk[4], ptr[4];
#pragma unroll
    for (int q = 0; q < 4; ++q) {
      const int h = (q & 1) * 4 + g;
      const float* v0 = tval + (q >> 1) * 256 + (h * 2) * 16;
      v1[q] = v0 + 16;
      sv0[q] = v0[li];
      ptr[q] = 0; rk[q] = 0;
      key[q] = mkkey8(sv0[q] + v1[q][0], 255 - li * 16);
    }
#pragma unroll 1
    for (int it = 0; it < 16; ++it) {
#pragma unroll
      for (int q = 0; q < 4; ++q) {
        const int M = grp_max_i(key[q]);
        const bool win = (key[q] == M);
        if (li == it) rk[q] = M;
        const int np = ptr[q] + (win ? 1 : 0);
        const int nk = (np < 16) ? mkkey8(sv0[q] + v1[q][np & 15], 255 - (li * 16 + np)) : (int)0x80000000;
        key[q] = win ? nk : key[q];
        ptr[q] = np;
      }
    }
#pragma unroll
    for (int q = 0; q < 4; ++q) {
      const int h = (q & 1) * 4 + g;
      const int t = tbase + (q >> 1);
      const int* t0 = tkey + (q >> 1) * 256 + (h * 2) * 16;
      const int rc = 255 - (rk[q] & 255);
      const float rv = keyval8(rk[q]);
      const int ia = keyidx(t0[rc >> 4]);
      const int ib = keyidx(t0[16 + (rc & 15)]);
      const float mx = grp_max_f(rv);
      const float ex = __expf(rv - mx);
      const float sm = grp_sum_f(ex);
      idx_out[(size_t)t * 128 + h * 16 + li] = ia * 128 + ib;
      gate_out[(size_t)t * 128 + h * 16 + li] = ex / sm;
    }
    __syncthreads();
  }
}

typedef float v2f __attribute__((ext_vector_type(2)));
template <int CTRL>
__device__ __forceinline__ float dpp_f(float v) { return __int_as_float(__builtin_amdgcn_update_dpp(0, __float_as_int(v), CTRL, 0xf, 0xf, false)); }
__device__ __forceinline__ float dot16_fp8(uint4 u, const v2f* x2) {
  v2f acc = {0.f, 0.f};
  acc = __builtin_elementwise_fma(__builtin_amdgcn_cvt_pk_f32_fp8((int)u.x, false), x2[0], acc);
  acc = __builtin_elementwise_fma(__builtin_amdgcn_cvt_pk_f32_fp8((int)u.x, true), x2[1], acc);
  acc = __builtin_elementwise_fma(__builtin_amdgcn_cvt_pk_f32_fp8((int)u.y, false), x2[2], acc);
  acc = __builtin_elementwise_fma(__builtin_amdgcn_cvt_pk_f32_fp8((int)u.y, true), x2[3], acc);
  acc = __builtin_elementwise_fma(__builtin_amdgcn_cvt_pk_f32_fp8((int)u.z, false), x2[4], acc);
  acc = __builtin_elementwise_fma(__builtin_amdgcn_cvt_pk_f32_fp8((int)u.z, true), x2[5], acc);
  acc = __builtin_elementwise_fma(__builtin_amdgcn_cvt_pk_f32_fp8((int)u.w, false), x2[6], acc);
  acc = __builtin_elementwise_fma(__builtin_amdgcn_cvt_pk_f32_fp8((int)u.w, true), x2[7], acc);
  return acc.x + acc.y;
}
__device__ __forceinline__ void axpy16_fp8(float w, uint4 u, v2f* o2) {
  const v2f w2 = {w, w};
  o2[0] = __builtin_elementwise_fma(__builtin_amdgcn_cvt_pk_f32_fp8((int)u.x, false), w2, o2[0]);
  o2[1] = __builtin_elementwise_fma(__builtin_amdgcn_cvt_pk_f32_fp8((int)u.x, true), w2, o2[1]);
  o2[2] = __builtin_elementwise_fma(__builtin_amdgcn_cvt_pk_f32_fp8((int)u.y, false), w2, o2[2]);
  o2[3] = __builtin_elementwise_fma(__builtin_amdgcn_cvt_pk_f32_fp8((int)u.y, true), w2, o2[3]);
  o2[4] = __builtin_elementwise_fma(__builtin_amdgcn_cvt_pk_f32_fp8((int)u.z, false), w2, o2[4]);
  o2[5] = __builtin_elementwise_fma(__builtin_amdgcn_cvt_pk_f32_fp8((int)u.z, true), w2, o2[5]);
  o2[6] = __builtin_elementwise_fma(__builtin_amdgcn_cvt_pk_f32_fp8((int)u.w, false), w2, o2[6]);
  o2[7] = __builtin_elementwise_fma(__builtin_amdgcn_cvt_pk_f32_fp8((int)u.w, true), w2, o2[7]);
}
__device__ __forceinline__ float reduce4_row(float d0, float d1, float d2, float d3, int lane) {
  const bool b0 = lane & 1, b1 = lane & 2;
  const float k0 = b0 ? d1 : d0, s0 = b0 ? d0 : d1;
  const float k1 = b0 ? d3 : d2, s1 = b0 ? d2 : d3;
  const float r0 = k0 + dpp_f<0xB1>(s0);
  const float r1 = k1 + dpp_f<0xB1>(s1);
  const float kk = b1 ? r1 : r0, ss = b1 ? r0 : r1;
  float q = kk + dpp_f<0x4E>(ss);
  q += dpp_f<0x128>(q);
  q += dpp_f<0x124>(q);
  return q;
}
#define EXP_LOAD(dst, dsc, TAB, SC, kbase, esrc)                                     \
  _Pragma("unroll") for (int j = 0; j < 8; ++j) {                                   \
    const int e = __builtin_amdgcn_readlane(esrc, ((kbase) + j) & 63);              \
    dst[j] = ((const uint4*)(TAB + (size_t)e * 1024))[lane];                        \
    dsc[j] = SC[e];                                                                  \
  }
#define EXP_LOADV(dst, TAB, kbase, esrc)                                             \
  _Pragma("unroll") for (int j = 0; j < 8; ++j) {                                   \
    const int e = __builtin_amdgcn_readlane(esrc, ((kbase) + j) & 63);              \
    dst[j] = ((const uint4*)(TAB + (size_t)e * 1024))[lane];                        \
  }
#define EXP_UDOT(src, ssc, kbase)                                                    \
  {                                                                                  \
    float d[8];                                                                      \
    _Pragma("unroll") for (int j = 0; j < 8; ++j) d[j] = dot16_fp8(src[j], x2) * ssc[j]; \
    const float qa = reduce4_row(d[0], d[1], d[2], d[3], lane);                      \
    const float qb = reduce4_row(d[4], d[5], d[6], d[7], lane);                      \
    float q = (lane & 4) ? qb : qa;                                                  \
    q += __shfl_xor(q, 16);                                                          \
    q += __shfl_xor(q, 32);                                                          \
    if ((lane >> 3) == ((((kbase)) & 63) >> 3)) { if ((kbase) < 64) h_lo = q; else h_hi = q; } \
  }
#define EXP_VACC(src, kbase, wsrc)                                                   \
  _Pragma("unroll") for (int j = 0; j < 8; ++j) {                                   \
    const float w = __int_as_float(__builtin_amdgcn_readlane(__float_as_int(wsrc), ((kbase) + j) & 63)); \
    axpy16_fp8(w, src[j], o2);                                                       \
  }

__device__ __forceinline__ void ph_expert(const Params& p, int layer) {
  const int lane = ltid() & 63, wid = ltid() >> 6;
  u16* xn16 = (u16*)(p.ws + OFF_XN);
  float* xres = (float*)(p.ws + OFF_X);
  const int* idxs = (const int*)(p.ws + OFF_IDX);
  const float* gates = (const float*)(p.ws + OFF_PGATE);
  const unsigned char* U = (const unsigned char*)(p.ws + OFF_U8);
  const unsigned char* V = (const unsigned char*)(p.ws + OFF_V8);
  const float* USC = (const float*)(p.ws + OFF_USC);
  const float* VSC = (const float*)(p.ws + OFF_VSC);
  for (int tb = blockIdx.x; tb < 4352; tb += gridDim.x) {
    const int t = tb * 4 + wid;
    v2f x2[8];
    {
      const uint4* xr = (const uint4*)(xn16 + (size_t)t * 1024 + lane * 16);
      uint4 xa = xr[0], xb = xr[1];
      x2[0] = v2f{bflo(xa.x), bfhi(xa.x)}; x2[1] = v2f{bflo(xa.y), bfhi(xa.y)};
      x2[2] = v2f{bflo(xa.z), bfhi(xa.z)}; x2[3] = v2f{bflo(xa.w), bfhi(xa.w)};
      x2[4] = v2f{bflo(xb.x), bfhi(xb.x)}; x2[5] = v2f{bflo(xb.y), bfhi(xb.y)};
      x2[6] = v2f{bflo(xb.z), bfhi(xb.z)}; x2[7] = v2f{bflo(xb.w), bfhi(xb.w)};
    }
    const int e_lo = idxs[(size_t)t * 128 + lane], e_hi = idxs[(size_t)t * 128 + 64 + lane];
    const float g_lo = gates[(size_t)t * 128 + lane], g_hi = gates[(size_t)t * 128 + 64 + lane];
    const float vs_lo = VSC[e_lo], vs_hi = VSC[e_hi];
    float h_lo = 0.f, h_hi = 0.f;
    {
      uint4 ba[8], bb[8]; float sa[8], sb[8];
      EXP_LOAD(ba, sa, U, USC, 0, e_lo)
#pragma unroll 1
      for (int kb = 0; kb < 64; kb += 16) {
        EXP_LOAD(bb, sb, U, USC, kb + 8, e_lo)
        EXP_UDOT(ba, sa, kb)
        if (kb + 16 < 64) { EXP_LOAD(ba, sa, U, USC, kb + 16, e_lo) } else { EXP_LOAD(ba, sa, U, USC, 0, e_hi) }
        EXP_UDOT(bb, sb, kb + 8)
      }
#pragma unroll 1
      for (int kb = 64; kb < 128; kb += 16) {
        EXP_LOAD(bb, sb, U, USC, kb + 8, e_hi)
        EXP_UDOT(ba, sa, kb)
        if (kb + 16 < 128) { EXP_LOAD(ba, sa, U, USC, kb + 16, e_hi) }
        EXP_UDOT(bb, sb, kb + 8)
      }
    }
    const float w_lo = 0.5f * h_lo * (1.f + erff(h_lo * 0.70710678118654752f)) * g_lo * vs_lo;
    const float w_hi = 0.5f * h_hi * (1.f + erff(h_hi * 0.70710678118654752f)) * g_hi * vs_hi;
    v2f o2[8];
#pragma unroll
    for (int i = 0; i < 8; ++i) o2[i] = v2f{0.f, 0.f};
    {
      uint4 ba[8], bb[8];
      EXP_LOADV(ba, V, 0, e_lo)
#pragma unroll 1
      for (int kb = 0; kb < 64; kb += 16) {
        EXP_LOADV(bb, V, kb + 8, e_lo)
        EXP_VACC(ba, kb, w_lo)
        if (kb + 16 < 64) { EXP_LOADV(ba, V, kb + 16, e_lo) } else { EXP_LOADV(ba, V, 0, e_hi) }
        EXP_VACC(bb, kb + 8, w_lo)
      }
#pragma unroll 1
      for (int kb = 64; kb < 128; kb += 16) {
        EXP_LOADV(bb, V, kb + 8, e_hi)
        EXP_VACC(ba, kb, w_hi)
        if (kb + 16 < 128) { EXP_LOADV(ba, V, kb + 16, e_hi) }
        EXP_VACC(bb, kb + 8, w_hi)
      }
    }
    float o[16];
#pragma unroll
    for (int i = 0; i < 8; ++i) { o[2 * i] = o2[i].x; o[2 * i + 1] = o2[i].y; }
    float* xr = xres + (size_t)t * 1024 + lane * 16;
    float ss = 0.f;
#pragma unroll
    for (int i = 0; i < 4; ++i) {
      float4 r = *(const float4*)(xr + i * 4);
      o[4 * i] += r.x; o[4 * i + 1] += r.y; o[4 * i + 2] += r.z; o[4 * i + 3] += r.w;
      ss += o[4 * i] * o[4 * i] + o[4 * i + 1] * o[4 * i + 1] + o[4 * i + 2] * o[4 * i + 2] + o[4 * i + 3] * o[4 * i + 3];
    }
    ss = wave_sum(ss);
    const float rs = rsqrtf(ss * (1.f / 1024.f) + 1e-6f);
    if (layer == 0) {
#pragma unroll
      for (int i = 0; i < 4; ++i) *(float4*)(xr + i * 4) = make_float4(o[4 * i], o[4 * i + 1], o[4 * i + 2], o[4 * i + 3]);
      uint4 wa, wb;
      wa.x = pack2(o[0] * rs, o[1] * rs); wa.y = pack2(o[2] * rs, o[3] * rs); wa.z = pack2(o[4] * rs, o[5] * rs); wa.w = pack2(o[6] * rs, o[7] * rs);
      wb.x = pack2(o[8] * rs, o[9] * rs); wb.y = pack2(o[10] * rs, o[11] * rs); wb.z = pack2(o[12] * rs, o[13] * rs); wb.w = pack2(o[14] * rs, o[15] * rs);
      uint4* xw = (uint4*)(xn16 + (size_t)t * 1024 + lane * 16);
      xw[0] = wa; xw[1] = wb;
    } else {
      const float* fg = p.final_norm + lane * 16;
      float* y = p.out + OUT_Y + (size_t)t * 1024 + lane * 16;
#pragma unroll
      for (int i = 0; i < 4; ++i) {
        float4 g = *(const float4*)(fg + i * 4);
        *(float4*)(y + i * 4) = make_float4(o[4 * i] * rs * g.x, o[4 * i + 1] * rs * g.y, o[4 * i + 2] * rs * g.z, o[4 * i + 3] * rs * g.w);
      }
    }
  }
}

struct XInfo { int nloc, nx, rank, xr; };
__device__ __forceinline__ float reduce8(float v) {
  v += dpp_f<0xB1>(v); v += dpp_f<0x4E>(v); v += dpp_f<0x141>(v);
  return v;
}
__device__ __forceinline__ void ph_expert_u(const Params& p, const XInfo xi) {
  const int lane = ltid() & 63, wid = ltid() >> 6, g = lane >> 3, i8 = lane & 7;
  const u16* xn16 = (const u16*)(p.ws + OFF_XN);
  const int* idxs = (const int*)(p.ws + OFF_IDX);
  float* ph = (float*)(p.ws + OFF_PH);
  for (int c = xi.xr; c < 8; c += xi.nx) {
    const unsigned char* Us = (const unsigned char*)(p.ws + OFF_U8) + (size_t)c * 2097152;
    const unsigned lo = (unsigned)i8 * 16u;
    int t = xi.rank * 4 + wid;
    int e[16];
    {
      const int t0 = min(t, NTOK - 1);
      const int4* ip = (const int4*)(idxs + (size_t)t0 * 128 + g * 16);
#pragma unroll
      for (int j = 0; j < 4; ++j) { int4 q = ip[j]; e[4 * j] = q.x; e[4 * j + 1] = q.y; e[4 * j + 2] = q.z; e[4 * j + 3] = q.w; }
    }
    for (; t < NTOK; t += xi.nloc * 4) {
      uint4 seg[16];
#pragma unroll
      for (int j = 0; j < 16; ++j) seg[j] = *(const uint4*)(Us + ((unsigned)e[j] * 128u + lo));
      v2f x2[8];
      {
        const uint4* xr = (const uint4*)(xn16 + (size_t)t * 1024 + c * 128 + i8 * 16);
        uint4 xa = xr[0], xb = xr[1];
        x2[0] = v2f{bflo(xa.x), bfhi(xa.x)}; x2[1] = v2f{bflo(xa.y), bfhi(xa.y)};
        x2[2] = v2f{bflo(xa.z), bfhi(xa.z)}; x2[3] = v2f{bflo(xa.w), bfhi(xa.w)};
        x2[4] = v2f{bflo(xb.x), bfhi(xb.x)}; x2[5] = v2f{bflo(xb.y), bfhi(xb.y)};
        x2[6] = v2f{bflo(xb.z), bfhi(xb.z)}; x2[7] = v2f{bflo(xb.w), bfhi(xb.w)};
      }
      {
        const int tn = min(t + xi.nloc * 4, NTOK - 1);
        const int4* ip = (const int4*)(idxs + (size_t)tn * 128 + g * 16);
#pragma unroll
        for (int j = 0; j < 4; ++j) { int4 q = ip[j]; e[4 * j] = q.x; e[4 * j + 1] = q.y; e[4 * j + 2] = q.z; e[4 * j + 3] = q.w; }
      }
      float d[16];
#pragma unroll
      for (int j = 0; j < 16; ++j) d[j] = reduce8(dot16_fp8(seg[j], x2));
      if (i8 == 0) {
        float* o = ph + ((size_t)c * NTOK + t) * 128 + g * 16;
#pragma unroll
        for (int j = 0; j < 4; ++j) *(float4*)(o + 4 * j) = make_float4(d[4 * j], d[4 * j + 1], d[4 * j + 2], d[4 * j + 3]);
      }
    }
  }
}
__device__ __forceinline__ void ph_expert_combine(const Params& p) {
  const int* idxs = (const int*)(p.ws + OFF_IDX);
  float* gates = (float*)(p.ws + OFF_PGATE);
  const float* ph = (const float*)(p.ws + OFF_PH);
  const float* USC = (const float*)(p.ws + OFF_USC);
  const float* VSC = (const float*)(p.ws + OFF_VSC);
  for (int i = blockIdx.x * 256 + ltid(); i < NTOK * 128; i += gridDim.x * 256) {
    float s = 0.f;
#pragma unroll
    for (int c = 0; c < 8; ++c) s += ph[(size_t)c * NTOK * 128 + i];
    const int e = idxs[i];
    const float h = s * USC[e];
    gates[i] = 0.5f * h * (1.f + erff(h * 0.70710678118654752f)) * gates[i] * VSC[e];
  }
}
__device__ __forceinline__ void ph_expert_v(const Params& p, const XInfo xi) {
  const int lane = ltid() & 63, wid = ltid() >> 6, g = lane >> 3, i8 = lane & 7;
  const int* idxs = (const int*)(p.ws + OFF_IDX);
  const float* wts = (const float*)(p.ws + OFF_PGATE);
  float* xres = (float*)(p.ws + OFF_X);
  for (int c = xi.xr; c < 8; c += xi.nx) {
    const unsigned char* Vs = (const unsigned char*)(p.ws + OFF_V8) + (size_t)c * 2097152;
    const unsigned lo = (unsigned)i8 * 16u;
    int t = xi.rank * 4 + wid;
    int e[16]; float w[16];
    {
      const int t0 = min(t, NTOK - 1);
      const int4* ip = (const int4*)(idxs + (size_t)t0 * 128 + g * 16);
      const float4* wp = (const float4*)(wts + (size_t)t0 * 128 + g * 16);
#pragma unroll
      for (int j = 0; j < 4; ++j) { int4 q = ip[j]; float4 r = wp[j]; e[4 * j] = q.x; e[4 * j + 1] = q.y; e[4 * j + 2] = q.z; e[4 * j + 3] = q.w; w[4 * j] = r.x; w[4 * j + 1] = r.y; w[4 * j + 2] = r.z; w[4 * j + 3] = r.w; }
    }
    for (; t < NTOK; t += xi.nloc * 4) {
      v2f o2[8];
#pragma unroll
      for (int i = 0; i < 8; ++i) o2[i] = v2f{0.f, 0.f};
#pragma unroll
      for (int hb = 0; hb < 2; ++hb) {
        uint4 seg[8];
#pragma unroll
        for (int j = 0; j < 8; ++j) seg[j] = *(const uint4*)(Vs + ((unsigned)e[hb * 8 + j] * 128u + lo));
#pragma unroll
        for (int j = 0; j < 8; ++j) axpy16_fp8(w[hb * 8 + j], seg[j], o2);
        __builtin_amdgcn_sched_barrier(0);
      }
      {
        const int tn = min(t + xi.nloc * 4, NTOK - 1);
        const int4* ip = (const int4*)(idxs + (size_t)tn * 128 + g * 16);
        const float4* wp = (const float4*)(wts + (size_t)tn * 128 + g * 16);
#pragma unroll
        for (int j = 0; j < 4; ++j) { int4 q = ip[j]; float4 r = wp[j]; e[4 * j] = q.x; e[4 * j + 1] = q.y; e[4 * j + 2] = q.z; e[4 * j + 3] = q.w; w[4 * j] = r.x; w[4 * j + 1] = r.y; w[4 * j + 2] = r.z; w[4 * j + 3] = r.w; }
      }
      float o[16];
#pragma unroll
      for (int i = 0; i < 8; ++i) { o[2 * i] = o2[i].x; o[2 * i + 1] = o2[i].y; }
#pragma unroll
      for (int i = 0; i < 16; ++i) {
        float v = o[i];
        v += dpp_f<0x128>(v);
        v += __shfl_xor(v, 16);
        v += __shfl_xor(v, 32);
        o[i] = v;
      }
      if (g == 0) {
        float* xr = xres + (size_t)t * 1024 + c * 128 + i8 * 16;
#pragma unroll
        for (int i = 0; i < 4; ++i) {
          float4 r = *(const float4*)(xr + i * 4);
          *(float4*)(xr + i * 4) = make_float4(r.x + o[4 * i], r.y + o[4 * i + 1], r.z + o[4 * i + 2], r.w + o[4 * i + 3]);
        }
      }
    }
  }
}
__device__ __forceinline__ void ph_post_norm(const Params& p, int layer) {
  const int lane = ltid() & 63, wid = ltid() >> 6;
  const float* xres = (const float*)(p.ws + OFF_X);
  u16* xn16 = (u16*)(p.ws + OFF_XN);
  for (int u = blockIdx.x; u < 4352; u += gridDim.x) {
    const int t = u * 4 + wid;
    const float* x = xres + (size_t)t * 1024;
    float4 v[4]; float ss = 0.f;
#pragma unroll
    for (int i = 0; i < 4; ++i) {
      v[i] = *(const float4*)(x + i * 256 + lane * 4);
      ss += v[i].x * v[i].x + v[i].y * v[i].y + v[i].z * v[i].z + v[i].w * v[i].w;
    }
    ss = wave_sum(ss);
    const float r = rsqrtf(ss * (1.f / 1024.f) + 1e-6f);
    if (layer == 0) {
#pragma unroll
      for (int i = 0; i < 4; ++i) {
        uint2 w; w.x = pack2(v[i].x * r, v[i].y * r); w.y = pack2(v[i].z * r, v[i].w * r);
        *(uint2*)(xn16 + (size_t)t * 1024 + i * 256 + lane * 4) = w;
      }
    } else {
      float* y = p.out + OUT_Y + (size_t)t * 1024;
#pragma unroll
      for (int i = 0; i < 4; ++i) {
        float4 gg = *(const float4*)(p.final_norm + i * 256 + lane * 4);
        *(float4*)(y + i * 256 + lane * 4) = make_float4(v[i].x * r * gg.x, v[i].y * r * gg.y, v[i].z * r * gg.z, v[i].w * r * gg.w);
      }
    }
  }
}

__device__ __forceinline__ void ph_attn(const Params& p, char* smem) {
  const int tid = ltid(), lane = tid & 63, wid = tid >> 6, fr = lane & 15, fq = lane >> 4;
  const u16* k16 = (const u16*)(p.ws + OFF_K16);
  const u16* v16 = (const u16*)(p.ws + OFF_V16A);
  const u16* q16 = (const u16*)(p.ws + OFF_Q16);
  u16* o16 = (u16*)(p.ws + OFF_O16);
  u16* Ks = (u16*)smem;
  u16* Vt = (u16*)(smem + 27648);
  for (int item = blockIdx.x; item < 1536; item += gridDim.x) {
    const bool is_p = item < 1024;
    int b, kvh, q0 = 0, nsub, nvalid, kpos0, minpos, tokbase;
    if (is_p) { b = item >> 7; kvh = (item >> 5) & 3; q0 = (item & 31) * 64; nsub = 4; nvalid = 192; kpos0 = q0 - 128; minpos = 0; tokbase = b * 2048; }
    else { int it2 = item - 1024; b = it2 >> 2; kvh = it2 & 3; nsub = 1; nvalid = 136; kpos0 = -128; minpos = -100000; tokbase = NTP + b * 8; }
    __syncthreads();
#pragma unroll 1
    for (int c = tid; c < 1536; c += 256) {
      const int j = c >> 3, ch = c & 7;
      uint4 kk = make_uint4(0, 0, 0, 0), vv = make_uint4(0, 0, 0, 0);
      if (is_p) {
        const int kp = kpos0 + j;
        if (kp >= 0) {
          const size_t off = (size_t)(tokbase + kp) * 256 + kvh * 64 + ch * 8;
          kk = *(const uint4*)(k16 + off); vv = *(const uint4*)(v16 + off);
        }
      } else {
        if (j < 128) {
          const size_t off = ((size_t)(b * 128 + j) * 4 + kvh) * 64 + ch * 8;
          float4 a0 = *(const float4*)(p.cache_k + off), a1 = *(const float4*)(p.cache_k + off + 4);
          float4 c0 = *(const float4*)(p.cache_v + off), c1 = *(const float4*)(p.cache_v + off + 4);
          kk.x = pack2(a0.x, a0.y); kk.y = pack2(a0.z, a0.w); kk.z = pack2(a1.x, a1.y); kk.w = pack2(a1.z, a1.w);
          vv.x = pack2(c0.x, c0.y); vv.y = pack2(c0.z, c0.w); vv.z = pack2(c1.x, c1.y); vv.w = pack2(c1.z, c1.w);
        } else if (j < 136) {
          const size_t off = (size_t)(tokbase + j - 128) * 256 + kvh * 64 + ch * 8;
          kk = *(const uint4*)(k16 + off); vv = *(const uint4*)(v16 + off);
        }
      }
      *(uint4*)(Ks + j * 72 + ch * 8) = kk;
      u16* vd = Vt + (ch * 8) * 200 + j;
      vd[0] = (u16)(vv.x & 0xffff); vd[200] = (u16)(vv.x >> 16);
      vd[400] = (u16)(vv.y & 0xffff); vd[600] = (u16)(vv.y >> 16);
      vd[800] = (u16)(vv.z & 0xffff); vd[1000] = (u16)(vv.z >> 16);
      vd[1200] = (u16)(vv.w & 0xffff); vd[1400] = (u16)(vv.w >> 16);
    }
    __syncthreads();
    const int head = kvh * 4 + wid;
    const float sink = p.sinks[head];
#pragma unroll 1
    for (int sub = 0; sub < nsub; ++sub) {
      int qtok, qp;
      if (is_p) { qp = q0 + sub * 16 + fr; qtok = tokbase + qp; }
      else { qp = fr & 7; qtok = tokbase + (fr & 7); }
      const u16* qrow = q16 + (size_t)qtok * 1024 + head * 64;
      const bf16x8 qf0 = *(const bf16x8*)(qrow + fq * 8);
      const bf16x8 qf1 = *(const bf16x8*)(qrow + 32 + fq * 8);
      f32x4 s[12];
#pragma unroll
      for (int ks = 0; ks < 12; ++ks) {
        const bf16x8 kf0 = *(const bf16x8*)(Ks + (ks * 16 + fr) * 72 + fq * 8);
        const bf16x8 kf1 = *(const bf16x8*)(Ks + (ks * 16 + fr) * 72 + 32 + fq * 8);
        f32x4 z = {0.f, 0.f, 0.f, 0.f};
        z = __builtin_amdgcn_mfma_f32_16x16x32_bf16(kf0, qf0, z, 0, 0, 0);
        s[ks] = __builtin_amdgcn_mfma_f32_16x16x32_bf16(kf1, qf1, z, 0, 0, 0);
        if ((ks & 3) == 3) __builtin_amdgcn_sched_barrier(0);
      }
      float mx = sink;
      const int lo_ = max(minpos, qp - 127), hi_ = min(qp, kpos0 + nvalid - 1);
      const unsigned span_ = (unsigned)(hi_ - lo_);
      const int kp0_ = kpos0 + fq * 4 - lo_;
#pragma unroll
      for (int ks = 0; ks < 12; ++ks)
#pragma unroll
        for (int j = 0; j < 4; ++j) {
          const bool valid = (unsigned)(kp0_ + ks * 16 + j) <= span_;
          const float v = valid ? s[ks][j] : -1.0e30f;
          s[ks][j] = v;
          mx = fmaxf(mx, v);
          if (j == 3) __builtin_amdgcn_sched_barrier(0);
        }
      mx = fmaxf(mx, __shfl_xor(mx, 16));
      mx = fmaxf(mx, __shfl_xor(mx, 32));
      float sum = 0.f;
#pragma unroll
      for (int ks = 0; ks < 12; ++ks)
#pragma unroll
        for (int j = 0; j < 4; ++j) {
          const float pv = (s[ks][j] > -1.0e29f) ? __expf(s[ks][j] - mx) : 0.f;
          s[ks][j] = pv;
          sum += pv;
          if (j == 3) __builtin_amdgcn_sched_barrier(0);
        }
      sum += __shfl_xor(sum, 16);
      sum += __shfl_xor(sum, 32);
      sum += __expf(sink - mx);
      const float inv = 1.f / sum;
      f32x4 o[4];
#pragma unroll
      for (int d = 0; d < 4; ++d) o[d] = f32x4{0.f, 0.f, 0.f, 0.f};
#pragma unroll
      for (int kk = 0; kk < 6; ++kk) {
        union { bf16x8 v; unsigned u[4]; } pb;
        pb.u[0] = pack2(s[2 * kk][0], s[2 * kk][1]); pb.u[1] = pack2(s[2 * kk][2], s[2 * kk][3]);
        pb.u[2] = pack2(s[2 * kk + 1][0], s[2 * kk + 1][1]); pb.u[3] = pack2(s[2 * kk + 1][2], s[2 * kk + 1][3]);
#pragma unroll
        for (int d = 0; d < 4; ++d) {
          union { bf16x8 v; uint2 h[2]; } vf;
          const u16* vr = Vt + (d * 16 + fr) * 200 + fq * 4;
          vf.h[0] = *(const uint2*)(vr + (2 * kk) * 16);
          vf.h[1] = *(const uint2*)(vr + (2 * kk + 1) * 16);
          o[d] = __builtin_amdgcn_mfma_f32_16x16x32_bf16(vf.v, pb.v, o[d], 0, 0, 0);
        }
        __builtin_amdgcn_sched_barrier(0);
      }
      if (is_p || fr < 8) {
#pragma unroll
        for (int d = 0; d < 4; ++d) {
          uint2 w; w.x = pack2(o[d][0] * inv, o[d][1] * inv); w.y = pack2(o[d][2] * inv, o[d][3] * inv);
          *(uint2*)(o16 + (size_t)qtok * 1024 + head * 64 + d * 16 + fq * 4) = w;
        }
      }
    }
  }
}


#define XB_TMO      128
#define XB_XCNT(j)  (256  + 64 * (j))
#define XB_XSUB(j)  (1280 + 64 * (j))
#define XB_XGEN(j)  (2304 + 64 * (j))
#define XB_TOP      3328
#define XB_TOPGEN   3392
#define XCD_BAR_WORDS 3456
#define XB_SPIN_CAP (1u << 20)
#define LAS __attribute__((address_space(3)))
__device__ __forceinline__ unsigned xb_ld(unsigned* p) { return __hip_atomic_load(p, __ATOMIC_RELAXED, __HIP_MEMORY_SCOPE_AGENT); }
__device__ __forceinline__ unsigned xb_add(unsigned* p, unsigned v) { return __hip_atomic_fetch_add(p, v, __ATOMIC_RELAXED, __HIP_MEMORY_SCOPE_AGENT); }
__device__ __forceinline__ unsigned xb_xcc_id() { return (unsigned)__builtin_amdgcn_s_getreg((3 << 11) | 20) & 0xFu; }
#define XB_SPIN(cond, bar) do { unsigned _sp = 0; while (cond) { __builtin_amdgcn_s_sleep(1); \
    if ((++_sp & 255u) == 0u) { if (xb_ld(&(bar)[XB_TMO])) break; if (_sp > XB_SPIN_CAP) { atomicAdd(&(bar)[XB_TMO], 1u); break; } } } } while (0)
struct XcdBarrier { unsigned* bar; unsigned x; volatile LAS unsigned* st; };
__device__ __forceinline__ XcdBarrier xcd_barrier_post(unsigned* bar, volatile LAS unsigned* st) {
  XcdBarrier b; b.bar = bar; b.x = xb_xcc_id(); b.st = st;
  if (threadIdx.x == 0) st[2] = xb_add(&bar[XB_XCNT(b.x)], 1u);
  return b;
}
__device__ __forceinline__ void xcd_barrier_complete(unsigned* bar, unsigned x, unsigned& nloc, unsigned& nx, unsigned& xr) {
  const unsigned G = gridDim.x * gridDim.y * gridDim.z;
  unsigned sum, cnt, mine, below, sp = 0u;
  for (;;) {
    sum = 0u; cnt = 0u; mine = 0u; below = 0u;
#pragma unroll
    for (unsigned j = 0; j < 16; ++j) { const unsigned c = xb_ld(&bar[XB_XCNT(j)]); sum += c; cnt += (c > 0u) ? 1u : 0u; mine = (j == x) ? c : mine; below += (j < x && c > 0u) ? 1u : 0u; }
    if (sum == G) break;
    __builtin_amdgcn_s_sleep(1);
    if ((++sp & 255u) == 0u) { if (xb_ld(&bar[XB_TMO])) break; if (sp > XB_SPIN_CAP) { atomicAdd(&bar[XB_TMO], 1u); break; } }
  }
  nloc = mine > 0u ? mine : 1u; nx = cnt > 0u ? cnt : 1u; xr = below;
}
__device__ __forceinline__ void xcd_barrier(const XcdBarrier& b) {
  asm volatile("s_waitcnt vmcnt(0)" ::: "memory");
  __syncthreads();
  if (threadIdx.x == 0) {
    unsigned* bar = b.bar;
    __builtin_amdgcn_s_waitcnt(0);
    unsigned nloc = b.st[0], nx = b.st[1];
    if (nloc == 0u) { unsigned xr; xcd_barrier_complete(bar, b.x, nloc, nx, xr); b.st[0] = nloc; b.st[1] = nx; b.st[3] = xr; }
    const unsigned old = xb_add(&bar[XB_XSUB(b.x)], 1u);
    const unsigned gen = old / nloc;
    if (old + 1u == (gen + 1u) * nloc) {
      __builtin_amdgcn_fence(__ATOMIC_RELEASE, "agent");
      asm volatile("s_waitcnt vmcnt(0)" ::: "memory");
      const unsigned og = xb_add(&bar[XB_TOP], 1u);
      const unsigned tg = og / nx;
      if (og + 1u == (tg + 1u) * nx) xb_add(&bar[XB_TOPGEN], 1u);
      else XB_SPIN(xb_ld(&bar[XB_TOPGEN]) == tg, bar);
      __builtin_amdgcn_fence(__ATOMIC_ACQUIRE, "agent");
      xb_add(&bar[XB_XGEN(b.x)], 1u);
      asm volatile("s_waitcnt vmcnt(0)" ::: "memory");
    } else {
      XB_SPIN(xb_ld(&bar[XB_XGEN(b.x)]) == gen, bar);
      __builtin_amdgcn_fence(__ATOMIC_ACQUIRE, "agent");
      asm volatile("s_waitcnt vmcnt(0)" ::: "memory");
    }
  }
  __syncthreads();
}

typedef const Params __attribute__((address_space(4))) CParams;
__device__ __forceinline__ Params load_params(CParams* q) {
  Params r;
  r.x_prompt = q->x_prompt;
  r.x_sample = q->x_sample;
  r.state_conv = q->state_conv;
  r.state_h = q->state_h;
  r.cache_k = q->cache_k;
  r.cache_v = q->cache_v;
  r.rg_norm = q->rg_norm;
  r.rg_w_in = q->rg_w_in;
  r.rg_conv_w = q->rg_conv_w;
  r.rg_conv_b = q->rg_conv_b;
  r.rg_wa = q->rg_wa;
  r.rg_ba = q->rg_ba;
  r.rg_wx = q->rg_wx;
  r.rg_bx = q->rg_bx;
  r.rg_lambda = q->rg_lambda;
  r.rg_w_out = q->rg_w_out;
  r.kv_norm = q->kv_norm;
  r.w_kv = q->w_kv;
  r.attn_norm = q->attn_norm;
  r.w_q = q->w_q;
  r.sinks = q->sinks;
  r.w_o = q->w_o;
  r.ffn_norm = q->ffn_norm;
  r.peer_wq = q->peer_wq;
  r.peer_subkeys = q->peer_subkeys;
  r.peer_u = q->peer_u;
  r.peer_v = q->peer_v;
  r.final_norm = q->final_norm;
  r.out = q->out;
  r.ws = q->ws;
  r.ph_begin = q->ph_begin;
  r.ph_end = q->ph_end;
  return r;
}

template <int ph>
__device__ __forceinline__ void run_phase(const Params& p, char* smem, const XInfo xi) {
  char* ws = p.ws;
  switch (ph) {
    case 0: ph_convert0(p, smem); break;
    case 1: {
      EpiWin e{(u16*)(ws + OFF_GATE16), (float*)(ws + OFF_REC32)};
      gemm_tiles((const u16*)(ws + OFF_XN), 1024, (const u16*)(ws + OFF_WT_IN), 1024, 1024, 0, 16, e, smem);
    } break;
    case 2: ph_conv(p); break;
    case 3: {
      EpiBd e{(float*)(ws + OFF_LOGA), (u16*)(ws + OFF_IG16), p.rg_ba, p.rg_bx, p.rg_lambda};
      gemm_tiles((const u16*)(ws + OFF_XC16), 1024, (const u16*)(ws + OFF_WT_BD), 128, 128, 8, 16, e, smem);
    } break;
    case 4: ph_scanA(p); break;
    case 20: ph_scanA2(p); break;
    case 5: ph_scanB(p); break;
    case 6: {
      EpiResid e{p.x_prompt, p.x_sample, (float*)(ws + OFF_X), 1};
      gemm_tiles((const u16*)(ws + OFF_HG16), 1024, (const u16*)(ws + OFF_WT_OUT), 1024, 1024, 0, 8, e, smem);
      ph_cvt_tables(p, 0);
    } break;
    case 7: ph_rmsnorm(p, p.ffn_norm); break;
    case 8: case 16: {
      EpiScoresTopk e{(const u16*)(ws + (ph == 8 ? OFF_WT_SK0 : OFF_WT_SK1)), (int*)(ws + OFF_TKEY), smem};
      gemm_tiles((const u16*)(ws + OFF_XN), 1024, (const u16*)(ws + (ph == 8 ? OFF_WT_PQ0 : OFF_WT_PQ1)), 1024, 1024, 0, 16, e, smem);
    } break;
    case 9: case 17: {
      EpiTopk e{(int*)(ws + OFF_TKEY), smem};
      gemm_tiles((const u16*)(ws + OFF_QP16), 2048, (const u16*)(ws + (ph == 9 ? OFF_WT_SK0 : OFF_WT_SK1)), 128, 128, 16, 16, e, smem);
    } break;
    case 10: case 18: ph_topk(p, smem); break;
    case 11: case 19: ph_expert_u(p, xi); break;
    case 21: case 24: ph_expert_combine(p); break;
    case 22: case 25: ph_expert_v(p, xi); break;
    case 23: ph_post_norm(p, 0); break;
    case 26: ph_post_norm(p, 1); break;
    case 12: {
      EpiKvq e{(u16*)(ws + OFF_K16), (u16*)(ws + OFF_V16A), (u16*)(ws + OFF_Q16), (const float2*)(ws + OFF_ROPE), p.out};
      gemm_tiles((const u16*)(ws + OFF_XN), 1024, (const u16*)(ws + OFF_WT_KVQ), 1024, 1024, 0, 12, e, smem);
      ph_cvt_tables(p, 1);
    } break;
    case 13: ph_attn(p, smem); break;
    case 14: {
      EpiResid e{p.x_prompt, p.x_sample, (float*)(ws + OFF_X), 0};
      gemm_tiles((const u16*)(ws + OFF_O16), 1024, (const u16*)(ws + OFF_WT_O), 1024, 1024, 0, 8, e, smem);
    } break;
    case 15: ph_rmsnorm(p, p.ffn_norm + 1024); break;
    default: break;
  }
}

__global__ void __launch_bounds__(256, 3) yoco_megakernel(Params p) {
  __shared__ __attribute__((aligned(16))) char smem[53376];
  __shared__ uint4 xb_words;
  cg::grid_group grid = cg::this_grid();
  if (threadIdx.x == 0) xb_words = make_uint4(0u, 0u, 0u, 0u);
  __syncthreads();
  XcdBarrier xb = xcd_barrier_post((unsigned*)(p.ws + OFF_BAR), (volatile LAS unsigned*)&xb_words);
  if (p.ph_end > 1000) grid.sync();
#define LAUNDER(q) CParams* q = (CParams*)__builtin_amdgcn_kernarg_segment_ptr(); asm volatile("" : "+s"(q));
#define LOAD_XI() XInfo xi; { volatile LAS unsigned* st_ = (volatile LAS unsigned*)&xb_words; xi.nloc = __builtin_amdgcn_readfirstlane((int)st_[0]); xi.nx = __builtin_amdgcn_readfirstlane((int)st_[1]); xi.rank = __builtin_amdgcn_readfirstlane((int)st_[2]); xi.xr = __builtin_amdgcn_readfirstlane((int)st_[3]); if (xi.nloc < 1) xi.nloc = 1; if (xi.nx < 1) xi.nx = 1; }
#define PH(k) { typedef const Params __attribute__((address_space(4))) CP_; CP_* q_ = (CP_*)__builtin_amdgcn_kernarg_segment_ptr(); asm volatile("" : "+s"(q_)); Params pl_; pl_.ws = q_->ws; pl_.out = q_->out; pl_.final_norm = q_->final_norm; pl_.ffn_norm = q_->ffn_norm; LOAD_XI() if (k == 19 || k == 24 || k == 25 || k == 26) { run_phase<k>(pl_, smem, xi); } else { run_phase<k>(p, smem, xi); } } xcd_barrier(xb);
  PH(0)
  PH(1) PH(2) PH(3) PH(4) PH(20) PH(5) PH(6) PH(7) PH(8)
  PH(10) PH(11) PH(21) PH(22) PH(23) PH(12) PH(13) PH(14) PH(15) PH(16) PH(18) PH(19) PH(24) PH(25)
  { LOAD_XI() run_phase<26>(p, smem, xi); }
}

extern "C" void kernel_launch(void* const* d_in, const int* in_sizes, int n_in, void* d_out, int out_size,
                              void* d_ws, size_t ws_size, hipStream_t stream) {
  static int grid_blocks = 0;
  if (!grid_blocks) {
    int dev = 0, cus = 0, per_cu = 0;
    hipGetDevice(&dev);
    hipDeviceGetAttribute(&cus, hipDeviceAttributeMultiprocessorCount, dev);
    hipOccupancyMaxActiveBlocksPerMultiprocessor(&per_cu, yoco_megakernel, 256, 0);
    if (per_cu > 3) per_cu = 3;
    if (per_cu < 1) per_cu = 1;
    grid_blocks = cus * per_cu;
    if (ws_size < WS_NEEDED) fprintf(stderr, "workspace too small: %zu < %llu\n", ws_size, (unsigned long long)WS_NEEDED);
  }
  Params p{};
  const float** f = (const float**)&p;
  for (int i = 0; i < 28; ++i) f[i] = (const float*)d_in[i];
  p.out = (float*)d_out;
  p.ws = (char*)d_ws;
  hipMemsetAsync((char*)d_ws + OFF_BAR, 0, XCD_BAR_WORDS * sizeof(unsigned), stream);
#if MULTI_LAUNCH
  for (int ph = 0; ph < NPHASE; ++ph) {
    p.ph_begin = ph; p.ph_end = ph + 1;
    hipLaunchKernelGGL(yoco_megakernel, dim3(grid_blocks), dim3(256), 0, stream, p);
  }
#else
  p.ph_begin = 0; p.ph_end = NPHASE;
  void* args[] = {&p};
  hipError_t e = hipLaunchCooperativeKernel((void*)yoco_megakernel, dim3(grid_blocks), dim3(256), args, 0, stream);
  if (e != hipSuccess) fprintf(stderr, "cooperative launch failed: %s (grid %d)\n", hipGetErrorString(e), grid_blocks);
#endif
}
```
